# Optimizing an MI355X kernel written in HIP

```python
import math
import jax, jax.numpy as jnp
from jax import lax
import numpy as np

D_MODEL = 1024
BATCH = 32
SEQ = 2048
DEPTH = 4

GRID_W = 64
CTX_LEN = 256

MLA_HEADS = 8
QK_NOPE = 64
QK_ROPE = 32
V_DIM = 64
Q_LORA = 256
KV_LORA = 128
Q_BLOCK = 128
ROPE_BASE = 10000.0
ATTN_SCALE = (QK_NOPE + QK_ROPE) ** -0.5
ATTN_W = MLA_HEADS * V_DIM

POOL_WINDOWS = (2, 4, 8, 16)
POOL_GROUPS = 4
POOL_W = D_MODEL // 2
POOL_GC = POOL_W // POOL_GROUPS

IN_W = Q_LORA + KV_LORA + QK_ROPE + POOL_W
IN_SPLITS = (Q_LORA, Q_LORA + KV_LORA, Q_LORA + KV_LORA + QK_ROPE)
MIX_W = ATTN_W + POOL_W

FNET_GROUPS = 4
FNET_GC = D_MODEL // FNET_GROUPS

D_FF_DENSE = 2816
N_EXPERTS = 8
TOP_K = 2
D_FF_EXPERT = 3584

N_EVEN = (DEPTH + 1) // 2
N_ODD = DEPTH // 2
EPS = 1e-6

kernel_name = "hybrid_mla_pool_fnet_moe_prefix_dit"


def rmsnorm(x, g):
    x32 = x.astype(jnp.float32)
    y = x32 * lax.rsqrt(jnp.mean(x32 * x32, axis=-1, keepdims=True) + EPS)
    return (y * g.astype(jnp.float32)).astype(x.dtype)


def modulate(x, g, shift, scale):
    return rmsnorm(x, g) * (1.0 + scale) + shift


def axial_rope_tables(rows, dtype):
    row = jnp.repeat(jnp.arange(rows), GRID_W).astype(jnp.float32)
    col = jnp.tile(jnp.arange(GRID_W), rows).astype(jnp.float32)
    half = QK_ROPE // 2
    inv = 1.0 / (ROPE_BASE ** (jnp.arange(0, half, 2, dtype=jnp.float32) / half))
    ang_r = row[:, None] * inv[None, :]
    ang_c = col[:, None] * inv[None, :]
    return (jnp.cos(ang_r).astype(dtype), jnp.sin(ang_r).astype(dtype),
            jnp.cos(ang_c).astype(dtype), jnp.sin(ang_c).astype(dtype))


def rotate(x, cos, sin):
    x1, x2 = jnp.split(x, 2, axis=-1)
    return jnp.concatenate([x1 * cos - x2 * sin, x1 * sin + x2 * cos], axis=-1)


def axial_rope(x, tabs):
    cos_r, sin_r, cos_c, sin_c = tabs
    xr, xc = jnp.split(x, 2, axis=-1)
    return jnp.concatenate([rotate(xr, cos_r, sin_r), rotate(xc, cos_c, sin_c)], axis=-1)


def mla_q(c_q, g_cq, w_uq):
    B, L, _ = c_q.shape
    q = (rmsnorm(c_q, g_cq) @ w_uq).reshape(B, L, MLA_HEADS, QK_NOPE + QK_ROPE)
    return q[..., :QK_NOPE], q[..., QK_NOPE:]


def mla_kv(c_kv, g_ckv, w_ukv):
    B, L, _ = c_kv.shape
    kv = (rmsnorm(c_kv, g_ckv) @ w_ukv).reshape(B, L, MLA_HEADS, QK_NOPE + V_DIM)
    return kv[..., :QK_NOPE], kv[..., QK_NOPE:]


def mla_attend(q_nope, q_rope, k_nope, k_rope, v):
    s = (jnp.einsum('bqhd,bkhd->bhqk', q_nope, k_nope)
         + jnp.einsum('bqhr,bkr->bhqk', q_rope, k_rope))
    p = jax.nn.softmax(s.astype(jnp.float32) * ATTN_SCALE, axis=-1).astype(v.dtype)
    return jnp.einsum('bhqk,bkhd->bqhd', p, v)


def mla_blocked(q_nope, q_rope, k_nope, k_rope, v):
    B, L, H, _ = q_nope.shape
    nb = L // Q_BLOCK

    def to_blocks(t):
        return jnp.moveaxis(t.reshape(B, nb, Q_BLOCK, *t.shape[2:]), 1, 0)

    out = lax.map(lambda qs: mla_attend(qs[0], qs[1], k_nope, k_rope, v),
                  (to_blocks(q_nope), to_blocks(q_rope)))
    return jnp.moveaxis(out, 0, 1).reshape(B, L, H * V_DIM)


def multiscale_pool(p, pool_w, pool_scale):
    B, L, _ = p.shape
    pg = p.reshape(B, L, POOL_GROUPS, POOL_GC)
    csum = jnp.cumsum(pg.astype(jnp.float32), axis=1)
    csum = jnp.concatenate([jnp.zeros_like(csum[:, :1]), csum], axis=1)
    t = jnp.arange(L)[:, None]
    w = jnp.array(POOL_WINDOWS)[None, :]
    lo = jnp.clip(t - w // 2, 0, L)
    hi = jnp.clip(t - w // 2 + w, 0, L)
    g = jnp.arange(POOL_GROUPS)[None, :]
    win_sum = csum[:, hi, g, :] - csum[:, lo, g, :]
    mean = win_sum / (hi - lo).astype(jnp.float32)[:, :, None]
    mixed = (mean - pg.astype(jnp.float32)).astype(p.dtype)
    y = jnp.einsum('blgc,gcd->blgd', mixed, pool_w).reshape(B, L, POOL_W)
    return y * pool_scale


def fourier_mix(h, w_out):
    B, L, D = h.shape
    hg = h.astype(jnp.float32).reshape(B, L, FNET_GROUPS, FNET_GC)
    f = jnp.fft.fft2(hg, axes=(1, 3), norm='ortho').real.astype(h.dtype)
    return f.reshape(B, L, D) @ w_out


def swiglu(h, w1, w3, w2):
    return (jax.nn.silu(h @ w1) * (h @ w3)) @ w2


def moe_swiglu(h, router_w, w1, w3, w2):
    logits = (h @ router_w).astype(jnp.float32)
    top_v, top_i = lax.top_k(logits, TOP_K)
    top_p = jax.nn.softmax(top_v, axis=-1)
    gates = jnp.sum(jax.nn.one_hot(top_i, N_EXPERTS, dtype=jnp.float32) * top_p[..., None],
                    axis=-2).astype(h.dtype)
    y = jnp.zeros_like(h)
    for e in range(N_EXPERTS):
        y = y + gates[..., e:e + 1] * swiglu(h, w1[e], w3[e], w2[e])
    return y


def setup_inputs(seed: int = 0) -> dict:
    key = jax.random.key(seed)
    ks = iter(jax.random.split(key, 32))
    D = D_MODEL
    HQ = MLA_HEADS * (QK_NOPE + QK_ROPE)
    HKV = MLA_HEADS * (QK_NOPE + V_DIM)

    def nrm(shape, scale):
        return jax.random.normal(next(ks), shape, jnp.float32) * scale

    return {
        "x": nrm((BATCH, SEQ, D), 1.0),
        "c": nrm((BATCH, D), 1.0),
        "ctx": nrm((BATCH, CTX_LEN, D), 1.0),
        "c_ctx": nrm((D,), 1.0),
        "ada_w": nrm((DEPTH, D, 6 * D), 0.5 * D ** -0.5),
        "ada_b": nrm((DEPTH, 6 * D), 0.02),
        "norm_mix_g": 1.0 + nrm((DEPTH, D), 0.02),
        "norm_ffn_g": 1.0 + nrm((DEPTH, D), 0.02),
        "mix_in_w": nrm((N_EVEN, D, IN_W), D ** -0.5),
        "cq_norm_g": 1.0 + nrm((N_EVEN, Q_LORA), 0.02),
        "ckv_norm_g": 1.0 + nrm((N_EVEN, KV_LORA), 0.02),
        "w_uq": nrm((N_EVEN, Q_LORA, HQ), Q_LORA ** -0.5),
        "w_ukv": nrm((N_EVEN, KV_LORA, HKV), KV_LORA ** -0.5),
        "pool_w": nrm((N_EVEN, POOL_GROUPS, POOL_GC, POOL_GC), POOL_GC ** -0.5),
        "pool_scale": 1.0 + nrm((N_EVEN, POOL_W), 0.02),
        "mix_out_w": nrm((N_EVEN, MIX_W, D), MIX_W ** -0.5),
        "ffn_w1": nrm((N_EVEN, D, D_FF_DENSE), D ** -0.5),
        "ffn_w3": nrm((N_EVEN, D, D_FF_DENSE), D ** -0.5),
        "ffn_w2": nrm((N_EVEN, D_FF_DENSE, D), D_FF_DENSE ** -0.5),
        "fnet_out_w": nrm((N_ODD, D, D), D ** -0.5),
        "router_w": nrm((N_ODD, D, N_EXPERTS), D ** -0.5),
        "moe_w1": nrm((N_ODD, N_EXPERTS, D, D_FF_EXPERT), D ** -0.5),
        "moe_w3": nrm((N_ODD, N_EXPERTS, D, D_FF_EXPERT), D ** -0.5),
        "moe_w2": nrm((N_ODD, N_EXPERTS, D_FF_EXPERT, D), D_FF_EXPERT ** -0.5),
        "final_g": 1.0 + nrm((D,), 0.02),
    }


def reference(x, c, ctx, c_ctx, ada_w, ada_b, norm_mix_g, norm_ffn_g, mix_in_w, cq_norm_g,
              ckv_norm_g, w_uq, w_ukv, pool_w, pool_scale, mix_out_w, ffn_w1, ffn_w3, ffn_w2,
              fnet_out_w, router_w, moe_w1, moe_w3, moe_w2, final_g):
    B, L, D = x.shape
    Lc = ctx.shape[1]
    ROWS = L // GRID_W
    tabs = axial_rope_tables(ROWS, x.dtype)
    tabs_q = tuple(t[:, None, :] for t in tabs)
    s_lat = jax.nn.silu(c)
    s_ctx = jax.nn.silu(c_ctx)[None, :]

    for i in range(DEPTH):
        sh1, sc1, g1, sh2, sc2, g2 = jnp.split((s_lat @ ada_w[i] + ada_b[i])[:, None, :], 6, axis=-1)
        cs1, cc1, cg1, cs2, cc2, cg2 = jnp.split((s_ctx @ ada_w[i] + ada_b[i])[:, None, :], 6, axis=-1)
        ctx_needed = any(j % 2 == 0 for j in range(i + 1, DEPTH))

        h = modulate(x, norm_mix_g[i], sh1, sc1)
        if i % 2 == 0:
            e = i // 2
            hc = modulate(ctx, norm_mix_g[i], cs1, cc1)
            cq_c, ckv_c, kr_c, pool_c = jnp.split(hc @ mix_in_w[e], IN_SPLITS, axis=-1)
            kn_c, v_c = mla_kv(ckv_c, ckv_norm_g[e], w_ukv[e])
            cq_l, ckv_l, kr_l, pool_l = jnp.split(h @ mix_in_w[e], IN_SPLITS, axis=-1)
            qn_l, qr_l = mla_q(cq_l, cq_norm_g[e], w_uq[e])
            kn_l, v_l = mla_kv(ckv_l, ckv_norm_g[e], w_ukv[e])
            qr_l = axial_rope(qr_l, tabs_q)
            kr_l = axial_rope(kr_l, tabs)
            attn_l = mla_blocked(qn_l, qr_l,
                                 jnp.concatenate([kn_l, kn_c], axis=1),
                                 jnp.concatenate([kr_l, kr_c], axis=1),
                                 jnp.concatenate([v_l, v_c], axis=1))
            pool_out_l = multiscale_pool(pool_l, pool_w[e], pool_scale[e])
            mix_l = jnp.concatenate([attn_l, pool_out_l], axis=-1) @ mix_out_w[e]
            if ctx_needed:
                qn_c, qr_c = mla_q(cq_c, cq_norm_g[e], w_uq[e])
                attn_c = mla_attend(qn_c, qr_c, kn_c, kr_c, v_c).reshape(B, Lc, ATTN_W)
                pool_out_c = multiscale_pool(pool_c, pool_w[e], pool_scale[e])
                mix_c = jnp.concatenate([attn_c, pool_out_c], axis=-1) @ mix_out_w[e]
        else:
            o = i // 2
            mix_l = fourier_mix(h, fnet_out_w[o])
            if ctx_needed:
                hc = modulate(ctx, norm_mix_g[i], cs1, cc1)
                mix_c = fourier_mix(hc, fnet_out_w[o])

        x = x + g1 * mix_l
        h = modulate(x, norm_ffn_g[i], sh2, sc2)
        if i % 2 == 0:
            x = x + g2 * swiglu(h, ffn_w1[i // 2], ffn_w3[i // 2], ffn_w2[i // 2])
        else:
            x = x + g2 * moe_swiglu(h, router_w[i // 2], moe_w1[i // 2], moe_w3[i // 2], moe_w2[i // 2])

        if ctx_needed:
            ctx = ctx + cg1 * mix_c
            hc = modulate(ctx, norm_ffn_g[i], cs2, cc2)
            if i % 2 == 0:
                ctx = ctx + cg2 * swiglu(hc, ffn_w1[i // 2], ffn_w3[i // 2], ffn_w2[i // 2])
            else:
                ctx = ctx + cg2 * moe_swiglu(hc, router_w[i // 2], moe_w1[i // 2], moe_w3[i // 2], moe_w2[i // 2])

    return rmsnorm(x, final_g)
```

```cpp
#include <hip/hip_runtime.h>
#include <cstdio>
#include <cstdint>

#ifndef MK_FP8_L1
#define MK_FP8_L1 1
#endif
#define FP8_MOE(i) ((i) == 3 || MK_FP8_L1)
#ifndef MK_BG
#define MK_BG 1
#endif
#define BG_ON (MK_BG && MK_FP8_L1)
#ifndef MK_FP8_DFT
#define MK_FP8_DFT 1
#endif
#ifndef MK_FP8_MIXIN
#define MK_FP8_MIXIN 0
#endif
#ifndef MK_FP8_FFN
#define MK_FP8_FFN 2
#endif
#define FP8_FFN(i) (((MK_FP8_FFN) >> ((i) >> 1)) & 1)
#ifndef MK_DUP
#define MK_DUP 0u
#endif
#ifndef MK_PER_PHASE
#define MK_PER_PHASE 0
#endif

#define LAS __attribute__((address_space(3)))
#define GAS __attribute__((address_space(1)))
typedef unsigned short bf16;
typedef short bf16x8 __attribute__((ext_vector_type(8)));
typedef short s16x4 __attribute__((ext_vector_type(4)));
typedef float f32x4 __attribute__((ext_vector_type(4)));
typedef float f32x2 __attribute__((ext_vector_type(2)));
typedef float f32x16 __attribute__((ext_vector_type(16)));
typedef unsigned u32x4 __attribute__((ext_vector_type(4)));
typedef unsigned u32x2 __attribute__((ext_vector_type(2)));
typedef __bf16 bf16x2_t __attribute__((ext_vector_type(2)));

constexpr int NB = 32, SEQ = 2048, LC = 256, D = 1024, DEPTH = 4;
constexpr int MLAT = NB * SEQ, MCTX = NB * LC, MALL = MLAT + MCTX;
constexpr int TLAT = MLAT / 256, TCTX = MCTX / 256, TALL = MALL / 256;
constexpr int HEADS = 8, QKN = 64, QKR = 32, VD = 64, QLORA = 256, KVLORA = 128;
constexpr int QW = HEADS * (QKN + QKR);
constexpr int NKEY = SEQ + LC;
constexpr int DFF = 2816, DFFE = 3584, NEXP = 8;
constexpr float EPS = 1e-6f;
constexpr float QSCALE = 0.10206207261596577f * 1.4426950408889634f;

enum { I_X = 0, I_C, I_CTX, I_CCTX, I_ADAW, I_ADAB, I_NMG, I_NFG, I_MIXIN, I_CQG, I_CKVG, I_WUQ, I_WUKV, I_POOLW, I_POOLS, I_MIXOUT,
       I_FW1, I_FW3, I_FW2, I_FNET, I_ROUTER, I_MW1, I_MW3, I_MW2, I_FINALG, N_IN };

constexpr size_t al(size_t x) { return (x + 4095) & ~(size_t)4095; }
constexpr size_t WS_CTL = 0, CTL_BYTES = 1u << 20;
constexpr size_t WS_MOD = WS_CTL + CTL_BYTES;
constexpr size_t WS_ROPE = al(WS_MOD + (size_t)DEPTH * 33 * 6 * D * 4);
constexpr size_t WS_SSQQ = al(WS_ROPE + 64 * 16 * 4);
constexpr size_t WS_SSQK = al(WS_SSQQ + (size_t)MALL * 16);
constexpr size_t WS_HMID = al(WS_SSQK + (size_t)MALL * 16);
constexpr size_t WS_AMID = al(WS_HMID + 64 * D * 4);
constexpr size_t WS_LIST = al(WS_AMID + 64 * D * 4);
constexpr size_t WS_GLIST = al(WS_LIST + (size_t)2 * 8 * MALL * 4);
constexpr size_t WS_WMIXIN = al(WS_GLIST + (size_t)2 * 8 * MALL * 4);
constexpr size_t WS_WUQ = al(WS_WMIXIN + (size_t)2 * 1024 * 1024 * 2);
constexpr size_t WS_WUK = al(WS_WUQ + (size_t)2 * 768 * 256 * 2);
constexpr size_t WS_WUV = al(WS_WUK + (size_t)2 * 512 * 128 * 2);
constexpr size_t WS_WMIXOUT = al(WS_WUV + (size_t)2 * 512 * 128 * 2);
constexpr size_t WS_WFFN13 = al(WS_WMIXOUT + (size_t)2 * 1024 * 1024 * 2);
constexpr size_t WS_WFFN2 = al(WS_WFFN13 + (size_t)2 * 5632 * 1024 * 2);
constexpr size_t WS_WFNET = al(WS_WFFN2 + (size_t)2 * 1024 * 2816 * 2);
constexpr size_t WS_WDFTC = al(WS_WFNET + (size_t)2 * 1024 * 1024 * 2);
constexpr size_t WS_WDFTL = al(WS_WDFTC + (size_t)2 * 256 * 256 * 2);
constexpr size_t WS_WDFTX = al(WS_WDFTL + (size_t)2048 * 2048 * 2);
constexpr size_t WS_WMOE13 = al(WS_WDFTX + (size_t)256 * 256 * 2);
constexpr size_t WS_WMOE2 = al(WS_WMOE13 + (size_t)8 * 7168 * 1024 * 2);
constexpr size_t WS_XCUR = al(WS_WMOE2 + (size_t)8 * 1024 * 3584 * 2);
constexpr size_t WS_RA = al(WS_XCUR + (size_t)MALL * D * 2);
constexpr size_t WS_RB = al(WS_RA + (size_t)MALL * D * 2);
constexpr size_t RB_CQ = 0;
constexpr size_t RB_CKV = al(RB_CQ + (size_t)MALL * 256 * 2);
constexpr size_t RB_KR = al(RB_CKV + (size_t)MALL * 128 * 2);
constexpr size_t RB_POOL = al(RB_KR + (size_t)MALL * 32 * 2);
constexpr size_t RB_Q = al(RB_POOL + (size_t)MALL * 512 * 2);
constexpr size_t RB_KN = al(RB_Q + (size_t)MALL * 768 * 2);
constexpr size_t RB_VT = al(RB_KN + (size_t)MALL * 512 * 2);
constexpr size_t RB_EVEN_END = al(RB_VT + (size_t)NB * 512 * NKEY * 2);
constexpr size_t RB_Z = 0;
constexpr size_t RB_ZC = al(RB_Z + (size_t)NB * 4 * 256 * 2048 * 2);
constexpr size_t RB_ACT = 0;
constexpr size_t RB_SIZE = al((size_t)(MALL + 2048) * DFFE * 2);
static_assert(RB_EVEN_END <= RB_SIZE && (size_t)MALL * DFF * 2 <= RB_SIZE && RB_ZC + (size_t)NB * 4 * 256 * 256 * 2 <= RB_SIZE, "region B");
constexpr size_t WS_END = WS_RB + RB_SIZE;
static_assert(WS_END < 1150000000ull, "workspace budget");

constexpr int CW_TMO = 0;
constexpr int CW_BAR = 4096;
constexpr int CW_CNT = 16384;

constexpr int STAGE_BYTES = 131072;
constexpr int ATQ_OFF = 90112;
constexpr int MISC_OFF = 143360;
constexpr int LDS_BYTES = 147456;

__device__ __forceinline__ unsigned pkbf(float lo, float hi) { f32x2 v = {lo, hi}; bf16x2_t b = __builtin_convertvector(v, bf16x2_t); return __builtin_bit_cast(unsigned, b); }
__device__ __forceinline__ float bf2f(unsigned short b) { return __uint_as_float(((unsigned)b) << 16); }
__device__ __forceinline__ float wave_sum(float v) {
#pragma unroll
    for (int o = 1; o < 64; o <<= 1) v += __shfl_xor(v, o);
    return v;
}
__device__ __forceinline__ float silu_f(float x) { return x / (1.0f + __expf(-x)); }

#define XB_TMO      128
#define XB_XCNT(j)  (256  + 64 * (j))
#define XB_XSUB(j)  (1280 + 64 * (j))
#define XB_XGEN(j)  (2304 + 64 * (j))
#define XB_TOP      3328
#define XB_TOPGEN   3392
#define XCD_BAR_WORDS 3456
#define XB_SPIN_CAP (1u << 22)

__device__ __forceinline__ unsigned xb_ld(unsigned* p)              { return __hip_atomic_load(p, __ATOMIC_RELAXED, __HIP_MEMORY_SCOPE_AGENT); }
__device__ __forceinline__ unsigned xb_add(unsigned* p, unsigned v) { return __hip_atomic_fetch_add(p, v, __ATOMIC_RELAXED, __HIP_MEMORY_SCOPE_AGENT); }
__device__ __forceinline__ unsigned xb_xcc_id() { return (unsigned)__builtin_amdgcn_s_getreg((3 << 11) | 20) & 0xFu; }
#define XB_SPIN(cond, bar) do { unsigned _sp = 0; while (cond) { __builtin_amdgcn_s_sleep(1); \
    if ((++_sp & 255u) == 0u) { if (xb_ld(&(bar)[XB_TMO])) break; if (_sp > XB_SPIN_CAP) { atomicAdd(&(bar)[XB_TMO], 1u); break; } } } } while (0)

struct XcdBarrier { unsigned* bar; unsigned x; volatile LAS unsigned* st; };

__device__ __forceinline__ XcdBarrier xcd_barrier_post(unsigned* bar, volatile LAS unsigned* st) {
    XcdBarrier b; b.bar = bar; b.x = xb_xcc_id(); b.st = st;
    if (threadIdx.x == 0) (void)xb_add(&bar[XB_XCNT(b.x)], 1u);
    return b;
}
__device__ __forceinline__ void xcd_barrier_complete(unsigned* bar, unsigned x, unsigned& nloc, unsigned& nx) {
    const unsigned G = gridDim.x * gridDim.y * gridDim.z;
    unsigned sum, cnt, mine, sp = 0u;
    for (;;) {
        sum = 0u; cnt = 0u; mine = 0u;
#pragma unroll
        for (unsigned j = 0; j < 16; ++j) { const unsigned c = xb_ld(&bar[XB_XCNT(j)]); sum += c; cnt += (c > 0u) ? 1u : 0u; mine = (j == x) ? c : mine; }
        if (sum == G) break;
        __builtin_amdgcn_s_sleep(1);
        if ((++sp & 255u) == 0u) { if (xb_ld(&bar[XB_TMO])) break; if (sp > XB_SPIN_CAP) { atomicAdd(&bar[XB_TMO], 1u); break; } }
    }
    nloc = mine > 0u ? mine : 1u; nx = cnt > 0u ? cnt : 1u;
}
template <bool FIRST>
__device__ __forceinline__ void xcd_barrier(const XcdBarrier& b) {
    asm volatile("s_waitcnt vmcnt(0)" ::: "memory");
    __syncthreads();
    if (threadIdx.x == 0) {
        unsigned* bar = b.bar; asm volatile("" : "+s"(bar));
        __builtin_amdgcn_s_waitcnt(0);
        unsigned nloc = b.st[0], nx = b.st[1];
        if constexpr (FIRST) { if (nloc == 0u) { xcd_barrier_complete(bar, b.x, nloc, nx); b.st[0] = nloc; b.st[1] = nx; } }
        const unsigned old = xb_add(&bar[XB_XSUB(b.x)], 1u);
        const unsigned gen = old / nloc;
        if (old + 1u == (gen + 1u) * nloc) {
            __builtin_amdgcn_fence(__ATOMIC_RELEASE, "agent");
            asm volatile("s_waitcnt vmcnt(0)" ::: "memory");
            const unsigned og = xb_add(&bar[XB_TOP], 1u);
            const unsigned tg = og / nx;
            if (og + 1u == (tg + 1u) * nx) xb_add(&bar[XB_TOPGEN], 1u);
            else XB_SPIN(xb_ld(&bar[XB_TOPGEN]) == tg, bar);
            __builtin_amdgcn_fence(__ATOMIC_ACQUIRE, "agent");
            xb_add(&bar[XB_XGEN(b.x)], 1u);
            asm volatile("s_waitcnt vmcnt(0)" ::: "memory");
        } else {
            XB_SPIN(xb_ld(&bar[XB_XGEN(b.x)]) == gen, bar);
            __builtin_amdgcn_fence(__ATOMIC_ACQUIRE, "agent");
            asm volatile("s_waitcnt vmcnt(0)" ::: "memory");
        }
    }
    __syncthreads();
}

namespace gm {
constexpr int BK = 64, HALF = 128, HTB = HALF * BK * 2;
__device__ __forceinline__ int lds_byte(int r, int c) { const int st = (r >> 4) * 2 + (c >> 5), rr = r & 15, cc = c & 31, ob = rr * 64 + cc * 2; return st * 1024 + (ob ^ (((ob >> 9) & 1) << 5)); }
__device__ __forceinline__ void stage_rc(int b, int& R, int& C) { const int st = b / 1024, sb = b % 1024, swz = sb ^ (((sb >> 9) & 1) << 5); R = (st >> 1) * 16 + swz / 64; C = (st & 1) * 32 + (swz % 64) / 2; }
__device__ __forceinline__ int perm32(int rho) { const int n = rho >> 4, i = rho & 15; return 8 * (i >> 2) + 4 * n + (i & 3); }

struct Unit { const char* A; const char* B; unsigned lda, ldb; int nt; int x0, x1, x2, x3; };
typedef int v8i_t __attribute__((ext_vector_type(8))); typedef int v4i_t __attribute__((ext_vector_type(4)));


__device__ __forceinline__ bool flat_index(int i, int G, int c, int total, int& idx) {
    const long Lx = (long)i * G + c; if (Lx >= total) return false;
    int wgid = (int)Lx; const int q = total / 8, r = total % 8, xcd = wgid % 8, off = wgid / 8;
    idx = (xcd < r ? xcd * (q + 1) : r * (q + 1) + (xcd - r) * q) + off; return true;
}
__device__ __forceinline__ void tile_order(int idx, int nM, int nN, int& pm, int& pn) {
    const int nig = 8 * nN, gid = idx / nig, fm = gid * 8, gsz = (nM - fm) < 8 ? (nM - fm) : 8;
    pm = fm + ((idx % nig) % gsz); pn = (idx % nig) / gsz;
}

template <class Epi, class Sched, bool GATHER, bool FP8 = false>
__device__ __forceinline__ void gemm_phase(LAS unsigned char* lds, const Sched& S, const Epi& E) {
    int tid = threadIdx.x; asm volatile("" : "+v"(tid));
    const int wid = __builtin_amdgcn_readfirstlane(tid >> 6), lane = tid & 63, wr = wid >> 2, wc = wid & 3, fr = lane & 15, fq = lane >> 4;
    const unsigned ldsw = (unsigned)wid * 1024u;
    const int aoff = lds_byte(wr * 64 + fr, fq * 8), boff = lds_byte(wc * 32 + fr, fq * 8);
#define G_SA(b, h) (((b) * 2 + (h)) * HTB)
#define G_SB(b, h) ((4 + (b) * 2 + (h)) * HTB)
#define G_LD(ptr, dst) __builtin_amdgcn_global_load_lds((const unsigned*)(ptr), (LAS unsigned*)(dst), 16, 0, 0)
#define G_STAGE_B(bufoff, P, hh, kb) do { const char* _p0 = P##p + (size_t)(kb) + ((hh) ? (size_t)P##s * 128u : (size_t)0); const char* _p1 = _p0 + (size_t)P##s * 64u; \
        asm volatile("" : "+s"(_p0), "+s"(_p1)); \
        G_LD(_p0 + P##v, lds + (bufoff) + ldsw); G_LD(_p1 + P##v, lds + (bufoff) + ldsw + 8192); } while (0)
#define G_STAGE_A(bufoff, P, hh, kb) do { if constexpr (GATHER) { const char* _p = P##p + (size_t)(kb); asm volatile("" : "+s"(_p)); \
        G_LD(_p + P##g[(hh) * 2], lds + (bufoff) + ldsw); G_LD(_p + P##g[(hh) * 2 + 1], lds + (bufoff) + ldsw + 8192); } else { G_STAGE_B(bufoff, P, hh, kb); } } while (0)
#define G_LDA(dst, b, h) do { _Pragma("unroll") for (int m = 0; m < 4; ++m) { const v4i_t _l = *(const LAS v4i_t*)(lds + G_SA(b, h) + aoff + m * 2048), _h = *(const LAS v4i_t*)(lds + G_SA(b, h) + aoff + m * 2048 + 1024); \
        dst[m] = __builtin_shufflevector(_l, _h, 0, 1, 2, 3, 4, 5, 6, 7); } } while (0)
#define G_LDB(dst, b, h) do { _Pragma("unroll") for (int n = 0; n < 2; ++n) { const v4i_t _l = *(const LAS v4i_t*)(lds + G_SB(b, h) + boff + n * 2048), _h = *(const LAS v4i_t*)(lds + G_SB(b, h) + boff + n * 2048 + 1024); \
        dst[n] = __builtin_shufflevector(_l, _h, 0, 1, 2, 3, 4, 5, 6, 7); } } while (0)
#define G_LO(x) __builtin_bit_cast(bf16x8, (v4i_t)__builtin_shufflevector(x, x, 0, 1, 2, 3))
#define G_HI(x) __builtin_bit_cast(bf16x8, (v4i_t)__builtin_shufflevector(x, x, 4, 5, 6, 7))
#define G_MMA(ai, bj, At, Bt) do { __builtin_amdgcn_s_setprio(1); \
        if constexpr (FP8) { _Pragma("unroll") for (int m = 0; m < 4; ++m) _Pragma("unroll") for (int n = 0; n < 2; ++n) \
            asm volatile("v_mfma_f32_16x16x128_f8f6f4 %0, %1, %2, %0" : "+v"(acc[ai][bj][m][n]) : "v"(Bt[n]), "v"(At[m])); } \
        else { _Pragma("unroll") for (int m = 0; m < 4; ++m) _Pragma("unroll") for (int n = 0; n < 2; ++n) { \
            acc[ai][bj][m][n] = __builtin_amdgcn_mfma_f32_16x16x32_bf16(G_LO(Bt[n]), G_LO(At[m]), acc[ai][bj][m][n], 0, 0, 0); \
            acc[ai][bj][m][n] = __builtin_amdgcn_mfma_f32_16x16x32_bf16(G_HI(Bt[n]), G_HI(At[m]), acc[ai][bj][m][n], 0, 0, 0); } } \
        __builtin_amdgcn_s_setprio(0); } while (0)
#define G_WAIT_V(n) asm volatile("s_waitcnt vmcnt(" #n ")" ::: "memory")
#define G_WAIT_L(n) asm volatile("s_waitcnt lgkmcnt(" #n ")" ::: "memory")
#define G_BAR __builtin_amdgcn_s_barrier()
#define G_SCHED __builtin_amdgcn_sched_barrier(0)
#define G_SETUP(P_A, P_B, U) do { int _t = threadIdx.x; asm volatile("" : "+v"(_t)); int R0, C0; stage_rc(_t * 16, R0, C0); const int Rb0 = (R0 & ~31) + perm32(R0 & 31);     \
        P_A##p = (U).A; P_A##s = (U).lda; P_B##p = (U).B; P_B##s = (U).ldb; P_B##v = (unsigned)Rb0 * (U).ldb + (unsigned)C0 * 2u; \
        if constexpr (GATHER) { _Pragma("unroll") for (int _q = 0; _q < 4; ++_q) P_A##g[_q] = (unsigned)S.gather_row((U), R0 + 64 * _q) * (U).lda + (unsigned)C0 * 2u; P_A##v = 0u; } \
        else { P_A##v = (unsigned)R0 * (U).lda + (unsigned)C0 * 2u; } } while (0)
    Unit cur, nxt; int ui = 0;
    if (!S.next(0, cur)) return;
    f32x4 acc[2][2][4][2];
#pragma unroll
    for (int a = 0; a < 2; ++a)
#pragma unroll
        for (int b = 0; b < 2; ++b)
#pragma unroll
            for (int m = 0; m < 4; ++m)
#pragma unroll
                for (int n = 0; n < 2; ++n) acc[a][b][m][n] = (f32x4){0.f, 0.f, 0.f, 0.f};
    v8i_t At[4], B0[2], B1[2];
    const char *cAp, *cBp, *nAp, *nBp; unsigned cAs, cBs, nAs, nBs, cAv, cBv, nAv, nBv; unsigned cAg[4], nAg[4];
#pragma unroll
    for (int q = 0; q < 4; ++q) { cAg[q] = 0u; nAg[q] = 0u; }
    G_SETUP(cA, cB, cur);
    G_STAGE_B(G_SB(0, 0), cB, 0, 0); G_STAGE_B(G_SB(0, 1), cB, 1, 0); G_STAGE_A(G_SA(0, 0), cA, 0, 0); G_STAGE_A(G_SA(0, 1), cA, 1, 0);
    if (wr == 1) G_BAR;
    G_WAIT_V(2); G_BAR;
    G_STAGE_B(G_SB(1, 0), cB, 0, 128); G_STAGE_A(G_SA(1, 0), cA, 0, 128); G_STAGE_B(G_SB(1, 1), cB, 1, 128);
    G_WAIT_V(6); G_BAR;
    for (;;) {
        const bool has_next = S.next(ui + 1, nxt);
        if (has_next) { G_SETUP(nA, nB, nxt); } else { nAp = cAp; nBp = cBp; nAs = cAs; nBs = cBs; nAv = cAv; nBv = cBv;
#pragma unroll
            for (int q = 0; q < 4; ++q) nAg[q] = cAg[q]; }
        int nt = cur.nt; asm volatile("" : "+s"(nt));
        for (int t = 0; t < nt; t += 2) {
            const bool last = (t == nt - 2);
            const size_t k1 = (size_t)(t + 1) * 128;
            G_LDB(B0, 0, 0); G_LDB(B1, 0, 1); G_SCHED; G_LDA(At, 0, 0); G_STAGE_A(G_SA(1, 1), cA, 1, k1);
            G_WAIT_V(8); G_WAIT_L(0); G_BAR; G_MMA(0, 0, At, B0); G_MMA(0, 1, At, B1); G_BAR; G_SCHED;
            G_LDA(At, 0, 1);
            if (last) { G_STAGE_B(G_SB(0, 0), nB, 0, 0); G_STAGE_B(G_SB(0, 1), nB, 1, 0); G_STAGE_A(G_SA(0, 0), nA, 0, 0); }
            else { const size_t k2 = (size_t)(t + 2) * 128; G_STAGE_B(G_SB(0, 0), cB, 0, k2); G_STAGE_B(G_SB(0, 1), cB, 1, k2); G_STAGE_A(G_SA(0, 0), cA, 0, k2); }
            G_WAIT_V(8); G_WAIT_L(0); G_BAR; G_MMA(1, 0, At, B0); G_MMA(1, 1, At, B1); G_BAR; G_SCHED;
            G_LDB(B0, 1, 0); G_LDB(B1, 1, 1); G_SCHED; G_LDA(At, 1, 0);
            if (last) { G_STAGE_A(G_SA(0, 1), nA, 1, 0); } else { const size_t k2 = (size_t)(t + 2) * 128; G_STAGE_A(G_SA(0, 1), cA, 1, k2); }
            G_WAIT_V(8); G_WAIT_L(0); G_BAR; G_MMA(0, 0, At, B0); G_MMA(0, 1, At, B1); G_BAR; G_SCHED;
            G_LDA(At, 1, 1);
            if (last) { G_STAGE_B(G_SB(1, 0), nB, 0, 128); G_STAGE_B(G_SB(1, 1), nB, 1, 128); G_STAGE_A(G_SA(1, 0), nA, 0, 128); }
            else { const size_t k3 = (size_t)(t + 3) * 128; G_STAGE_B(G_SB(1, 0), cB, 0, k3); G_STAGE_B(G_SB(1, 1), cB, 1, k3); G_STAGE_A(G_SA(1, 0), cA, 0, k3); }
            G_WAIT_V(8); G_WAIT_L(0); G_BAR; G_MMA(1, 0, At, B0); G_MMA(1, 1, At, B1); G_BAR; G_SCHED;
        }
        if (wr == 0) G_BAR;
        if constexpr (FP8) asm volatile("s_nop 15\n\ts_nop 15" ::: "memory");
        { int _t = threadIdx.x; asm volatile("" : "+v"(_t)); const int _w = __builtin_amdgcn_readfirstlane(_t >> 6), _l = _t & 63;
          E(acc, cur, _w >> 2, _w & 3, _l & 15, _l >> 4); }
        if (!has_next) break;
#pragma unroll
        for (int a = 0; a < 2; ++a)
#pragma unroll
            for (int b = 0; b < 2; ++b)
#pragma unroll
                for (int m = 0; m < 4; ++m)
#pragma unroll
                    for (int n = 0; n < 2; ++n) acc[a][b][m][n] = (f32x4){0.f, 0.f, 0.f, 0.f};
        if constexpr (FP8) asm volatile("s_nop 7" ::: "memory");
        cur = nxt; cAp = nAp; cBp = nBp; cAs = nAs; cBs = nBs; cAv = nAv; cBv = nBv;
#pragma unroll
        for (int q = 0; q < 4; ++q) cAg[q] = nAg[q];
        ++ui;
        if (wr == 1) G_BAR;
    }
    G_WAIT_V(0);
    G_BAR;
#undef G_SA
#undef G_SB
#undef G_LD
#undef G_STAGE_A
#undef G_STAGE_B
#undef G_LDA
#undef G_LDB
#undef G_MMA
#undef G_WAIT_V
#undef G_WAIT_L
#undef G_BAR
#undef G_SCHED
#undef G_SETUP
}
}

typedef const f32x4 (&AccRef)[2][2][4][2];
__device__ __forceinline__ u32x4 pack8(const f32x4 a, const f32x4 b) { u32x4 w; w.x = pkbf(a[0], a[1]); w.y = pkbf(a[2], a[3]); w.z = pkbf(b[0], b[1]); w.w = pkbf(b[2], b[3]); return w; }

__device__ __forceinline__ void rope8(f32x4& v0, f32x4& v1, int fq, int t, const float* ropeC, const float* ropeS) {
    const int pos = (fq < 2) ? (t >> 6) : (t & 63);
    const f32x4 c0 = *(const f32x4*)(ropeC + pos * 8), c1 = *(const f32x4*)(ropeC + pos * 8 + 4);
    const f32x4 s0 = *(const f32x4*)(ropeS + pos * 8), s1 = *(const f32x4*)(ropeS + pos * 8 + 4);
    f32x4 p0, p1;
#pragma unroll
    for (int j = 0; j < 4; ++j) { p0[j] = __shfl_xor(v0[j], 16); p1[j] = __shfl_xor(v1[j], 16); }
    const float sg = (fq & 1) ? 1.0f : -1.0f;
    v0 = v0 * c0 + (p0 * s0) * sg; v1 = v1 * c1 + (p1 * s1) * sg;
}

struct SchedMixIn {
    const char* H; const char* W; int G, c, total; bool ctx_full;
    __device__ __forceinline__ bool next(int i, gm::Unit& u) const {
        int idx; if (!gm::flat_index(i, G, c, total, idx)) return false;
        int pm, pn;
        if (idx < 1024) gm::tile_order(idx, 256, 4, pm, pn);
        else { const int j = idx - 1024; if (ctx_full) { gm::tile_order(j, 32, 4, pm, pn); pm += 256; } else { pm = 256 + j; pn = 1; } }
        constexpr unsigned P = MK_FP8_MIXIN ? 1024u : 2048u;
        u.A = H + (size_t)pm * 256 * P; u.lda = P; u.B = W + (size_t)pn * 256 * P; u.ldb = P; u.nt = 16 / (MK_FP8_MIXIN ? 2 : 1); u.x0 = pm; u.x1 = pn; u.x2 = 0; u.x3 = 0; return true;
    }
};
struct EpiMixIn {
    bf16 *CQ, *CKV, *KR, *POOL; float *SSQQ, *SSQK; const float *ropeC, *ropeS;
    __device__ __forceinline__ void operator()(AccRef accr, const gm::Unit& u, int wr, int wc, int fr, int fq) const {
        const int pn = u.x1, row0 = u.x0 * 256 + wr * 64 + fr, cl = wc * 32 + fq * 8;
        constexpr float WS = MK_FP8_MIXIN ? (1.0f / 32.0f) : 1.0f;
        f32x4 acc[2][2][4][2];
#pragma unroll
        for (int a_ = 0; a_ < 2; ++a_)
#pragma unroll
            for (int b_ = 0; b_ < 2; ++b_)
#pragma unroll
                for (int m_ = 0; m_ < 4; ++m_)
#pragma unroll
                    for (int n_ = 0; n_ < 2; ++n_) acc[a_][b_][m_][n_] = accr[a_][b_][m_][n_] * WS;
        if (pn == 0) {
#pragma unroll
            for (int ai = 0; ai < 2; ++ai)
#pragma unroll
                for (int m = 0; m < 4; ++m) { const int row = row0 + ai * 128 + m * 16; float ss = 0.f;
#pragma unroll
                    for (int bj = 0; bj < 2; ++bj) { const f32x4 a = acc[ai][bj][m][0], b = acc[ai][bj][m][1];
                        ss += (a[0] * a[0] + a[1] * a[1]) + (a[2] * a[2] + a[3] * a[3]) + (b[0] * b[0] + b[1] * b[1]) + (b[2] * b[2] + b[3] * b[3]);
                        *(u32x4*)(CQ + (size_t)row * 256 + bj * 128 + cl) = pack8(a, b); }
                    ss += __shfl_xor(ss, 16); ss += __shfl_xor(ss, 32);
                    if (fq == 0) SSQQ[(size_t)row * 4 + wc] = ss; }
        } else if (pn == 1) {
            const bool lat = u.x0 < TLAT;
#pragma unroll
            for (int ai = 0; ai < 2; ++ai)
#pragma unroll
                for (int m = 0; m < 4; ++m) { const int row = row0 + ai * 128 + m * 16;
                    const f32x4 a = acc[ai][0][m][0], b = acc[ai][0][m][1];
                    float ss = (a[0] * a[0] + a[1] * a[1]) + (a[2] * a[2] + a[3] * a[3]) + (b[0] * b[0] + b[1] * b[1]) + (b[2] * b[2] + b[3] * b[3]);
                    *(u32x4*)(CKV + (size_t)row * 128 + cl) = pack8(a, b);
                    ss += __shfl_xor(ss, 16); ss += __shfl_xor(ss, 32);
                    if (fq == 0) SSQK[(size_t)row * 4 + wc] = ss;
                    if (wc == 0) { f32x4 r0 = acc[ai][1][m][0], r1 = acc[ai][1][m][1];
                        if (lat) rope8(r0, r1, fq, row & (SEQ - 1), ropeC, ropeS);
                        *(u32x4*)(KR + (size_t)row * 32 + fq * 8) = pack8(r0, r1); } }
        } else {
#pragma unroll
            for (int ai = 0; ai < 2; ++ai)
#pragma unroll
                for (int m = 0; m < 4; ++m) { const int row = row0 + ai * 128 + m * 16;
#pragma unroll
                    for (int bj = 0; bj < 2; ++bj) *(u32x4*)(POOL + (size_t)row * 512 + (pn - 2) * 256 + bj * 128 + cl) = pack8(acc[ai][bj][m][0], acc[ai][bj][m][1]); }
        }
    }
};

struct SchedE3 {
    const char *CQ, *CKV, *WUQ, *WUK, *WUV; int G, c, nq, total;
    __device__ __forceinline__ bool next(int i, gm::Unit& u) const {
        int idx; if (!gm::flat_index(i, G, c, total, idx)) return false;
        int pm, pn; u.x3 = 0;
        if (idx < nq * 3) { gm::tile_order(idx, nq, 3, pm, pn);
            u.A = CQ + (size_t)pm * 256 * 512; u.lda = 512; u.B = WUQ + (size_t)pn * 256 * 512; u.ldb = 512; u.nt = 4; u.x0 = pm; u.x1 = pn; u.x2 = 0; return true; }
        int j = idx - nq * 3;
        if (j < 576) { gm::tile_order(j, 288, 2, pm, pn);
            u.A = CKV + (size_t)pm * 256 * 256; u.lda = 256; u.B = WUK + (size_t)pn * 256 * 256; u.ldb = 256; u.nt = 2; u.x0 = pm; u.x1 = pn; u.x2 = 1; return true; }
        j -= 576; pm = j & 1; pn = j >> 1;
        u.A = WUV + (size_t)pm * 256 * 256; u.lda = 256; u.B = CKV + (size_t)pn * 256 * 256; u.ldb = 256; u.nt = 2; u.x0 = pm; u.x1 = pn; u.x2 = 2; return true;
    }
};
struct EpiE3 {
    bf16 *Q, *KN, *VT; const float *SSQQ, *SSQK, *ropeC, *ropeS;
    __device__ __forceinline__ void operator()(AccRef acc, const gm::Unit& u, int wr, int wc, int fr, int fq) const {
        const int pm = u.x0, pn = u.x1, ty = u.x2, cl = wc * 32 + fq * 8;
        if (ty == 0) {
            const bool lat = pm < TLAT;
            float rq[2][4];
#pragma unroll
            for (int ai = 0; ai < 2; ++ai)
#pragma unroll
                for (int m = 0; m < 4; ++m) { const f32x4 sq = *(const f32x4*)(SSQQ + (size_t)(pm * 256 + wr * 64 + fr + ai * 128 + m * 16) * 4);
                    rq[ai][m] = __builtin_amdgcn_rsqf(((sq[0] + sq[1]) + (sq[2] + sq[3])) * (1.0f / 256.0f) + EPS); }
#pragma unroll
            for (int ai = 0; ai < 2; ++ai)
#pragma unroll
                for (int m = 0; m < 4; ++m) { const int row = pm * 256 + wr * 64 + fr + ai * 128 + m * 16;
#pragma unroll
                    for (int bj = 0; bj < 2; ++bj) { f32x4 a = acc[ai][bj][m][0] * rq[ai][m], b = acc[ai][bj][m][1] * rq[ai][m];
                        const int g32 = 8 * pn + 4 * bj + wc;
                        if (lat && (g32 % 3) == 2) rope8(a, b, fq, row & (SEQ - 1), ropeC, ropeS);
                        *(u32x4*)(Q + (size_t)row * QW + pn * 256 + bj * 128 + cl) = pack8(a, b); } }
        } else if (ty == 1) {
            float rk[2][4];
#pragma unroll
            for (int ai = 0; ai < 2; ++ai)
#pragma unroll
                for (int m = 0; m < 4; ++m) { const f32x4 sq = *(const f32x4*)(SSQK + (size_t)(pm * 256 + wr * 64 + fr + ai * 128 + m * 16) * 4);
                    rk[ai][m] = __builtin_amdgcn_rsqf(((sq[0] + sq[1]) + (sq[2] + sq[3])) * (1.0f / 128.0f) + EPS); }
#pragma unroll
            for (int ai = 0; ai < 2; ++ai)
#pragma unroll
                for (int m = 0; m < 4; ++m) { const int row = pm * 256 + wr * 64 + fr + ai * 128 + m * 16;
#pragma unroll
                    for (int bj = 0; bj < 2; ++bj) *(u32x4*)(KN + (size_t)row * 512 + pn * 256 + bj * 128 + cl) = pack8(acc[ai][bj][m][0] * rk[ai][m], acc[ai][bj][m][1] * rk[ai][m]); }
        } else {
            const int b = pn < TLAT ? (pn >> 3) : (pn - TLAT), key0 = pn < TLAT ? ((pn & 7) * 256) : SEQ;
            f32x4 s0[2], s1[2];
#pragma unroll
            for (int bj = 0; bj < 2; ++bj)
#pragma unroll
                for (int j = 0; j < 8; ++j) { const f32x4 sq = *(const f32x4*)(SSQK + ((size_t)pn * 256 + bj * 128 + cl + j) * 4);
                    const float rk = __builtin_amdgcn_rsqf(((sq[0] + sq[1]) + (sq[2] + sq[3])) * (1.0f / 128.0f) + EPS);
                    if (j < 4) s0[bj][j] = rk; else s1[bj][j - 4] = rk; }
#pragma unroll
            for (int bj = 0; bj < 2; ++bj)
#pragma unroll
                for (int ai = 0; ai < 2; ++ai)
#pragma unroll
                    for (int m = 0; m < 4; ++m) { const int f = pm * 256 + wr * 64 + fr + ai * 128 + m * 16;
                        *(u32x4*)(VT + ((size_t)b * 512 + f) * NKEY + key0 + bj * 128 + cl) = pack8(acc[ai][bj][m][0] * s0[bj], acc[ai][bj][m][1] * s1[bj]); }
        }
    }
};

struct SchedResid {
    const char* A; const char* W; unsigned lda; int nt, nM, G, c;
    __device__ __forceinline__ bool next(int i, gm::Unit& u) const {
        int idx; if (!gm::flat_index(i, G, c, nM * 4, idx)) return false;
        int pm, pn; gm::tile_order(idx, nM, 4, pm, pn);
        u.A = A + (size_t)pm * 256 * lda; u.lda = lda; u.B = W + (size_t)pn * 256 * lda; u.ldb = lda; u.nt = nt; u.x0 = pm; u.x1 = pn; u.x2 = 0; u.x3 = 0; return true;
    }
};
struct EpiResid {
    const float *src_lat, *src_ctx; const bf16* src16; bf16* dst; const float* gate; float ascale;
    __device__ __forceinline__ void operator()(AccRef acc, const gm::Unit& u, int wr, int wc, int fr, int fq) const {
        const int pm = u.x0, pn = u.x1; const bool lat = pm < TLAT;
        const int b = lat ? (pm >> 3) : 32;
        const int col0 = pn * 256 + wc * 32 + fq * 8;
        f32x4 g[2][2];
#pragma unroll
        for (int bj = 0; bj < 2; ++bj) { g[bj][0] = *(const f32x4*)(gate + (size_t)b * 6144 + col0 + bj * 128) * ascale; g[bj][1] = *(const f32x4*)(gate + (size_t)b * 6144 + col0 + bj * 128 + 4) * ascale; }
        if (src16) {
            u32x4 xr[2][4][2];
#pragma unroll
            for (int ai = 0; ai < 2; ++ai)
#pragma unroll
                for (int m = 0; m < 4; ++m)
#pragma unroll
                    for (int bj = 0; bj < 2; ++bj) xr[ai][m][bj] = *(const u32x4*)(src16 + (size_t)(pm * 256 + wr * 64 + fr + ai * 128 + m * 16) * D + col0 + bj * 128);
#pragma unroll
            for (int ai = 0; ai < 2; ++ai)
#pragma unroll
                for (int m = 0; m < 4; ++m) { const size_t off = (size_t)(pm * 256 + wr * 64 + fr + ai * 128 + m * 16) * D + col0;
#pragma unroll
                    for (int bj = 0; bj < 2; ++bj) { const u32x4 w = xr[ai][m][bj];
                        const f32x4 x0 = (f32x4){__uint_as_float(w.x << 16), __uint_as_float(w.x & 0xffff0000u), __uint_as_float(w.y << 16), __uint_as_float(w.y & 0xffff0000u)};
                        const f32x4 x1 = (f32x4){__uint_as_float(w.z << 16), __uint_as_float(w.z & 0xffff0000u), __uint_as_float(w.w << 16), __uint_as_float(w.w & 0xffff0000u)};
                        *(u32x4*)(dst + off + bj * 128) = pack8(x0 + g[bj][0] * acc[ai][bj][m][0], x1 + g[bj][1] * acc[ai][bj][m][1]); } }
        } else {
            const float* sp = lat ? src_lat : src_ctx - (size_t)MLAT * D;
#pragma unroll
            for (int ai = 0; ai < 2; ++ai) {
                f32x4 xf[4][2][2];
#pragma unroll
                for (int m = 0; m < 4; ++m)
#pragma unroll
                    for (int bj = 0; bj < 2; ++bj) { const float* q = sp + (size_t)(pm * 256 + wr * 64 + fr + ai * 128 + m * 16) * D + col0 + bj * 128; xf[m][bj][0] = *(const f32x4*)q; xf[m][bj][1] = *(const f32x4*)(q + 4); }
#pragma unroll
                for (int m = 0; m < 4; ++m) { const size_t off = (size_t)(pm * 256 + wr * 64 + fr + ai * 128 + m * 16) * D + col0;
#pragma unroll
                    for (int bj = 0; bj < 2; ++bj) *(u32x4*)(dst + off + bj * 128) = pack8(xf[m][bj][0] + g[bj][0] * acc[ai][bj][m][0], xf[m][bj][1] + g[bj][1] * acc[ai][bj][m][1]); }
            }
        }
    }
};

struct SchedUp {
    const char* A; const char* W; int nM, nN, G, c; unsigned ld; int nt;
    __device__ __forceinline__ bool next(int i, gm::Unit& u) const {
        int idx; if (!gm::flat_index(i, G, c, nM * nN, idx)) return false;
        int pm, pn; gm::tile_order(idx, nM, nN, pm, pn);
        u.A = A + (size_t)pm * 256 * ld; u.lda = ld; u.B = W + (size_t)pn * 256 * ld; u.ldb = ld; u.nt = nt; u.x0 = pm; u.x1 = pn; u.x2 = 0; u.x3 = 0; return true;
    }
};
__device__ __forceinline__ f32x4 swiglu4s(const f32x4 a, const f32x4 b, float cexp, float cout) {
    const f32x4 t = a * cexp; f32x4 e;
#pragma unroll
    for (int j = 0; j < 4; ++j) e[j] = __builtin_amdgcn_exp2f(t[j]);
    const f32x4 d = e + 1.0f; f32x4 r;
#pragma unroll
    for (int j = 0; j < 4; ++j) r[j] = __builtin_amdgcn_rcpf(d[j]);
    return (a * b) * (r * cout); }
__device__ __forceinline__ f32x4 swiglu4(const f32x4 a, const f32x4 b) { return swiglu4s(a, b, -1.4426950408889634f, 1.0f); }
struct EpiSwiglu {
    bf16* ACT; int ld;
    __device__ __forceinline__ void operator()(AccRef acc, const gm::Unit& u, int wr, int wc, int fr, int fq) const {
        const int row0 = u.x0 * 256 + wr * 64 + fr, col = u.x1 * 128 + wc * 32 + fq * 8;
#pragma unroll
        for (int ai = 0; ai < 2; ++ai)
#pragma unroll
            for (int m = 0; m < 4; ++m)
                *(u32x4*)(ACT + (size_t)(row0 + ai * 128 + m * 16) * ld + col) = pack8(swiglu4(acc[ai][0][m][0], acc[ai][1][m][0]), swiglu4(acc[ai][0][m][1], acc[ai][1][m][1]));
    }
};

struct SchedDftC {
    const char *WC, *HF; int G, c, total;
    __device__ __forceinline__ bool next(int i, gm::Unit& u) const {
        int idx; if (!gm::flat_index(i, G, c, total, idx)) return false;
        u.lda = 512; u.ldb = 2048; u.nt = 4; u.x3 = 0;
        if (idx < 1024) { const int bg = idx >> 3, kt = idx & 7, b = bg >> 2, g = bg & 3, ty = kt < 4 ? 0 : 1;
            u.A = WC + (size_t)ty * 256 * 512; u.B = HF + ((size_t)(b * SEQ + kt * 256) * D + g * 256) * 2; u.x0 = bg; u.x1 = kt; u.x2 = 0; return true; }
        const int j = idx - 1024, bg = j >> 1, ty = j & 1, b = bg >> 2, g = bg & 3;
        u.A = WC + (size_t)ty * 256 * 512; u.B = HF + ((size_t)(MLAT + b * LC) * D + g * 256) * 2; u.x0 = bg; u.x1 = 0; u.x2 = 1 + ty; return true;
    }
};
__device__ __forceinline__ unsigned pk4_fp8(float a, float b, float c, float d);
__device__ __forceinline__ u32x2 pack8_fp8(const f32x4 a, const f32x4 b) { u32x2 w; w.x = pk4_fp8(a[0], a[1], a[2], a[3]); w.y = pk4_fp8(b[0], b[1], b[2], b[3]); return w; }
struct EpiDftC {
    bf16 *Z, *ZC;
    __device__ __forceinline__ void operator()(AccRef acc, const gm::Unit& u, int wr, int wc, int fr, int fq) const {
        const int bg = u.x0, cl = wc * 32 + fq * 8;
        if (MK_FP8_DFT) {
            unsigned char* z8 = (unsigned char*)Z; unsigned char* zc8 = (unsigned char*)ZC;
#pragma unroll
            for (int ai = 0; ai < 2; ++ai)
#pragma unroll
                for (int m = 0; m < 4; ++m) { const int f = wr * 64 + fr + ai * 128 + m * 16;
                    if (u.x2 == 0) {
#pragma unroll
                        for (int bj = 0; bj < 2; ++bj) *(u32x2*)(z8 + ((size_t)bg * 256 + f) * 2048 + u.x1 * 256 + bj * 128 + cl) = pack8_fp8(acc[ai][bj][m][0], acc[ai][bj][m][1]); }
                    else if (u.x2 == 1) *(u32x2*)(zc8 + ((size_t)bg * 256 + f) * 256 + cl) = pack8_fp8(acc[ai][0][m][0], acc[ai][0][m][1]);
                    else *(u32x2*)(zc8 + ((size_t)bg * 256 + f) * 256 + 128 + cl) = pack8_fp8(acc[ai][1][m][0], acc[ai][1][m][1]); }
        } else
        if (u.x2 == 0) {
#pragma unroll
            for (int ai = 0; ai < 2; ++ai)
#pragma unroll
                for (int m = 0; m < 4; ++m) { const int f = wr * 64 + fr + ai * 128 + m * 16;
#pragma unroll
                    for (int bj = 0; bj < 2; ++bj) *(u32x4*)(Z + ((size_t)bg * 256 + f) * 2048 + u.x1 * 256 + bj * 128 + cl) = pack8(acc[ai][bj][m][0], acc[ai][bj][m][1]); }
        } else {
            if (u.x2 == 1) {
#pragma unroll
                for (int ai = 0; ai < 2; ++ai)
#pragma unroll
                    for (int m = 0; m < 4; ++m) { const int f = wr * 64 + fr + ai * 128 + m * 16;
                        *(u32x4*)(ZC + ((size_t)bg * 256 + f) * 256 + cl) = pack8(acc[ai][0][m][0], acc[ai][0][m][1]); }
            } else {
#pragma unroll
                for (int ai = 0; ai < 2; ++ai)
#pragma unroll
                    for (int m = 0; m < 4; ++m) { const int f = wr * 64 + fr + ai * 128 + m * 16;
                        *(u32x4*)(ZC + ((size_t)bg * 256 + f) * 256 + 128 + cl) = pack8(acc[ai][1][m][0], acc[ai][1][m][1]); }
            }
        }
    }
};

struct SchedDftS {
    const char *WL, *WX, *Z, *ZC; int G, c, total;
    __device__ __forceinline__ bool next(int i, gm::Unit& u) const {
        int idx; if (!gm::flat_index(i, G, c, total, idx)) return false;
        u.x3 = 0;
        if (idx < 1024) { const int bg = idx >> 3, kt = idx & 7;
            constexpr unsigned P = MK_FP8_DFT ? 2048u : 4096u;
            u.A = WL + (size_t)kt * 256 * P; u.lda = P; u.B = Z + (size_t)bg * 256 * P; u.ldb = P; u.nt = 32 / (MK_FP8_DFT ? 2 : 1); u.x0 = bg; u.x1 = kt; u.x2 = 0; return true; }
        const int bg = idx - 1024; constexpr unsigned PX = MK_FP8_DFT ? 256u : 512u;
        u.A = WX; u.lda = PX; u.B = ZC + (size_t)bg * 256 * PX; u.ldb = PX; u.nt = 4 / (MK_FP8_DFT ? 2 : 1); u.x0 = bg; u.x1 = 0; u.x2 = 1; return true;
    }
};
struct EpiDftS {
    bf16* F; const float* AMID;
    __device__ __forceinline__ void operator()(AccRef acc, const gm::Unit& u, int wr, int wc, int fr, int fq) const {
        const int bg = u.x0, b = bg >> 2, g = bg & 3, cl = wc * 32 + fq * 8; const bool cx = u.x2 != 0;
        constexpr float TS = MK_FP8_DFT ? (1.0f / 16.0f) : 1.0f;
        const float scale = cx ? (1.0f / 256.0f) : 0.0013810679320049757f;
        const size_t rbase = cx ? (size_t)(MLAT + b * LC) : (size_t)b * SEQ + u.x1 * 256;
        const float* am = AMID + (size_t)(cx ? 32 + b : b) * D + g * 256;
        f32x4 a4[2][2];
#pragma unroll
        for (int bj = 0; bj < 2; ++bj) { a4[bj][0] = *(const f32x4*)(am + bj * 128 + cl); a4[bj][1] = *(const f32x4*)(am + bj * 128 + cl + 4); }
#pragma unroll
        for (int ai = 0; ai < 2; ++ai)
#pragma unroll
            for (int m = 0; m < 4; ++m) { const int k = wr * 64 + fr + ai * 128 + m * 16; const float sg = (k & 1) ? -1.0f : 1.0f;
#pragma unroll
                for (int bj = 0; bj < 2; ++bj)
                    *(u32x4*)(F + (rbase + k) * D + g * 256 + bj * 128 + cl) = pack8((acc[ai][bj][m][0] * TS + a4[bj][0] * sg) * scale, (acc[ai][bj][m][1] * TS + a4[bj][1] * sg) * scale); }
    }
};

constexpr float W8_SCALE = 32.0f, A8_SCALE = 4.0f;
__device__ __forceinline__ unsigned pk4_fp8(float a, float b, float c, float d) {
    a = __builtin_amdgcn_fmed3f(a, -448.f, 448.f); b = __builtin_amdgcn_fmed3f(b, -448.f, 448.f); c = __builtin_amdgcn_fmed3f(c, -448.f, 448.f); d = __builtin_amdgcn_fmed3f(d, -448.f, 448.f);
    int w = 0; w = __builtin_amdgcn_cvt_pk_fp8_f32(a, b, w, false); w = __builtin_amdgcn_cvt_pk_fp8_f32(c, d, w, true); return (unsigned)w; }
struct MoeInfo { int cnt[8]; int tb[9]; };
__device__ __forceinline__ void moe_info(const unsigned* cntw, MoeInfo& mi) {
    mi.tb[0] = 0;
#pragma unroll
    for (int e = 0; e < 8; ++e) { mi.cnt[e] = (int)__builtin_amdgcn_readfirstlane(__hip_atomic_load(cntw + 64 * e, __ATOMIC_RELAXED, __HIP_MEMORY_SCOPE_AGENT)); mi.tb[e + 1] = mi.tb[e] + ((mi.cnt[e] + 255) >> 8); }
}
__device__ __forceinline__ void moe_find(const MoeInfo& mi, int gt, int& e, int& rt, int& cnt) {
    e = 0; rt = gt; cnt = mi.cnt[0];
#pragma unroll
    for (int k = 1; k < 8; ++k) if (gt >= mi.tb[k]) { e = k; rt = gt - mi.tb[k]; cnt = mi.cnt[k]; }
}
struct SchedMoeUp {
    const char *H2, *W13; const int* list; MoeInfo mi; int G, c;
    __device__ __forceinline__ bool next(int i, gm::Unit& u) const {
        int idx; if (!gm::flat_index(i, G, c, mi.tb[8] * 28, idx)) return false;
        int gt, pn; gm::tile_order(idx, mi.tb[8], 28, gt, pn);
        int e, rt, cnt; moe_find(mi, gt, e, rt, cnt);
        u.A = H2; u.lda = 2048; u.B = W13 + ((size_t)e * 7168 + (size_t)pn * 256) * 2048; u.ldb = 2048; u.nt = 16; u.x0 = gt; u.x1 = pn; u.x2 = e * 65536 * 2 + cnt; u.x3 = rt * 256; return true;
    }
    __device__ __forceinline__ int gather_row(const gm::Unit& u, int lr) const {
        const int e = u.x2 >> 17, cnt = u.x2 & 0x1ffff; int j = u.x3 + lr; j = j < cnt ? j : cnt - 1;
        return list[(size_t)e * MALL + j];
    }
};
struct SchedMoeUp8 {
    const char *H2, *W13; const int* list; MoeInfo mi; int G, c;
    __device__ __forceinline__ bool next(int i, gm::Unit& u) const {
        int idx; if (!gm::flat_index(i, G, c, mi.tb[8] * 28, idx)) return false;
        int gt, pn; gm::tile_order(idx, mi.tb[8], 28, gt, pn);
        int e, rt, cnt; moe_find(mi, gt, e, rt, cnt);
        u.A = H2; u.lda = 1024; u.B = W13 + ((size_t)e * 7168 + (size_t)pn * 256) * 1024; u.ldb = 1024; u.nt = 8; u.x0 = gt; u.x1 = pn; u.x2 = e * 65536 * 2 + cnt; u.x3 = rt * 256; return true;
    }
    __device__ __forceinline__ int gather_row(const gm::Unit& u, int lr) const {
        const int e = u.x2 >> 17, cnt = u.x2 & 0x1ffff; int j = u.x3 + lr; j = j < cnt ? j : cnt - 1;
        return list[(size_t)e * MALL + j];
    }
};
struct EpiSwiglu8 {
    unsigned char* ACT8; int ld;
    __device__ __forceinline__ void operator()(AccRef acc, const gm::Unit& u, int wr, int wc, int fr, int fq) const {
        const int row0 = u.x0 * 256 + wr * 64 + fr, col = u.x1 * 128 + wc * 32 + fq * 8;
#pragma unroll 1
        for (int rep_ = 0; rep_ < 1 + (int)((MK_DUP >> 24) & 1u); ++rep_)
#pragma unroll
        for (int ai = 0; ai < 2; ++ai)
#pragma unroll
            for (int m = 0; m < 4; ++m) {
                constexpr float CE = -1.4426950408889634f / W8_SCALE, CO = A8_SCALE / (W8_SCALE * W8_SCALE);
                const f32x4 v0 = swiglu4s(acc[ai][0][m][0], acc[ai][1][m][0], CE, CO), v1 = swiglu4s(acc[ai][0][m][1], acc[ai][1][m][1], CE, CO);
                u32x2 w; w.x = pk4_fp8(v0[0], v0[1], v0[2], v0[3]); w.y = pk4_fp8(v1[0], v1[1], v1[2], v1[3]);
                *(u32x2*)(ACT8 + (size_t)(row0 + ai * 128 + m * 16) * ld + col) = w; }
    }
};
struct SchedMoeDown8 {
    const char *Ab, *W2; MoeInfo mi; int G, c;
    __device__ __forceinline__ bool next(int i, gm::Unit& u) const {
        int idx; if (!gm::flat_index(i, G, c, mi.tb[8] * 4, idx)) return false;
        int gt, pn; gm::tile_order(idx, mi.tb[8], 4, gt, pn);
        int e, rt, cnt; moe_find(mi, gt, e, rt, cnt);
        u.A = Ab + (size_t)gt * 256 * 3584; u.lda = 3584; u.B = W2 + ((size_t)e * 1024 + (size_t)pn * 256) * 3584; u.ldb = 3584; u.nt = 28; u.x0 = gt; u.x1 = pn; u.x2 = e * 65536 * 2 + cnt; u.x3 = rt * 256; return true;
    }
};
struct SchedMoeUpDense {
    const char *H2, *W13; MoeInfo mi; int G, c;
    __device__ __forceinline__ bool next(int i, gm::Unit& u) const {
        int idx; if (!gm::flat_index(i, G, c, mi.tb[8] * 28, idx)) return false;
        int gt, pn; gm::tile_order(idx, mi.tb[8], 28, gt, pn);
        int e, rt, cnt; moe_find(mi, gt, e, rt, cnt);
        u.A = H2 + (size_t)(gt & 255) * 256 * 2048; u.lda = 2048; u.B = W13 + ((size_t)e * 7168 + (size_t)pn * 256) * 2048; u.ldb = 2048; u.nt = 16; u.x0 = gt; u.x1 = pn; u.x2 = 0; u.x3 = 0; return true;
    }
};
struct SchedMoeDown {
    const char *Ab, *W2; MoeInfo mi; int G, c;
    __device__ __forceinline__ bool next(int i, gm::Unit& u) const {
        int idx; if (!gm::flat_index(i, G, c, mi.tb[8] * 4, idx)) return false;
        int gt, pn; gm::tile_order(idx, mi.tb[8], 4, gt, pn);
        int e, rt, cnt; moe_find(mi, gt, e, rt, cnt);
        u.A = Ab + (size_t)gt * 256 * 7168; u.lda = 7168; u.B = W2 + ((size_t)e * 1024 + (size_t)pn * 256) * 7168; u.ldb = 7168; u.nt = 56; u.x0 = gt; u.x1 = pn; u.x2 = e * 65536 * 2 + cnt; u.x3 = rt * 256; return true;
    }
};
struct EpiMoeDown {
    bf16* x16; const float* gate; const int* list; const float* glist; float ascale; bf16* dst16;
    __device__ __forceinline__ void operator()(AccRef acc, const gm::Unit& u, int wr, int wc, int fr, int fq) const {
        const int e = u.x2 >> 17, cnt = u.x2 & 0x1ffff, col0 = u.x1 * 256 + wc * 32 + fq * 8;
        int tok[2][4]; float gv[2][4];
#pragma unroll
        for (int ai = 0; ai < 2; ++ai)
#pragma unroll
            for (int m = 0; m < 4; ++m) { int j = u.x3 + wr * 64 + fr + ai * 128 + m * 16; const bool ok = j < cnt; j = ok ? j : cnt - 1;
                const int t = list[(size_t)e * MALL + j]; tok[ai][m] = ok ? t : -1 - t; gv[ai][m] = glist[(size_t)e * MALL + j] * ascale; }
        u32x4 xr[2][4][2];
#pragma unroll
        for (int ai = 0; ai < 2; ++ai)
#pragma unroll
            for (int m = 0; m < 4; ++m) { const int t = tok[ai][m] < 0 ? -1 - tok[ai][m] : tok[ai][m];
#pragma unroll
                for (int bj = 0; bj < 2; ++bj) xr[ai][m][bj] = *(const u32x4*)(x16 + (size_t)t * D + col0 + bj * 128); }
#pragma unroll
        for (int ai = 0; ai < 2; ++ai)
#pragma unroll
            for (int m = 0; m < 4; ++m) { const int t = tok[ai][m];
                if (t >= 0) { const int b = t < MLAT ? (t >> 11) : 32; const float* gp = gate + (size_t)b * 6144 + col0;
#pragma unroll
                    for (int bj = 0; bj < 2; ++bj) {
                        const f32x4 g0 = *(const f32x4*)(gp + bj * 128) * gv[ai][m], g1 = *(const f32x4*)(gp + bj * 128 + 4) * gv[ai][m];
                        const u32x4 w = xr[ai][m][bj];
                        const f32x4 x0 = (f32x4){__uint_as_float(w.x << 16), __uint_as_float(w.x & 0xffff0000u), __uint_as_float(w.y << 16), __uint_as_float(w.y & 0xffff0000u)};
                        const f32x4 x1 = (f32x4){__uint_as_float(w.z << 16), __uint_as_float(w.z & 0xffff0000u), __uint_as_float(w.w << 16), __uint_as_float(w.w & 0xffff0000u)};
                        *(u32x4*)(dst16 + (size_t)t * D + col0 + bj * 128) = pack8(x0 + g0 * acc[ai][bj][m][0], x1 + g1 * acc[ai][bj][m][1]); } } }
    }
};

struct ModP { f32x4 gm[4]; f32x4 sh[4]; };
__device__ __forceinline__ void load_modp(ModP& p, const float* g, const float* modrow, int off_sh, int off_sc, int lane) {
#pragma unroll
    for (int j = 0; j < 4; ++j) { const int c = 4 * lane + 256 * j;
        const f32x4 g4 = *(const f32x4*)(g + c), sc = *(const f32x4*)(modrow + off_sc + c);
        p.gm[j] = g4 * (sc + 1.0f); p.sh[j] = *(const f32x4*)(modrow + off_sh + c); }
}
struct XSrc { const float* lat; const float* ctx; const bf16* x16; };
__device__ __forceinline__ void load_xrow(const XSrc& xs, int row, int lane, f32x4 (&v)[4]) {
    if (xs.x16) { const u32x2* p = (const u32x2*)(xs.x16 + (size_t)row * D);
#pragma unroll
        for (int j = 0; j < 4; ++j) { const u32x2 w = p[lane + 64 * j]; v[j] = (f32x4){__uint_as_float(w.x << 16), __uint_as_float(w.x & 0xffff0000u), __uint_as_float(w.y << 16), __uint_as_float(w.y & 0xffff0000u)}; } }
    else { const f32x4* p = (const f32x4*)(row < MLAT ? xs.lat + (size_t)row * D : xs.ctx + (size_t)(row - MLAT) * D);
#pragma unroll
        for (int j = 0; j < 4; ++j) v[j] = p[lane + 64 * j]; }
}
struct XRaw { u32x2 w[4]; f32x4 f[4]; };
__device__ __forceinline__ void load_xraw(const XSrc& xs, int row, int lane, XRaw& r) {
    if (xs.x16) { const u32x2* p = (const u32x2*)(xs.x16 + (size_t)row * D);
#pragma unroll
        for (int j = 0; j < 4; ++j) r.w[j] = p[lane + 64 * j]; }
    else { const f32x4* p = (const f32x4*)(row < MLAT ? xs.lat + (size_t)row * D : xs.ctx + (size_t)(row - MLAT) * D);
#pragma unroll
        for (int j = 0; j < 4; ++j) r.f[j] = p[lane + 64 * j]; }
}
__device__ __forceinline__ void mod_row_raw(const XSrc& xs, const XRaw& r, const ModP& p, f32x4 (&h)[4]) {
    f32x4 v[4]; float ss = 0.f;
    if (xs.x16) {
#pragma unroll
        for (int j = 0; j < 4; ++j) { const u32x2 w = r.w[j]; v[j] = (f32x4){__uint_as_float(w.x << 16), __uint_as_float(w.x & 0xffff0000u), __uint_as_float(w.y << 16), __uint_as_float(w.y & 0xffff0000u)}; } }
    else {
#pragma unroll
        for (int j = 0; j < 4; ++j) v[j] = r.f[j]; }
#pragma unroll
    for (int j = 0; j < 4; ++j) ss += (v[j][0] * v[j][0] + v[j][1] * v[j][1]) + (v[j][2] * v[j][2] + v[j][3] * v[j][3]);
    ss = wave_sum(ss);
    const float rr = 1.0f / sqrtf(ss * (1.0f / D) + EPS);
#pragma unroll
    for (int j = 0; j < 4; ++j) h[j] = (v[j] * rr) * p.gm[j] + p.sh[j];
}
__device__ __forceinline__ void mod_row(const XSrc& xs, int row, const ModP& p, int lane, f32x4 (&h)[4]) {
    f32x4 v[4]; float ss = 0.f; load_xrow(xs, row, lane, v);
#pragma unroll
    for (int j = 0; j < 4; ++j) { ss += (v[j][0] * v[j][0] + v[j][1] * v[j][1]) + (v[j][2] * v[j][2] + v[j][3] * v[j][3]); }
    ss = wave_sum(ss);
    const float r = 1.0f / sqrtf(ss * (1.0f / D) + EPS);
#pragma unroll
    for (int j = 0; j < 4; ++j) h[j] = (v[j] * r) * p.gm[j] + p.sh[j];
}
__device__ __forceinline__ void store_row_bf16(bf16* dst, const f32x4 (&h)[4], int lane) {
#pragma unroll
    for (int j = 0; j < 4; ++j) { u32x2 w; w.x = pkbf(h[j][0], h[j][1]); w.y = pkbf(h[j][2], h[j][3]); ((u32x2*)dst)[lane + 64 * j] = w; }
}

__device__ __forceinline__ void phase_mod_plain(const XSrc& xs, const float* g, const float* modbase, int off_sh, int off_sc, bf16* H, bool out8, int nrows, int gw, int NGW, int lane) {
    const int rpw = (nrows + NGW - 1) / NGW; const int r0 = gw * rpw; int r1 = r0 + rpw; if (r1 > nrows) r1 = nrows;
    int curb = -1; ModP p; XRaw cur, nxt; nxt = XRaw{};
    if (r0 < r1) load_xraw(xs, r0, lane, cur);
    for (int row = r0; row < r1; ++row) {
        if (row + 1 < r1) load_xraw(xs, row + 1, lane, nxt);
        const int b = row < MLAT ? (row >> 11) : 32;
        if (b != curb) { load_modp(p, g, modbase + (size_t)b * 6144, off_sh, off_sc, lane); curb = b; }
        f32x4 h[4]; mod_row_raw(xs, cur, p, h); cur = nxt;
        if (out8) { unsigned char* o8 = (unsigned char*)H + (size_t)row * D;
#pragma unroll
            for (int j = 0; j < 4; ++j) ((unsigned*)o8)[lane + 64 * j] = pk4_fp8(h[j][0], h[j][1], h[j][2], h[j][3]); }
        else store_row_bf16(H + (size_t)row * D, h, lane);
    }
}

__device__ __forceinline__ void phase_mod_fold(const XSrc& xs, const float* g, const float* modbase, bf16* HF, float* HMID, bool with_ctx, int gw, int NGW, int lane) {
    constexpr int IL = SEQ / 2 + 1, IC = LC / 2 + 1;
    const int nitems = NB * IL + (with_ctx ? NB * IC : 0);
    const int ipw = (nitems + NGW - 1) / NGW; const int i0 = gw * ipw; int i1 = i0 + ipw; if (i1 > nitems) i1 = nitems;
    int curb = -1; ModP p;
    for (int it = i0; it < i1; ++it) {
        const bool cx = it >= NB * IL; const int j = cx ? it - NB * IL : it;
        const int b = cx ? j / IC : j / IL, n = cx ? j % IC : j % IL, Ls = cx ? LC : SEQ;
        const int mb = cx ? 32 : b, key = cx ? 64 : b;
        if (key != curb) { load_modp(p, g, modbase + (size_t)mb * 6144, 0, 1024, lane); curb = key; }
        const int rbase = cx ? MLAT + b * LC : b * SEQ;
        bf16* hf = HF + (size_t)rbase * D;
        f32x4 h1[4]; mod_row(xs, rbase + n, p, lane, h1);
        if (n == 0) { store_row_bf16(hf, h1, lane); f32x4 z[4];
#pragma unroll
            for (int q = 0; q < 4; ++q) z[q] = (f32x4){0.f, 0.f, 0.f, 0.f};
            store_row_bf16(hf + (size_t)(Ls / 2) * D, z, lane); }
        else if (n == Ls / 2) { float* hm = HMID + (size_t)(cx ? 32 + b : b) * D;
#pragma unroll
            for (int q = 0; q < 4; ++q) ((f32x4*)hm)[lane + 64 * q] = h1[q]; }
        else { f32x4 h2[4]; mod_row(xs, rbase + Ls - n, p, lane, h2); f32x4 s[4], d[4];
#pragma unroll
            for (int q = 0; q < 4; ++q) { s[q] = h1[q] + h2[q]; d[q] = h1[q] - h2[q]; }
            store_row_bf16(hf + (size_t)n * D, s, lane); store_row_bf16(hf + (size_t)(Ls / 2 + n) * D, d, lane); }
    }
}

template <bool ROUTER>
__device__ __forceinline__ void phase_mod2(const XSrc& xs, const float* g, const float* modbase, bf16* H2, bool out8, int nrows,
                                           const float* router_w, unsigned* gcnt, int* list, float* glist, LAS unsigned char* lds, int vcu, int G, int wave, int lane, int tid) {
    const int rpb = nrows / G, rpw = rpb / 8;
    const int r0 = vcu * rpb + wave * rpw;
    LAS float* rwT = (LAS float*)lds; LAS int* bcnt = (LAS int*)(lds + 32768); LAS int* bbase = (LAS int*)(lds + 32768 + 64);
    if constexpr (ROUTER) {
        for (int i = tid; i < 8192; i += 512) { const int c = i >> 3, e = i & 7; rwT[e * 1024 + c] = router_w[i]; }
        if (tid < 16) bcnt[tid] = 0;
        __syncthreads();
    }
    int curb = -1; ModP p; int me0 = -1, me1 = -1; float mp0 = 0.f, mp1 = 0.f; XRaw cur, nxt; nxt = XRaw{};
    load_xraw(xs, r0, lane, cur);
    for (int rr = 0; rr < rpw; ++rr) {
        const int row = r0 + rr; const int b = row < MLAT ? (row >> 11) : 32;
        if (rr + 1 < rpw) load_xraw(xs, row + 1, lane, nxt);
        if (b != curb) { load_modp(p, g, modbase + (size_t)b * 6144, 3072, 4096, lane); curb = b; }
        f32x4 h[4]; mod_row_raw(xs, cur, p, h); cur = nxt;
        if (out8) { unsigned char* o8 = (unsigned char*)H2 + (size_t)row * D;
#pragma unroll
            for (int j = 0; j < 4; ++j) ((unsigned*)o8)[lane + 64 * j] = pk4_fp8(h[j][0], h[j][1], h[j][2], h[j][3]); }
        else store_row_bf16(H2 + (size_t)row * D, h, lane);
        if constexpr (ROUTER) {
            asm volatile("" ::: "memory");
            float lg[8];
#pragma unroll
            for (int e = 0; e < 8; ++e) { float s = 0.f;
#pragma unroll
                for (int j = 0; j < 4; ++j) { const f32x4 w = *(const LAS f32x4*)(rwT + e * 1024 + 4 * lane + 256 * j); s += (h[j][0] * w[0] + h[j][1] * w[1]) + (h[j][2] * w[2] + h[j][3] * w[3]); }
                lg[e] = s; }
            {
                const bool b5 = (lane & 32) != 0, b4 = (lane & 16) != 0, b3 = (lane & 8) != 0;
                float v4[4], v2[2];
#pragma unroll
                for (int j = 0; j < 4; ++j) { const float snd = b5 ? lg[j] : lg[4 + j], kp = b5 ? lg[4 + j] : lg[j]; v4[j] = kp + __shfl_xor(snd, 32); }
#pragma unroll
                for (int j = 0; j < 2; ++j) { const float snd = b4 ? v4[j] : v4[2 + j], kp = b4 ? v4[2 + j] : v4[j]; v2[j] = kp + __shfl_xor(snd, 16); }
                float v1; { const float snd = b3 ? v2[0] : v2[1], kp = b3 ? v2[1] : v2[0]; v1 = kp + __shfl_xor(snd, 8); }
                v1 += __shfl_xor(v1, 4); v1 += __shfl_xor(v1, 2); v1 += __shfl_xor(v1, 1);
#pragma unroll
                for (int e = 0; e < 8; ++e) lg[e] = __uint_as_float((unsigned)__builtin_amdgcn_readlane((int)__float_as_uint(v1), e * 8));
            }
            int e0 = 0; float v0 = lg[0];
#pragma unroll
            for (int e = 1; e < 8; ++e) if (lg[e] > v0) { v0 = lg[e]; e0 = e; }
            int e1 = -1; float v1 = -3.0e38f;
#pragma unroll
            for (int e = 0; e < 8; ++e) if (e != e0 && lg[e] > v1) { v1 = lg[e]; e1 = e; }
            const float p0 = 1.0f / (1.0f + __expf(v1 - v0));
            if (lane == rr) { me0 = e0; me1 = e1; mp0 = p0; mp1 = 1.0f - p0; }
        }
    }
    if constexpr (ROUTER) {
        int rank0 = 0, rank1 = 0, mycnt = 0;
        const unsigned long long lt = (lane == 0) ? 0ull : (~0ull >> (64 - lane));
#pragma unroll
        for (int e = 0; e < 8; ++e) {
            const unsigned long long m0 = __ballot(me0 == e), m1 = __ballot(me1 == e);
            if (me0 == e) rank0 = __popcll(m0 & lt);
            if (me1 == e) rank1 = __popcll(m1 & lt);
            if (lane == e) mycnt = __popcll(m0);
            if (lane == 8 + e) mycnt = __popcll(m1);
        }
        int woff = 0;
        if (lane < 16) woff = __hip_atomic_fetch_add(bcnt + lane, mycnt, __ATOMIC_RELAXED, __HIP_MEMORY_SCOPE_WORKGROUP);
        __syncthreads();
        if (tid < 16) bbase[tid] = (int)__hip_atomic_fetch_add(gcnt + 64 * tid, (unsigned)bcnt[tid], __ATOMIC_RELAXED, __HIP_MEMORY_SCOPE_AGENT);
        __syncthreads();
        const int w0 = __shfl(woff, me0 < 0 ? 0 : me0), w1 = __shfl(woff, me1 < 0 ? 8 : 8 + me1);
        if (me0 >= 0) { const int row = r0 + lane;
            const int p0 = bbase[me0] + w0 + rank0, p1 = bbase[8 + me1] + w1 + rank1;
            list[(size_t)me0 * MALL + p0] = row; glist[(size_t)me0 * MALL + p0] = mp0;
            list[(size_t)(8 + me1) * MALL + p1] = row; glist[(size_t)(8 + me1) * MALL + p1] = mp1; }
        __syncthreads();
    }
}

__device__ __forceinline__ void phase_final(const bf16* x16, float* out, const float* g, int gw, int NGW, int lane) {
    const int rpw = (MLAT + NGW - 1) / NGW; const int r0 = gw * rpw; int r1 = r0 + rpw; if (r1 > MLAT) r1 = MLAT;
    f32x4 g4[4];
#pragma unroll
    for (int j = 0; j < 4; ++j) g4[j] = *(const f32x4*)(g + 4 * lane + 256 * j);
    XSrc xs{nullptr, nullptr, x16};
    for (int row = r0; row < r1; ++row) { f32x4 v[4]; float ss = 0.f; load_xrow(xs, row, lane, v);
#pragma unroll
        for (int j = 0; j < 4; ++j) ss += (v[j][0] * v[j][0] + v[j][1] * v[j][1]) + (v[j][2] * v[j][2] + v[j][3] * v[j][3]);
        ss = wave_sum(ss); const float r = 1.0f / sqrtf(ss * (1.0f / D) + EPS);
#pragma unroll
        for (int j = 0; j < 4; ++j) ((f32x4*)(out + (size_t)row * D))[lane + 64 * j] = (v[j] * r) * g4[j]; }
}

__device__ __forceinline__ void phase_pool(const bf16* POOL, bf16* MIXCAT, int nrows, int gw, int NGW, int lane) {
    const int rs = lane >> 4, cb = lane & 15;
    for (int it = gw; it < (nrows / 64) * 4; it += NGW) { const int seg = it >> 2, g = it & 3, w = 2 << g, hw = w >> 1;
        const int row0 = seg * 64 + rs * 16;
        const int Ls = row0 < MLAT ? SEQ : LC, sb = row0 < MLAT ? (row0 & ~(SEQ - 1)) : (MLAT + ((row0 - MLAT) & ~(LC - 1))), t0 = row0 - sb;
        const bf16* src = POOL + (size_t)sb * 512 + g * 128 + cb * 8; bf16* dstp = MIXCAT + (size_t)sb * D + 512 + g * 128 + cb * 8;
        float s[8];
#pragma unroll
        for (int k = 0; k < 8; ++k) s[k] = 0.f;
        for (int j = 0; j < w; ++j) { const int tt = t0 - hw + j;
            if (tt >= 0 && tt < Ls) { const u32x4 v = *(const u32x4*)(src + (size_t)tt * 512);
#pragma unroll
                for (int k = 0; k < 4; ++k) { s[2 * k] += __uint_as_float(v[k] << 16); s[2 * k + 1] += __uint_as_float(v[k] & 0xffff0000u); } } }
#pragma unroll 4
        for (int q = 0; q < 16; ++q) { const int t = t0 + q;
            int lo = t - hw; if (lo < 0) lo = 0; int hi = t + hw; if (hi > Ls) hi = Ls;
            const u32x4 self = *(const u32x4*)(src + (size_t)t * 512);
            const int tin = t + hw, tout = t - hw;
            u32x4 vin = (u32x4){0u, 0u, 0u, 0u}, vout = (u32x4){0u, 0u, 0u, 0u};
            if (q < 15) { if (tin < Ls) vin = *(const u32x4*)(src + (size_t)tin * 512); if (tout >= 0) vout = *(const u32x4*)(src + (size_t)tout * 512); }
            const float inv = 1.0f / (float)(hi - lo); u32x4 o;
#pragma unroll
            for (int k = 0; k < 4; ++k) o[k] = pkbf(s[2 * k] * inv - __uint_as_float(self[k] << 16), s[2 * k + 1] * inv - __uint_as_float(self[k] & 0xffff0000u));
            *(u32x4*)(dstp + (size_t)t * D) = o;
#pragma unroll
            for (int k = 0; k < 4; ++k) { s[2 * k] += __uint_as_float(vin[k] << 16) - __uint_as_float(vout[k] << 16); s[2 * k + 1] += __uint_as_float(vin[k] & 0xffff0000u) - __uint_as_float(vout[k] & 0xffff0000u); } }
    }
}

__device__ __forceinline__ void phase_amid(const float* HMID_, float* AMID_, LAS unsigned char* lds, int G, int bid, int tid) {
    LAS float* ct = (LAS float*)lds;
    if (tid < 256) ct[tid] = cospif((float)tid * (1.0f / 128.0f));
    __syncthreads();
    for (int o = bid * 512 + tid; o < 64 * 1024; o += G * 512) { const int r = o >> 10, gq = (o >> 8) & 3, m = o & 255;
        const float* hp = HMID_ + (size_t)r * D + gq * 256; float s = 0.f;
#pragma unroll 4
        for (int c = 0; c < 256; ++c) s += hp[c] * ct[(m * c) & 255];
        AMID_[o] = s; }
    __syncthreads();
}

constexpr int AT_KP = 208, AT_VP = 136, AT_VOFF = 64 * AT_KP, AT_BUF = 22528;
__device__ __forceinline__ f32x16 mfma32(bf16x8 a, bf16x8 b, f32x16 c) { return __builtin_amdgcn_mfma_f32_32x32x16_bf16(a, b, c, 0, 0, 0); }
__device__ __forceinline__ bf16x8 pack_s(const f32x16& x, int s) {
    u32x4 p; p.x = pkbf(x[8 * s], x[8 * s + 1]); p.y = pkbf(x[8 * s + 2], x[8 * s + 3]); p.z = pkbf(x[8 * s + 4], x[8 * s + 5]); p.w = pkbf(x[8 * s + 6], x[8 * s + 7]);
    return __builtin_bit_cast(bf16x8, p);
}
#define AT_MX3(a, b, c) __builtin_fmaxf(__builtin_fmaxf((a), (b)), (c))
#define AT_SOFTMAX(S0, S1, M, L, O0, O1, FIRST) do { \
        float ma_ = AT_MX3(S0[0], S0[1], S0[2]), mb_ = AT_MX3(S0[3], S0[4], S0[5]), mc_ = AT_MX3(S1[0], S1[1], S1[2]), md_ = AT_MX3(S1[3], S1[4], S1[5]); \
        ma_ = AT_MX3(ma_, S0[6], S0[7]); mb_ = AT_MX3(mb_, S0[8], S0[9]); mc_ = AT_MX3(mc_, S1[6], S1[7]); md_ = AT_MX3(md_, S1[8], S1[9]); \
        ma_ = AT_MX3(ma_, S0[10], S0[11]); mb_ = AT_MX3(mb_, S0[12], S0[13]); mc_ = AT_MX3(mc_, S1[10], S1[11]); md_ = AT_MX3(md_, S1[12], S1[13]); \
        ma_ = AT_MX3(ma_, S0[14], S0[15]); mc_ = AT_MX3(mc_, S1[14], S1[15]); \
        float mx = __builtin_fmaxf(__builtin_fmaxf(ma_, mb_), __builtin_fmaxf(mc_, md_)); \
        mx = __builtin_fmaxf(mx, __shfl_xor(mx, 32)); \
        if (FIRST) { M += mx; _Pragma("unroll") for (int i_ = 0; i_ < 16; ++i_) { S0[i_] -= mx; S1[i_] -= mx; } } \
        else if (__any(mx > 8.0f)) { const float dl_ = __builtin_fmaxf(mx, 0.f), alpha_ = __builtin_amdgcn_exp2f(-dl_); M += dl_; L *= alpha_; \
            _Pragma("unroll") for (int i_ = 0; i_ < 16; ++i_) { S0[i_] -= dl_; S1[i_] -= dl_; O0[i_] *= alpha_; O1[i_] *= alpha_; } } \
        float pa_ = 0.f, pb_ = 0.f, pc_ = 0.f, pd_ = 0.f; \
        _Pragma("unroll") for (int i_ = 0; i_ < 16; i_ += 2) { S0[i_] = __builtin_amdgcn_exp2f(S0[i_]); S0[i_ + 1] = __builtin_amdgcn_exp2f(S0[i_ + 1]); S1[i_] = __builtin_amdgcn_exp2f(S1[i_]); S1[i_ + 1] = __builtin_amdgcn_exp2f(S1[i_ + 1]); \
            pa_ += S0[i_]; pb_ += S0[i_ + 1]; pc_ += S1[i_]; pd_ += S1[i_ + 1]; } \
        L += (pa_ + pb_) + (pc_ + pd_); } while (0)
__device__ __forceinline__ void attn_store(bf16* op, const f32x16& o0, const f32x16& o1, float inv) {
#pragma unroll
    for (int gq = 0; gq < 4; ++gq) {
        u32x2 w0, w1; w0.x = pkbf(o0[4 * gq] * inv, o0[4 * gq + 1] * inv); w0.y = pkbf(o0[4 * gq + 2] * inv, o0[4 * gq + 3] * inv);
        w1.x = pkbf(o1[4 * gq] * inv, o1[4 * gq + 1] * inv); w1.y = pkbf(o1[4 * gq + 2] * inv, o1[4 * gq + 3] * inv);
        *(u32x2*)(op + 8 * gq) = w0; *(u32x2*)(op + 32 + 8 * gq) = w1; }
}
__device__ __forceinline__ void attn_unit(LAS unsigned char* lds, const bf16* Q, const bf16* KN, const bf16* KR, const bf16* VT, bf16* O,
                                          int b, int hp, int qrow0, int key_lo, int ntiles, int tid) {
    const int lane = tid & 63, r = lane & 31, hh = lane >> 5, wid = __builtin_amdgcn_readfirstlane(tid >> 6), gsel = wid >> 2, wq = wid & 3, gt = tid & 255;
    const int h = hp * 2 + gsel;
    LAS unsigned char* gl = lds + gsel * (2 * AT_BUF);
    const int qrA = qrow0 + wq * 64 + r;
    bf16x8 qa[6];
    LAS unsigned char* qbl = lds + ATQ_OFF + wid * 6656 + r * AT_KP + hh * 16;
#pragma unroll
    for (int c = 0; c < 6; ++c) { qa[c] = *(const bf16x8*)(Q + (size_t)qrA * QW + h * 96 + 16 * c + 8 * hh);
        *(LAS bf16x8*)(qbl + c * 32) = *(const bf16x8*)(Q + (size_t)(qrA + 32) * QW + h * 96 + 16 * c + 8 * hh); }
    f32x16 oA0, oA1, oB0, oB1;
#pragma unroll
    for (int i = 0; i < 16; ++i) { oA0[i] = 0.f; oA1[i] = 0.f; oB0[i] = 0.f; oB1[i] = 0.f; }
    float mA = 0.f, lA = 0.f, mB = 0.f, lB = 0.f;
    const int kkey = gt >> 3, kpc = gt & 7, rkey = gt >> 2, rpc = gt & 3;
    const bf16* vsrc = VT + ((size_t)b * 512 + h * 64 + kkey) * NKEY + kpc * 8;
    u32x4 rk0, rk1, rr, rv0, rv1;
#define AT_LOAD(t) do { const int key0 = key_lo + (t) * 64; const size_t krow = key0 < SEQ ? (size_t)b * SEQ + key0 : (size_t)MLAT + (size_t)b * LC + (key0 - SEQ); \
        rk0 = *(const u32x4*)(KN + (krow + kkey) * 512 + h * 64 + kpc * 8); rk1 = *(const u32x4*)(KN + (krow + kkey + 32) * 512 + h * 64 + kpc * 8); \
        rr = *(const u32x4*)(KR + (krow + rkey) * 32 + rpc * 8); \
        rv0 = *(const u32x4*)(vsrc + key0); rv1 = *(const u32x4*)(vsrc + (size_t)32 * NKEY + key0); } while (0)
#define AT_STORE(bufp) do { *(LAS u32x4*)((bufp) + kkey * AT_KP + kpc * 16) = rk0; *(LAS u32x4*)((bufp) + (kkey + 32) * AT_KP + kpc * 16) = rk1; \
        *(LAS u32x4*)((bufp) + rkey * AT_KP + 128 + rpc * 16) = rr; \
        *(LAS u32x2*)((bufp) + AT_VOFF + kkey * AT_VP + kpc * 16) = (u32x2){rv0.x, rv0.y}; *(LAS u32x2*)((bufp) + AT_VOFF + kkey * AT_VP + kpc * 16 + 8) = (u32x2){rv0.z, rv0.w}; \
        *(LAS u32x2*)((bufp) + AT_VOFF + (kkey + 32) * AT_VP + kpc * 16) = (u32x2){rv1.x, rv1.y}; *(LAS u32x2*)((bufp) + AT_VOFF + (kkey + 32) * AT_VP + kpc * 16 + 8) = (u32x2){rv1.z, rv1.w}; } while (0)
    AT_LOAD(0);
    AT_STORE(gl);
    __syncthreads();
    if (gsel == 1) __syncthreads();
    for (int t = 0; t < ntiles; ++t) {
        LAS unsigned char* buf = gl + (t & 1) * AT_BUF;
        f32x16 sA0, sA1, sB0, sB1;
        const LAS unsigned char* kb = buf + r * AT_KP + hh * 16;
#pragma unroll 1
        for (int rep_ = 0; rep_ < 1 + (int)((MK_DUP >> 25) & 1u); ++rep_) {
#pragma unroll
        for (int i = 0; i < 16; ++i) { sA0[i] = -mA; sA1[i] = -mA; sB0[i] = -mB; sB1[i] = -mB; }
#pragma unroll
        for (int c = 0; c < 6; ++c) {
            const bf16x8 a0 = *(const LAS bf16x8*)(kb + c * 32), a1 = *(const LAS bf16x8*)(kb + 32 * AT_KP + c * 32);
            const bf16x8 qbc = *(const LAS bf16x8*)(qbl + c * 32);
            sA0 = mfma32(a0, qa[c], sA0); sA1 = mfma32(a1, qa[c], sA1); sB0 = mfma32(a0, qbc, sB0); sB1 = mfma32(a1, qbc, sB1);
        }
        asm volatile("" ::: "memory"); }
        AT_SOFTMAX(sA0, sA1, mA, lA, oA0, oA1, t == 0);
        bf16x8 pA[4];
        pA[0] = pack_s(sA0, 0); pA[1] = pack_s(sA0, 1); pA[2] = pack_s(sA1, 0); pA[3] = pack_s(sA1, 1);
        AT_SOFTMAX(sB0, sB1, mB, lB, oB0, oB1, t == 0);
        bf16x8 pB[4];
        pB[0] = pack_s(sB0, 0); pB[1] = pack_s(sB0, 1); pB[2] = pack_s(sB1, 0); pB[3] = pack_s(sB1, 1);
        __syncthreads();
        __builtin_amdgcn_sched_barrier(0);
        if (t + 1 < ntiles) AT_LOAD(t + 1);
        const LAS unsigned char* vb = buf + AT_VOFF + r * AT_VP + hh * 8;
#pragma unroll
        for (int ks = 0; ks < 4; ++ks) {
            const s16x4 l0 = *(const LAS s16x4*)(vb + ks * 32), h0 = *(const LAS s16x4*)(vb + ks * 32 + 16);
            const s16x4 l1 = *(const LAS s16x4*)(vb + 32 * AT_VP + ks * 32), h1 = *(const LAS s16x4*)(vb + 32 * AT_VP + ks * 32 + 16);
            const bf16x8 v0 = __builtin_shufflevector(l0, h0, 0, 1, 2, 3, 4, 5, 6, 7), v1 = __builtin_shufflevector(l1, h1, 0, 1, 2, 3, 4, 5, 6, 7);
            oA0 = mfma32(v0, pA[ks], oA0); oA1 = mfma32(v1, pA[ks], oA1); oB0 = mfma32(v0, pB[ks], oB0); oB1 = mfma32(v1, pB[ks], oB1);
        }
        if (t + 1 < ntiles) { LAS unsigned char* nb = gl + ((t + 1) & 1) * AT_BUF; AT_STORE(nb); }
        __syncthreads();
    }
    if (gsel == 0) __syncthreads();
    lA += __shfl_xor(lA, 32); lB += __shfl_xor(lB, 32);
    attn_store(O + (size_t)qrA * D + h * 64 + 4 * hh, oA0, oA1, 1.0f / lA);
    attn_store(O + (size_t)(qrA + 32) * D + h * 64 + 4 * hh, oB0, oB1, 1.0f / lB);
#undef AT_LOAD
#undef AT_STORE
}
__device__ __forceinline__ void tr_item(const float* W, int N, int k0, int n0, bf16* dst, size_t drow0, int dld, const float* kscale, float cscale, LAS float* scr, int lane) {
#pragma unroll 1
    for (int ib = 0; ib < 32; ib += 16) { float wv[16];
#pragma unroll
        for (int ii = 0; ii < 16; ++ii) wv[ii] = W[(size_t)(k0 + 2 * (ib + ii) + (lane >> 5)) * N + n0 + (lane & 31)];
#pragma unroll
        for (int ii = 0; ii < 16; ++ii) { const int kk = 2 * (ib + ii) + (lane >> 5); float v = wv[ii] * cscale; if (kscale) v *= kscale[k0 + kk]; scr[kk * 33 + (lane & 31)] = v; } }
    asm volatile("s_waitcnt lgkmcnt(0)" ::: "memory");
    const int c = lane & 7;
#pragma unroll
    for (int j = 0; j < 4; ++j) { const int n = (lane >> 3) + 8 * j; const LAS float* s = scr + (8 * c) * 33 + n;
        u32x4 o; o.x = pkbf(s[0 * 33], s[1 * 33]); o.y = pkbf(s[2 * 33], s[3 * 33]); o.z = pkbf(s[4 * 33], s[5 * 33]); o.w = pkbf(s[6 * 33], s[7 * 33]);
        *(u32x4*)(dst + (drow0 + n) * (size_t)dld + k0 + 8 * c) = o; }
    asm volatile("s_waitcnt lgkmcnt(0)" ::: "memory");
}
__device__ __forceinline__ void tr_item8(const float* W, int N, int k0, int n0, unsigned char* dst, size_t drow0, int dld, float cscale, LAS float* scr, int lane) {
#pragma unroll 1
    for (int ib = 0; ib < 32; ib += 16) { float wv[16];
#pragma unroll
        for (int ii = 0; ii < 16; ++ii) wv[ii] = W[(size_t)(k0 + 2 * (ib + ii) + (lane >> 5)) * N + n0 + (lane & 31)];
#pragma unroll
        for (int ii = 0; ii < 16; ++ii) { const int kk = 2 * (ib + ii) + (lane >> 5); scr[kk * 33 + (lane & 31)] = wv[ii] * cscale; } }
    asm volatile("s_waitcnt lgkmcnt(0)" ::: "memory");
    const int c = lane & 7;
#pragma unroll
    for (int j = 0; j < 4; ++j) { const int n = (lane >> 3) + 8 * j; const LAS float* sp = scr + (8 * c) * 33 + n;
        u32x2 o; o.x = pk4_fp8(sp[0 * 33], sp[1 * 33], sp[2 * 33], sp[3 * 33]); o.y = pk4_fp8(sp[4 * 33], sp[5 * 33], sp[6 * 33], sp[7 * 33]);
        *(u32x2*)(dst + (drow0 + n) * (size_t)dld + k0 + 8 * c) = o; }
    asm volatile("s_waitcnt lgkmcnt(0)" ::: "memory");
}
__device__ __forceinline__ void tr_matrix(const float* W, int K, int N, bf16* dst, int dld, int mode, bf16* dst2, const float* kscale, float cscale, LAS float* scr, int gw, int NGW, int lane) {
    const int nblk = N / 32, nit = (K / 64) * nblk;
    for (int it = gw; it < nit; it += NGW) { const int kb = it / nblk, nb = it % nblk, n0 = 32 * nb; size_t dr; bf16* d = dst;
        if (mode == 0) dr = n0;
        else if (mode == 1) dr = n0 < 416 ? n0 : n0 + 96;
        else if (mode == 2) { const int hq = n0 >> 7, w = n0 & 127; if (w < 64) dr = hq * 64 + w; else { dr = hq * 64 + w - 64; d = dst2; } }
        else if (mode == 3) dr = (size_t)(n0 >> 7) * 256 + (n0 & 127);
        else dr = (size_t)(n0 >> 7) * 256 + 128 + (n0 & 127);
        tr_item(W, N, 64 * kb, n0, d, dr, dld, kscale, cscale, scr, lane); }
}
__device__ __forceinline__ void tr_matrix8(const float* W, int K, int N, unsigned char* dst, int dld, int mode, LAS float* scr, int gw, int NGW, int lane) {
    const int nblk = N / 32, nit = (K / 64) * nblk;
    for (int it = gw; it < nit; it += NGW) { const int kb = it / nblk, nb = it % nblk, n0 = 32 * nb; size_t dr;
        if (mode == 0) dr = n0; else if (mode == 1) dr = n0 < 416 ? n0 : n0 + 96; else if (mode == 3) dr = (size_t)(n0 >> 7) * 256 + (n0 & 127); else dr = (size_t)(n0 >> 7) * 256 + 128 + (n0 & 127);
        tr_item8(W, N, 64 * kb, n0, dst, dr, dld, W8_SCALE, scr, lane); }
}
__device__ __forceinline__ void mod_partial_item(const float* c, const float* cctx, const float* ada_w, float* MODP, int item, LAS float* st, int tid) {
    const int lane = tid & 63, wave = __builtin_amdgcn_readfirstlane(tid >> 6);
    const int li = item / 192, kc = (item / 12) % 16, cg = item % 12, col = cg * 512 + wave * 64 + lane;
    for (int idx = tid; idx < 36 * 64; idx += 512) { const int r = idx >> 6, k = idx & 63; float v = 0.f;
        if (r < 33) { const float x = r < 32 ? c[(size_t)r * D + kc * 64 + k] : cctx[kc * 64 + k]; v = silu_f(x); }
        st[k * 36 + r] = v; }
    __syncthreads();
    float acc[33];
#pragma unroll
    for (int r = 0; r < 33; ++r) acc[r] = 0.f;
    const float* wp = ada_w + ((size_t)li * D + kc * 64) * 6144 + col;
#pragma unroll 1
    for (int kb = 0; kb < 4; ++kb) {
        float wv[16];
#pragma unroll
        for (int kk = 0; kk < 16; ++kk) wv[kk] = wp[(size_t)(kb * 16 + kk) * 6144];
#pragma unroll
        for (int kk = 0; kk < 16; ++kk) { const float w = wv[kk]; const int k = kb * 16 + kk;
#pragma unroll
            for (int q = 0; q < 8; ++q) { const f32x4 sv = *(const LAS f32x4*)(st + k * 36 + 4 * q); acc[4 * q] += sv[0] * w; acc[4 * q + 1] += sv[1] * w; acc[4 * q + 2] += sv[2] * w; acc[4 * q + 3] += sv[3] * w; }
            acc[32] += st[k * 36 + 32] * w; }
    }
#pragma unroll
    for (int r = 0; r < 33; ++r) MODP[(((size_t)kc * 4 + li) * 33 + r) * 6144 + col] = acc[r];
    __syncthreads();
}

constexpr int NPH = 43;
struct Args { const float* in[N_IN]; float* out; unsigned char* ws; int ph_lo, ph_hi; };
#define AIN(i) ((const float*)(const GAS float*)a.in[i])
#define AOUT ((float*)(GAS float*)a.out)

__device__ __forceinline__ void moe_convert(const float* w1, const float* w3, const float* w2, bf16* W13, bf16* W2, LAS float* scr, int gw, int NGW, int lane) {
    constexpr int PER = 1792, TOT = 8 * 3 * PER;
    for (int it = gw; it < TOT; it += NGW) { const int ex = it / (3 * PER), rem = it % (3 * PER), which = rem / PER, j = rem % PER;
        if (which < 2) { const int nblk = DFFE / 32, kb = j / nblk, nb = j % nblk, n0 = 32 * nb;
            const float* W = (which ? w3 : w1) + (size_t)ex * D * DFFE;
            tr_item(W, DFFE, 64 * kb, n0, W13 + (size_t)ex * 7168 * 1024, (size_t)(n0 >> 7) * 256 + which * 128 + (n0 & 127), 1024, nullptr, 1.0f, scr, lane); }
        else { const int nblk = D / 32, kb = j / nblk, nb = j % nblk, n0 = 32 * nb;
            tr_item(w2 + (size_t)ex * DFFE * D, D, 64 * kb, n0, W2 + (size_t)ex * 1024 * DFFE, n0, DFFE, nullptr, 1.0f, scr, lane); } }
}

constexpr int MOE_CV_ITEMS = 8 * 3 * 1792;
constexpr int BG0_MIXIN_E = 1024 * 6, BG0_MIXOUT_E = BG0_MIXIN_E + 1024 * 6, BG0_UP_E = BG0_MIXOUT_E + 512 * 6, BG0_END = BG0_UP_E + 1024 * 14;
constexpr int BG1_DFTS_E = 1024 * 7, BG1_FNET_E = BG1_DFTS_E + 1024 * 6, BG1_MD0_E = BG1_FNET_E + 8064, BG1_MIXIN = BG1_MD0_E + 8064, BG1_END = BG1_MIXIN + 1792 * 6;
static_assert(BG0_END <= MOE_CV_ITEMS && BG1_END <= MOE_CV_ITEMS, "background plan");
__device__ __forceinline__ void moe_convert8(const float* w1, const float* w3, const float* w2, unsigned char* W13, unsigned char* W2, LAS float* scr, int gw, int NGW, int lane, int lo = 0, int hi = MOE_CV_ITEMS) {
    constexpr int PER = 1792;
    for (int it = lo + gw; it < hi; it += NGW) { const int ex = it / (3 * PER), rem = it % (3 * PER), which = rem / PER, j = rem % PER;
        if (which < 2) { const int nblk = DFFE / 32, kb = j / nblk, nb = j % nblk, n0 = 32 * nb;
            const float* W = (which ? w3 : w1) + (size_t)ex * D * DFFE;
            tr_item8(W, DFFE, 64 * kb, n0, W13 + (size_t)ex * 7168 * 1024, (size_t)(n0 >> 7) * 256 + which * 128 + (n0 & 127), 1024, W8_SCALE, scr, lane); }
        else { const int nblk = D / 32, kb = j / nblk, nb = j % nblk, n0 = 32 * nb;
            tr_item8(w2 + (size_t)ex * DFFE * D, D, 64 * kb, n0, W2 + (size_t)ex * 1024 * DFFE, n0, DFFE, W8_SCALE, scr, lane); } }
}

__global__ void __launch_bounds__(512, 2) fwd(Args a) {
    extern __shared__ __attribute__((aligned(16))) unsigned char lds_raw[];
    LAS unsigned char* lds = (LAS unsigned char*)lds_raw;
    volatile LAS unsigned* MISC = (volatile LAS unsigned*)(lds + MISC_OFF);
    const int G = gridDim.x, bid = blockIdx.x, NGW = G * 8;
    unsigned* ctl = (unsigned*)(GAS unsigned*)(a.ws + WS_CTL);
#define WSP_DECL GAS unsigned char* wsg_ = (GAS unsigned char*)a.ws; asm volatile("" : "+s"(wsg_)); unsigned char* wsp = (unsigned char*)wsg_; int tid = threadIdx.x; asm volatile("" : "+v"(tid)); const int lane = tid & 63, wave = __builtin_amdgcn_readfirstlane(tid >> 6), gw = bid * 8 + wave; (void)lane; (void)gw
#define MOD ((float*)(wsp + WS_MOD))
#define ROPEC ((float*)(wsp + WS_ROPE))
#define ROPES (ROPEC + 512)
#define SSQQ ((float*)(wsp + WS_SSQQ))
#define SSQK ((float*)(wsp + WS_SSQK))
#define HMID ((float*)(wsp + WS_HMID))
#define AMID ((float*)(wsp + WS_AMID))
#define LIST ((int*)(wsp + WS_LIST))
#define GLIST ((float*)(wsp + WS_GLIST))
#define WMIXIN ((bf16*)(wsp + WS_WMIXIN))
#define WUQ ((bf16*)(wsp + WS_WUQ))
#define WUK ((bf16*)(wsp + WS_WUK))
#define WUV ((bf16*)(wsp + WS_WUV))
#define WMIXOUT ((bf16*)(wsp + WS_WMIXOUT))
#define WFFN13 ((bf16*)(wsp + WS_WFFN13))
#define WFFN2 ((bf16*)(wsp + WS_WFFN2))
#define WFNET ((bf16*)(wsp + WS_WFNET))
#define WDFTC ((bf16*)(wsp + WS_WDFTC))
#define WDFTL ((bf16*)(wsp + WS_WDFTL))
#define WDFTX ((bf16*)(wsp + WS_WDFTX))
#define WMOE13 ((bf16*)(wsp + WS_WMOE13))
#define WMOE2 ((bf16*)(wsp + WS_WMOE2))
#define WMOE13_8(q) ((unsigned char*)WMOE13 + (BG_ON ? (size_t)(q) * 8 * 7168 * 1024 : (size_t)0))
#define WMOE2_8(q) ((unsigned char*)WMOE2 + (BG_ON ? (size_t)(q) * 8 * 1024 * 3584 : (size_t)0))
#define BG_FILL(T_, q_, lo_, hi_) do { if (BG_ON) { const int lo__ = (lo_), hi__ = (hi_); if (lo__ < hi__) { const int r__ = (T_) % G; \
    if (r__ == 0 || bid >= r__) { const int q__ = (q_); __syncthreads(); \
        moe_convert8(AIN(I_MW1) + (size_t)q__ * 8 * D * DFFE, AIN(I_MW3) + (size_t)q__ * 8 * D * DFFE, AIN(I_MW2) + (size_t)q__ * 8 * DFFE * D, WMOE13_8(q__), WMOE2_8(q__), (LAS float*)(lds + wave * 8448), \
                     (r__ == 0 ? bid : bid - r__) * 8 + wave, (r__ == 0 ? G : G - r__) * 8, lane, lo__, hi__); } } } } while (0)
#define XCUR ((bf16*)(wsp + WS_XCUR))
#define RA ((bf16*)(wsp + WS_RA))
#define CQ ((bf16*)(wsp + WS_RB + RB_CQ))
#define CKV ((bf16*)(wsp + WS_RB + RB_CKV))
#define KR ((bf16*)(wsp + WS_RB + RB_KR))
#define POOL ((bf16*)(wsp + WS_RB + RB_POOL))
#define QB ((bf16*)(wsp + WS_RB + RB_Q))
#define KN ((bf16*)(wsp + WS_RB + RB_KN))
#define VT ((bf16*)(wsp + WS_RB + RB_VT))
#define ZB ((bf16*)(wsp + WS_RB + RB_Z))
#define ZC ((bf16*)(wsp + WS_RB + RB_ZC))
#define ACT ((bf16*)(wsp + WS_RB + RB_ACT))

    const int lo = a.ph_lo, hi = a.ph_hi;
    if (threadIdx.x < 64) MISC[threadIdx.x] = 0u;
    __syncthreads();
    XcdBarrier bar; bar.bar = ctl + CW_BAR; bar.x = 0; bar.st = MISC + 8;
    if (hi - lo > 1) bar = xcd_barrier_post(ctl + CW_BAR, MISC + 8);
#ifndef MK_EN
#define MK_EN 0xFFFFFFFFu
#endif
#define EN(b) (((MK_EN) >> (b)) & 1u)
#ifndef MK_DUP
#define MK_DUP 0u
#endif
#define REP(b) _Pragma("unroll 1") for (int _rep = 0; _rep < ((((MK_DUP) >> (b)) & 1u) ? 2 : 1); ++_rep)
#define IN(p) (lo <= (p) && (p) < hi)
#define SEAM(p) do { if (hi > (p) + 1) { xcd_barrier<false>(bar); if ((MK_DUP >> 12) & 1u) xcd_barrier<false>(bar); } } while (0)
#define SEAM0(p) do { if (hi > (p) + 1) xcd_barrier<true>(bar); } while (0)

    if (EN(0) && IN(0)) REP(11) { WSP_DECL;
        LAS float* scr = (LAS float*)(lds + wave * 8448);
        for (int item = bid; item < 4 * 16 * 12; item += G) mod_partial_item(AIN(I_C), AIN(I_CCTX), AIN(I_ADAW), (float*)(wsp + WS_RB), item, (LAS float*)(lds + 67584), tid);
#pragma unroll 1
        for (int e = 0; e < 2; ++e) {
            if (MK_FP8_MIXIN) tr_matrix8(AIN(I_MIXIN) + (size_t)e * D * 928, D, 928, (unsigned char*)(WMIXIN + (size_t)e * 1024 * 1024), 1024, 1, scr, gw, NGW, lane);
            else tr_matrix(AIN(I_MIXIN) + (size_t)e * D * 928, D, 928, WMIXIN + (size_t)e * 1024 * 1024, 1024, 1, nullptr, nullptr, 1.0f, scr, gw, NGW, lane);
            tr_matrix(AIN(I_WUQ) + (size_t)e * 256 * 768, 256, 768, WUQ + (size_t)e * 768 * 256, 256, 0, nullptr, AIN(I_CQG) + e * 256, QSCALE, scr, gw, NGW, lane);
            tr_matrix(AIN(I_WUKV) + (size_t)e * 128 * 1024, 128, 1024, WUK + (size_t)e * 512 * 128, 128, 2, WUV + (size_t)e * 512 * 128, AIN(I_CKVG) + e * 128, 1.0f, scr, gw, NGW, lane);
            tr_matrix(AIN(I_MIXOUT) + (size_t)e * 1024 * 1024, 512, 1024, WMIXOUT + (size_t)e * 1024 * 1024, 1024, 0, nullptr, nullptr, 1.0f, scr, gw, NGW, lane);
            if (FP8_FFN(2 * e)) {
                tr_matrix8(AIN(I_FW1) + (size_t)e * D * DFF, D, DFF, (unsigned char*)(WFFN13 + (size_t)e * 5632 * 1024), 1024, 3, scr, gw, NGW, lane);
                tr_matrix8(AIN(I_FW3) + (size_t)e * D * DFF, D, DFF, (unsigned char*)(WFFN13 + (size_t)e * 5632 * 1024), 1024, 4, scr, gw, NGW, lane);
                tr_matrix8(AIN(I_FW2) + (size_t)e * DFF * D, DFF, D, (unsigned char*)(WFFN2 + (size_t)e * 1024 * DFF), DFF, 0, scr, gw, NGW, lane);
            } else {
            tr_matrix(AIN(I_FW1) + (size_t)e * D * DFF, D, DFF, WFFN13 + (size_t)e * 5632 * 1024, 1024, 3, nullptr, nullptr, 1.0f, scr, gw, NGW, lane);
            tr_matrix(AIN(I_FW3) + (size_t)e * D * DFF, D, DFF, WFFN13 + (size_t)e * 5632 * 1024, 1024, 4, nullptr, nullptr, 1.0f, scr, gw, NGW, lane);
            tr_matrix(AIN(I_FW2) + (size_t)e * DFF * D, DFF, D, WFFN2 + (size_t)e * 1024 * DFF, DFF, 0, nullptr, nullptr, 1.0f, scr, gw, NGW, lane);
            }
            tr_matrix(AIN(I_FNET) + (size_t)e * D * D, D, D, WFNET + (size_t)e * 1024 * 1024, 1024, 0, nullptr, nullptr, 1.0f, scr, gw, NGW, lane);
            if (MK_FP8_MIXIN) { for (int i = gw * 64 + lane; i < 96 * 1024 / 16; i += NGW * 64) *(u32x4*)((unsigned char*)(WMIXIN + (size_t)e * 1024 * 1024) + 416 * 1024 + (size_t)i * 16) = (u32x4){0u, 0u, 0u, 0u}; }
            else for (int i = gw * 64 + lane; i < 96 * 1024 / 8; i += NGW * 64) *(u32x4*)(WMIXIN + (size_t)e * 1024 * 1024 + 416 * 1024 + (size_t)i * 8) = (u32x4){0u, 0u, 0u, 0u};
            for (int it = gw; it < 4 * 16 * 16; it += NGW) { const int gq = it >> 8, ic = (it >> 4) & 15, nb = it & 15, n = nb * 64 + lane;
                const float* pw = AIN(I_POOLW) + ((size_t)(e * 4 + gq) * 128 + ic * 8) * 128; const float* ps = AIN(I_POOLS) + e * 512 + gq * 128;
                const float* mw = AIN(I_MIXOUT) + ((size_t)e * 1024 + 512 + gq * 128) * 1024 + n;
                float acc[8];
#pragma unroll
                for (int q = 0; q < 8; ++q) acc[q] = 0.f;
#pragma unroll 1
                for (int jb = 0; jb < 128; jb += 16) { float wv[16];
#pragma unroll
                    for (int jj = 0; jj < 16; ++jj) wv[jj] = mw[(size_t)(jb + jj) * 1024];
#pragma unroll
                    for (int jj = 0; jj < 16; ++jj) { const float w = wv[jj] * ps[jb + jj];
#pragma unroll
                        for (int q = 0; q < 8; ++q) acc[q] += pw[q * 128 + jb + jj] * w; } }
                u32x4 o; o.x = pkbf(acc[0], acc[1]); o.y = pkbf(acc[2], acc[3]); o.z = pkbf(acc[4], acc[5]); o.w = pkbf(acc[6], acc[7]);
                *(u32x4*)(WMIXOUT + (size_t)e * 1024 * 1024 + (size_t)n * 1024 + 512 + gq * 128 + ic * 8) = o; }
        }
        const int gt = bid * 512 + tid, NT = G * 512;
        for (int i = gt; i < 2 * 65536; i += NT) { const int ty = i >> 16, m = (i >> 8) & 255, c = i & 255; const float x = (float)((m * c) & 255) * (1.0f / 128.0f);
            WDFTC[i] = (bf16)(pkbf(ty ? sinpif(x) : cospif(x), 0.f) & 0xffffu); }
        if (MK_FP8_DFT) {
            for (int i4 = gt; i4 < 2048 * 2048 / 4; i4 += NT) { float v[4];
#pragma unroll
                for (int q = 0; q < 4; ++q) { const int i = i4 * 4 + q, k = i >> 11, kk = i & 2047;
                    if (kk < 1024) v[q] = __builtin_amdgcn_cosf((float)((k * kk) & 2047) * (1.0f / 2048.0f)); else if (kk == 1024) v[q] = 0.f; else v[q] = -__builtin_amdgcn_sinf((float)((k * (kk - 1024)) & 2047) * (1.0f / 2048.0f)); }
                ((unsigned*)WDFTL)[i4] = pk4_fp8(v[0] * 16.f, v[1] * 16.f, v[2] * 16.f, v[3] * 16.f); }
            for (int i4 = gt; i4 < 65536 / 4; i4 += NT) { float v[4];
#pragma unroll
                for (int q = 0; q < 4; ++q) { const int i = i4 * 4 + q, k = i >> 8, kk = i & 255;
                    if (kk < 128) v[q] = __builtin_amdgcn_cosf((float)((k * kk) & 255) * (1.0f / 256.0f)); else if (kk == 128) v[q] = 0.f; else v[q] = -__builtin_amdgcn_sinf((float)((k * (kk - 128)) & 255) * (1.0f / 256.0f)); }
                ((unsigned*)WDFTX)[i4] = pk4_fp8(v[0] * 16.f, v[1] * 16.f, v[2] * 16.f, v[3] * 16.f); }
        } else {
        for (int i4 = gt; i4 < 2048 * 2048 / 4; i4 += NT) { float v[4];
#pragma unroll
            for (int q = 0; q < 4; ++q) { const int i = i4 * 4 + q, k = i >> 11, kk = i & 2047;
                if (kk < 1024) v[q] = __builtin_amdgcn_cosf((float)((k * kk) & 2047) * (1.0f / 2048.0f)); else if (kk == 1024) v[q] = 0.f; else v[q] = -__builtin_amdgcn_sinf((float)((k * (kk - 1024)) & 2047) * (1.0f / 2048.0f)); }
            u32x2 w; w.x = pkbf(v[0], v[1]); w.y = pkbf(v[2], v[3]); ((u32x2*)WDFTL)[i4] = w; }
        for (int i4 = gt; i4 < 65536 / 4; i4 += NT) { float v[4];
#pragma unroll
            for (int q = 0; q < 4; ++q) { const int i = i4 * 4 + q, k = i >> 8, kk = i & 255;
                if (kk < 128) v[q] = __builtin_amdgcn_cosf((float)((k * kk) & 255) * (1.0f / 256.0f)); else if (kk == 128) v[q] = 0.f; else v[q] = -__builtin_amdgcn_sinf((float)((k * (kk - 128)) & 255) * (1.0f / 256.0f)); }
            u32x2 w; w.x = pkbf(v[0], v[1]); w.y = pkbf(v[2], v[3]); ((u32x2*)WDFTX)[i4] = w; }
        }
        if (gt < 512) { const int pos = gt >> 3, j = gt & 7; const double inv = pow(10000.0, -(double)j / 8.0), ang = (double)pos * inv; ROPEC[gt] = (float)cos(ang); ROPES[gt] = (float)sin(ang); }
    }
    if (lo == 0) SEAM0(0);
    if (IN(1)) { WSP_DECL; const float* MODP = (const float*)(wsp + WS_RB);
        for (int o = bid * 512 + tid; o < 4 * 33 * 6144; o += G * 512) { float sacc = 0.f;
#pragma unroll
            for (int kc = 0; kc < 16; ++kc) sacc += MODP[(size_t)kc * (4 * 33 * 6144) + o];
            const int li = o / (33 * 6144), col = o % 6144;
            MOD[o] = sacc + AIN(I_ADAB)[(size_t)li * 6144 + col]; }
        SEAM(1);
    }

#pragma unroll 1
    for (int i = 0; i < DEPTH; ++i) {
        const int pb = 2 + 10 * i; const bool even = !(i & 1); const int e = i >> 1; const bool ctxn = i < 2;
#define modbase (MOD + (size_t)i * 33 * 6144)
#define XS_MIX (XSrc{AIN(I_X), AIN(I_CTX), (i == 0) ? (const bf16*)nullptr : (const bf16*)XCUR})
#define XS_CUR (XSrc{nullptr, nullptr, (const bf16*)XCUR})
        const int nrows = ctxn ? MALL : MLAT;
        if (EN(1) && IN(pb + 0)) { WSP_DECL;
            if (even) { REP(5) phase_mod_plain(XS_MIX, AIN(I_NMG) + i * D, modbase, 0, 1024, RA, MK_FP8_MIXIN != 0, MALL, gw, NGW, lane); }
            else REP(6) { phase_mod_fold(XS_MIX, AIN(I_NMG) + i * D, modbase, RA, HMID, i == 1, gw, NGW, lane);
                   if (FP8_MOE(i)) moe_convert8(AIN(I_MW1) + (size_t)e * 8 * D * DFFE, AIN(I_MW3) + (size_t)e * 8 * D * DFFE, AIN(I_MW2) + (size_t)e * 8 * DFFE * D, WMOE13_8(e), WMOE2_8(e), (LAS float*)(lds + wave * 8448), gw, NGW, lane, BG_ON ? (e == 0 ? BG0_END : BG1_END) : 0, MOE_CV_ITEMS);
                   else moe_convert(AIN(I_MW1) + (size_t)e * 8 * D * DFFE, AIN(I_MW3) + (size_t)e * 8 * D * DFFE, AIN(I_MW2) + (size_t)e * 8 * DFFE * D, WMOE13, WMOE2, (LAS float*)(lds + wave * 8448), gw, NGW, lane); }
            SEAM(pb + 0);
        }
        if (IN(pb + 1)) { WSP_DECL;
            if (even) { if (EN(2)) { SchedMixIn S{(const char*)RA, (const char*)(WMIXIN + (size_t)e * 1024 * 1024), G, bid, 1024 + (i == 0 ? 128 : 32), i == 0};
                        EpiMixIn E{CQ, CKV, KR, POOL, SSQQ, SSQK, ROPEC, ROPES};
                        REP(16) gm::gemm_phase<EpiMixIn, SchedMixIn, false, MK_FP8_MIXIN != 0>(lds, S, E);
                        BG_FILL(1024 + (i == 0 ? 128 : 32), i == 0 ? 0 : 1, i == 0 ? 0 : BG1_MIXIN, i == 0 ? BG0_MIXIN_E : BG1_END); } }
            else if (EN(3)) { phase_amid(HMID, AMID, lds, G, bid, tid);
                   SchedDftC S{(const char*)WDFTC, (const char*)RA, G, bid, 1024 + (i == 1 ? 256 : 0)}; EpiDftC E{ZB, ZC};
                   REP(17) gm::gemm_phase<EpiDftC, SchedDftC, false>(lds, S, E); }
            SEAM(pb + 1);
        }
        if (IN(pb + 2)) { WSP_DECL;
            if (even) { if (EN(4)) { REP(14) phase_pool(POOL, RA, nrows, gw, NGW, lane);
                        const int nq = (i == 0) ? TALL : TLAT;
                        SchedE3 S{(const char*)CQ, (const char*)CKV, (const char*)(WUQ + (size_t)e * 768 * 256), (const char*)(WUK + (size_t)e * 512 * 128), (const char*)(WUV + (size_t)e * 512 * 128), G, bid, nq, nq * 3 + 1152};
                        EpiE3 E{QB, KN, VT, SSQQ, SSQK, ROPEC, ROPES};
                        REP(15) gm::gemm_phase<EpiE3, SchedE3, false>(lds, S, E); } }
            else if (EN(5)) { SchedDftS S{(const char*)WDFTL, (const char*)WDFTX, (const char*)ZB, (const char*)ZC, G, bid, 1024 + (i == 1 ? 128 : 0)}; EpiDftS E{RA, AMID};
                   REP(18) gm::gemm_phase<EpiDftS, SchedDftS, false, MK_FP8_DFT != 0>(lds, S, E);
                   BG_FILL(1024 + (i == 1 ? 128 : 0), 1, 0, i == 1 ? BG1_DFTS_E : 0); }
            SEAM(pb + 2);
        }
        if (EN(6) && even && IN(pb + 3)) { WSP_DECL;
            const int total = 1024 + (i == 0 ? 128 : 0);
            REP(2) for (int it = 0;; ++it) { const int u = it * G + bid; if (u >= total) break;
                const bool cx = u >= 1024; const int bhp = cx ? u - 1024 : (u & 127), qt = cx ? 0 : (u >> 7), b = bhp >> 2, hp = bhp & 3;
                attn_unit(lds, QB, KN, KR, VT, RA, b, hp, cx ? MLAT + b * LC : b * SEQ + qt * 256, cx ? SEQ : 0, cx ? 4 : 36, tid); }
            SEAM(pb + 3);
        }
        if (EN(7) && IN(pb + 4)) { WSP_DECL;
            SchedResid S{(const char*)RA, (const char*)(even ? WMIXOUT + (size_t)e * 1024 * 1024 : WFNET + (size_t)e * 1024 * 1024), 2048u, 16, nrows / 256, G, bid};
            if ((MK_DUP >> 8) & 1u) { EpiResid Ed{AIN(I_X), AIN(I_CTX), (i == 0) ? (const bf16*)nullptr : (const bf16*)XCUR, (bf16*)AOUT, modbase + 2048, 1.0f}; gm::gemm_phase<EpiResid, SchedResid, false>(lds, S, Ed); }
            EpiResid E{AIN(I_X), AIN(I_CTX), (i == 0) ? (const bf16*)nullptr : (const bf16*)XCUR, XCUR, modbase + 2048, 1.0f};
            gm::gemm_phase<EpiResid, SchedResid, false>(lds, S, E);
            BG_FILL((nrows / 256) * 4, i == 0 ? 0 : 1, i == 0 ? BG0_MIXIN_E : BG1_DFTS_E, i == 0 ? BG0_MIXOUT_E : (i == 1 ? BG1_FNET_E : 0));
            SEAM(pb + 4);
        }
        if (EN(8) && IN(pb + 5)) { WSP_DECL;
            if (even) REP(7) phase_mod2<false>(XS_CUR, AIN(I_NFG) + i * D, modbase, RA, FP8_FFN(i), nrows, nullptr, nullptr, nullptr, nullptr, lds, bid, G, wave, lane, tid);
            else phase_mod2<true>(XS_CUR, AIN(I_NFG) + i * D, modbase, RA, FP8_MOE(i), nrows, AIN(I_ROUTER) + (size_t)e * D * 8, (unsigned*)(wsp + WS_CTL) + CW_CNT + e * 16 * 64, LIST, GLIST, lds, bid, G, wave, lane, tid);
            SEAM(pb + 5);
        }
        if (even) {
            if (EN(9) && IN(pb + 6)) { WSP_DECL;
                if (FP8_FFN(i)) { SchedUp S{(const char*)RA, (const char*)(WFFN13 + (size_t)e * 5632 * 1024), nrows / 256, 22, G, bid, 1024u, 8}; EpiSwiglu8 E{(unsigned char*)ACT, DFF};
                    REP(1) gm::gemm_phase<EpiSwiglu8, SchedUp, false, true>(lds, S, E); }
                else { SchedUp S{(const char*)RA, (const char*)(WFFN13 + (size_t)e * 5632 * 1024), nrows / 256, 22, G, bid, 2048u, 16}; EpiSwiglu E{ACT, DFF};
                    REP(1) gm::gemm_phase<EpiSwiglu, SchedUp, false>(lds, S, E); }
                BG_FILL((nrows / 256) * 22, 0, BG0_MIXOUT_E, i == 0 ? BG0_UP_E : 0);
                SEAM(pb + 6); }
            if (EN(10) && IN(pb + 7)) { WSP_DECL;
                if (FP8_FFN(i)) { SchedResid S{(const char*)ACT, (const char*)(WFFN2 + (size_t)e * 1024 * DFF), (unsigned)DFF, DFF / 128, nrows / 256, G, bid};
                    if ((MK_DUP >> 9) & 1u) { EpiResid Ed{nullptr, nullptr, (const bf16*)XCUR, (bf16*)AOUT, modbase + 5 * 1024, 1.0f / (W8_SCALE * A8_SCALE)}; gm::gemm_phase<EpiResid, SchedResid, false, true>(lds, S, Ed); }
                    EpiResid E{nullptr, nullptr, (const bf16*)XCUR, XCUR, modbase + 5 * 1024, 1.0f / (W8_SCALE * A8_SCALE)};
                    gm::gemm_phase<EpiResid, SchedResid, false, true>(lds, S, E); }
                else { SchedResid S{(const char*)ACT, (const char*)(WFFN2 + (size_t)e * 1024 * DFF), (unsigned)(DFF * 2), DFF / 64, nrows / 256, G, bid};
                    if ((MK_DUP >> 9) & 1u) { EpiResid Ed{nullptr, nullptr, (const bf16*)XCUR, (bf16*)AOUT, modbase + 5 * 1024, 1.0f}; gm::gemm_phase<EpiResid, SchedResid, false>(lds, S, Ed); }
                    EpiResid E{nullptr, nullptr, (const bf16*)XCUR, XCUR, modbase + 5 * 1024, 1.0f};
                    gm::gemm_phase<EpiResid, SchedResid, false>(lds, S, E); }
                BG_FILL((nrows / 256) * 4, 0, BG0_UP_E, i == 0 ? BG0_END : 0);
                SEAM(pb + 7); }
        } else {
#pragma unroll 1
            for (int s = 0; s < 2; ++s) {
                const int cwo = CW_CNT + (e * 16 + s * 8) * 64;
                if (EN(11) && IN(pb + 6 + 2 * s)) { WSP_DECL;
                    if (FP8_MOE(i)) { SchedMoeUp8 S; S.H2 = (const char*)RA; S.W13 = (const char*)WMOE13_8(e); S.list = LIST + (size_t)s * 8 * MALL; moe_info((const unsigned*)(wsp + WS_CTL) + cwo, S.mi); S.G = G; S.c = bid;
                        EpiSwiglu8 E{(unsigned char*)ACT, DFFE};
                        REP(0) gm::gemm_phase<EpiSwiglu8, SchedMoeUp8, true, true>(lds, S, E); }
                    else { SchedMoeUp S; S.H2 = (const char*)RA; S.W13 = (const char*)WMOE13; S.list = LIST + (size_t)s * 8 * MALL; moe_info((const unsigned*)(wsp + WS_CTL) + cwo, S.mi); S.G = G; S.c = bid;
                        EpiSwiglu E{ACT, DFFE};
                        REP(0) gm::gemm_phase<EpiSwiglu, SchedMoeUp, true>(lds, S, E); }
                    SEAM(pb + 6 + 2 * s); }
                if (EN(12) && IN(pb + 7 + 2 * s)) { WSP_DECL;
                    if (FP8_MOE(i)) { SchedMoeDown8 S; S.Ab = (const char*)ACT; S.W2 = (const char*)WMOE2_8(e); moe_info((const unsigned*)(wsp + WS_CTL) + cwo, S.mi); S.G = G; S.c = bid;
                        if ((MK_DUP >> 10) & 1u) { EpiMoeDown Ed{XCUR, modbase + 5 * 1024, LIST + (size_t)s * 8 * MALL, GLIST + (size_t)s * 8 * MALL, 1.0f / (W8_SCALE * A8_SCALE), (bf16*)AOUT}; gm::gemm_phase<EpiMoeDown, SchedMoeDown8, false, true>(lds, S, Ed); }
                        EpiMoeDown E{XCUR, modbase + 5 * 1024, LIST + (size_t)s * 8 * MALL, GLIST + (size_t)s * 8 * MALL, 1.0f / (W8_SCALE * A8_SCALE), XCUR};
                        gm::gemm_phase<EpiMoeDown, SchedMoeDown8, false, true>(lds, S, E);
                        BG_FILL(S.mi.tb[8] * 4, 1, s == 0 ? BG1_FNET_E : BG1_MD0_E, i == 1 ? (s == 0 ? BG1_MD0_E : BG1_MIXIN) : 0); }
                    else { SchedMoeDown S; S.Ab = (const char*)ACT; S.W2 = (const char*)WMOE2; moe_info((const unsigned*)(wsp + WS_CTL) + cwo, S.mi); S.G = G; S.c = bid;
                        EpiMoeDown E{XCUR, modbase + 5 * 1024, LIST + (size_t)s * 8 * MALL, GLIST + (size_t)s * 8 * MALL, 1.0f, XCUR};
                        gm::gemm_phase<EpiMoeDown, SchedMoeDown, false>(lds, S, E); }
                    SEAM(pb + 7 + 2 * s); }
            }
        }
    }
    if (EN(13) && IN(NPH - 1)) { WSP_DECL; phase_final(XCUR, AOUT, AIN(I_FINALG), gw, NGW, lane); }
#undef IN
#undef SEAM
}

extern "C" void kernel_launch(void* const* d_in, const int* in_sizes, int n_in, void* d_out, int out_size, void* d_ws, size_t ws_size, hipStream_t stream) {
    static int grid = 0;
    if (grid == 0) {
        if (n_in != N_IN || out_size != MLAT * D || ws_size < WS_END) { fprintf(stderr, "kernel_launch: unexpected problem (n_in %d, out %d, ws %zu < %zu)\n", n_in, out_size, ws_size, (size_t)WS_END); grid = -1; return; }
        int dev = 0, cus = 0, per_cu = 0;
        if (hipGetDevice(&dev) != hipSuccess || hipDeviceGetAttribute(&cus, hipDeviceAttributeMultiprocessorCount, dev) != hipSuccess) { grid = -1; return; }
        if (hipFuncSetAttribute((const void*)fwd, hipFuncAttributeMaxDynamicSharedMemorySize, LDS_BYTES) != hipSuccess) { fprintf(stderr, "kernel_launch: hipFuncSetAttribute failed\n"); grid = -1; return; }
        if (hipOccupancyMaxActiveBlocksPerMultiprocessor(&per_cu, (const void*)fwd, 512, LDS_BYTES) != hipSuccess || per_cu < 1) fprintf(stderr, "kernel_launch: occupancy query reports %d\n", per_cu);
        (void)hipGetLastError();
        grid = cus;
        if (grid != 256) fprintf(stderr, "kernel_launch: %d CUs (built for 256)\n", grid);
    }
    if (grid < 0) return;
    (void)hipMemsetAsync((char*)d_ws + WS_CTL, 0, CTL_BYTES, stream);
    Args a{};
    for (int i = 0; i < N_IN; ++i) a.in[i] = (const float*)d_in[i];
    a.out = (float*)d_out; a.ws = (unsigned char*)d_ws;
#if MK_PER_PHASE
    for (int p = 0; p < NPH; ++p) {
        const int k = (p - 2) % 10, layer = (p - 2) / 10;
        if (p >= 2 && p < NPH - 1) { const bool even = !(layer & 1); if (even && k >= 8) continue; if (!even && k == 3) continue; }
        a.ph_lo = p; a.ph_hi = p + 1;
        hipLaunchKernelGGL(fwd, dim3(grid), dim3(512), LDS_BYTES, stream, a);
    }
#else
    a.ph_lo = 0; a.ph_hi = NPH;
    hipLaunchKernelGGL(fwd, dim3(grid), dim3(512), LDS_BYTES, stream, a);
#endif
}
```

```cpp
#include <hip/hip_runtime.h>
#include <cstdio>
#include <cstdint>

#ifndef MK_FP8_L1
#define MK_FP8_L1 1
#endif
#define FP8_MOE(i) ((i) == 3 || MK_FP8_L1)
#ifndef MK_BG
#define MK_BG 1
#endif
#define BG_ON (MK_BG && MK_FP8_L1)
#ifndef MK_FP8_DFT
#define MK_FP8_DFT 1
#endif
#ifndef MK_FP8_MIXIN
#define MK_FP8_MIXIN 0
#endif
#ifndef MK_FP8_FFN
#define MK_FP8_FFN 2
#endif
#define FP8_FFN(i) (((MK_FP8_FFN) >> ((i) >> 1)) & 1)
#ifndef MK_DUP
#define MK_DUP 0u
#endif
#ifndef MK_PER_PHASE
#define MK_PER_PHASE 0
#endif

#define LAS __attribute__((address_space(3)))
#define GAS __attribute__((address_space(1)))
typedef unsigned short bf16;
typedef short bf16x8 __attribute__((ext_vector_type(8)));
typedef short s16x4 __attribute__((ext_vector_type(4)));
typedef float f32x4 __attribute__((ext_vector_type(4)));
typedef float f32x2 __attribute__((ext_vector_type(2)));
typedef float f32x16 __attribute__((ext_vector_type(16)));
typedef unsigned u32x4 __attribute__((ext_vector_type(4)));
typedef unsigned u32x2 __attribute__((ext_vector_type(2)));
typedef __bf16 bf16x2_t __attribute__((ext_vector_type(2)));

constexpr int NB = 32, SEQ = 2048, LC = 256, D = 1024, DEPTH = 4;
constexpr int MLAT = NB * SEQ, MCTX = NB * LC, MALL = MLAT + MCTX;
constexpr int TLAT = MLAT / 256, TCTX = MCTX / 256, TALL = MALL / 256;
constexpr int HEADS = 8, QKN = 64, QKR = 32, VD = 64, QLORA = 256, KVLORA = 128;
constexpr int QW = HEADS * (QKN + QKR);
constexpr int NKEY = SEQ + LC;
constexpr int DFF = 2816, DFFE = 3584, NEXP = 8;
constexpr float EPS = 1e-6f;
constexpr float QSCALE = 0.10206207261596577f * 1.4426950408889634f;

enum { I_X = 0, I_C, I_CTX, I_CCTX, I_ADAW, I_ADAB, I_NMG, I_NFG, I_MIXIN, I_CQG, I_CKVG, I_WUQ, I_WUKV, I_POOLW, I_POOLS, I_MIXOUT,
       I_FW1, I_FW3, I_FW2, I_FNET, I_ROUTER, I_MW1, I_MW3, I_MW2, I_FINALG, N_IN };

constexpr size_t al(size_t x) { return (x + 4095) & ~(size_t)4095; }
constexpr size_t WS_CTL = 0, CTL_BYTES = 1u << 20;
constexpr size_t WS_MOD = WS_CTL + CTL_BYTES;
constexpr size_t WS_ROPE = al(WS_MOD + (size_t)DEPTH * 33 * 6 * D * 4);
constexpr size_t WS_SSQQ = al(WS_ROPE + 64 * 16 * 4);
constexpr size_t WS_SSQK = al(WS_SSQQ + (size_t)MALL * 16);
constexpr size_t WS_HMID = al(WS_SSQK + (size_t)MALL * 16);
constexpr size_t WS_AMID = al(WS_HMID + 64 * D * 4);
constexpr size_t WS_LIST = al(WS_AMID + 64 * D * 4);
constexpr size_t WS_GLIST = al(WS_LIST + (size_t)2 * 8 * MALL * 4);
constexpr size_t WS_WMIXIN = al(WS_GLIST + (size_t)2 * 8 * MALL * 4);
constexpr size_t WS_WUQ = al(WS_WMIXIN + (size_t)2 * 1024 * 1024 * 2);
constexpr size_t WS_WUK = al(WS_WUQ + (size_t)2 * 768 * 256 * 2);
constexpr size_t WS_WUV = al(WS_WUK + (size_t)2 * 512 * 128 * 2);
constexpr size_t WS_WMIXOUT = al(WS_WUV + (size_t)2 * 512 * 128 * 2);
constexpr size_t WS_WFFN13 = al(WS_WMIXOUT + (size_t)2 * 1024 * 1024 * 2);
constexpr size_t WS_WFFN2 = al(WS_WFFN13 + (size_t)2 * 5632 * 1024 * 2);
constexpr size_t WS_WFNET = al(WS_WFFN2 + (size_t)2 * 1024 * 2816 * 2);
constexpr size_t WS_WDFTC = al(WS_WFNET + (size_t)2 * 1024 * 1024 * 2);
constexpr size_t WS_WDFTL = al(WS_WDFTC + (size_t)2 * 256 * 256 * 2);
constexpr size_t WS_WDFTX = al(WS_WDFTL + (size_t)2048 * 2048 * 2);
constexpr size_t WS_WMOE13 = al(WS_WDFTX + (size_t)256 * 256 * 2);
constexpr size_t WS_WMOE2 = al(WS_WMOE13 + (size_t)8 * 7168 * 1024 * 2);
constexpr size_t WS_XCUR = al(WS_WMOE2 + (size_t)8 * 1024 * 3584 * 2);
constexpr size_t WS_RA = al(WS_XCUR + (size_t)MALL * D * 2);
constexpr size_t WS_RB = al(WS_RA + (size_t)MALL * D * 2);
constexpr size_t RB_CQ = 0;
constexpr size_t RB_CKV = al(RB_CQ + (size_t)MALL * 256 * 2);
constexpr size_t RB_KR = al(RB_CKV + (size_t)MALL * 128 * 2);
constexpr size_t RB_POOL = al(RB_KR + (size_t)MALL * 32 * 2);
constexpr size_t RB_Q = al(RB_POOL + (size_t)MALL * 512 * 2);
constexpr size_t RB_KN = al(RB_Q + (size_t)MALL * 768 * 2);
constexpr size_t RB_VT = al(RB_KN + (size_t)MALL * 512 * 2);
constexpr size_t RB_EVEN_END = al(RB_VT + (size_t)NB * 512 * NKEY * 2);
constexpr size_t RB_Z = 0;
constexpr size_t RB_ZC = al(RB_Z + (size_t)NB * 4 * 256 * 2048 * 2);
constexpr size_t RB_ACT = 0;
constexpr size_t RB_SIZE = al((size_t)(MALL + 2048) * DFFE * 2);
static_assert(RB_EVEN_END <= RB_SIZE && (size_t)MALL * DFF * 2 <= RB_SIZE && RB_ZC + (size_t)NB * 4 * 256 * 256 * 2 <= RB_SIZE, "region B");
constexpr size_t WS_END = WS_RB + RB_SIZE;
static_assert(WS_END < 1150000000ull, "workspace budget");

constexpr int CW_TMO = 0;
constexpr int CW_BAR = 4096;
constexpr int CW_CNT = 16384;

constexpr int STAGE_BYTES = 131072;
constexpr int ATQ_OFF = 90112;
constexpr int MISC_OFF = 143360;
constexpr int LDS_BYTES = 147456;

__device__ __forceinline__ unsigned pkbf(float lo, float hi) { f32x2 v = {lo, hi}; bf16x2_t b = __builtin_convertvector(v, bf16x2_t); return __builtin_bit_cast(unsigned, b); }
__device__ __forceinline__ float bf2f(unsigned short b) { return __uint_as_float(((unsigned)b) << 16); }
__device__ __forceinline__ float wave_sum(float v) {
#pragma unroll
    for (int o = 1; o < 64; o <<= 1) v += __shfl_xor(v, o);
    return v;
}
__device__ __forceinline__ float silu_f(float x) { return x / (1.0f + __expf(-x)); }

#define XB_TMO      128
#define XB_XCNT(j)  (256  + 64 * (j))
#define XB_XSUB(j)  (1280 + 64 * (j))
#define XB_XGEN(j)  (2304 + 64 * (j))
#define XB_TOP      3328
#define XB_TOPGEN   3392
#define XCD_BAR_WORDS 3456
#define XB_SPIN_CAP (1u << 22)

__device__ __forceinline__ unsigned xb_ld(unsigned* p)              { return __hip_atomic_load(p, __ATOMIC_RELAXED, __HIP_MEMORY_SCOPE_AGENT); }
__device__ __forceinline__ unsigned xb_add(unsigned* p, unsigned v) { return __hip_atomic_fetch_add(p, v, __ATOMIC_RELAXED, __HIP_MEMORY_SCOPE_AGENT); }
__device__ __forceinline__ unsigned xb_xcc_id() { return (unsigned)__builtin_amdgcn_s_getreg((3 << 11) | 20) & 0xFu; }
#define XB_SPIN(cond, bar) do { unsigned _sp = 0; while (cond) { __builtin_amdgcn_s_sleep(1); \
    if ((++_sp & 255u) == 0u) { if (xb_ld(&(bar)[XB_TMO])) break; if (_sp > XB_SPIN_CAP) { atomicAdd(&(bar)[XB_TMO], 1u); break; } } } } while (0)

struct XcdBarrier { unsigned* bar; unsigned x; volatile LAS unsigned* st; };

__device__ __forceinline__ XcdBarrier xcd_barrier_post(unsigned* bar, volatile LAS unsigned* st) {
    XcdBarrier b; b.bar = bar; b.x = xb_xcc_id(); b.st = st;
    if (threadIdx.x == 0) (void)xb_add(&bar[XB_XCNT(b.x)], 1u);
    return b;
}
__device__ __forceinline__ void xcd_barrier_complete(unsigned* bar, unsigned x, unsigned& nloc, unsigned& nx) {
    const unsigned G = gridDim.x * gridDim.y * gridDim.z;
    unsigned sum, cnt, mine, sp = 0u;
    for (;;) {
        sum = 0u; cnt = 0u; mine = 0u;
#pragma unroll
        for (unsigned j = 0; j < 16; ++j) { const unsigned c = xb_ld(&bar[XB_XCNT(j)]); sum += c; cnt += (c > 0u) ? 1u : 0u; mine = (j == x) ? c : mine; }
        if (sum == G) break;
        __builtin_amdgcn_s_sleep(1);
        if ((++sp & 255u) == 0u) { if (xb_ld(&bar[XB_TMO])) break; if (sp > XB_SPIN_CAP) { atomicAdd(&bar[XB_TMO], 1u); break; } }
    }
    nloc = mine > 0u ? mine : 1u; nx = cnt > 0u ? cnt : 1u;
}
template <bool FIRST>
__device__ __forceinline__ void xcd_barrier(const XcdBarrier& b) {
    asm volatile("s_waitcnt vmcnt(0)" ::: "memory");
    __syncthreads();
    if (threadIdx.x == 0) {
        unsigned* bar = b.bar; asm volatile("" : "+s"(bar));
        __builtin_amdgcn_s_waitcnt(0);
        unsigned nloc = b.st[0], nx = b.st[1];
        if constexpr (FIRST) { if (nloc == 0u) { xcd_barrier_complete(bar, b.x, nloc, nx); b.st[0] = nloc; b.st[1] = nx; } }
        const unsigned old = xb_add(&bar[XB_XSUB(b.x)], 1u);
        const unsigned gen = old / nloc;
        if (old + 1u == (gen + 1u) * nloc) {
            __builtin_amdgcn_fence(__ATOMIC_RELEASE, "agent");
            asm volatile("s_waitcnt vmcnt(0)" ::: "memory");
            const unsigned og = xb_add(&bar[XB_TOP], 1u);
            const unsigned tg = og / nx;
            if (og + 1u == (tg + 1u) * nx) xb_add(&bar[XB_TOPGEN], 1u);
            else XB_SPIN(xb_ld(&bar[XB_TOPGEN]) == tg, bar);
            __builtin_amdgcn_fence(__ATOMIC_ACQUIRE, "agent");
            xb_add(&bar[XB_XGEN(b.x)], 1u);
            asm volatile("s_waitcnt vmcnt(0)" ::: "memory");
        } else {
            XB_SPIN(xb_ld(&bar[XB_XGEN(b.x)]) == gen, bar);
            __builtin_amdgcn_fence(__ATOMIC_ACQUIRE, "agent");
            asm volatile("s_waitcnt vmcnt(0)" ::: "memory");
        }
    }
    __syncthreads();
}

namespace gm {
constexpr int BK = 64, HALF = 128, HTB = HALF * BK * 2;
__device__ __forceinline__ int lds_byte(int r, int c) { const int st = (r >> 4) * 2 + (c >> 5), rr = r & 15, cc = c & 31, ob = rr * 64 + cc * 2; return st * 1024 + (ob ^ (((ob >> 9) & 1) << 5)); }
__device__ __forceinline__ void stage_rc(int b, int& R, int& C) { const int st = b / 1024, sb = b % 1024, swz = sb ^ (((sb >> 9) & 1) << 5); R = (st >> 1) * 16 + swz / 64; C = (st & 1) * 32 + (swz % 64) / 2; }
__device__ __forceinline__ int perm32(int rho) { const int n = rho >> 4, i = rho & 15; return 8 * (i >> 2) + 4 * n + (i & 3); }

struct Unit { const char* A; const char* B; unsigned lda, ldb; int nt; int x0, x1, x2, x3; };
typedef int v8i_t __attribute__((ext_vector_type(8))); typedef int v4i_t __attribute__((ext_vector_type(4)));


__device__ __forceinline__ bool flat_index(int i, int G, int c, int total, int& idx) {
    const long Lx = (long)i * G + c; if (Lx >= total) return false;
    int wgid = (int)Lx; const int q = total / 8, r = total % 8, xcd = wgid % 8, off = wgid / 8;
    idx = (xcd < r ? xcd * (q + 1) : r * (q + 1) + (xcd - r) * q) + off; return true;
}
__device__ __forceinline__ void tile_order(int idx, int nM, int nN, int& pm, int& pn) {
    const int nig = 8 * nN, gid = idx / nig, fm = gid * 8, gsz = (nM - fm) < 8 ? (nM - fm) : 8;
    pm = fm + ((idx % nig) % gsz); pn = (idx % nig) / gsz;
}

template <class Epi, class Sched, bool GATHER, bool FP8 = false>
__device__ __forceinline__ void gemm_phase(LAS unsigned char* lds, const Sched& S, const Epi& E) {
    int tid = threadIdx.x; asm volatile("" : "+v"(tid));
    const int wid = __builtin_amdgcn_readfirstlane(tid >> 6), lane = tid & 63, wr = wid >> 2, wc = wid & 3, fr = lane & 15, fq = lane >> 4;
    const unsigned ldsw = (unsigned)wid * 1024u;
    const int aoff = lds_byte(wr * 64 + fr, fq * 8), boff = lds_byte(wc * 32 + fr, fq * 8);
#define G_SA(b, h) (((b) * 2 + (h)) * HTB)
#define G_SB(b, h) ((4 + (b) * 2 + (h)) * HTB)
#define G_LD(ptr, dst) __builtin_amdgcn_global_load_lds((const unsigned*)(ptr), (LAS unsigned*)(dst), 16, 0, 0)
#define G_STAGE_B(bufoff, P, hh, kb) do { const char* _p0 = P##p + (size_t)(kb) + ((hh) ? (size_t)P##s * 128u : (size_t)0); const char* _p1 = _p0 + (size_t)P##s * 64u; \
        asm volatile("" : "+s"(_p0), "+s"(_p1)); \
        G_LD(_p0 + P##v, lds + (bufoff) + ldsw); G_LD(_p1 + P##v, lds + (bufoff) + ldsw + 8192); } while (0)
#define G_STAGE_A(bufoff, P, hh, kb) do { if constexpr (GATHER) { const char* _p = P##p + (size_t)(kb); asm volatile("" : "+s"(_p)); \
        G_LD(_p + P##g[(hh) * 2], lds + (bufoff) + ldsw); G_LD(_p + P##g[(hh) * 2 + 1], lds + (bufoff) + ldsw + 8192); } else { G_STAGE_B(bufoff, P, hh, kb); } } while (0)
#define G_LDA(dst, b, h) do { _Pragma("unroll") for (int m = 0; m < 4; ++m) { const v4i_t _l = *(const LAS v4i_t*)(lds + G_SA(b, h) + aoff + m * 2048), _h = *(const LAS v4i_t*)(lds + G_SA(b, h) + aoff + m * 2048 + 1024); \
        dst[m] = __builtin_shufflevector(_l, _h, 0, 1, 2, 3, 4, 5, 6, 7); } } while (0)
#define G_LDB(dst, b, h) do { _Pragma("unroll") for (int n = 0; n < 2; ++n) { const v4i_t _l = *(const LAS v4i_t*)(lds + G_SB(b, h) + boff + n * 2048), _h = *(const LAS v4i_t*)(lds + G_SB(b, h) + boff + n * 2048 + 1024); \
        dst[n] = __builtin_shufflevector(_l, _h, 0, 1, 2, 3, 4, 5, 6, 7); } } while (0)
#define G_LO(x) __builtin_bit_cast(bf16x8, (v4i_t)__builtin_shufflevector(x, x, 0, 1, 2, 3))
#define G_HI(x) __builtin_bit_cast(bf16x8, (v4i_t)__builtin_shufflevector(x, x, 4, 5, 6, 7))
#define G_MMA(ai, bj, At, Bt) do { __builtin_amdgcn_s_setprio(1); \
        if constexpr (FP8) { _Pragma("unroll") for (int m = 0; m < 4; ++m) _Pragma("unroll") for (int n = 0; n < 2; ++n) \
            asm volatile("v_mfma_f32_16x16x128_f8f6f4 %0, %1, %2, %0" : "+v"(acc[ai][bj][m][n]) : "v"(Bt[n]), "v"(At[m])); } \
        else { _Pragma("unroll") for (int m = 0; m < 4; ++m) _Pragma("unroll") for (int n = 0; n < 2; ++n) { \
            acc[ai][bj][m][n] = __builtin_amdgcn_mfma_f32_16x16x32_bf16(G_LO(Bt[n]), G_LO(At[m]), acc[ai][bj][m][n], 0, 0, 0); \
            acc[ai][bj][m][n] = __builtin_amdgcn_mfma_f32_16x16x32_bf16(G_HI(Bt[n]), G_HI(At[m]), acc[ai][bj][m][n], 0, 0, 0); } } \
        __builtin_amdgcn_s_setprio(0); } while (0)
#define G_WAIT_V(n) asm volatile("s_waitcnt vmcnt(" #n ")" ::: "memory")
#define G_WAIT_L(n) asm volatile("s_waitcnt lgkmcnt(" #n ")" ::: "memory")
#define G_BAR __builtin_amdgcn_s_barrier()
#define G_SCHED __builtin_amdgcn_sched_barrier(0)
#define G_SETUP(P_A, P_B, U) do { int _t = threadIdx.x; asm volatile("" : "+v"(_t)); int R0, C0; stage_rc(_t * 16, R0, C0); const int Rb0 = (R0 & ~31) + perm32(R0 & 31);     \
        P_A##p = (U).A; P_A##s = (U).lda; P_B##p = (U).B; P_B##s = (U).ldb; P_B##v = (unsigned)Rb0 * (U).ldb + (unsigned)C0 * 2u; \
        if constexpr (GATHER) { _Pragma("unroll") for (int _q = 0; _q < 4; ++_q) P_A##g[_q] = (unsigned)S.gather_row((U), R0 + 64 * _q) * (U).lda + (unsigned)C0 * 2u; P_A##v = 0u; } \
        else { P_A##v = (unsigned)R0 * (U).lda + (unsigned)C0 * 2u; } } while (0)
    Unit cur, nxt; int ui = 0;
    if (!S.next(0, cur)) return;
    f32x4 acc[2][2][4][2];
#pragma unroll
    for (int a = 0; a < 2; ++a)
#pragma unroll
        for (int b = 0; b < 2; ++b)
#pragma unroll
            for (int m = 0; m < 4; ++m)
#pragma unroll
                for (int n = 0; n < 2; ++n) acc[a][b][m][n] = (f32x4){0.f, 0.f, 0.f, 0.f};
    v8i_t At[4], B0[2], B1[2];
    const char *cAp, *cBp, *nAp, *nBp; unsigned cAs, cBs, nAs, nBs, cAv, cBv, nAv, nBv; unsigned cAg[4], nAg[4];
#pragma unroll
    for (int q = 0; q < 4; ++q) { cAg[q] = 0u; nAg[q] = 0u; }
    G_SETUP(cA, cB, cur);
    G_STAGE_B(G_SB(0, 0), cB, 0, 0); G_STAGE_B(G_SB(0, 1), cB, 1, 0); G_STAGE_A(G_SA(0, 0), cA, 0, 0); G_STAGE_A(G_SA(0, 1), cA, 1, 0);
    if (wr == 1) G_BAR;
    G_WAIT_V(2); G_BAR;
    G_STAGE_B(G_SB(1, 0), cB, 0, 128); G_STAGE_A(G_SA(1, 0), cA, 0, 128); G_STAGE_B(G_SB(1, 1), cB, 1, 128);
    G_WAIT_V(6); G_BAR;
    for (;;) {
        const bool has_next = S.next(ui + 1, nxt);
        if (has_next) { G_SETUP(nA, nB, nxt); } else { nAp = cAp; nBp = cBp; nAs = cAs; nBs = cBs; nAv = cAv; nBv = cBv;
#pragma unroll
            for (int q = 0; q < 4; ++q) nAg[q] = cAg[q]; }
        int nt = cur.nt; asm volatile("" : "+s"(nt));
        for (int t = 0; t < nt; t += 2) {
            const bool last = (t == nt - 2);
            const size_t k1 = (size_t)(t + 1) * 128;
            G_LDB(B0, 0, 0); G_LDB(B1, 0, 1); G_SCHED; G_LDA(At, 0, 0); G_STAGE_A(G_SA(1, 1), cA, 1, k1);
            G_WAIT_V(8); G_WAIT_L(0); G_BAR; G_MMA(0, 0, At, B0); G_MMA(0, 1, At, B1); G_BAR; G_SCHED;
            G_LDA(At, 0, 1);
            if (last) { G_STAGE_B(G_SB(0, 0), nB, 0, 0); G_STAGE_B(G_SB(0, 1), nB, 1, 0); G_STAGE_A(G_SA(0, 0), nA, 0, 0); }
            else { const size_t k2 = (size_t)(t + 2) * 128; G_STAGE_B(G_SB(0, 0), cB, 0, k2); G_STAGE_B(G_SB(0, 1), cB, 1, k2); G_STAGE_A(G_SA(0, 0), cA, 0, k2); }
            G_WAIT_V(8); G_WAIT_L(0); G_BAR; G_MMA(1, 0, At, B0); G_MMA(1, 1, At, B1); G_BAR; G_SCHED;
            G_LDB(B0, 1, 0); G_LDB(B1, 1, 1); G_SCHED; G_LDA(At, 1, 0);
            if (last) { G_STAGE_A(G_SA(0, 1), nA, 1, 0); } else { const size_t k2 = (size_t)(t + 2) * 128; G_STAGE_A(G_SA(0, 1), cA, 1, k2); }
            G_WAIT_V(8); G_WAIT_L(0); G_BAR; G_MMA(0, 0, At, B0); G_MMA(0, 1, At, B1); G_BAR; G_SCHED;
            G_LDA(At, 1, 1);
            if (last) { G_STAGE_B(G_SB(1, 0), nB, 0, 128); G_STAGE_B(G_SB(1, 1), nB, 1, 128); G_STAGE_A(G_SA(1, 0), nA, 0, 128); }
            else { const size_t k3 = (size_t)(t + 3) * 128; G_STAGE_B(G_SB(1, 0), cB, 0, k3); G_STAGE_B(G_SB(1, 1), cB, 1, k3); G_STAGE_A(G_SA(1, 0), cA, 0, k3); }
            G_WAIT_V(8); G_WAIT_L(0); G_BAR; G_MMA(1, 0, At, B0); G_MMA(1, 1, At, B1); G_BAR; G_SCHED;
        }
        if (wr == 0) G_BAR;
        if constexpr (FP8) asm volatile("s_nop 15\n\ts_nop 15" ::: "memory");
        { int _t = threadIdx.x; asm volatile("" : "+v"(_t)); const int _w = __builtin_amdgcn_readfirstlane(_t >> 6), _l = _t & 63;
          E(acc, cur, _w >> 2, _w & 3, _l & 15, _l >> 4); }
        if (!has_next) break;
#pragma unroll
        for (int a = 0; a < 2; ++a)
#pragma unroll
            for (int b = 0; b < 2; ++b)
#pragma unroll
                for (int m = 0; m < 4; ++m)
#pragma unroll
                    for (int n = 0; n < 2; ++n) acc[a][b][m][n] = (f32x4){0.f, 0.f, 0.f, 0.f};
        if constexpr (FP8) asm volatile("s_nop 7" ::: "memory");
        cur = nxt; cAp = nAp; cBp = nBp; cAs = nAs; cBs = nBs; cAv = nAv; cBv = nBv;
#pragma unroll
        for (int q = 0; q < 4; ++q) cAg[q] = nAg[q];
        ++ui;
        if (wr == 1) G_BAR;
    }
    G_WAIT_V(0);
    G_BAR;
#undef G_SA
#undef G_SB
#undef G_LD
#undef G_STAGE_A
#undef G_STAGE_B
#undef G_LDA
#undef G_LDB
#undef G_MMA
#undef G_WAIT_V
#undef G_WAIT_L
#undef G_BAR
#undef G_SCHED
#undef G_SETUP
}
}

typedef const f32x4 (&AccRef)[2][2][4][2];
__device__ __forceinline__ u32x4 pack8(const f32x4 a, const f32x4 b) { u32x4 w; w.x = pkbf(a[0], a[1]); w.y = pkbf(a[2], a[3]); w.z = pkbf(b[0], b[1]); w.w = pkbf(b[2], b[3]); return w; }

__device__ __forceinline__ void rope8(f32x4& v0, f32x4& v1, int fq, int t, const float* ropeC, const float* ropeS) {
    const int pos = (fq < 2) ? (t >> 6) : (t & 63);
    const f32x4 c0 = *(const f32x4*)(ropeC + pos * 8), c1 = *(const f32x4*)(ropeC + pos * 8 + 4);
    const f32x4 s0 = *(const f32x4*)(ropeS + pos * 8), s1 = *(const f32x4*)(ropeS + pos * 8 + 4);
    f32x4 p0, p1;
#pragma unroll
    for (int j = 0; j < 4; ++j) { p0[j] = __shfl_xor(v0[j], 16); p1[j] = __shfl_xor(v1[j], 16); }
    const float sg = (fq & 1) ? 1.0f : -1.0f;
    v0 = v0 * c0 + (p0 * s0) * sg; v1 = v1 * c1 + (p1 * s1) * sg;
}

struct SchedMixIn {
    const char* H; const char* W; int G, c, total; bool ctx_full;
    __device__ __forceinline__ bool next(int i, gm::Unit& u) const {
        int idx; if (!gm::flat_index(i, G, c, total, idx)) return false;
        int pm, pn;
        if (idx < 1024) gm::tile_order(idx, 256, 4, pm, pn);
        else { const int j = idx - 1024; if (ctx_full) { gm::tile_order(j, 32, 4, pm, pn); pm += 256; } else { pm = 256 + j; pn = 1; } }
        constexpr unsigned P = MK_FP8_MIXIN ? 1024u : 2048u;
        u.A = H + (size_t)pm * 256 * P; u.lda = P; u.B = W + (size_t)pn * 256 * P; u.ldb = P; u.nt = 16 / (MK_FP8_MIXIN ? 2 : 1); u.x0 = pm; u.x1 = pn; u.x2 = 0; u.x3 = 0; return true;
    }
};
struct EpiMixIn {
    bf16 *CQ, *CKV, *KR, *POOL; float *SSQQ, *SSQK; const float *ropeC, *ropeS;
    __device__ __forceinline__ void operator()(AccRef accr, const gm::Unit& u, int wr, int wc, int fr, int fq) const {
        const int pn = u.x1, row0 = u.x0 * 256 + wr * 64 + fr, cl = wc * 32 + fq * 8;
        constexpr float WS = MK_FP8_MIXIN ? (1.0f / 32.0f) : 1.0f;
        f32x4 acc[2][2][4][2];
#pragma unroll
        for (int a_ = 0; a_ < 2; ++a_)
#pragma unroll
            for (int b_ = 0; b_ < 2; ++b_)
#pragma unroll
                for (int m_ = 0; m_ < 4; ++m_)
#pragma unroll
                    for (int n_ = 0; n_ < 2; ++n_) acc[a_][b_][m_][n_] = accr[a_][b_][m_][n_] * WS;
        if (pn == 0) {
#pragma unroll
            for (int ai = 0; ai < 2; ++ai)
#pragma unroll
                for (int m = 0; m < 4; ++m) { const int row = row0 + ai * 128 + m * 16; float ss = 0.f;
#pragma unroll
                    for (int bj = 0; bj < 2; ++bj) { const f32x4 a = acc[ai][bj][m][0], b = acc[ai][bj][m][1];
                        ss += (a[0] * a[0] + a[1] * a[1]) + (a[2] * a[2] + a[3] * a[3]) + (b[0] * b[0] + b[1] * b[1]) + (b[2] * b[2] + b[3] * b[3]);
                        *(u32x4*)(CQ + (size_t)row * 256 + bj * 128 + cl) = pack8(a, b); }
                    ss += __shfl_xor(ss, 16); ss += __shfl_xor(ss, 32);
                    if (fq == 0) SSQQ[(size_t)row * 4 + wc] = ss; }
        } else if (pn == 1) {
            const bool lat = u.x0 < TLAT;
#pragma unroll
            for (int ai = 0; ai < 2; ++ai)
#pragma unroll
                for (int m = 0; m < 4; ++m) { const int row = row0 + ai * 128 + m * 16;
                    const f32x4 a = acc[ai][0][m][0], b = acc[ai][0][m][1];
                    float ss = (a[0] * a[0] + a[1] * a[1]) + (a[2] * a[2] + a[3] * a[3]) + (b[0] * b[0] + b[1] * b[1]) + (b[2] * b[2] + b[3] * b[3]);
                    *(u32x4*)(CKV + (size_t)row * 128 + cl) = pack8(a, b);
                    ss += __shfl_xor(ss, 16); ss += __shfl_xor(ss, 32);
                    if (fq == 0) SSQK[(size_t)row * 4 + wc] = ss;
                    if (wc == 0) { f32x4 r0 = acc[ai][1][m][0], r1 = acc[ai][1][m][1];
                        if (lat) rope8(r0, r1, fq, row & (SEQ - 1), ropeC, ropeS);
                        *(u32x4*)(KR + (size_t)row * 32 + fq * 8) = pack8(r0, r1); } }
        } else {
#pragma unroll
            for (int ai = 0; ai < 2; ++ai)
#pragma unroll
                for (int m = 0; m < 4; ++m) { const int row = row0 + ai * 128 + m * 16;
#pragma unroll
                    for (int bj = 0; bj < 2; ++bj) *(u32x4*)(POOL + (size_t)row * 512 + (pn - 2) * 256 + bj * 128 + cl) = pack8(acc[ai][bj][m][0], acc[ai][bj][m][1]); }
        }
    }
};

struct SchedE3 {
    const char *CQ, *CKV, *WUQ, *WUK, *WUV; int G, c, nq, total;
    __device__ __forceinline__ bool next(int i, gm::Unit& u) const {
        int idx; if (!gm::flat_index(i, G, c, total, idx)) return false;
        int pm, pn; u.x3 = 0;
        if (idx < nq * 3) { gm::tile_order(idx, nq, 3, pm, pn);
            u.A = CQ + (size_t)pm * 256 * 512; u.lda = 512; u.B = WUQ + (size_t)pn * 256 * 512; u.ldb = 512; u.nt = 4; u.x0 = pm; u.x1 = pn; u.x2 = 0; return true; }
        int j = idx - nq * 3;
        if (j < 576) { gm::tile_order(j, 288, 2, pm, pn);
            u.A = CKV + (size_t)pm * 256 * 256; u.lda = 256; u.B = WUK + (size_t)pn * 256 * 256; u.ldb = 256; u.nt = 2; u.x0 = pm; u.x1 = pn; u.x2 = 1; return true; }
        j -= 576; pm = j & 1; pn = j >> 1;
        u.A = WUV + (size_t)pm * 256 * 256; u.lda = 256; u.B = CKV + (size_t)pn * 256 * 256; u.ldb = 256; u.nt = 2; u.x0 = pm; u.x1 = pn; u.x2 = 2; return true;
    }
};
struct EpiE3 {
    bf16 *Q, *KN, *VT; const float *SSQQ, *SSQK, *ropeC, *ropeS;
    __device__ __forceinline__ void operator()(AccRef acc, const gm::Unit& u, int wr, int wc, int fr, int fq) const {
        const int pm = u.x0, pn = u.x1, ty = u.x2, cl = wc * 32 + fq * 8;
        if (ty == 0) {
            const bool lat = pm < TLAT;
            float rq[2][4];
#pragma unroll
            for (int ai = 0; ai < 2; ++ai)
#pragma unroll
                for (int m = 0; m < 4; ++m) { const f32x4 sq = *(const f32x4*)(SSQQ + (size_t)(pm * 256 + wr * 64 + fr + ai * 128 + m * 16) * 4);
                    rq[ai][m] = __builtin_amdgcn_rsqf(((sq[0] + sq[1]) + (sq[2] + sq[3])) * (1.0f / 256.0f) + EPS); }
#pragma unroll
            for (int ai = 0; ai < 2; ++ai)
#pragma unroll
                for (int m = 0; m < 4; ++m) { const int row = pm * 256 + wr * 64 + fr + ai * 128 + m * 16;
#pragma unroll
                    for (int bj = 0; bj < 2; ++bj) { f32x4 a = acc[ai][bj][m][0] * rq[ai][m], b = acc[ai][bj][m][1] * rq[ai][m];
                        const int g32 = 8 * pn + 4 * bj + wc;
                        if (lat && (g32 % 3) == 2) rope8(a, b, fq, row & (SEQ - 1), ropeC, ropeS);
                        *(u32x4*)(Q + (size_t)row * QW + pn * 256 + bj * 128 + cl) = pack8(a, b); } }
        } else if (ty == 1) {
            float rk[2][4];
#pragma unroll
            for (int ai = 0; ai < 2; ++ai)
#pragma unroll
                for (int m = 0; m < 4; ++m) { const f32x4 sq = *(const f32x4*)(SSQK + (size_t)(pm * 256 + wr * 64 + fr + ai * 128 + m * 16) * 4);
                    rk[ai][m] = __builtin_amdgcn_rsqf(((sq[0] + sq[1]) + (sq[2] + sq[3])) * (1.0f / 128.0f) + EPS); }
#pragma unroll
            for (int ai = 0; ai < 2; ++ai)
#pragma unroll
                for (int m = 0; m < 4; ++m) { const int row = pm * 256 + wr * 64 + fr + ai * 128 + m * 16;
#pragma unroll
                    for (int bj = 0; bj < 2; ++bj) *(u32x4*)(KN + (size_t)row * 512 + pn * 256 + bj * 128 + cl) = pack8(acc[ai][bj][m][0] * rk[ai][m], acc[ai][bj][m][1] * rk[ai][m]); }
        } else {
            const int b = pn < TLAT ? (pn >> 3) : (pn - TLAT), key0 = pn < TLAT ? ((pn & 7) * 256) : SEQ;
            f32x4 s0[2], s1[2];
#pragma unroll
            for (int bj = 0; bj < 2; ++bj)
#pragma unroll
                for (int j = 0; j < 8; ++j) { const f32x4 sq = *(const f32x4*)(SSQK + ((size_t)pn * 256 + bj * 128 + cl + j) * 4);
                    const float rk = __builtin_amdgcn_rsqf(((sq[0] + sq[1]) + (sq[2] + sq[3])) * (1.0f / 128.0f) + EPS);
                    if (j < 4) s0[bj][j] = rk; else s1[bj][j - 4] = rk; }
#pragma unroll
            for (int bj = 0; bj < 2; ++bj)
#pragma unroll
                for (int ai = 0; ai < 2; ++ai)
#pragma unroll
                    for (int m = 0; m < 4; ++m) { const int f = pm * 256 + wr * 64 + fr + ai * 128 + m * 16;
                        *(u32x4*)(VT + ((size_t)b * 512 + f) * NKEY + key0 + bj * 128 + cl) = pack8(acc[ai][bj][m][0] * s0[bj], acc[ai][bj][m][1] * s1[bj]); }
        }
    }
};

struct SchedResid {
    const char* A; const char* W; unsigned lda; int nt, nM, G, c;
    __device__ __forceinline__ bool next(int i, gm::Unit& u) const {
        int idx; if (!gm::flat_index(i, G, c, nM * 4, idx)) return false;
        int pm, pn; gm::tile_order(idx, nM, 4, pm, pn);
        u.A = A + (size_t)pm * 256 * lda; u.lda = lda; u.B = W + (size_t)pn * 256 * lda; u.ldb = lda; u.nt = nt; u.x0 = pm; u.x1 = pn; u.x2 = 0; u.x3 = 0; return true;
    }
};
struct EpiResid {
    const float *src_lat, *src_ctx; const bf16* src16; bf16* dst; const float* gate; float ascale;
    __device__ __forceinline__ void operator()(AccRef acc, const gm::Unit& u, int wr, int wc, int fr, int fq) const {
        const int pm = u.x0, pn = u.x1; const bool lat = pm < TLAT;
        const int b = lat ? (pm >> 3) : 32;
        const int col0 = pn * 256 + wc * 32 + fq * 8;
        f32x4 g[2][2];
#pragma unroll
        for (int bj = 0; bj < 2; ++bj) { g[bj][0] = *(const f32x4*)(gate + (size_t)b * 6144 + col0 + bj * 128) * ascale; g[bj][1] = *(const f32x4*)(gate + (size_t)b * 6144 + col0 + bj * 128 + 4) * ascale; }
        if (src16) {
            u32x4 xr[2][4][2];
#pragma unroll
            for (int ai = 0; ai < 2; ++ai)
#pragma unroll
                for (int m = 0; m < 4; ++m)
#pragma unroll
                    for (int bj = 0; bj < 2; ++bj) xr[ai][m][bj] = *(const u32x4*)(src16 + (size_t)(pm * 256 + wr * 64 + fr + ai * 128 + m * 16) * D + col0 + bj * 128);
#pragma unroll
            for (int ai = 0; ai < 2; ++ai)
#pragma unroll
                for (int m = 0; m < 4; ++m) { const size_t off = (size_t)(pm * 256 + wr * 64 + fr + ai * 128 + m * 16) * D + col0;
#pragma unroll
                    for (int bj = 0; bj < 2; ++bj) { const u32x4 w = xr[ai][m][bj];
                        const f32x4 x0 = (f32x4){__uint_as_float(w.x << 16), __uint_as_float(w.x & 0xffff0000u), __uint_as_float(w.y << 16), __uint_as_float(w.y & 0xffff0000u)};
                        const f32x4 x1 = (f32x4){__uint_as_float(w.z << 16), __uint_as_float(w.z & 0xffff0000u), __uint_as_float(w.w << 16), __uint_as_float(w.w & 0xffff0000u)};
                        *(u32x4*)(dst + off + bj * 128) = pack8(x0 + g[bj][0] * acc[ai][bj][m][0], x1 + g[bj][1] * acc[ai][bj][m][1]); } }
        } else {
            const float* sp = lat ? src_lat : src_ctx - (size_t)MLAT * D;
#pragma unroll
            for (int ai = 0; ai < 2; ++ai) {
                f32x4 xf[4][2][2];
#pragma unroll
                for (int m = 0; m < 4; ++m)
#pragma unroll
                    for (int bj = 0; bj < 2; ++bj) { const float* q = sp + (size_t)(pm * 256 + wr * 64 + fr + ai * 128 + m * 16) * D + col0 + bj * 128; xf[m][bj][0] = *(const f32x4*)q; xf[m][bj][1] = *(const f32x4*)(q + 4); }
#pragma unroll
                for (int m = 0; m < 4; ++m) { const size_t off = (size_t)(pm * 256 + wr * 64 + fr + ai * 128 + m * 16) * D + col0;
#pragma unroll
                    for (int bj = 0; bj < 2; ++bj) *(u32x4*)(dst + off + bj * 128) = pack8(xf[m][bj][0] + g[bj][0] * acc[ai][bj][m][0], xf[m][bj][1] + g[bj][1] * acc[ai][bj][m][1]); }
            }
        }
    }
};

struct SchedUp {
    const char* A; const char* W; int nM, nN, G, c; unsigned ld; int nt;
    __device__ __forceinline__ bool next(int i, gm::Unit& u) const {
        int idx; if (!gm::flat_index(i, G, c, nM * nN, idx)) return false;
        int pm, pn; gm::tile_order(idx, nM, nN, pm, pn);
        u.A = A + (size_t)pm * 256 * ld; u.lda = ld; u.B = W + (size_t)pn * 256 * ld; u.ldb = ld; u.nt = nt; u.x0 = pm; u.x1 = pn; u.x2 = 0; u.x3 = 0; return true;
    }
};
__device__ __forceinline__ f32x4 swiglu4s(const f32x4 a, const f32x4 b, float cexp, float cout) {
    const f32x4 t = a * cexp; f32x4 e;
#pragma unroll
    for (int j = 0; j < 4; ++j) e[j] = __builtin_amdgcn_exp2f(t[j]);
    const f32x4 d = e + 1.0f; f32x4 r;
#pragma unroll
    for (int j = 0; j < 4; ++j) r[j] = __builtin_amdgcn_rcpf(d[j]);
    return (a * b) * (r * cout); }
__device__ __forceinline__ f32x4 swiglu4(const f32x4 a, const f32x4 b) { return swiglu4s(a, b, -1.4426950408889634f, 1.0f); }
struct EpiSwiglu {
    bf16* ACT; int ld;
    __device__ __forceinline__ void operator()(AccRef acc, const gm::Unit& u, int wr, int wc, int fr, int fq) const {
        const int row0 = u.x0 * 256 + wr * 64 + fr, col = u.x1 * 128 + wc * 32 + fq * 8;
#pragma unroll
        for (int ai = 0; ai < 2; ++ai)
#pragma unroll
            for (int m = 0; m < 4; ++m)
                *(u32x4*)(ACT + (size_t)(row0 + ai * 128 + m * 16) * ld + col) = pack8(swiglu4(acc[ai][0][m][0], acc[ai][1][m][0]), swiglu4(acc[ai][0][m][1], acc[ai][1][m][1]));
    }
};

struct SchedDftC {
    const char *WC, *HF; int G, c, total;
    __device__ __forceinline__ bool next(int i, gm::Unit& u) const {
        int idx; if (!gm::flat_index(i, G, c, total, idx)) return false;
        u.lda = 512; u.ldb = 2048; u.nt = 4; u.x3 = 0;
        if (idx < 1024) { const int bg = idx >> 3, kt = idx & 7, b = bg >> 2, g = bg & 3, ty = kt < 4 ? 0 : 1;
            u.A = WC + (size_t)ty * 256 * 512; u.B = HF + ((size_t)(b * SEQ + kt * 256) * D + g * 256) * 2; u.x0 = bg; u.x1 = kt; u.x2 = 0; return true; }
        const int j = idx - 1024, bg = j >> 1, ty = j & 1, b = bg >> 2, g = bg & 3;
        u.A = WC + (size_t)ty * 256 * 512; u.B = HF + ((size_t)(MLAT + b * LC) * D + g * 256) * 2; u.x0 = bg; u.x1 = 0; u.x2 = 1 + ty; return true;
    }
};
__device__ __forceinline__ unsigned pk4_fp8(float a, float b, float c, float d);
__device__ __forceinline__ u32x2 pack8_fp8(const f32x4 a, const f32x4 b) { u32x2 w; w.x = pk4_fp8(a[0], a[1], a[2], a[3]); w.y = pk4_fp8(b[0], b[1], b[2], b[3]); return w; }
struct EpiDftC {
    bf16 *Z, *ZC;
    __device__ __forceinline__ void operator()(AccRef acc, const gm::Unit& u, int wr, int wc, int fr, int fq) const {
        const int bg = u.x0, cl = wc * 32 + fq * 8;
        if (MK_FP8_DFT) {
            unsigned char* z8 = (unsigned char*)Z; unsigned char* zc8 = (unsigned char*)ZC;
#pragma unroll
            for (int ai = 0; ai < 2; ++ai)
#pragma unroll
                for (int m = 0; m < 4; ++m) { const int f = wr * 64 + fr + ai * 128 + m * 16;
                    if (u.x2 == 0) {
#pragma unroll
                        for (int bj = 0; bj < 2; ++bj) *(u32x2*)(z8 + ((size_t)bg * 256 + f) * 2048 + u.x1 * 256 + bj * 128 + cl) = pack8_fp8(acc[ai][bj][m][0], acc[ai][bj][m][1]); }
                    else if (u.x2 == 1) *(u32x2*)(zc8 + ((size_t)bg * 256 + f) * 256 + cl) = pack8_fp8(acc[ai][0][m][0], acc[ai][0][m][1]);
                    else *(u32x2*)(zc8 + ((size_t)bg * 256 + f) * 256 + 128 + cl) = pack8_fp8(acc[ai][1][m][0], acc[ai][1][m][1]); }
        } else
        if (u.x2 == 0) {
#pragma unroll
            for (int ai = 0; ai < 2; ++ai)
#pragma unroll
                for (int m = 0; m < 4; ++m) { const int f = wr * 64 + fr + ai * 128 + m * 16;
#pragma unroll
                    for (int bj = 0; bj < 2; ++bj) *(u32x4*)(Z + ((size_t)bg * 256 + f) * 2048 + u.x1 * 256 + bj * 128 + cl) = pack8(acc[ai][bj][m][0], acc[ai][bj][m][1]); }
        } else {
            if (u.x2 == 1) {
#pragma unroll
                for (int ai = 0; ai < 2; ++ai)
#pragma unroll
                    for (int m = 0; m < 4; ++m) { const int f = wr * 64 + fr + ai * 128 + m * 16;
                        *(u32x4*)(ZC + ((size_t)bg * 256 + f) * 256 + cl) = pack8(acc[ai][0][m][0], acc[ai][0][m][1]); }
            } else {
#pragma unroll
                for (int ai = 0; ai < 2; ++ai)
#pragma unroll
                    for (int m = 0; m < 4; ++m) { const int f = wr * 64 + fr + ai * 128 + m * 16;
                        *(u32x4*)(ZC + ((size_t)bg * 256 + f) * 256 + 128 + cl) = pack8(acc[ai][1][m][0], acc[ai][1][m][1]); }
            }
        }
    }
};

struct SchedDftS {
    const char *WL, *WX, *Z, *ZC; int G, c, total;
    __device__ __forceinline__ bool next(int i, gm::Unit& u) const {
        int idx; if (!gm::flat_index(i, G, c, total, idx)) return false;
        u.x3 = 0;
        if (idx < 1024) { const int bg = idx >> 3, kt = idx & 7;
            constexpr unsigned P = MK_FP8_DFT ? 2048u : 4096u;
            u.A = WL + (size_t)kt * 256 * P; u.lda = P; u.B = Z + (size_t)bg * 256 * P; u.ldb = P; u.nt = 32 / (MK_FP8_DFT ? 2 : 1); u.x0 = bg; u.x1 = kt; u.x2 = 0; return true; }
        const int bg = idx - 1024; constexpr unsigned PX = MK_FP8_DFT ? 256u : 512u;
        u.A = WX; u.lda = PX; u.B = ZC + (size_t)bg * 256 * PX; u.ldb = PX; u.nt = 4 / (MK_FP8_DFT ? 2 : 1); u.x0 = bg; u.x1 = 0; u.x2 = 1; return true;
    }
};
struct EpiDftS {
    bf16* F; const float* AMID;
    __device__ __forceinline__ void operator()(AccRef acc, const gm::Unit& u, int wr, int wc, int fr, int fq) const {
        const int bg = u.x0, b = bg >> 2, g = bg & 3, cl = wc * 32 + fq * 8; const bool cx = u.x2 != 0;
        constexpr float TS = MK_FP8_DFT ? (1.0f / 16.0f) : 1.0f;
        const float scale = cx ? (1.0f / 256.0f) : 0.0013810679320049757f;
        const size_t rbase = cx ? (size_t)(MLAT + b * LC) : (size_t)b * SEQ + u.x1 * 256;
        const float* am = AMID + (size_t)(cx ? 32 + b : b) * D + g * 256;
        f32x4 a4[2][2];
#pragma unroll
        for (int bj = 0; bj < 2; ++bj) { a4[bj][0] = *(const f32x4*)(am + bj * 128 + cl); a4[bj][1] = *(const f32x4*)(am + bj * 128 + cl + 4); }
#pragma unroll
        for (int ai = 0; ai < 2; ++ai)
#pragma unroll
            for (int m = 0; m < 4; ++m) { const int k = wr * 64 + fr + ai * 128 + m * 16; const float sg = (k & 1) ? -1.0f : 1.0f;
#pragma unroll
                for (int bj = 0; bj < 2; ++bj)
                    *(u32x4*)(F + (rbase + k) * D + g * 256 + bj * 128 + cl) = pack8((acc[ai][bj][m][0] * TS + a4[bj][0] * sg) * scale, (acc[ai][bj][m][1] * TS + a4[bj][1] * sg) * scale); }
    }
};

constexpr float W8_SCALE = 32.0f, A8_SCALE = 4.0f;
__device__ __forceinline__ unsigned pk4_fp8(float a, float b, float c, float d) {
    a = __builtin_amdgcn_fmed3f(a, -448.f, 448.f); b = __builtin_amdgcn_fmed3f(b, -448.f, 448.f); c = __builtin_amdgcn_fmed3f(c, -448.f, 448.f); d = __builtin_amdgcn_fmed3f(d, -448.f, 448.f);
    int w = 0; w = __builtin_amdgcn_cvt_pk_fp8_f32(a, b, w, false); w = __builtin_amdgcn_cvt_pk_fp8_f32(c, d, w, true); return (unsigned)w; }
struct MoeInfo { int cnt[8]; int tb[9]; };
__device__ __forceinline__ void moe_info(const unsigned* cntw, MoeInfo& mi) {
    mi.tb[0] = 0;
#pragma unroll
    for (int e = 0; e < 8; ++e) { mi.cnt[e] = (int)__builtin_amdgcn_readfirstlane(__hip_atomic_load(cntw + 64 * e, __ATOMIC_RELAXED, __HIP_MEMORY_SCOPE_AGENT)); mi.tb[e + 1] = mi.tb[e] + ((mi.cnt[e] + 255) >> 8); }
}
__device__ __forceinline__ void moe_find(const MoeInfo& mi, int gt, int& e, int& rt, int& cnt) {
    e = 0; rt = gt; cnt = mi.cnt[0];
#pragma unroll
    for (int k = 1; k < 8; ++k) if (gt >= mi.tb[k]) { e = k; rt = gt - mi.tb[k]; cnt = mi.cnt[k]; }
}
struct SchedMoeUp {
    const char *H2, *W13; const int* list; MoeInfo mi; int G, c;
    __device__ __forceinline__ bool next(int i, gm::Unit& u) const {
        int idx; if (!gm::flat_index(i, G, c, mi.tb[8] * 28, idx)) return false;
        int gt, pn; gm::tile_order(idx, mi.tb[8], 28, gt, pn);
        int e, rt, cnt; moe_find(mi, gt, e, rt, cnt);
        u.A = H2; u.lda = 2048; u.B = W13 + ((size_t)e * 7168 + (size_t)pn * 256) * 2048; u.ldb = 2048; u.nt = 16; u.x0 = gt; u.x1 = pn; u.x2 = e * 65536 * 2 + cnt; u.x3 = rt * 256; return true;
    }
    __device__ __forceinline__ int gather_row(const gm::Unit& u, int lr) const {
        const int e = u.x2 >> 17, cnt = u.x2 & 0x1ffff; int j = u.x3 + lr; j = j < cnt ? j : cnt - 1;
        return list[(size_t)e * MALL + j];
    }
};
struct SchedMoeUp8 {
    const char *H2, *W13; const int* list; MoeInfo mi; int G, c;
    __device__ __forceinline__ bool next(int i, gm::Unit& u) const {
        int idx; if (!gm::flat_index(i, G, c, mi.tb[8] * 28, idx)) return false;
        int gt, pn; gm::tile_order(idx, mi.tb[8], 28, gt, pn);
        int e, rt, cnt; moe_find(mi, gt, e, rt, cnt);
        u.A = H2; u.lda = 1024; u.B = W13 + ((size_t)e * 7168 + (size_t)pn * 256) * 1024; u.ldb = 1024; u.nt = 8; u.x0 = gt; u.x1 = pn; u.x2 = e * 65536 * 2 + cnt; u.x3 = rt * 256; return true;
    }
    __device__ __forceinline__ int gather_row(const gm::Unit& u, int lr) const {
        const int e = u.x2 >> 17, cnt = u.x2 & 0x1ffff; int j = u.x3 + lr; j = j < cnt ? j : cnt - 1;
        return list[(size_t)e * MALL + j];
    }
};
struct EpiSwiglu8 {
    unsigned char* ACT8; int ld;
    __device__ __forceinline__ void operator()(AccRef acc, const gm::Unit& u, int wr, int wc, int fr, int fq) const {
        const int row0 = u.x0 * 256 + wr * 64 + fr, col = u.x1 * 128 + wc * 32 + fq * 8;
#pragma unroll 1
        for (int rep_ = 0; rep_ < 1 + (int)((MK_DUP >> 24) & 1u); ++rep_)
#pragma unroll
        for (int ai = 0; ai < 2; ++ai)
#pragma unroll
            for (int m = 0; m < 4; ++m) {
                constexpr float CE = -1.4426950408889634f / W8_SCALE, CO = A8_SCALE / (W8_SCALE * W8_SCALE);
                const f32x4 v0 = swiglu4s(acc[ai][0][m][0], acc[ai][1][m][0], CE, CO), v1 = swiglu4s(acc[ai][0][m][1], acc[ai][1][m][1], CE, CO);
                u32x2 w; w.x = pk4_fp8(v0[0], v0[1], v0[2], v0[3]); w.y = pk4_fp8(v1[0], v1[1], v1[2], v1[3]);
                *(u32x2*)(ACT8 + (size_t)(row0 + ai * 128 + m * 16) * ld + col) = w; }
    }
};
struct SchedMoeDown8 {
    const char *Ab, *W2; MoeInfo mi; int G, c;
    __device__ __forceinline__ bool next(int i, gm::Unit& u) const {
        int idx; if (!gm::flat_index(i, G, c, mi.tb[8] * 4, idx)) return false;
        int gt, pn; gm::tile_order(idx, mi.tb[8], 4, gt, pn);
        int e, rt, cnt; moe_find(mi, gt, e, rt, cnt);
        u.A = Ab + (size_t)gt * 256 * 3584; u.lda = 3584; u.B = W2 + ((size_t)e * 1024 + (size_t)pn * 256) * 3584; u.ldb = 3584; u.nt = 28; u.x0 = gt; u.x1 = pn; u.x2 = e * 65536 * 2 + cnt; u.x3 = rt * 256; return true;
    }
};
struct SchedMoeUpDense {
    const char *H2, *W13; MoeInfo mi; int G, c;
    __device__ __forceinline__ bool next(int i, gm::Unit& u) const {
        int idx; if (!gm::flat_index(i, G, c, mi.tb[8] * 28, idx)) return false;
        int gt, pn; gm::tile_order(idx, mi.tb[8], 28, gt, pn);
        int e, rt, cnt; moe_find(mi, gt, e, rt, cnt);
        u.A = H2 + (size_t)(gt & 255) * 256 * 2048; u.lda = 2048; u.B = W13 + ((size_t)e * 7168 + (size_t)pn * 256) * 2048; u.ldb = 2048; u.nt = 16; u.x0 = gt; u.x1 = pn; u.x2 = 0; u.x3 = 0; return true;
    }
};
struct SchedMoeDown {
    const char *Ab, *W2; MoeInfo mi; int G, c;
    __device__ __forceinline__ bool next(int i, gm::Unit& u) const {
        int idx; if (!gm::flat_index(i, G, c, mi.tb[8] * 4, idx)) return false;
        int gt, pn; gm::tile_order(idx, mi.tb[8], 4, gt, pn);
        int e, rt, cnt; moe_find(mi, gt, e, rt, cnt);
        u.A = Ab + (size_t)gt * 256 * 7168; u.lda = 7168; u.B = W2 + ((size_t)e * 1024 + (size_t)pn * 256) * 7168; u.ldb = 7168; u.nt = 56; u.x0 = gt; u.x1 = pn; u.x2 = e * 65536 * 2 + cnt; u.x3 = rt * 256; return true;
    }
};
struct EpiMoeDown {
    bf16* x16; const float* gate; const int* list; const float* glist; float ascale; bf16* dst16;
    __device__ __forceinline__ void operator()(AccRef acc, const gm::Unit& u, int wr, int wc, int fr, int fq) const {
        const int e = u.x2 >> 17, cnt = u.x2 & 0x1ffff, col0 = u.x1 * 256 + wc * 32 + fq * 8;
        int tok[2][4]; float gv[2][4];
#pragma unroll
        for (int ai = 0; ai < 2; ++ai)
#pragma unroll
            for (int m = 0; m < 4; ++m) { int j = u.x3 + wr * 64 + fr + ai * 128 + m * 16; const bool ok = j < cnt; j = ok ? j : cnt - 1;
                const int t = list[(size_t)e * MALL + j]; tok[ai][m] = ok ? t : -1 - t; gv[ai][m] = glist[(size_t)e * MALL + j] * ascale; }
        u32x4 xr[2][4][2];
#pragma unroll
        for (int ai = 0; ai < 2; ++ai)
#pragma unroll
            for (int m = 0; m < 4; ++m) { const int t = tok[ai][m] < 0 ? -1 - tok[ai][m] : tok[ai][m];
#pragma unroll
                for (int bj = 0; bj < 2; ++bj) xr[ai][m][bj] = *(const u32x4*)(x16 + (size_t)t * D + col0 + bj * 128); }
#pragma unroll
        for (int ai = 0; ai < 2; ++ai)
#pragma unroll
            for (int m = 0; m < 4; ++m) { const int t = tok[ai][m];
                if (t >= 0) { const int b = t < MLAT ? (t >> 11) : 32; const float* gp = gate + (size_t)b * 6144 + col0;
#pragma unroll
                    for (int bj = 0; bj < 2; ++bj) {
                        const f32x4 g0 = *(const f32x4*)(gp + bj * 128) * gv[ai][m], g1 = *(const f32x4*)(gp + bj * 128 + 4) * gv[ai][m];
                        const u32x4 w = xr[ai][m][bj];
                        const f32x4 x0 = (f32x4){__uint_as_float(w.x << 16), __uint_as_float(w.x & 0xffff0000u), __uint_as_float(w.y << 16), __uint_as_float(w.y & 0xffff0000u)};
                        const f32x4 x1 = (f32x4){__uint_as_float(w.z << 16), __uint_as_float(w.z & 0xffff0000u), __uint_as_float(w.w << 16), __uint_as_float(w.w & 0xffff0000u)};
                        *(u32x4*)(dst16 + (size_t)t * D + col0 + bj * 128) = pack8(x0 + g0 * acc[ai][bj][m][0], x1 + g1 * acc[ai][bj][m][1]); } } }
    }
};

struct ModP { f32x4 gm[4]; f32x4 sh[4]; };
__device__ __forceinline__ void load_modp(ModP& p, const float* g, const float* modrow, int off_sh, int off_sc, int lane) {
#pragma unroll
    for (int j = 0; j < 4; ++j) { const int c = 4 * lane + 256 * j;
        const f32x4 g4 = *(const f32x4*)(g + c), sc = *(const f32x4*)(modrow + off_sc + c);
        p.gm[j] = g4 * (sc + 1.0f); p.sh[j] = *(const f32x4*)(modrow + off_sh + c); }
}
struct XSrc { const float* lat; const float* ctx; const bf16* x16; };
__device__ __forceinline__ void load_xrow(const XSrc& xs, int row, int lane, f32x4 (&v)[4]) {
    if (xs.x16) { const u32x2* p = (const u32x2*)(xs.x16 + (size_t)row * D);
#pragma unroll
        for (int j = 0; j < 4; ++j) { const u32x2 w = p[lane + 64 * j]; v[j] = (f32x4){__uint_as_float(w.x << 16), __uint_as_float(w.x & 0xffff0000u), __uint_as_float(w.y << 16), __uint_as_float(w.y & 0xffff0000u)}; } }
    else { const f32x4* p = (const f32x4*)(row < MLAT ? xs.lat + (size_t)row * D : xs.ctx + (size_t)(row - MLAT) * D);
#pragma unroll
        for (int j = 0; j < 4; ++j) v[j] = p[lane + 64 * j]; }
}
struct XRaw { u32x2 w[4]; f32x4 f[4]; };
__device__ __forceinline__ void load_xraw(const XSrc& xs, int row, int lane, XRaw& r) {
    if (xs.x16) { const u32x2* p = (const u32x2*)(xs.x16 + (size_t)row * D);
#pragma unroll
        for (int j = 0; j < 4; ++j) r.w[j] = p[lane + 64 * j]; }
    else { const f32x4* p = (const f32x4*)(row < MLAT ? xs.lat + (size_t)row * D : xs.ctx + (size_t)(row - MLAT) * D);
#pragma unroll
        for (int j = 0; j < 4; ++j) r.f[j] = p[lane + 64 * j]; }
}
__device__ __forceinline__ void mod_row_raw(const XSrc& xs, const XRaw& r, const ModP& p, f32x4 (&h)[4]) {
    f32x4 v[4]; float ss = 0.f;
    if (xs.x16) {
#pragma unroll
        for (int j = 0; j < 4; ++j) { const u32x2 w = r.w[j]; v[j] = (f32x4){__uint_as_float(w.x << 16), __uint_as_float(w.x & 0xffff0000u), __uint_as_float(w.y << 16), __uint_as_float(w.y & 0xffff0000u)}; } }
    else {
#pragma unroll
        for (int j = 0; j < 4; ++j) v[j] = r.f[j]; }
#pragma unroll
    for (int j = 0; j < 4; ++j) ss += (v[j][0] * v[j][0] + v[j][1] * v[j][1]) + (v[j][2] * v[j][2] + v[j][3] * v[j][3]);
    ss = wave_sum(ss);
    const float rr = 1.0f / sqrtf(ss * (1.0f / D) + EPS);
#pragma unroll
    for (int j = 0; j < 4; ++j) h[j] = (v[j] * rr) * p.gm[j] + p.sh[j];
}
__device__ __forceinline__ void mod_row(const XSrc& xs, int row, const ModP& p, int lane, f32x4 (&h)[4]) {
    f32x4 v[4]; float ss = 0.f; load_xrow(xs, row, lane, v);
#pragma unroll
    for (int j = 0; j < 4; ++j) { ss += (v[j][0] * v[j][0] + v[j][1] * v[j][1]) + (v[j][2] * v[j][2] + v[j][3] * v[j][3]); }
    ss = wave_sum(ss);
    const float r = 1.0f / sqrtf(ss * (1.0f / D) + EPS);
#pragma unroll
    for (int j = 0; j < 4; ++j) h[j] = (v[j] * r) * p.gm[j] + p.sh[j];
}
__device__ __forceinline__ void store_row_bf16(bf16* dst, const f32x4 (&h)[4], int lane) {
#pragma unroll
    for (int j = 0; j < 4; ++j) { u32x2 w; w.x = pkbf(h[j][0], h[j][1]); w.y = pkbf(h[j][2], h[j][3]); ((u32x2*)dst)[lane + 64 * j] = w; }
}

__device__ __forceinline__ void phase_mod_plain(const XSrc& xs, const float* g, const float* modbase, int off_sh, int off_sc, bf16* H, bool out8, int nrows, int gw, int NGW, int lane) {
    const int rpw = (nrows + NGW - 1) / NGW; const int r0 = gw * rpw; int r1 = r0 + rpw; if (r1 > nrows) r1 = nrows;
    int curb = -1; ModP p; XRaw cur, nxt; nxt = XRaw{};
    if (r0 < r1) load_xraw(xs, r0, lane, cur);
    for (int row = r0; row < r1; ++row) {
        if (row + 1 < r1) load_xraw(xs, row + 1, lane, nxt);
        const int b = row < MLAT ? (row >> 11) : 32;
        if (b != curb) { load_modp(p, g, modbase + (size_t)b * 6144, off_sh, off_sc, lane); curb = b; }
        f32x4 h[4]; mod_row_raw(xs, cur, p, h); cur = nxt;
        if (out8) { unsigned char* o8 = (unsigned char*)H + (size_t)row * D;
#pragma unroll
            for (int j = 0; j < 4; ++j) ((unsigned*)o8)[lane + 64 * j] = pk4_fp8(h[j][0], h[j][1], h[j][2], h[j][3]); }
        else store_row_bf16(H + (size_t)row * D, h, lane);
    }
}

__device__ __forceinline__ void phase_mod_fold(const XSrc& xs, const float* g, const float* modbase, bf16* HF, float* HMID, bool with_ctx, int gw, int NGW, int lane) {
    constexpr int IL = SEQ / 2 + 1, IC = LC / 2 + 1;
    const int nitems = NB * IL + (with_ctx ? NB * IC : 0);
    const int ipw = (nitems + NGW - 1) / NGW; const int i0 = gw * ipw; int i1 = i0 + ipw; if (i1 > nitems) i1 = nitems;
    int curb = -1; ModP p;
    for (int it = i0; it < i1; ++it) {
        const bool cx = it >= NB * IL; const int j = cx ? it - NB * IL : it;
        const int b = cx ? j / IC : j / IL, n = cx ? j % IC : j % IL, Ls = cx ? LC : SEQ;
        const int mb = cx ? 32 : b, key = cx ? 64 : b;
        if (key != curb) { load_modp(p, g, modbase + (size_t)mb * 6144, 0, 1024, lane); curb = key; }
        const int rbase = cx ? MLAT + b * LC : b * SEQ;
        bf16* hf = HF + (size_t)rbase * D;
        f32x4 h1[4]; mod_row(xs, rbase + n, p, lane, h1);
        if (n == 0) { store_row_bf16(hf, h1, lane); f32x4 z[4];
#pragma unroll
            for (int q = 0; q < 4; ++q) z[q] = (f32x4){0.f, 0.f, 0.f, 0.f};
            store_row_bf16(hf + (size_t)(Ls / 2) * D, z, lane); }
        else if (n == Ls / 2) { float* hm = HMID + (size_t)(cx ? 32 + b : b) * D;
#pragma unroll
            for (int q = 0; q < 4; ++q) ((f32x4*)hm)[lane + 64 * q] = h1[q]; }
        else { f32x4 h2[4]; mod_row(xs, rbase + Ls - n, p, lane, h2); f32x4 s[4], d[4];
#pragma unroll
            for (int q = 0; q < 4; ++q) { s[q] = h1[q] + h2[q]; d[q] = h1[q] - h2[q]; }
            store_row_bf16(hf + (size_t)n * D, s, lane); store_row_bf16(hf + (size_t)(Ls / 2 + n) * D, d, lane); }
    }
}

template <bool ROUTER>
__device__ __forceinline__ void phase_mod2(const XSrc& xs, const float* g, const float* modbase, bf16* H2, bool out8, int nrows,
                                           const float* router_w, unsigned* gcnt, int* list, float* glist, LAS unsigned char* lds, int vcu, int G, int wave, int lane, int tid) {
    const int rpb = nrows / G, rpw = rpb / 8;
    const int r0 = vcu * rpb + wave * rpw;
    LAS float* rwT = (LAS float*)lds; LAS int* bcnt = (LAS int*)(lds + 32768); LAS int* bbase = (LAS int*)(lds + 32768 + 64);
    if constexpr (ROUTER) {
        for (int i = tid; i < 8192; i += 512) { const int c = i >> 3, e = i & 7; rwT[e * 1024 + c] = router_w[i]; }
        if (tid < 16) bcnt[tid] = 0;
        __syncthreads();
    }
    int curb = -1; ModP p; int me0 = -1, me1 = -1; float mp0 = 0.f, mp1 = 0.f; XRaw cur, nxt; nxt = XRaw{};
    load_xraw(xs, r0, lane, cur);
    for (int rr = 0; rr < rpw; ++rr) {
        const int row = r0 + rr; const int b = row < MLAT ? (row >> 11) : 32;
        if (rr + 1 < rpw) load_xraw(xs, row + 1, lane, nxt);
        if (b != curb) { load_modp(p, g, modbase + (size_t)b * 6144, 3072, 4096, lane); curb = b; }
        f32x4 h[4]; mod_row_raw(xs, cur, p, h); cur = nxt;
        if (out8) { unsigned char* o8 = (unsigned char*)H2 + (size_t)row * D;
#pragma unroll
            for (int j = 0; j < 4; ++j) ((unsigned*)o8)[lane + 64 * j] = pk4_fp8(h[j][0], h[j][1], h[j][2], h[j][3]); }
        else store_row_bf16(H2 + (size_t)row * D, h, lane);
        if constexpr (ROUTER) {
            asm volatile("" ::: "memory");
            float lg[8];
#pragma unroll
            for (int e = 0; e < 8; ++e) { float s = 0.f;
#pragma unroll
                for (int j = 0; j < 4; ++j) { const f32x4 w = *(const LAS f32x4*)(rwT + e * 1024 + 4 * lane + 256 * j); s += (h[j][0] * w[0] + h[j][1] * w[1]) + (h[j][2] * w[2] + h[j][3] * w[3]); }
                lg[e] = s; }
            {
                const bool b5 = (lane & 32) != 0, b4 = (lane & 16) != 0, b3 = (lane & 8) != 0;
                float v4[4], v2[2];
#pragma unroll
                for (int j = 0; j < 4; ++j) { const float snd = b5 ? lg[j] : lg[4 + j], kp = b5 ? lg[4 + j] : lg[j]; v4[j] = kp + __shfl_xor(snd, 32); }
#pragma unroll
                for (int j = 0; j < 2; ++j) { const float snd = b4 ? v4[j] : v4[2 + j], kp = b4 ? v4[2 + j] : v4[j]; v2[j] = kp + __shfl_xor(snd, 16); }
                float v1; { const float snd = b3 ? v2[0] : v2[1], kp = b3 ? v2[1] : v2[0]; v1 = kp + __shfl_xor(snd, 8); }
                v1 += __shfl_xor(v1, 4); v1 += __shfl_xor(v1, 2); v1 += __shfl_xor(v1, 1);
#pragma unroll
                for (int e = 0; e < 8; ++e) lg[e] = __uint_as_float((unsigned)__builtin_amdgcn_readlane((int)__float_as_uint(v1), e * 8));
            }
            int e0 = 0; float v0 = lg[0];
#pragma unroll
            for (int e = 1; e < 8; ++e) if (lg[e] > v0) { v0 = lg[e]; e0 = e; }
            int e1 = -1; float v1 = -3.0e38f;
#pragma unroll
            for (int e = 0; e < 8; ++e) if (e != e0 && lg[e] > v1) { v1 = lg[e]; e1 = e; }
            const float p0 = 1.0f / (1.0f + __expf(v1 - v0));
            if (lane == rr) { me0 = e0; me1 = e1; mp0 = p0; mp1 = 1.0f - p0; }
        }
    }
    if constexpr (ROUTER) {
        int rank0 = 0, rank1 = 0, mycnt = 0;
        const unsigned long long lt = (lane == 0) ? 0ull : (~0ull >> (64 - lane));
#pragma unroll
        for (int e = 0; e < 8; ++e) {
            const unsigned long long m0 = __ballot(me0 == e), m1 = __ballot(me1 == e);
            if (me0 == e) rank0 = __popcll(m0 & lt);
            if (me1 == e) rank1 = __popcll(m1 & lt);
            if (lane == e) mycnt = __popcll(m0);
            if (lane == 8 + e) mycnt = __popcll(m1);
        }
        int woff = 0;
        if (lane < 16) woff = __hip_atomic_fetch_add(bcnt + lane, mycnt, __ATOMIC_RELAXED, __HIP_MEMORY_SCOPE_WORKGROUP);
        __syncthreads();
        if (tid < 16) bbase[tid] = (int)__hip_atomic_fetch_add(gcnt + 64 * tid, (unsigned)bcnt[tid], __ATOMIC_RELAXED, __HIP_MEMORY_SCOPE_AGENT);
        __syncthreads();
        const int w0 = __shfl(woff, me0 < 0 ? 0 : me0), w1 = __shfl(woff, me1 < 0 ? 8 : 8 + me1);
        if (me0 >= 0) { const int row = r0 + lane;
            const int p0 = bbase[me0] + w0 + rank0, p1 = bbase[8 + me1] + w1 + rank1;
            list[(size_t)me0 * MALL + p0] = row; glist[(size_t)me0 * MALL + p0] = mp0;
            list[(size_t)(8 + me1) * MALL + p1] = row; glist[(size_t)(8 + me1) * MALL + p1] = mp1; }
        __syncthreads();
    }
}

__device__ __forceinline__ void phase_final(const bf16* x16, float* out, const float* g, int gw, int NGW, int lane) {
    const int rpw = (MLAT + NGW - 1) / NGW; const int r0 = gw * rpw; int r1 = r0 + rpw; if (r1 > MLAT) r1 = MLAT;
    f32x4 g4[4];
#pragma unroll
    for (int j = 0; j < 4; ++j) g4[j] = *(const f32x4*)(g + 4 * lane + 256 * j);
    XSrc xs{nullptr, nullptr, x16};
    for (int row = r0; row < r1; ++row) { f32x4 v[4]; float ss = 0.f; load_xrow(xs, row, lane, v);
#pragma unroll
        for (int j = 0; j < 4; ++j) ss += (v[j][0] * v[j][0] + v[j][1] * v[j][1]) + (v[j][2] * v[j][2] + v[j][3] * v[j][3]);
        ss = wave_sum(ss); const float r = 1.0f / sqrtf(ss * (1.0f / D) + EPS);
#pragma unroll
        for (int j = 0; j < 4; ++j) ((f32x4*)(out + (size_t)row * D))[lane + 64 * j] = (v[j] * r) * g4[j]; }
}

__device__ __forceinline__ void phase_pool(const bf16* POOL, bf16* MIXCAT, int nrows, int gw, int NGW, int lane) {
    const int rs = lane >> 4, cb = lane & 15;
    for (int it = gw; it < (nrows / 64) * 4; it += NGW) { const int seg = it >> 2, g = it & 3, w = 2 << g, hw = w >> 1;
        const int row0 = seg * 64 + rs * 16;
        const int Ls = row0 < MLAT ? SEQ : LC, sb = row0 < MLAT ? (row0 & ~(SEQ - 1)) : (MLAT + ((row0 - MLAT) & ~(LC - 1))), t0 = row0 - sb;
        const bf16* src = POOL + (size_t)sb * 512 + g * 128 + cb * 8; bf16* dstp = MIXCAT + (size_t)sb * D + 512 + g * 128 + cb * 8;
        float s[8];
#pragma unroll
        for (int k = 0; k < 8; ++k) s[k] = 0.f;
        for (int j = 0; j < w; ++j) { const int tt = t0 - hw + j;
            if (tt >= 0 && tt < Ls) { const u32x4 v = *(const u32x4*)(src + (size_t)tt * 512);
#pragma unroll
                for (int k = 0; k < 4; ++k) { s[2 * k] += __uint_as_float(v[k] << 16); s[2 * k + 1] += __uint_as_float(v[k] & 0xffff0000u); } } }
#pragma unroll 4
        for (int q = 0; q < 16; ++q) { const int t = t0 + q;
            int lo = t - hw; if (lo < 0) lo = 0; int hi = t + hw; if (hi > Ls) hi = Ls;
            const u32x4 self = *(const u32x4*)(src + (size_t)t * 512);
            const int tin = t + hw, tout = t - hw;
            u32x4 vin = (u32x4){0u, 0u, 0u, 0u}, vout = (u32x4){0u, 0u, 0u, 0u};
            if (q < 15) { if (tin < Ls) vin = *(const u32x4*)(src + (size_t)tin * 512); if (tout >= 0) vout = *(const u32x4*)(src + (size_t)tout * 512); }
            const float inv = 1.0f / (float)(hi - lo); u32x4 o;
#pragma unroll
            for (int k = 0; k < 4; ++k) o[k] = pkbf(s[2 * k] * inv - __uint_as_float(self[k] << 16), s[2 * k + 1] * inv - __uint_as_float(self[k] & 0xffff0000u));
            *(u32x4*)(dstp + (size_t)t * D) = o;
#pragma unroll
            for (int k = 0; k < 4; ++k) { s[2 * k] += __uint_as_float(vin[k] << 16) - __uint_as_float(vout[k] << 16); s[2 * k + 1] += __uint_as_float(vin[k] & 0xffff0000u) - __uint_as_float(vout[k] & 0xffff0000u); } }
    }
}

__device__ __forceinline__ void phase_amid(const float* HMID_, float* AMID_, LAS unsigned char* lds, int G, int bid, int tid) {
    LAS float* ct = (LAS float*)lds;
    if (tid < 256) ct[tid] = cospif((float)tid * (1.0f / 128.0f));
    __syncthreads();
    for (int o = bid * 512 + tid; o < 64 * 1024; o += G * 512) { const int r = o >> 10, gq = (o >> 8) & 3, m = o & 255;
        const float* hp = HMID_ + (size_t)r * D + gq * 256; float s = 0.f;
#pragma unroll 4
        for (int c = 0; c < 256; ++c) s += hp[c] * ct[(m * c) & 255];
        AMID_[o] = s; }
    __syncthreads();
}

constexpr int AT_KP = 208, AT_VP = 136, AT_VOFF = 64 * AT_KP, AT_BUF = 22528;
__device__ __forceinline__ f32x16 mfma32(bf16x8 a, bf16x8 b, f32x16 c) { return __builtin_amdgcn_mfma_f32_32x32x16_bf16(a, b, c, 0, 0, 0); }
__device__ __forceinline__ bf16x8 pack_s(const f32x16& x, int s) {
    u32x4 p; p.x = pkbf(x[8 * s], x[8 * s + 1]); p.y = pkbf(x[8 * s + 2], x[8 * s + 3]); p.z = pkbf(x[8 * s + 4], x[8 * s + 5]); p.w = pkbf(x[8 * s + 6], x[8 * s + 7]);
    return __builtin_bit_cast(bf16x8, p);
}
#define AT_MX3(a, b, c) __builtin_fmaxf(__builtin_fmaxf((a), (b)), (c))
#define AT_SOFTMAX(S0, S1, M, L, O0, O1, FIRST) do { \
        float ma_ = AT_MX3(S0[0], S0[1], S0[2]), mb_ = AT_MX3(S0[3], S0[4], S0[5]), mc_ = AT_MX3(S1[0], S1[1], S1[2]), md_ = AT_MX3(S1[3], S1[4], S1[5]); \
        ma_ = AT_MX3(ma_, S0[6], S0[7]); mb_ = AT_MX3(mb_, S0[8], S0[9]); mc_ = AT_MX3(mc_, S1[6], S1[7]); md_ = AT_MX3(md_, S1[8], S1[9]); \
        ma_ = AT_MX3(ma_, S0[10], S0[11]); mb_ = AT_MX3(mb_, S0[12], S0[13]); mc_ = AT_MX3(mc_, S1[10], S1[11]); md_ = AT_MX3(md_, S1[12], S1[13]); \
        ma_ = AT_MX3(ma_, S0[14], S0[15]); mc_ = AT_MX3(mc_, S1[14], S1[15]); \
        float mx = __builtin_fmaxf(__builtin_fmaxf(ma_, mb_), __builtin_fmaxf(mc_, md_)); \
        mx = __builtin_fmaxf(mx, __shfl_xor(mx, 32)); \
        if (FIRST) { M += mx; _Pragma("unroll") for (int i_ = 0; i_ < 16; ++i_) { S0[i_] -= mx; S1[i_] -= mx; } } \
        else if (__any(mx > 8.0f)) { const float dl_ = __builtin_fmaxf(mx, 0.f), alpha_ = __builtin_amdgcn_exp2f(-dl_); M += dl_; L *= alpha_; \
            _Pragma("unroll") for (int i_ = 0; i_ < 16; ++i_) { S0[i_] -= dl_; S1[i_] -= dl_; O0[i_] *= alpha_; O1[i_] *= alpha_; } } \
        float pa_ = 0.f, pb_ = 0.f, pc_ = 0.f, pd_ = 0.f; \
        _Pragma("unroll") for (int i_ = 0; i_ < 16; i_ += 2) { S0[i_] = __builtin_amdgcn_exp2f(S0[i_]); S0[i_ + 1] = __builtin_amdgcn_exp2f(S0[i_ + 1]); S1[i_] = __builtin_amdgcn_exp2f(S1[i_]); S1[i_ + 1] = __builtin_amdgcn_exp2f(S1[i_ + 1]); \
            pa_ += S0[i_]; pb_ += S0[i_ + 1]; pc_ += S1[i_]; pd_ += S1[i_ + 1]; } \
        L += (pa_ + pb_) + (pc_ + pd_); } while (0)
__device__ __forceinline__ void attn_store(bf16* op, const f32x16& o0, const f32x16& o1, float inv) {
#pragma unroll
    for (int gq = 0; gq < 4; ++gq) {
        u32x2 w0, w1; w0.x = pkbf(o0[4 * gq] * inv, o0[4 * gq + 1] * inv); w0.y = pkbf(o0[4 * gq + 2] * inv, o0[4 * gq + 3] * inv);
        w1.x = pkbf(o1[4 * gq] * inv, o1[4 * gq + 1] * inv); w1.y = pkbf(o1[4 * gq + 2] * inv, o1[4 * gq + 3] * inv);
        *(u32x2*)(op + 8 * gq) = w0; *(u32x2*)(op + 32 + 8 * gq) = w1; }
}
__device__ __forceinline__ void attn_unit(LAS unsigned char* lds, const bf16* Q, const bf16* KN, const bf16* KR, const bf16* VT, bf16* O,
                                          int b, int hp, int qrow0, int key_lo, int ntiles, int tid) {
    const int lane = tid & 63, r = lane & 31, hh = lane >> 5, wid = __builtin_amdgcn_readfirstlane(tid >> 6), gsel = wid >> 2, wq = wid & 3, gt = tid & 255;
    const int h = hp * 2 + gsel;
    LAS unsigned char* gl = lds + gsel * (2 * AT_BUF);
    const int qrA = qrow0 + wq * 64 + r;
    bf16x8 qa[6];
    LAS unsigned char* qbl = lds + ATQ_OFF + wid * 6656 + r * AT_KP + hh * 16;
#pragma unroll
    for (int c = 0; c < 6; ++c) { qa[c] = *(const bf16x8*)(Q + (size_t)qrA * QW + h * 96 + 16 * c + 8 * hh);
        *(LAS bf16x8*)(qbl + c * 32) = *(const bf16x8*)(Q + (size_t)(qrA + 32) * QW + h * 96 + 16 * c + 8 * hh); }
    f32x16 oA0, oA1, oB0, oB1;
#pragma unroll
    for (int i = 0; i < 16; ++i) { oA0[i] = 0.f; oA1[i] = 0.f; oB0[i] = 0.f; oB1[i] = 0.f; }
    float mA = 0.f, lA = 0.f, mB = 0.f, lB = 0.f;
    const int kkey = gt >> 3, kpc = gt & 7, rkey = gt >> 2, rpc = gt & 3;
    const bf16* vsrc = VT + ((size_t)b * 512 + h * 64 + kkey) * NKEY + kpc * 8;
    u32x4 rk0, rk1, rr, rv0, rv1;
#define AT_LOAD(t) do { const int key0 = key_lo + (t) * 64; const size_t krow = key0 < SEQ ? (size_t)b * SEQ + key0 : (size_t)MLAT + (size_t)b * LC + (key0 - SEQ); \
        rk0 = *(const u32x4*)(KN + (krow + kkey) * 512 + h * 64 + kpc * 8); rk1 = *(const u32x4*)(KN + (krow + kkey + 32) * 512 + h * 64 + kpc * 8); \
        rr = *(const u32x4*)(KR + (krow + rkey) * 32 + rpc * 8); \
        rv0 = *(const u32x4*)(vsrc + key0); rv1 = *(const u32x4*)(vsrc + (size_t)32 * NKEY + key0); } while (0)
#define AT_STORE(bufp) do { *(LAS u32x4*)((bufp) + kkey * AT_KP + kpc * 16) = rk0; *(LAS u32x4*)((bufp) + (kkey + 32) * AT_KP + kpc * 16) = rk1; \
        *(LAS u32x4*)((bufp) + rkey * AT_KP + 128 + rpc * 16) = rr; \
        *(LAS u32x2*)((bufp) + AT_VOFF + kkey * AT_VP + kpc * 16) = (u32x2){rv0.x, rv0.y}; *(LAS u32x2*)((bufp) + AT_VOFF + kkey * AT_VP + kpc * 16 + 8) = (u32x2){rv0.z, rv0.w}; \
        *(LAS u32x2*)((bufp) + AT_VOFF + (kkey + 32) * AT_VP + kpc * 16) = (u32x2){rv1.x, rv1.y}; *(LAS u32x2*)((bufp) + AT_VOFF + (kkey + 32) * AT_VP + kpc * 16 + 8) = (u32x2){rv1.z, rv1.w}; } while (0)
    AT_LOAD(0);
    AT_STORE(gl);
    __syncthreads();
    if (gsel == 1) __syncthreads();
    for (int t = 0; t < ntiles; ++t) {
        LAS unsigned char* buf = gl + (t & 1) * AT_BUF;
        f32x16 sA0, sA1, sB0, sB1;
        const LAS unsigned char* kb = buf + r * AT_KP + hh * 16;
#pragma unroll 1
        for (int rep_ = 0; rep_ < 1 + (int)((MK_DUP >> 25) & 1u); ++rep_) {
#pragma unroll
        for (int i = 0; i < 16; ++i) { sA0[i] = -mA; sA1[i] = -mA; sB0[i] = -mB; sB1[i] = -mB; }
#pragma unroll
        for (int c = 0; c < 6; ++c) {
            const bf16x8 a0 = *(const LAS bf16x8*)(kb + c * 32), a1 = *(const LAS bf16x8*)(kb + 32 * AT_KP + c * 32);
            const bf16x8 qbc = *(const LAS bf16x8*)(qbl + c * 32);
            sA0 = mfma32(a0, qa[c], sA0); sA1 = mfma32(a1, qa[c], sA1); sB0 = mfma32(a0, qbc, sB0); sB1 = mfma32(a1, qbc, sB1);
        }
        asm volatile("" ::: "memory"); }
        AT_SOFTMAX(sA0, sA1, mA, lA, oA0, oA1, t == 0);
        bf16x8 pA[4];
        pA[0] = pack_s(sA0, 0); pA[1] = pack_s(sA0, 1); pA[2] = pack_s(sA1, 0); pA[3] = pack_s(sA1, 1);
        AT_SOFTMAX(sB0, sB1, mB, lB, oB0, oB1, t == 0);
        bf16x8 pB[4];
        pB[0] = pack_s(sB0, 0); pB[1] = pack_s(sB0, 1); pB[2] = pack_s(sB1, 0); pB[3] = pack_s(sB1, 1);
        __syncthreads();
        __builtin_amdgcn_sched_barrier(0);
        if (t + 1 < ntiles) AT_LOAD(t + 1);
        const LAS unsigned char* vb = buf + AT_VOFF + r * AT_VP + hh * 8;
#pragma unroll
        for (int ks = 0; ks < 4; ++ks) {
            const s16x4 l0 = *(const LAS s16x4*)(vb + ks * 32), h0 = *(const LAS s16x4*)(vb + ks * 32 + 16);
            const s16x4 l1 = *(const LAS s16x4*)(vb + 32 * AT_VP + ks * 32), h1 = *(const LAS s16x4*)(vb + 32 * AT_VP + ks * 32 + 16);
            const bf16x8 v0 = __builtin_shufflevector(l0, h0, 0, 1, 2, 3, 4, 5, 6, 7), v1 = __builtin_shufflevector(l1, h1, 0, 1, 2, 3, 4, 5, 6, 7);
            oA0 = mfma32(v0, pA[ks], oA0); oA1 = mfma32(v1, pA[ks], oA1); oB0 = mfma32(v0, pB[ks], oB0); oB1 = mfma32(v1, pB[ks], oB1);
        }
        if (t + 1 < ntiles) { LAS unsigned char* nb = gl + ((t + 1) & 1) * AT_BUF; AT_STORE(nb); }
        __syncthreads();
    }
    if (gsel == 0) __syncthreads();
    lA += __shfl_xor(lA, 32); lB += __shfl_xor(lB, 32);
    attn_store(O + (size_t)qrA * D + h * 64 + 4 * hh, oA0, oA1, 1.0f / lA);
    attn_store(O + (size_t)(qrA + 32) * D + h * 64 + 4 * hh, oB0, oB1, 1.0f / lB);
#undef AT_LOAD
#undef AT_STORE
}
__device__ __forceinline__ void tr_item(const float* W, int N, int k0, int n0, bf16* dst, size_t drow0, int dld, const float* kscale, float cscale, LAS float* scr, int lane) {
#pragma unroll 1
    for (int ib = 0; ib < 32; ib += 16) { float wv[16];
#pragma unroll
        for (int ii = 0; ii < 16; ++ii) wv[ii] = W[(size_t)(k0 + 2 * (ib + ii) + (lane >> 5)) * N + n0 + (lane & 31)];
#pragma unroll
        for (int ii = 0; ii < 16; ++ii) { const int kk = 2 * (ib + ii) + (lane >> 5); float v = wv[ii] * cscale; if (kscale) v *= kscale[k0 + kk]; scr[kk * 33 + (lane & 31)] = v; } }
    asm volatile("s_waitcnt lgkmcnt(0)" ::: "memory");
    const int c = lane & 7;
#pragma unroll
    for (int j = 0; j < 4; ++j) { const int n = (lane >> 3) + 8 * j; const LAS float* s = scr + (8 * c) * 33 + n;
        u32x4 o; o.x = pkbf(s[0 * 33], s[1 * 33]); o.y = pkbf(s[2 * 33], s[3 * 33]); o.z = pkbf(s[4 * 33], s[5 * 33]); o.w = pkbf(s[6 * 33], s[7 * 33]);
        *(u32x4*)(dst + (drow0 + n) * (size_t)dld + k0 + 8 * c) = o; }
    asm volatile("s_waitcnt lgkmcnt(0)" ::: "memory");
}
__device__ __forceinline__ void tr_item8(const float* W, int N, int k0, int n0, unsigned char* dst, size_t drow0, int dld, float cscale, LAS float* scr, int lane) {
#pragma unroll 1
    for (int ib = 0; ib < 32; ib += 16) { float wv[16];
#pragma unroll
        for (int ii = 0; ii < 16; ++ii) wv[ii] = W[(size_t)(k0 + 2 * (ib + ii) + (lane >> 5)) * N + n0 + (lane & 31)];
#pragma unroll
        for (int ii = 0; ii < 16; ++ii) { const int kk = 2 * (ib + ii) + (lane >> 5); scr[kk * 33 + (lane & 31)] = wv[ii] * cscale; } }
    asm volatile("s_waitcnt lgkmcnt(0)" ::: "memory");
    const int c = lane & 7;
#pragma unroll
    for (int j = 0; j < 4; ++j) { const int n = (lane >> 3) + 8 * j; const LAS float* sp = scr + (8 * c) * 33 + n;
        u32x2 o; o.x = pk4_fp8(sp[0 * 33], sp[1 * 33], sp[2 * 33], sp[3 * 33]); o.y = pk4_fp8(sp[4 * 33], sp[5 * 33], sp[6 * 33], sp[7 * 33]);
        *(u32x2*)(dst + (drow0 + n) * (size_t)dld + k0 + 8 * c) = o; }
    asm volatile("s_waitcnt lgkmcnt(0)" ::: "memory");
}
__device__ __forceinline__ void tr_matrix(const float* W, int K, int N, bf16* dst, int dld, int mode, bf16* dst2, const float* kscale, float cscale, LAS float* scr, int gw, int NGW, int lane) {
    const int nblk = N / 32, nit = (K / 64) * nblk;
    for (int it = gw; it < nit; it += NGW) { const int kb = it / nblk, nb = it % nblk, n0 = 32 * nb; size_t dr; bf16* d = dst;
        if (mode == 0) dr = n0;
        else if (mode == 1) dr = n0 < 416 ? n0 : n0 + 96;
        else if (mode == 2) { const int hq = n0 >> 7, w = n0 & 127; if (w < 64) dr = hq * 64 + w; else { dr = hq * 64 + w - 64; d = dst2; } }
        else if (mode == 3) dr = (size_t)(n0 >> 7) * 256 + (n0 & 127);
        else dr = (size_t)(n0 >> 7) * 256 + 128 + (n0 & 127);
        tr_item(W, N, 64 * kb, n0, d, dr, dld, kscale, cscale, scr, lane); }
}
__device__ __forceinline__ void tr_matrix8(const float* W, int K, int N, unsigned char* dst, int dld, int mode, LAS float* scr, int gw, int NGW, int lane) {
    const int nblk = N / 32, nit = (K / 64) * nblk;
    for (int it = gw; it < nit; it += NGW) { const int kb = it / nblk, nb = it % nblk, n0 = 32 * nb; size_t dr;
        if (mode == 0) dr = n0; else if (mode == 1) dr = n0 < 416 ? n0 : n0 + 96; else if (mode == 3) dr = (size_t)(n0 >> 7) * 256 + (n0 & 127); else dr = (size_t)(n0 >> 7) * 256 + 128 + (n0 & 127);
        tr_item8(W, N, 64 * kb, n0, dst, dr, dld, W8_SCALE, scr, lane); }
}
__device__ __forceinline__ void split8(const float* v, bf16x8& hi, bf16x8& lo) {
    u32x4 h, l;
#pragma unroll
    for (int q = 0; q < 4; ++q) { const unsigned ph = pkbf(v[2 * q], v[2 * q + 1]); const float h0 = __uint_as_float(ph << 16), h1 = __uint_as_float(ph & 0xffff0000u);
        h[q] = ph; l[q] = pkbf(v[2 * q] - h0, v[2 * q + 1] - h1); }
    hi = __builtin_bit_cast(bf16x8, h); lo = __builtin_bit_cast(bf16x8, l);
}
__device__ __forceinline__ f32x16 mfma32m(bf16x8 a, bf16x8 b, f32x16 c) { return __builtin_amdgcn_mfma_f32_32x32x16_bf16(a, b, c, 0, 0, 0); }
__device__ __forceinline__ void mod_partial_item(const float* c, const float* cctx, const float* ada_w, float* MODP, int item, LAS float* st, int tid) {
    const int lane = tid & 63, wave = __builtin_amdgcn_readfirstlane(tid >> 6);
    const int li = item / 192, kc = (item / 12) % 16, cg = item % 12;
    for (int idx = tid; idx < 36 * 64; idx += 512) { const int r = idx >> 6, k = idx & 63; float v = 0.f;
        if (r < 33) { const float x = r < 32 ? c[(size_t)r * D + kc * 64 + k] : cctx[kc * 64 + k]; v = silu_f(x); }
        st[k * 36 + r] = v; }
    __syncthreads();
    const int m = lane & 31, kg = lane >> 5;
    bf16x8 ah[2][4], al[2][4];
#pragma unroll
    for (int ks = 0; ks < 4; ++ks) { float v0[8], v1[8];
#pragma unroll
        for (int j = 0; j < 8; ++j) { const int k = ks * 16 + kg * 8 + j; v0[j] = st[k * 36 + m]; const float x = st[k * 36 + 32]; v1[j] = m == 0 ? x : 0.f; }
        split8(v0, ah[0][ks], al[0][ks]); split8(v1, ah[1][ks], al[1][ks]); }
#pragma unroll 1
    for (int cb = 0; cb < 2; ++cb) {
        const int col = cg * 512 + wave * 64 + cb * 32 + m;
        const float* wp = ada_w + ((size_t)li * D + kc * 64 + kg * 8) * 6144 + col;
        float w[32];
#pragma unroll
        for (int ks = 0; ks < 4; ++ks)
#pragma unroll
            for (int j = 0; j < 8; ++j) w[ks * 8 + j] = wp[(size_t)(ks * 16 + j) * 6144];
        f32x16 a0, a1;
#pragma unroll
        for (int i = 0; i < 16; ++i) { a0[i] = 0.f; a1[i] = 0.f; }
#pragma unroll
        for (int ks = 0; ks < 4; ++ks) { bf16x8 bh, bl; split8(&w[ks * 8], bh, bl);
            a0 = mfma32m(ah[0][ks], bh, a0); a0 = mfma32m(ah[0][ks], bl, a0); a0 = mfma32m(al[0][ks], bh, a0);
            a1 = mfma32m(ah[1][ks], bh, a1); a1 = mfma32m(ah[1][ks], bl, a1); a1 = mfma32m(al[1][ks], bh, a1); }
        float* mp = MODP + (((size_t)kc * 4 + li) * 33) * 6144 + col;
#pragma unroll
        for (int i = 0; i < 16; ++i) mp[(size_t)(8 * (i >> 2) + 4 * kg + (i & 3)) * 6144] = a0[i];
        if (kg == 0) mp[(size_t)32 * 6144] = a1[0];
    }
    __syncthreads();
}

constexpr int NPH = 43;
struct Args { const float* in[N_IN]; float* out; unsigned char* ws; int ph_lo, ph_hi; };
#define AIN(i) ((const float*)(const GAS float*)a.in[i])
#define AOUT ((float*)(GAS float*)a.out)

__device__ __forceinline__ void moe_convert(const float* w1, const float* w3, const float* w2, bf16* W13, bf16* W2, LAS float* scr, int gw, int NGW, int lane) {
    constexpr int PER = 1792, TOT = 8 * 3 * PER;
    for (int it = gw; it < TOT; it += NGW) { const int ex = it / (3 * PER), rem = it % (3 * PER), which = rem / PER, j = rem % PER;
        if (which < 2) { const int nblk = DFFE / 32, kb = j / nblk, nb = j % nblk, n0 = 32 * nb;
            const float* W = (which ? w3 : w1) + (size_t)ex * D * DFFE;
            tr_item(W, DFFE, 64 * kb, n0, W13 + (size_t)ex * 7168 * 1024, (size_t)(n0 >> 7) * 256 + which * 128 + (n0 & 127), 1024, nullptr, 1.0f, scr, lane); }
        else { const int nblk = D / 32, kb = j / nblk, nb = j % nblk, n0 = 32 * nb;
            tr_item(w2 + (size_t)ex * DFFE * D, D, 64 * kb, n0, W2 + (size_t)ex * 1024 * DFFE, n0, DFFE, nullptr, 1.0f, scr, lane); } }
}

constexpr int MOE_CV_ITEMS = 8 * 3 * 1792;
constexpr int BG0_MIXIN_E = 1024 * 6, BG0_MIXOUT_E = BG0_MIXIN_E + 1024 * 6, BG0_UP_E = BG0_MIXOUT_E + 512 * 6, BG0_END = BG0_UP_E + 1024 * 14;
constexpr int BG1_DFTS_E = 1024 * 7, BG1_FNET_E = BG1_DFTS_E + 1024 * 6, BG1_MD0_E = BG1_FNET_E + 8064, BG1_MIXIN = BG1_MD0_E + 8064, BG1_END = BG1_MIXIN + 1792 * 6;
static_assert(BG0_END <= MOE_CV_ITEMS && BG1_END <= MOE_CV_ITEMS, "background plan");
__device__ __forceinline__ void moe_convert8(const float* w1, const float* w3, const float* w2, unsigned char* W13, unsigned char* W2, LAS float* scr, int gw, int NGW, int lane, int lo = 0, int hi = MOE_CV_ITEMS) {
    constexpr int PER = 1792;
    for (int it = lo + gw; it < hi; it += NGW) { const int ex = it / (3 * PER), rem = it % (3 * PER), which = rem / PER, j = rem % PER;
        if (which < 2) { const int nblk = DFFE / 32, kb = j / nblk, nb = j % nblk, n0 = 32 * nb;
            const float* W = (which ? w3 : w1) + (size_t)ex * D * DFFE;
            tr_item8(W, DFFE, 64 * kb, n0, W13 + (size_t)ex * 7168 * 1024, (size_t)(n0 >> 7) * 256 + which * 128 + (n0 & 127), 1024, W8_SCALE, scr, lane); }
        else { const int nblk = D / 32, kb = j / nblk, nb = j % nblk, n0 = 32 * nb;
            tr_item8(w2 + (size_t)ex * DFFE * D, D, 64 * kb, n0, W2 + (size_t)ex * 1024 * DFFE, n0, DFFE, W8_SCALE, scr, lane); } }
}

__global__ void __launch_bounds__(512, 2) fwd(Args a) {
    extern __shared__ __attribute__((aligned(16))) unsigned char lds_raw[];
    LAS unsigned char* lds = (LAS unsigned char*)lds_raw;
    volatile LAS unsigned* MISC = (volatile LAS unsigned*)(lds + MISC_OFF);
    const int G = gridDim.x, bid = blockIdx.x, NGW = G * 8;
    unsigned* ctl = (unsigned*)(GAS unsigned*)(a.ws + WS_CTL);
#define WSP_DECL GAS unsigned char* wsg_ = (GAS unsigned char*)a.ws; asm volatile("" : "+s"(wsg_)); unsigned char* wsp = (unsigned char*)wsg_; int tid = threadIdx.x; asm volatile("" : "+v"(tid)); const int lane = tid & 63, wave = __builtin_amdgcn_readfirstlane(tid >> 6), gw = bid * 8 + wave; (void)lane; (void)gw
#define MOD ((float*)(wsp + WS_MOD))
#define ROPEC ((float*)(wsp + WS_ROPE))
#define ROPES (ROPEC + 512)
#define SSQQ ((float*)(wsp + WS_SSQQ))
#define SSQK ((float*)(wsp + WS_SSQK))
#define HMID ((float*)(wsp + WS_HMID))
#define AMID ((float*)(wsp + WS_AMID))
#define LIST ((int*)(wsp + WS_LIST))
#define GLIST ((float*)(wsp + WS_GLIST))
#define WMIXIN ((bf16*)(wsp + WS_WMIXIN))
#define WUQ ((bf16*)(wsp + WS_WUQ))
#define WUK ((bf16*)(wsp + WS_WUK))
#define WUV ((bf16*)(wsp + WS_WUV))
#define WMIXOUT ((bf16*)(wsp + WS_WMIXOUT))
#define WFFN13 ((bf16*)(wsp + WS_WFFN13))
#define WFFN2 ((bf16*)(wsp + WS_WFFN2))
#define WFNET ((bf16*)(wsp + WS_WFNET))
#define WDFTC ((bf16*)(wsp + WS_WDFTC))
#define WDFTL ((bf16*)(wsp + WS_WDFTL))
#define WDFTX ((bf16*)(wsp + WS_WDFTX))
#define WMOE13 ((bf16*)(wsp + WS_WMOE13))
#define WMOE2 ((bf16*)(wsp + WS_WMOE2))
#define WMOE13_8(q) ((unsigned char*)WMOE13 + (BG_ON ? (size_t)(q) * 8 * 7168 * 1024 : (size_t)0))
#define WMOE2_8(q) ((unsigned char*)WMOE2 + (BG_ON ? (size_t)(q) * 8 * 1024 * 3584 : (size_t)0))
#define BG_FILL(T_, q_, lo_, hi_) do { if (BG_ON) { const int lo__ = (lo_), hi__ = (hi_); if (lo__ < hi__) { const int r__ = (T_) % G; \
    if (r__ == 0 || bid >= r__) { const int q__ = (q_); __syncthreads(); \
        moe_convert8(AIN(I_MW1) + (size_t)q__ * 8 * D * DFFE, AIN(I_MW3) + (size_t)q__ * 8 * D * DFFE, AIN(I_MW2) + (size_t)q__ * 8 * DFFE * D, WMOE13_8(q__), WMOE2_8(q__), (LAS float*)(lds + wave * 8448), \
                     (r__ == 0 ? bid : bid - r__) * 8 + wave, (r__ == 0 ? G : G - r__) * 8, lane, lo__, hi__); } } } } while (0)
#define XCUR ((bf16*)(wsp + WS_XCUR))
#define RA ((bf16*)(wsp + WS_RA))
#define CQ ((bf16*)(wsp + WS_RB + RB_CQ))
#define CKV ((bf16*)(wsp + WS_RB + RB_CKV))
#define KR ((bf16*)(wsp + WS_RB + RB_KR))
#define POOL ((bf16*)(wsp + WS_RB + RB_POOL))
#define QB ((bf16*)(wsp + WS_RB + RB_Q))
#define KN ((bf16*)(wsp + WS_RB + RB_KN))
#define VT ((bf16*)(wsp + WS_RB + RB_VT))
#define ZB ((bf16*)(wsp + WS_RB + RB_Z))
#define ZC ((bf16*)(wsp + WS_RB + RB_ZC))
#define ACT ((bf16*)(wsp + WS_RB + RB_ACT))

    const int lo = a.ph_lo, hi = a.ph_hi;
    if (threadIdx.x < 64) MISC[threadIdx.x] = 0u;
    __syncthreads();
    XcdBarrier bar; bar.bar = ctl + CW_BAR; bar.x = 0; bar.st = MISC + 8;
    if (hi - lo > 1) bar = xcd_barrier_post(ctl + CW_BAR, MISC + 8);
#ifndef MK_EN
#define MK_EN 0xFFFFFFFFu
#endif
#define EN(b) (((MK_EN) >> (b)) & 1u)
#ifndef MK_DUP
#define MK_DUP 0u
#endif
#define REP(b) _Pragma("unroll 1") for (int _rep = 0; _rep < ((((MK_DUP) >> (b)) & 1u) ? 2 : 1); ++_rep)
#define IN(p) (lo <= (p) && (p) < hi)
#define SEAM(p) do { if (hi > (p) + 1) { xcd_barrier<false>(bar); if ((MK_DUP >> 12) & 1u) xcd_barrier<false>(bar); } } while (0)
#define SEAM0(p) do { if (hi > (p) + 1) xcd_barrier<true>(bar); } while (0)

    if (EN(0) && IN(0)) REP(11) { WSP_DECL;
        LAS float* scr = (LAS float*)(lds + wave * 8448);
        for (int item = bid; item < 4 * 16 * 12; item += G) mod_partial_item(AIN(I_C), AIN(I_CCTX), AIN(I_ADAW), (float*)(wsp + WS_RB), item, (LAS float*)(lds + 67584), tid);
        int gwr = gw;
#define ADV(nit) gwr = (gwr - ((nit) % NGW) + NGW) % NGW
#pragma unroll 1
        for (int e = 0; e < 2; ++e) {
            if (MK_FP8_MIXIN) tr_matrix8(AIN(I_MIXIN) + (size_t)e * D * 928, D, 928, (unsigned char*)(WMIXIN + (size_t)e * 1024 * 1024), 1024, 1, scr, gwr, NGW, lane);
            else tr_matrix(AIN(I_MIXIN) + (size_t)e * D * 928, D, 928, WMIXIN + (size_t)e * 1024 * 1024, 1024, 1, nullptr, nullptr, 1.0f, scr, gwr, NGW, lane); ADV(464);
            tr_matrix(AIN(I_WUQ) + (size_t)e * 256 * 768, 256, 768, WUQ + (size_t)e * 768 * 256, 256, 0, nullptr, AIN(I_CQG) + e * 256, QSCALE, scr, gwr, NGW, lane); ADV(96);
            tr_matrix(AIN(I_WUKV) + (size_t)e * 128 * 1024, 128, 1024, WUK + (size_t)e * 512 * 128, 128, 2, WUV + (size_t)e * 512 * 128, AIN(I_CKVG) + e * 128, 1.0f, scr, gwr, NGW, lane); ADV(64);
            tr_matrix(AIN(I_MIXOUT) + (size_t)e * 1024 * 1024, 512, 1024, WMIXOUT + (size_t)e * 1024 * 1024, 1024, 0, nullptr, nullptr, 1.0f, scr, gwr, NGW, lane); ADV(256);
            if (FP8_FFN(2 * e)) {
                tr_matrix8(AIN(I_FW1) + (size_t)e * D * DFF, D, DFF, (unsigned char*)(WFFN13 + (size_t)e * 5632 * 1024), 1024, 3, scr, gwr, NGW, lane); ADV(1408);
                tr_matrix8(AIN(I_FW3) + (size_t)e * D * DFF, D, DFF, (unsigned char*)(WFFN13 + (size_t)e * 5632 * 1024), 1024, 4, scr, gwr, NGW, lane); ADV(1408);
                tr_matrix8(AIN(I_FW2) + (size_t)e * DFF * D, DFF, D, (unsigned char*)(WFFN2 + (size_t)e * 1024 * DFF), DFF, 0, scr, gwr, NGW, lane); ADV(1408);
            } else {
            tr_matrix(AIN(I_FW1) + (size_t)e * D * DFF, D, DFF, WFFN13 + (size_t)e * 5632 * 1024, 1024, 3, nullptr, nullptr, 1.0f, scr, gwr, NGW, lane); ADV(1408);
            tr_matrix(AIN(I_FW3) + (size_t)e * D * DFF, D, DFF, WFFN13 + (size_t)e * 5632 * 1024, 1024, 4, nullptr, nullptr, 1.0f, scr, gwr, NGW, lane); ADV(1408);
            tr_matrix(AIN(I_FW2) + (size_t)e * DFF * D, DFF, D, WFFN2 + (size_t)e * 1024 * DFF, DFF, 0, nullptr, nullptr, 1.0f, scr, gwr, NGW, lane); ADV(1408);
            }
            tr_matrix(AIN(I_FNET) + (size_t)e * D * D, D, D, WFNET + (size_t)e * 1024 * 1024, 1024, 0, nullptr, nullptr, 1.0f, scr, gwr, NGW, lane); ADV(512);
            if (MK_FP8_MIXIN) { for (int i = gw * 64 + lane; i < 96 * 1024 / 16; i += NGW * 64) *(u32x4*)((unsigned char*)(WMIXIN + (size_t)e * 1024 * 1024) + 416 * 1024 + (size_t)i * 16) = (u32x4){0u, 0u, 0u, 0u}; }
            else for (int i = gw * 64 + lane; i < 96 * 1024 / 8; i += NGW * 64) *(u32x4*)(WMIXIN + (size_t)e * 1024 * 1024 + 416 * 1024 + (size_t)i * 8) = (u32x4){0u, 0u, 0u, 0u};
            for (int it = (gw - e * 1024 + NGW) % NGW; it < 4 * 16 * 16; it += NGW) {        const int gq = it >> 8, ic = (it >> 4) & 15, nb = it & 15, n = nb * 64 + lane;
                const float* pw = AIN(I_POOLW) + ((size_t)(e * 4 + gq) * 128 + ic * 8) * 128; const float* ps = AIN(I_POOLS) + e * 512 + gq * 128;
                const float* mw = AIN(I_MIXOUT) + ((size_t)e * 1024 + 512 + gq * 128) * 1024 + n;
                float acc[8];
#pragma unroll
                for (int q = 0; q < 8; ++q) acc[q] = 0.f;
#pragma unroll 1
                for (int jb = 0; jb < 128; jb += 16) { float wv[16];
#pragma unroll
                    for (int jj = 0; jj < 16; ++jj) wv[jj] = mw[(size_t)(jb + jj) * 1024];
#pragma unroll
                    for (int jj = 0; jj < 16; ++jj) { const float w = wv[jj] * ps[jb + jj];
#pragma unroll
                        for (int q = 0; q < 8; ++q) acc[q] += pw[q * 128 + jb + jj] * w; } }
                u32x4 o; o.x = pkbf(acc[0], acc[1]); o.y = pkbf(acc[2], acc[3]); o.z = pkbf(acc[4], acc[5]); o.w = pkbf(acc[6], acc[7]);
                *(u32x4*)(WMIXOUT + (size_t)e * 1024 * 1024 + (size_t)n * 1024 + 512 + gq * 128 + ic * 8) = o; }
        }
#undef ADV
        const int gt = bid * 512 + tid, NT = G * 512;
        for (int i = gt; i < 2 * 65536; i += NT) { const int ty = i >> 16, m = (i >> 8) & 255, c = i & 255; const float x = (float)((m * c) & 255) * (1.0f / 128.0f);
            WDFTC[i] = (bf16)(pkbf(ty ? sinpif(x) : cospif(x), 0.f) & 0xffffu); }
        if (MK_FP8_DFT) {
            for (int i4 = gt; i4 < 2048 * 2048 / 4; i4 += NT) { float v[4];
#pragma unroll
                for (int q = 0; q < 4; ++q) { const int i = i4 * 4 + q, k = i >> 11, kk = i & 2047;
                    if (kk < 1024) v[q] = __builtin_amdgcn_cosf((float)((k * kk) & 2047) * (1.0f / 2048.0f)); else if (kk == 1024) v[q] = 0.f; else v[q] = -__builtin_amdgcn_sinf((float)((k * (kk - 1024)) & 2047) * (1.0f / 2048.0f)); }
                ((unsigned*)WDFTL)[i4] = pk4_fp8(v[0] * 16.f, v[1] * 16.f, v[2] * 16.f, v[3] * 16.f); }
            for (int i4 = gt; i4 < 65536 / 4; i4 += NT) { float v[4];
#pragma unroll
                for (int q = 0; q < 4; ++q) { const int i = i4 * 4 + q, k = i >> 8, kk = i & 255;
                    if (kk < 128) v[q] = __builtin_amdgcn_cosf((float)((k * kk) & 255) * (1.0f / 256.0f)); else if (kk == 128) v[q] = 0.f; else v[q] = -__builtin_amdgcn_sinf((float)((k * (kk - 128)) & 255) * (1.0f / 256.0f)); }
                ((unsigned*)WDFTX)[i4] = pk4_fp8(v[0] * 16.f, v[1] * 16.f, v[2] * 16.f, v[3] * 16.f); }
        } else {
        for (int i4 = gt; i4 < 2048 * 2048 / 4; i4 += NT) { float v[4];
#pragma unroll
            for (int q = 0; q < 4; ++q) { const int i = i4 * 4 + q, k = i >> 11, kk = i & 2047;
                if (kk < 1024) v[q] = __builtin_amdgcn_cosf((float)((k * kk) & 2047) * (1.0f / 2048.0f)); else if (kk == 1024) v[q] = 0.f; else v[q] = -__builtin_amdgcn_sinf((float)((k * (kk - 1024)) & 2047) * (1.0f / 2048.0f)); }
            u32x2 w; w.x = pkbf(v[0], v[1]); w.y = pkbf(v[2], v[3]); ((u32x2*)WDFTL)[i4] = w; }
        for (int i4 = gt; i4 < 65536 / 4; i4 += NT) { float v[4];
#pragma unroll
            for (int q = 0; q < 4; ++q) { const int i = i4 * 4 + q, k = i >> 8, kk = i & 255;
                if (kk < 128) v[q] = __builtin_amdgcn_cosf((float)((k * kk) & 255) * (1.0f / 256.0f)); else if (kk == 128) v[q] = 0.f; else v[q] = -__builtin_amdgcn_sinf((float)((k * (kk - 128)) & 255) * (1.0f / 256.0f)); }
            u32x2 w; w.x = pkbf(v[0], v[1]); w.y = pkbf(v[2], v[3]); ((u32x2*)WDFTX)[i4] = w; }
        }
        if (gt < 512) { const int pos = gt >> 3, j = gt & 7; const double inv = pow(10000.0, -(double)j / 8.0), ang = (double)pos * inv; ROPEC[gt] = (float)cos(ang); ROPES[gt] = (float)sin(ang); }
    }
    if (lo == 0) SEAM0(0);
    if (IN(1)) { WSP_DECL; const float* MODP = (const float*)(wsp + WS_RB);
        for (int o = bid * 512 + tid; o < 4 * 33 * 6144; o += G * 512) { float sacc = 0.f;
#pragma unroll
            for (int kc = 0; kc < 16; ++kc) sacc += MODP[(size_t)kc * (4 * 33 * 6144) + o];
            const int li = o / (33 * 6144), col = o % 6144;
            MOD[o] = sacc + AIN(I_ADAB)[(size_t)li * 6144 + col]; }
        SEAM(1);
    }

#pragma unroll 1
    for (int i = 0; i < DEPTH; ++i) {
        const int pb = 2 + 10 * i; const bool even = !(i & 1); const int e = i >> 1; const bool ctxn = i < 2;
#define modbase (MOD + (size_t)i * 33 * 6144)
#define XS_MIX (XSrc{AIN(I_X), AIN(I_CTX), (i == 0) ? (const bf16*)nullptr : (const bf16*)XCUR})
#define XS_CUR (XSrc{nullptr, nullptr, (const bf16*)XCUR})
        const int nrows = ctxn ? MALL : MLAT;
        if (EN(1) && IN(pb + 0)) { WSP_DECL;
            if (even) { REP(5) phase_mod_plain(XS_MIX, AIN(I_NMG) + i * D, modbase, 0, 1024, RA, MK_FP8_MIXIN != 0, MALL, gw, NGW, lane); }
            else REP(6) { phase_mod_fold(XS_MIX, AIN(I_NMG) + i * D, modbase, RA, HMID, i == 1, gw, NGW, lane);
                   if (FP8_MOE(i)) moe_convert8(AIN(I_MW1) + (size_t)e * 8 * D * DFFE, AIN(I_MW3) + (size_t)e * 8 * D * DFFE, AIN(I_MW2) + (size_t)e * 8 * DFFE * D, WMOE13_8(e), WMOE2_8(e), (LAS float*)(lds + wave * 8448), gw, NGW, lane, BG_ON ? (e == 0 ? BG0_END : BG1_END) : 0, MOE_CV_ITEMS);
                   else moe_convert(AIN(I_MW1) + (size_t)e * 8 * D * DFFE, AIN(I_MW3) + (size_t)e * 8 * D * DFFE, AIN(I_MW2) + (size_t)e * 8 * DFFE * D, WMOE13, WMOE2, (LAS float*)(lds + wave * 8448), gw, NGW, lane); }
            SEAM(pb + 0);
        }
        if (IN(pb + 1)) { WSP_DECL;
            if (even) { if (EN(2)) { SchedMixIn S{(const char*)RA, (const char*)(WMIXIN + (size_t)e * 1024 * 1024), G, bid, 1024 + (i == 0 ? 128 : 32), i == 0};
                        EpiMixIn E{CQ, CKV, KR, POOL, SSQQ, SSQK, ROPEC, ROPES};
                        REP(16) gm::gemm_phase<EpiMixIn, SchedMixIn, false, MK_FP8_MIXIN != 0>(lds, S, E);
                        BG_FILL(1024 + (i == 0 ? 128 : 32), i == 0 ? 0 : 1, i == 0 ? 0 : BG1_MIXIN, i == 0 ? BG0_MIXIN_E : BG1_END); } }
            else if (EN(3)) { phase_amid(HMID, AMID, lds, G, bid, tid);
                   SchedDftC S{(const char*)WDFTC, (const char*)RA, G, bid, 1024 + (i == 1 ? 256 : 0)}; EpiDftC E{ZB, ZC};
                   REP(17) gm::gemm_phase<EpiDftC, SchedDftC, false>(lds, S, E); }
            SEAM(pb + 1);
        }
        if (IN(pb + 2)) { WSP_DECL;
            if (even) { if (EN(4)) { REP(14) phase_pool(POOL, RA, nrows, gw, NGW, lane);
                        const int nq = (i == 0) ? TALL : TLAT;
                        SchedE3 S{(const char*)CQ, (const char*)CKV, (const char*)(WUQ + (size_t)e * 768 * 256), (const char*)(WUK + (size_t)e * 512 * 128), (const char*)(WUV + (size_t)e * 512 * 128), G, bid, nq, nq * 3 + 1152};
                        EpiE3 E{QB, KN, VT, SSQQ, SSQK, ROPEC, ROPES};
                        REP(15) gm::gemm_phase<EpiE3, SchedE3, false>(lds, S, E); } }
            else if (EN(5)) { SchedDftS S{(const char*)WDFTL, (const char*)WDFTX, (const char*)ZB, (const char*)ZC, G, bid, 1024 + (i == 1 ? 128 : 0)}; EpiDftS E{RA, AMID};
                   REP(18) gm::gemm_phase<EpiDftS, SchedDftS, false, MK_FP8_DFT != 0>(lds, S, E);
                   BG_FILL(1024 + (i == 1 ? 128 : 0), 1, 0, i == 1 ? BG1_DFTS_E : 0); }
            SEAM(pb + 2);
        }
        if (EN(6) && even && IN(pb + 3)) { WSP_DECL;
            const int total = 1024 + (i == 0 ? 128 : 0);
            REP(2) for (int it = 0;; ++it) { const int u = it * G + bid; if (u >= total) break;
                const bool cx = u >= 1024; const int bhp = cx ? u - 1024 : (u & 127), qt = cx ? 0 : (u >> 7), b = bhp >> 2, hp = bhp & 3;
                attn_unit(lds, QB, KN, KR, VT, RA, b, hp, cx ? MLAT + b * LC : b * SEQ + qt * 256, cx ? SEQ : 0, cx ? 4 : 36, tid); }
            SEAM(pb + 3);
        }
        if (EN(7) && IN(pb + 4)) { WSP_DECL;
            SchedResid S{(const char*)RA, (const char*)(even ? WMIXOUT + (size_t)e * 1024 * 1024 : WFNET + (size_t)e * 1024 * 1024), 2048u, 16, nrows / 256, G, bid};
            if ((MK_DUP >> 8) & 1u) { EpiResid Ed{AIN(I_X), AIN(I_CTX), (i == 0) ? (const bf16*)nullptr : (const bf16*)XCUR, (bf16*)AOUT, modbase + 2048, 1.0f}; gm::gemm_phase<EpiResid, SchedResid, false>(lds, S, Ed); }
            EpiResid E{AIN(I_X), AIN(I_CTX), (i == 0) ? (const bf16*)nullptr : (const bf16*)XCUR, XCUR, modbase + 2048, 1.0f};
            gm::gemm_phase<EpiResid, SchedResid, false>(lds, S, E);
            BG_FILL((nrows / 256) * 4, i == 0 ? 0 : 1, i == 0 ? BG0_MIXIN_E : BG1_DFTS_E, i == 0 ? BG0_MIXOUT_E : (i == 1 ? BG1_FNET_E : 0));
            SEAM(pb + 4);
        }
        if (EN(8) && IN(pb + 5)) { WSP_DECL;
            if (even) REP(7) phase_mod2<false>(XS_CUR, AIN(I_NFG) + i * D, modbase, RA, FP8_FFN(i), nrows, nullptr, nullptr, nullptr, nullptr, lds, bid, G, wave, lane, tid);
            else phase_mod2<true>(XS_CUR, AIN(I_NFG) + i * D, modbase, RA, FP8_MOE(i), nrows, AIN(I_ROUTER) + (size_t)e * D * 8, (unsigned*)(wsp + WS_CTL) + CW_CNT + e * 16 * 64, LIST, GLIST, lds, bid, G, wave, lane, tid);
            SEAM(pb + 5);
        }
        if (even) {
            if (EN(9) && IN(pb + 6)) { WSP_DECL;
                if (FP8_FFN(i)) { SchedUp S{(const char*)RA, (const char*)(WFFN13 + (size_t)e * 5632 * 1024), nrows / 256, 22, G, bid, 1024u, 8}; EpiSwiglu8 E{(unsigned char*)ACT, DFF};
                    REP(1) gm::gemm_phase<EpiSwiglu8, SchedUp, false, true>(lds, S, E); }
                else { SchedUp S{(const char*)RA, (const char*)(WFFN13 + (size_t)e * 5632 * 1024), nrows / 256, 22, G, bid, 2048u, 16}; EpiSwiglu E{ACT, DFF};
                    REP(1) gm::gemm_phase<EpiSwiglu, SchedUp, false>(lds, S, E); }
                BG_FILL((nrows / 256) * 22, 0, BG0_MIXOUT_E, i == 0 ? BG0_UP_E : 0);
                SEAM(pb + 6); }
            if (EN(10) && IN(pb + 7)) { WSP_DECL;
                if (FP8_FFN(i)) { SchedResid S{(const char*)ACT, (const char*)(WFFN2 + (size_t)e * 1024 * DFF), (unsigned)DFF, DFF / 128, nrows / 256, G, bid};
                    if ((MK_DUP >> 9) & 1u) { EpiResid Ed{nullptr, nullptr, (const bf16*)XCUR, (bf16*)AOUT, modbase + 5 * 1024, 1.0f / (W8_SCALE * A8_SCALE)}; gm::gemm_phase<EpiResid, SchedResid, false, true>(lds, S, Ed); }
                    EpiResid E{nullptr, nullptr, (const bf16*)XCUR, XCUR, modbase + 5 * 1024, 1.0f / (W8_SCALE * A8_SCALE)};
                    gm::gemm_phase<EpiResid, SchedResid, false, true>(lds, S, E); }
                else { SchedResid S{(const char*)ACT, (const char*)(WFFN2 + (size_t)e * 1024 * DFF), (unsigned)(DFF * 2), DFF / 64, nrows / 256, G, bid};
                    if ((MK_DUP >> 9) & 1u) { EpiResid Ed{nullptr, nullptr, (const bf16*)XCUR, (bf16*)AOUT, modbase + 5 * 1024, 1.0f}; gm::gemm_phase<EpiResid, SchedResid, false>(lds, S, Ed); }
                    EpiResid E{nullptr, nullptr, (const bf16*)XCUR, XCUR, modbase + 5 * 1024, 1.0f};
                    gm::gemm_phase<EpiResid, SchedResid, false>(lds, S, E); }
                BG_FILL((nrows / 256) * 4, 0, BG0_UP_E, i == 0 ? BG0_END : 0);
                SEAM(pb + 7); }
        } else {
#pragma unroll 1
            for (int s = 0; s < 2; ++s) {
                const int cwo = CW_CNT + (e * 16 + s * 8) * 64;
                if (EN(11) && IN(pb + 6 + 2 * s)) { WSP_DECL;
                    if (FP8_MOE(i)) { SchedMoeUp8 S; S.H2 = (const char*)RA; S.W13 = (const char*)WMOE13_8(e); S.list = LIST + (size_t)s * 8 * MALL; moe_info((const unsigned*)(wsp + WS_CTL) + cwo, S.mi); S.G = G; S.c = bid;
                        EpiSwiglu8 E{(unsigned char*)ACT, DFFE};
                        REP(0) gm::gemm_phase<EpiSwiglu8, SchedMoeUp8, true, true>(lds, S, E); }
                    else { SchedMoeUp S; S.H2 = (const char*)RA; S.W13 = (const char*)WMOE13; S.list = LIST + (size_t)s * 8 * MALL; moe_info((const unsigned*)(wsp + WS_CTL) + cwo, S.mi); S.G = G; S.c = bid;
                        EpiSwiglu E{ACT, DFFE};
                        REP(0) gm::gemm_phase<EpiSwiglu, SchedMoeUp, true>(lds, S, E); }
                    SEAM(pb + 6 + 2 * s); }
                if (EN(12) && IN(pb + 7 + 2 * s)) { WSP_DECL;
                    if (FP8_MOE(i)) { SchedMoeDown8 S; S.Ab = (const char*)ACT; S.W2 = (const char*)WMOE2_8(e); moe_info((const unsigned*)(wsp + WS_CTL) + cwo, S.mi); S.G = G; S.c = bid;
                        if ((MK_DUP >> 10) & 1u) { EpiMoeDown Ed{XCUR, modbase + 5 * 1024, LIST + (size_t)s * 8 * MALL, GLIST + (size_t)s * 8 * MALL, 1.0f / (W8_SCALE * A8_SCALE), (bf16*)AOUT}; gm::gemm_phase<EpiMoeDown, SchedMoeDown8, false, true>(lds, S, Ed); }
                        EpiMoeDown E{XCUR, modbase + 5 * 1024, LIST + (size_t)s * 8 * MALL, GLIST + (size_t)s * 8 * MALL, 1.0f / (W8_SCALE * A8_SCALE), XCUR};
                        gm::gemm_phase<EpiMoeDown, SchedMoeDown8, false, true>(lds, S, E);
                        BG_FILL(S.mi.tb[8] * 4, 1, s == 0 ? BG1_FNET_E : BG1_MD0_E, i == 1 ? (s == 0 ? BG1_MD0_E : BG1_MIXIN) : 0); }
                    else { SchedMoeDown S; S.Ab = (const char*)ACT; S.W2 = (const char*)WMOE2; moe_info((const unsigned*)(wsp + WS_CTL) + cwo, S.mi); S.G = G; S.c = bid;
                        EpiMoeDown E{XCUR, modbase + 5 * 1024, LIST + (size_t)s * 8 * MALL, GLIST + (size_t)s * 8 * MALL, 1.0f, XCUR};
                        gm::gemm_phase<EpiMoeDown, SchedMoeDown, false>(lds, S, E); }
                    SEAM(pb + 7 + 2 * s); }
            }
        }
    }
    if (EN(13) && IN(NPH - 1)) { WSP_DECL; phase_final(XCUR, AOUT, AIN(I_FINALG), gw, NGW, lane); }
#undef IN
#undef SEAM
}

extern "C" void kernel_launch(void* const* d_in, const int* in_sizes, int n_in, void* d_out, int out_size, void* d_ws, size_t ws_size, hipStream_t stream) {
    static int grid = 0;
    if (grid == 0) {
        if (n_in != N_IN || out_size != MLAT * D || ws_size < WS_END) { fprintf(stderr, "kernel_launch: unexpected problem (n_in %d, out %d, ws %zu < %zu)\n", n_in, out_size, ws_size, (size_t)WS_END); grid = -1; return; }
        int dev = 0, cus = 0, per_cu = 0;
        if (hipGetDevice(&dev) != hipSuccess || hipDeviceGetAttribute(&cus, hipDeviceAttributeMultiprocessorCount, dev) != hipSuccess) { grid = -1; return; }
        if (hipFuncSetAttribute((const void*)fwd, hipFuncAttributeMaxDynamicSharedMemorySize, LDS_BYTES) != hipSuccess) { fprintf(stderr, "kernel_launch: hipFuncSetAttribute failed\n"); grid = -1; return; }
        if (hipOccupancyMaxActiveBlocksPerMultiprocessor(&per_cu, (const void*)fwd, 512, LDS_BYTES) != hipSuccess || per_cu < 1) fprintf(stderr, "kernel_launch: occupancy query reports %d\n", per_cu);
        (void)hipGetLastError();
        grid = cus;
        if (grid != 256) fprintf(stderr, "kernel_launch: %d CUs (built for 256)\n", grid);
    }
    if (grid < 0) return;
    (void)hipMemsetAsync((char*)d_ws + WS_CTL, 0, CTL_BYTES, stream);
    Args a{};
    for (int i = 0; i < N_IN; ++i) a.in[i] = (const float*)d_in[i];
    a.out = (float*)d_out; a.ws = (unsigned char*)d_ws;
#if MK_PER_PHASE
    for (int p = 0; p < NPH; ++p) {
        const int k = (p - 2) % 10, layer = (p - 2) / 10;
        if (p >= 2 && p < NPH - 1) { const bool even = !(layer & 1); if (even && k >= 8) continue; if (!even && k == 3) continue; }
        a.ph_lo = p; a.ph_hi = p + 1;
        hipLaunchKernelGGL(fwd, dim3(grid), dim3(512), LDS_BYTES, stream, a);
    }
#else
    a.ph_lo = 0; a.ph_hi = NPH;
    hipLaunchKernelGGL(fwd, dim3(grid), dim3(512), LDS_BYTES, stream, a);
#endif
}
```

```cpp
#include <hip/hip_runtime.h>
#include <cstdio>
#include <cstdint>

#ifndef MK_FP8_L1
#define MK_FP8_L1 1
#endif
#define FP8_MOE(i) ((i) == 3 || MK_FP8_L1)
#ifndef MK_BG
#define MK_BG 1
#endif
#define BG_ON (MK_BG && MK_FP8_L1)
#ifndef MK_FP8_DFT
#define MK_FP8_DFT 1
#endif
#ifndef MK_FP8_MIXIN
#define MK_FP8_MIXIN 0
#endif
#ifndef MK_FP8_FFN
#define MK_FP8_FFN 2
#endif
#define FP8_FFN(i) (((MK_FP8_FFN) >> ((i) >> 1)) & 1)
#ifndef MK_DUP
#define MK_DUP 0u
#endif
#ifndef MK_PER_PHASE
#define MK_PER_PHASE 0
#endif

#define LAS __attribute__((address_space(3)))
#define GAS __attribute__((address_space(1)))
typedef unsigned short bf16;
typedef short bf16x8 __attribute__((ext_vector_type(8)));
typedef short s16x4 __attribute__((ext_vector_type(4)));
typedef float f32x4 __attribute__((ext_vector_type(4)));
typedef float f32x2 __attribute__((ext_vector_type(2)));
typedef float f32x16 __attribute__((ext_vector_type(16)));
typedef unsigned u32x4 __attribute__((ext_vector_type(4)));
typedef unsigned u32x2 __attribute__((ext_vector_type(2)));
typedef __bf16 bf16x2_t __attribute__((ext_vector_type(2)));

constexpr int NB = 32, SEQ = 2048, LC = 256, D = 1024, DEPTH = 4;
constexpr int MLAT = NB * SEQ, MCTX = NB * LC, MALL = MLAT + MCTX;
constexpr int TLAT = MLAT / 256, TCTX = MCTX / 256, TALL = MALL / 256;
constexpr int HEADS = 8, QKN = 64, QKR = 32, VD = 64, QLORA = 256, KVLORA = 128;
constexpr int QW = HEADS * (QKN + QKR);
constexpr int NKEY = SEQ + LC;
constexpr int DFF = 2816, DFFE = 3584, NEXP = 8;
constexpr float EPS = 1e-6f;
constexpr float QSCALE = 0.10206207261596577f * 1.4426950408889634f;

enum { I_X = 0, I_C, I_CTX, I_CCTX, I_ADAW, I_ADAB, I_NMG, I_NFG, I_MIXIN, I_CQG, I_CKVG, I_WUQ, I_WUKV, I_POOLW, I_POOLS, I_MIXOUT,
       I_FW1, I_FW3, I_FW2, I_FNET, I_ROUTER, I_MW1, I_MW3, I_MW2, I_FINALG, N_IN };

constexpr size_t al(size_t x) { return (x + 4095) & ~(size_t)4095; }
constexpr size_t WS_CTL = 0, CTL_BYTES = 1u << 20;
constexpr size_t WS_MOD = WS_CTL + CTL_BYTES;
constexpr size_t WS_ROPE = al(WS_MOD + (size_t)DEPTH * 33 * 6 * D * 4);
constexpr size_t WS_SSQQ = al(WS_ROPE + 64 * 16 * 4);
constexpr size_t WS_SSQK = al(WS_SSQQ + (size_t)MALL * 16);
constexpr size_t WS_HMID = al(WS_SSQK + (size_t)MALL * 16);
constexpr size_t WS_AMID = al(WS_HMID + 64 * D * 4);
constexpr size_t WS_LIST = al(WS_AMID + 64 * D * 4);
constexpr size_t WS_GLIST = al(WS_LIST + (size_t)2 * 8 * MALL * 4);
constexpr size_t WS_WMIXIN = al(WS_GLIST + (size_t)2 * 8 * MALL * 4);
constexpr size_t WS_WUQ = al(WS_WMIXIN + (size_t)2 * 1024 * 1024 * 2);
constexpr size_t WS_WUK = al(WS_WUQ + (size_t)2 * 768 * 256 * 2);
constexpr size_t WS_WUV = al(WS_WUK + (size_t)2 * 512 * 128 * 2);
constexpr size_t WS_WMIXOUT = al(WS_WUV + (size_t)2 * 512 * 128 * 2);
constexpr size_t WS_WFFN13 = al(WS_WMIXOUT + (size_t)2 * 1024 * 1024 * 2);
constexpr size_t WS_WFFN2 = al(WS_WFFN13 + (size_t)2 * 5632 * 1024 * 2);
constexpr size_t WS_WFNET = al(WS_WFFN2 + (size_t)2 * 1024 * 2816 * 2);
constexpr size_t WS_WDFTC = al(WS_WFNET + (size_t)2 * 1024 * 1024 * 2);
constexpr size_t WS_WDFTL = al(WS_WDFTC + (size_t)2 * 256 * 256 * 2);
constexpr size_t WS_WDFTX = al(WS_WDFTL + (size_t)2048 * 2048 * 2);
constexpr size_t WS_WMOE13 = al(WS_WDFTX + (size_t)256 * 256 * 2);
constexpr size_t WS_WMOE2 = al(WS_WMOE13 + (size_t)8 * 7168 * 1024 * 2);
constexpr size_t WS_XCUR = al(WS_WMOE2 + (size_t)8 * 1024 * 3584 * 2);
constexpr size_t WS_RA = al(WS_XCUR + (size_t)MALL * D * 2);
constexpr size_t WS_RB = al(WS_RA + (size_t)MALL * D * 2);
constexpr size_t RB_CQ = 0;
constexpr size_t RB_CKV = al(RB_CQ + (size_t)MALL * 256 * 2);
constexpr size_t RB_KR = al(RB_CKV + (size_t)MALL * 128 * 2);
constexpr size_t RB_POOL = al(RB_KR + (size_t)MALL * 32 * 2);
constexpr size_t RB_Q = al(RB_POOL + (size_t)MALL * 512 * 2);
constexpr size_t RB_KN = al(RB_Q + (size_t)MALL * 768 * 2);
constexpr size_t RB_VT = al(RB_KN + (size_t)MALL * 512 * 2);
constexpr size_t RB_EVEN_END = al(RB_VT + (size_t)NB * 512 * NKEY * 2);
constexpr size_t RB_Z = 0;
constexpr size_t RB_ZC = al(RB_Z + (size_t)NB * 4 * 256 * 2048 * 2);
constexpr size_t RB_ACT = 0;
constexpr size_t RB_SIZE = al((size_t)(MALL + 2048) * DFFE * 2);
static_assert(RB_EVEN_END <= RB_SIZE && (size_t)MALL * DFF * 2 <= RB_SIZE && RB_ZC + (size_t)NB * 4 * 256 * 256 * 2 <= RB_SIZE, "region B");
constexpr size_t WS_END = WS_RB + RB_SIZE;
static_assert(WS_END < 1150000000ull, "workspace budget");

constexpr int CW_TMO = 0;
constexpr int CW_BAR = 4096;
constexpr int CW_CNT = 16384;

constexpr int STAGE_BYTES = 131072;
constexpr int ATQ_OFF = 90112;
constexpr int MISC_OFF = 143360;
constexpr int LDS_BYTES = 147456;

__device__ __forceinline__ unsigned pkbf(float lo, float hi) { f32x2 v = {lo, hi}; bf16x2_t b = __builtin_convertvector(v, bf16x2_t); return __builtin_bit_cast(unsigned, b); }
__device__ __forceinline__ float bf2f(unsigned short b) { return __uint_as_float(((unsigned)b) << 16); }
__device__ __forceinline__ float wave_sum(float v) {
#pragma unroll
    for (int o = 1; o < 64; o <<= 1) v += __shfl_xor(v, o);
    return v;
}
__device__ __forceinline__ float silu_f(float x) { return x / (1.0f + __expf(-x)); }

#define XB_TMO      128
#define XB_XCNT(j)  (256  + 64 * (j))
#define XB_XSUB(j)  (1280 + 64 * (j))
#define XB_XGEN(j)  (2304 + 64 * (j))
#define XB_TOP      3328
#define XB_TOPGEN   3392
#define XCD_BAR_WORDS 3456
#define XB_SPIN_CAP (1u << 22)

__device__ __forceinline__ unsigned xb_ld(unsigned* p)              { return __hip_atomic_load(p, __ATOMIC_RELAXED, __HIP_MEMORY_SCOPE_AGENT); }
__device__ __forceinline__ unsigned xb_add(unsigned* p, unsigned v) { return __hip_atomic_fetch_add(p, v, __ATOMIC_RELAXED, __HIP_MEMORY_SCOPE_AGENT); }
__device__ __forceinline__ unsigned xb_xcc_id() { return (unsigned)__builtin_amdgcn_s_getreg((3 << 11) | 20) & 0xFu; }
#define XB_SPIN(cond, bar) do { unsigned _sp = 0; while (cond) { __builtin_amdgcn_s_sleep(1); \
    if ((++_sp & 255u) == 0u) { if (xb_ld(&(bar)[XB_TMO])) break; if (_sp > XB_SPIN_CAP) { atomicAdd(&(bar)[XB_TMO], 1u); break; } } } } while (0)

struct XcdBarrier { unsigned* bar; unsigned x; volatile LAS unsigned* st; };

__device__ __forceinline__ XcdBarrier xcd_barrier_post(unsigned* bar, volatile LAS unsigned* st) {
    XcdBarrier b; b.bar = bar; b.x = xb_xcc_id(); b.st = st;
    if (threadIdx.x == 0) (void)xb_add(&bar[XB_XCNT(b.x)], 1u);
    return b;
}
__device__ __forceinline__ void xcd_barrier_complete(unsigned* bar, unsigned x, unsigned& nloc, unsigned& nx) {
    const unsigned G = gridDim.x * gridDim.y * gridDim.z;
    unsigned sum, cnt, mine, sp = 0u;
    for (;;) {
        sum = 0u; cnt = 0u; mine = 0u;
#pragma unroll
        for (unsigned j = 0; j < 16; ++j) { const unsigned c = xb_ld(&bar[XB_XCNT(j)]); sum += c; cnt += (c > 0u) ? 1u : 0u; mine = (j == x) ? c : mine; }
        if (sum == G) break;
        __builtin_amdgcn_s_sleep(1);
        if ((++sp & 255u) == 0u) { if (xb_ld(&bar[XB_TMO])) break; if (sp > XB_SPIN_CAP) { atomicAdd(&bar[XB_TMO], 1u); break; } }
    }
    nloc = mine > 0u ? mine : 1u; nx = cnt > 0u ? cnt : 1u;
}
template <bool FIRST>
__device__ __forceinline__ void xcd_barrier(const XcdBarrier& b) {
    asm volatile("s_waitcnt vmcnt(0)" ::: "memory");
    __syncthreads();
    if (threadIdx.x == 0) {
        unsigned* bar = b.bar; asm volatile("" : "+s"(bar));
        __builtin_amdgcn_s_waitcnt(0);
        unsigned nloc = b.st[0], nx = b.st[1];
        if constexpr (FIRST) { if (nloc == 0u) { xcd_barrier_complete(bar, b.x, nloc, nx); b.st[0] = nloc; b.st[1] = nx; } }
        const unsigned old = xb_add(&bar[XB_XSUB(b.x)], 1u);
        const unsigned gen = old / nloc;
        if (old + 1u == (gen + 1u) * nloc) {
            __builtin_amdgcn_fence(__ATOMIC_RELEASE, "agent");
            asm volatile("s_waitcnt vmcnt(0)" ::: "memory");
            const unsigned og = xb_add(&bar[XB_TOP], 1u);
            const unsigned tg = og / nx;
            if (og + 1u == (tg + 1u) * nx) xb_add(&bar[XB_TOPGEN], 1u);
            else XB_SPIN(xb_ld(&bar[XB_TOPGEN]) == tg, bar);
            __builtin_amdgcn_fence(__ATOMIC_ACQUIRE, "agent");
            xb_add(&bar[XB_XGEN(b.x)], 1u);
            asm volatile("s_waitcnt vmcnt(0)" ::: "memory");
        } else {
            XB_SPIN(xb_ld(&bar[XB_XGEN(b.x)]) == gen, bar);
            __builtin_amdgcn_fence(__ATOMIC_ACQUIRE, "agent");
            asm volatile("s_waitcnt vmcnt(0)" ::: "memory");
        }
    }
    __syncthreads();
}

namespace gm {
constexpr int BK = 64, HALF = 128, HTB = HALF * BK * 2;
__device__ __forceinline__ int lds_byte(int r, int c) { const int st = (r >> 4) * 2 + (c >> 5), rr = r & 15, cc = c & 31, ob = rr * 64 + cc * 2; return st * 1024 + (ob ^ (((ob >> 9) & 1) << 5)); }
__device__ __forceinline__ void stage_rc(int b, int& R, int& C) { const int st = b / 1024, sb = b % 1024, swz = sb ^ (((sb >> 9) & 1) << 5); R = (st >> 1) * 16 + swz / 64; C = (st & 1) * 32 + (swz % 64) / 2; }
__device__ __forceinline__ int perm32(int rho) { const int n = rho >> 4, i = rho & 15; return 8 * (i >> 2) + 4 * n + (i & 3); }

struct Unit { const char* A; const char* B; unsigned lda, ldb; int nt; int x0, x1, x2, x3; };
typedef int v8i_t __attribute__((ext_vector_type(8))); typedef int v4i_t __attribute__((ext_vector_type(4)));


__device__ __forceinline__ bool flat_index(int i, int G, int c, int total, int& idx) {
    const long Lx = (long)i * G + c; if (Lx >= total) return false;
    int wgid = (int)Lx; const int q = total / 8, r = total % 8, xcd = wgid % 8, off = wgid / 8;
    idx = (xcd < r ? xcd * (q + 1) : r * (q + 1) + (xcd - r) * q) + off; return true;
}
__device__ __forceinline__ void tile_order(int idx, int nM, int nN, int& pm, int& pn) {
    const int nig = 8 * nN, gid = idx / nig, fm = gid * 8, gsz = (nM - fm) < 8 ? (nM - fm) : 8;
    pm = fm + ((idx % nig) % gsz); pn = (idx % nig) / gsz;
}

template <class Epi, class Sched, bool GATHER, bool FP8 = false>
__device__ __forceinline__ void gemm_phase(LAS unsigned char* lds, const Sched& S, const Epi& E) {
    int tid = threadIdx.x; asm volatile("" : "+v"(tid));
    const int wid = __builtin_amdgcn_readfirstlane(tid >> 6), lane = tid & 63, wr = wid >> 2, wc = wid & 3, fr = lane & 15, fq = lane >> 4;
    const unsigned ldsw = (unsigned)wid * 1024u;
    const int aoff = lds_byte(wr * 64 + fr, fq * 8), boff = lds_byte(wc * 32 + fr, fq * 8);
#define G_SA(b, h) (((b) * 2 + (h)) * HTB)
#define G_SB(b, h) ((4 + (b) * 2 + (h)) * HTB)
#define G_LD(ptr, dst) __builtin_amdgcn_global_load_lds((const unsigned*)(ptr), (LAS unsigned*)(dst), 16, 0, 0)
#define G_STAGE_B(bufoff, P, hh, kb) do { const char* _p0 = P##p + (size_t)(kb) + ((hh) ? (size_t)P##s * 128u : (size_t)0); const char* _p1 = _p0 + (size_t)P##s * 64u; \
        asm volatile("" : "+s"(_p0), "+s"(_p1)); \
        G_LD(_p0 + P##v, lds + (bufoff) + ldsw); G_LD(_p1 + P##v, lds + (bufoff) + ldsw + 8192); } while (0)
#define G_STAGE_A(bufoff, P, hh, kb) do { if constexpr (GATHER) { const char* _p = P##p + (size_t)(kb); asm volatile("" : "+s"(_p)); \
        G_LD(_p + P##g[(hh) * 2], lds + (bufoff) + ldsw); G_LD(_p + P##g[(hh) * 2 + 1], lds + (bufoff) + ldsw + 8192); } else { G_STAGE_B(bufoff, P, hh, kb); } } while (0)
#define G_LDA(dst, b, h) do { _Pragma("unroll") for (int m = 0; m < 4; ++m) { const v4i_t _l = *(const LAS v4i_t*)(lds + G_SA(b, h) + aoff + m * 2048), _h = *(const LAS v4i_t*)(lds + G_SA(b, h) + aoff + m * 2048 + 1024); \
        dst[m] = __builtin_shufflevector(_l, _h, 0, 1, 2, 3, 4, 5, 6, 7); } } while (0)
#define G_LDB(dst, b, h) do { _Pragma("unroll") for (int n = 0; n < 2; ++n) { const v4i_t _l = *(const LAS v4i_t*)(lds + G_SB(b, h) + boff + n * 2048), _h = *(const LAS v4i_t*)(lds + G_SB(b, h) + boff + n * 2048 + 1024); \
        dst[n] = __builtin_shufflevector(_l, _h, 0, 1, 2, 3, 4, 5, 6, 7); } } while (0)
#define G_LO(x) __builtin_bit_cast(bf16x8, (v4i_t)__builtin_shufflevector(x, x, 0, 1, 2, 3))
#define G_HI(x) __builtin_bit_cast(bf16x8, (v4i_t)__builtin_shufflevector(x, x, 4, 5, 6, 7))
#define G_MMA(ai, bj, At, Bt) do { __builtin_amdgcn_s_setprio(1); \
        if constexpr (FP8) { _Pragma("unroll") for (int m = 0; m < 4; ++m) _Pragma("unroll") for (int n = 0; n < 2; ++n) \
            asm volatile("v_mfma_f32_16x16x128_f8f6f4 %0, %1, %2, %0" : "+v"(acc[ai][bj][m][n]) : "v"(Bt[n]), "v"(At[m])); } \
        else { _Pragma("unroll") for (int m = 0; m < 4; ++m) _Pragma("unroll") for (int n = 0; n < 2; ++n) { \
            acc[ai][bj][m][n] = __builtin_amdgcn_mfma_f32_16x16x32_bf16(G_LO(Bt[n]), G_LO(At[m]), acc[ai][bj][m][n], 0, 0, 0); \
            acc[ai][bj][m][n] = __builtin_amdgcn_mfma_f32_16x16x32_bf16(G_HI(Bt[n]), G_HI(At[m]), acc[ai][bj][m][n], 0, 0, 0); } } \
        __builtin_amdgcn_s_setprio(0); } while (0)
#define G_MMA0(ai, bj, At, Bt) do { __builtin_amdgcn_s_setprio(1);     \
        if constexpr (FP8) { _Pragma("unroll") for (int m = 0; m < 4; ++m) _Pragma("unroll") for (int n = 0; n < 2; ++n) \
            asm volatile("v_mfma_f32_16x16x128_f8f6f4 %0, %1, %2, 0" : "=&v"(acc[ai][bj][m][n]) : "v"(Bt[n]), "v"(At[m])); } \
        else { _Pragma("unroll") for (int m = 0; m < 4; ++m) _Pragma("unroll") for (int n = 0; n < 2; ++n) { \
            acc[ai][bj][m][n] = __builtin_amdgcn_mfma_f32_16x16x32_bf16(G_LO(Bt[n]), G_LO(At[m]), (f32x4){0.f, 0.f, 0.f, 0.f}, 0, 0, 0); \
            acc[ai][bj][m][n] = __builtin_amdgcn_mfma_f32_16x16x32_bf16(G_HI(Bt[n]), G_HI(At[m]), acc[ai][bj][m][n], 0, 0, 0); } } \
        __builtin_amdgcn_s_setprio(0); } while (0)
#define G_WAIT_V(n) asm volatile("s_waitcnt vmcnt(" #n ")" ::: "memory")
#define G_WAIT_L(n) asm volatile("s_waitcnt lgkmcnt(" #n ")" ::: "memory")
#define G_BAR __builtin_amdgcn_s_barrier()
#define G_SCHED __builtin_amdgcn_sched_barrier(0)
#define G_SETUP(P_A, P_B, U) do { int _t = threadIdx.x; asm volatile("" : "+v"(_t)); int R0, C0; stage_rc(_t * 16, R0, C0); const int Rb0 = (R0 & ~31) + perm32(R0 & 31);     \
        P_A##p = (U).A; P_A##s = (U).lda; P_B##p = (U).B; P_B##s = (U).ldb; P_B##v = (unsigned)Rb0 * (U).ldb + (unsigned)C0 * 2u; \
        if constexpr (GATHER) { _Pragma("unroll") for (int _q = 0; _q < 4; ++_q) P_A##g[_q] = (unsigned)S.gather_row((U), R0 + 64 * _q) * (U).lda + (unsigned)C0 * 2u; P_A##v = 0u; } \
        else { P_A##v = (unsigned)R0 * (U).lda + (unsigned)C0 * 2u; } } while (0)
    Unit cur, nxt; int ui = 0;
    if (!S.next(0, cur)) return;
    f32x4 acc[2][2][4][2];
    v8i_t At[4], B0[2], B1[2];
    const char *cAp, *cBp, *nAp, *nBp; unsigned cAs, cBs, nAs, nBs, cAv, cBv, nAv, nBv; unsigned cAg[4], nAg[4];
#pragma unroll
    for (int q = 0; q < 4; ++q) { cAg[q] = 0u; nAg[q] = 0u; }
    G_SETUP(cA, cB, cur);
    G_STAGE_B(G_SB(0, 0), cB, 0, 0); G_STAGE_B(G_SB(0, 1), cB, 1, 0); G_STAGE_A(G_SA(0, 0), cA, 0, 0); G_STAGE_A(G_SA(0, 1), cA, 1, 0);
    if (wr == 1) G_BAR;
    G_WAIT_V(2); G_BAR;
    G_STAGE_B(G_SB(1, 0), cB, 0, 128); G_STAGE_A(G_SA(1, 0), cA, 0, 128); G_STAGE_B(G_SB(1, 1), cB, 1, 128);
    G_WAIT_V(6); G_BAR;
    for (;;) {
        const bool has_next = S.next(ui + 1, nxt);
        if (has_next) { G_SETUP(nA, nB, nxt); } else { nAp = cAp; nBp = cBp; nAs = cAs; nBs = cBs; nAv = cAv; nBv = cBv;
#pragma unroll
            for (int q = 0; q < 4; ++q) nAg[q] = cAg[q]; }
        int nt = cur.nt; asm volatile("" : "+s"(nt));
#define G_KSTEP(MM) { \
            const bool last = (t == nt - 2); \
            const size_t k1 = (size_t)(t + 1) * 128; \
              \
            G_LDB(B0, 0, 0); G_LDB(B1, 0, 1); G_SCHED; G_LDA(At, 0, 0); G_STAGE_A(G_SA(1, 1), cA, 1, k1); \
            G_WAIT_V(8); G_WAIT_L(0); G_BAR; MM(0, 0, At, B0); MM(0, 1, At, B1); G_BAR; G_SCHED; \
              \
            G_LDA(At, 0, 1); \
            if (last) { G_STAGE_B(G_SB(0, 0), nB, 0, 0); G_STAGE_B(G_SB(0, 1), nB, 1, 0); G_STAGE_A(G_SA(0, 0), nA, 0, 0); } \
            else { const size_t k2 = (size_t)(t + 2) * 128; G_STAGE_B(G_SB(0, 0), cB, 0, k2); G_STAGE_B(G_SB(0, 1), cB, 1, k2); G_STAGE_A(G_SA(0, 0), cA, 0, k2); } \
            G_WAIT_V(8); G_WAIT_L(0); G_BAR; MM(1, 0, At, B0); MM(1, 1, At, B1); G_BAR; G_SCHED; \
              \
            G_LDB(B0, 1, 0); G_LDB(B1, 1, 1); G_SCHED; G_LDA(At, 1, 0); \
            if (last) { G_STAGE_A(G_SA(0, 1), nA, 1, 0); } else { const size_t k2 = (size_t)(t + 2) * 128; G_STAGE_A(G_SA(0, 1), cA, 1, k2); } \
            G_WAIT_V(8); G_WAIT_L(0); G_BAR; G_MMA(0, 0, At, B0); G_MMA(0, 1, At, B1); G_BAR; G_SCHED; \
              \
            G_LDA(At, 1, 1); \
            if (last) { G_STAGE_B(G_SB(1, 0), nB, 0, 128); G_STAGE_B(G_SB(1, 1), nB, 1, 128); G_STAGE_A(G_SA(1, 0), nA, 0, 128); } \
            else { const size_t k3 = (size_t)(t + 3) * 128; G_STAGE_B(G_SB(1, 0), cB, 0, k3); G_STAGE_B(G_SB(1, 1), cB, 1, k3); G_STAGE_A(G_SA(1, 0), cA, 0, k3); } \
            G_WAIT_V(8); G_WAIT_L(0); G_BAR; G_MMA(1, 0, At, B0); G_MMA(1, 1, At, B1); G_BAR; G_SCHED; \
        }
        { const int t = 0; G_KSTEP(G_MMA0) }
        for (int t = 2; t < nt; t += 2) G_KSTEP(G_MMA)
#undef G_KSTEP
        if (wr == 0) G_BAR;
        if constexpr (FP8) asm volatile("s_nop 15\n\ts_nop 15" ::: "memory");
        { int _t = threadIdx.x; asm volatile("" : "+v"(_t)); const int _w = __builtin_amdgcn_readfirstlane(_t >> 6), _l = _t & 63;
          E(acc, cur, _w >> 2, _w & 3, _l & 15, _l >> 4); }
        if (!has_next) break;
        cur = nxt; cAp = nAp; cBp = nBp; cAs = nAs; cBs = nBs; cAv = nAv; cBv = nBv;
#pragma unroll
        for (int q = 0; q < 4; ++q) cAg[q] = nAg[q];
        ++ui;
        if (wr == 1) G_BAR;
    }
    G_WAIT_V(0);
    G_BAR;
#undef G_SA
#undef G_SB
#undef G_LD
#undef G_STAGE_A
#undef G_STAGE_B
#undef G_LDA
#undef G_LDB
#undef G_MMA
#undef G_MMA0
#undef G_WAIT_V
#undef G_WAIT_L
#undef G_BAR
#undef G_SCHED
#undef G_SETUP
}
}

typedef const f32x4 (&AccRef)[2][2][4][2];
__device__ __forceinline__ u32x4 pack8(const f32x4 a, const f32x4 b) { u32x4 w; w.x = pkbf(a[0], a[1]); w.y = pkbf(a[2], a[3]); w.z = pkbf(b[0], b[1]); w.w = pkbf(b[2], b[3]); return w; }

__device__ __forceinline__ void rope8(f32x4& v0, f32x4& v1, int fq, int t, const float* ropeC, const float* ropeS) {
    const int pos = (fq < 2) ? (t >> 6) : (t & 63);
    const f32x4 c0 = *(const f32x4*)(ropeC + pos * 8), c1 = *(const f32x4*)(ropeC + pos * 8 + 4);
    const f32x4 s0 = *(const f32x4*)(ropeS + pos * 8), s1 = *(const f32x4*)(ropeS + pos * 8 + 4);
    f32x4 p0, p1;
#pragma unroll
    for (int j = 0; j < 4; ++j) { p0[j] = __shfl_xor(v0[j], 16); p1[j] = __shfl_xor(v1[j], 16); }
    const float sg = (fq & 1) ? 1.0f : -1.0f;
    v0 = v0 * c0 + (p0 * s0) * sg; v1 = v1 * c1 + (p1 * s1) * sg;
}

struct SchedMixIn {
    const char* H; const char* W; int G, c, total; bool ctx_full;
    __device__ __forceinline__ bool next(int i, gm::Unit& u) const {
        int idx; if (!gm::flat_index(i, G, c, total, idx)) return false;
        int pm, pn;
        if (idx < 1024) gm::tile_order(idx, 256, 4, pm, pn);
        else { const int j = idx - 1024; if (ctx_full) { gm::tile_order(j, 32, 4, pm, pn); pm += 256; } else { pm = 256 + j; pn = 1; } }
        constexpr unsigned P = MK_FP8_MIXIN ? 1024u : 2048u;
        u.A = H + (size_t)pm * 256 * P; u.lda = P; u.B = W + (size_t)pn * 256 * P; u.ldb = P; u.nt = 16 / (MK_FP8_MIXIN ? 2 : 1); u.x0 = pm; u.x1 = pn; u.x2 = 0; u.x3 = 0; return true;
    }
};
struct EpiMixIn {
    bf16 *CQ, *CKV, *KR, *POOL; float *SSQQ, *SSQK; const float *ropeC, *ropeS;
    __device__ __forceinline__ void operator()(AccRef accr, const gm::Unit& u, int wr, int wc, int fr, int fq) const {
        const int pn = u.x1, row0 = u.x0 * 256 + wr * 64 + fr, cl = wc * 32 + fq * 8;
        constexpr float WS = MK_FP8_MIXIN ? (1.0f / 32.0f) : 1.0f;
        f32x4 acc[2][2][4][2];
#pragma unroll
        for (int a_ = 0; a_ < 2; ++a_)
#pragma unroll
            for (int b_ = 0; b_ < 2; ++b_)
#pragma unroll
                for (int m_ = 0; m_ < 4; ++m_)
#pragma unroll
                    for (int n_ = 0; n_ < 2; ++n_) acc[a_][b_][m_][n_] = accr[a_][b_][m_][n_] * WS;
        if (pn == 0) {
#pragma unroll
            for (int ai = 0; ai < 2; ++ai)
#pragma unroll
                for (int m = 0; m < 4; ++m) { const int row = row0 + ai * 128 + m * 16; float ss = 0.f;
#pragma unroll
                    for (int bj = 0; bj < 2; ++bj) { const f32x4 a = acc[ai][bj][m][0], b = acc[ai][bj][m][1];
                        ss += (a[0] * a[0] + a[1] * a[1]) + (a[2] * a[2] + a[3] * a[3]) + (b[0] * b[0] + b[1] * b[1]) + (b[2] * b[2] + b[3] * b[3]);
                        *(u32x4*)(CQ + (size_t)row * 256 + bj * 128 + cl) = pack8(a, b); }
                    ss += __shfl_xor(ss, 16); ss += __shfl_xor(ss, 32);
                    if (fq == 0) SSQQ[(size_t)row * 4 + wc] = ss; }
        } else if (pn == 1) {
            const bool lat = u.x0 < TLAT;
#pragma unroll
            for (int ai = 0; ai < 2; ++ai)
#pragma unroll
                for (int m = 0; m < 4; ++m) { const int row = row0 + ai * 128 + m * 16;
                    const f32x4 a = acc[ai][0][m][0], b = acc[ai][0][m][1];
                    float ss = (a[0] * a[0] + a[1] * a[1]) + (a[2] * a[2] + a[3] * a[3]) + (b[0] * b[0] + b[1] * b[1]) + (b[2] * b[2] + b[3] * b[3]);
                    *(u32x4*)(CKV + (size_t)row * 128 + cl) = pack8(a, b);
                    ss += __shfl_xor(ss, 16); ss += __shfl_xor(ss, 32);
                    if (fq == 0) SSQK[(size_t)row * 4 + wc] = ss;
                    if (wc == 0) { f32x4 r0 = acc[ai][1][m][0], r1 = acc[ai][1][m][1];
                        if (lat) rope8(r0, r1, fq, row & (SEQ - 1), ropeC, ropeS);
                        *(u32x4*)(KR + (size_t)row * 32 + fq * 8) = pack8(r0, r1); } }
        } else {
#pragma unroll
            for (int ai = 0; ai < 2; ++ai)
#pragma unroll
                for (int m = 0; m < 4; ++m) { const int row = row0 + ai * 128 + m * 16;
#pragma unroll
                    for (int bj = 0; bj < 2; ++bj) *(u32x4*)(POOL + (size_t)row * 512 + (pn - 2) * 256 + bj * 128 + cl) = pack8(acc[ai][bj][m][0], acc[ai][bj][m][1]); }
        }
    }
};

struct SchedE3 {
    const char *CQ, *CKV, *WUQ, *WUK, *WUV; int G, c, nq, total;
    __device__ __forceinline__ bool next(int i, gm::Unit& u) const {
        int idx; if (!gm::flat_index(i, G, c, total, idx)) return false;
        int pm, pn; u.x3 = 0;
        if (idx < nq * 3) { gm::tile_order(idx, nq, 3, pm, pn);
            u.A = CQ + (size_t)pm * 256 * 512; u.lda = 512; u.B = WUQ + (size_t)pn * 256 * 512; u.ldb = 512; u.nt = 4; u.x0 = pm; u.x1 = pn; u.x2 = 0; return true; }
        int j = idx - nq * 3;
        if (j < 576) { gm::tile_order(j, 288, 2, pm, pn);
            u.A = CKV + (size_t)pm * 256 * 256; u.lda = 256; u.B = WUK + (size_t)pn * 256 * 256; u.ldb = 256; u.nt = 2; u.x0 = pm; u.x1 = pn; u.x2 = 1; return true; }
        j -= 576; pm = j & 1; pn = j >> 1;
        u.A = WUV + (size_t)pm * 256 * 256; u.lda = 256; u.B = CKV + (size_t)pn * 256 * 256; u.ldb = 256; u.nt = 2; u.x0 = pm; u.x1 = pn; u.x2 = 2; return true;
    }
};
struct EpiE3 {
    bf16 *Q, *KN, *VT; const float *SSQQ, *SSQK, *ropeC, *ropeS;
    __device__ __forceinline__ void operator()(AccRef acc, const gm::Unit& u, int wr, int wc, int fr, int fq) const {
        const int pm = u.x0, pn = u.x1, ty = u.x2, cl = wc * 32 + fq * 8;
        if (ty == 0) {
            const bool lat = pm < TLAT;
            float rq[2][4];
#pragma unroll
            for (int ai = 0; ai < 2; ++ai)
#pragma unroll
                for (int m = 0; m < 4; ++m) { const f32x4 sq = *(const f32x4*)(SSQQ + (size_t)(pm * 256 + wr * 64 + fr + ai * 128 + m * 16) * 4);
                    rq[ai][m] = __builtin_amdgcn_rsqf(((sq[0] + sq[1]) + (sq[2] + sq[3])) * (1.0f / 256.0f) + EPS); }
#pragma unroll
            for (int ai = 0; ai < 2; ++ai)
#pragma unroll
                for (int m = 0; m < 4; ++m) { const int row = pm * 256 + wr * 64 + fr + ai * 128 + m * 16;
#pragma unroll
                    for (int bj = 0; bj < 2; ++bj) { f32x4 a = acc[ai][bj][m][0] * rq[ai][m], b = acc[ai][bj][m][1] * rq[ai][m];
                        const int g32 = 8 * pn + 4 * bj + wc;
                        if (lat && (g32 % 3) == 2) rope8(a, b, fq, row & (SEQ - 1), ropeC, ropeS);
                        *(u32x4*)(Q + (size_t)row * QW + pn * 256 + bj * 128 + cl) = pack8(a, b); } }
        } else if (ty == 1) {
            float rk[2][4];
#pragma unroll
            for (int ai = 0; ai < 2; ++ai)
#pragma unroll
                for (int m = 0; m < 4; ++m) { const f32x4 sq = *(const f32x4*)(SSQK + (size_t)(pm * 256 + wr * 64 + fr + ai * 128 + m * 16) * 4);
                    rk[ai][m] = __builtin_amdgcn_rsqf(((sq[0] + sq[1]) + (sq[2] + sq[3])) * (1.0f / 128.0f) + EPS); }
#pragma unroll
            for (int ai = 0; ai < 2; ++ai)
#pragma unroll
                for (int m = 0; m < 4; ++m) { const int row = pm * 256 + wr * 64 + fr + ai * 128 + m * 16;
#pragma unroll
                    for (int bj = 0; bj < 2; ++bj) *(u32x4*)(KN + (size_t)row * 512 + pn * 256 + bj * 128 + cl) = pack8(acc[ai][bj][m][0] * rk[ai][m], acc[ai][bj][m][1] * rk[ai][m]); }
        } else {
            const int b = pn < TLAT ? (pn >> 3) : (pn - TLAT), key0 = pn < TLAT ? ((pn & 7) * 256) : SEQ;
            f32x4 s0[2], s1[2];
#pragma unroll
            for (int bj = 0; bj < 2; ++bj)
#pragma unroll
                for (int j = 0; j < 8; ++j) { const f32x4 sq = *(const f32x4*)(SSQK + ((size_t)pn * 256 + bj * 128 + cl + j) * 4);
                    const float rk = __builtin_amdgcn_rsqf(((sq[0] + sq[1]) + (sq[2] + sq[3])) * (1.0f / 128.0f) + EPS);
                    if (j < 4) s0[bj][j] = rk; else s1[bj][j - 4] = rk; }
#pragma unroll
            for (int bj = 0; bj < 2; ++bj)
#pragma unroll
                for (int ai = 0; ai < 2; ++ai)
#pragma unroll
                    for (int m = 0; m < 4; ++m) { const int f = pm * 256 + wr * 64 + fr + ai * 128 + m * 16;
                        *(u32x4*)(VT + ((size_t)b * 512 + f) * NKEY + key0 + bj * 128 + cl) = pack8(acc[ai][bj][m][0] * s0[bj], acc[ai][bj][m][1] * s1[bj]); }
        }
    }
};

struct SchedResid {
    const char* A; const char* W; unsigned lda; int nt, nM, G, c;
    __device__ __forceinline__ bool next(int i, gm::Unit& u) const {
        int idx; if (!gm::flat_index(i, G, c, nM * 4, idx)) return false;
        int pm, pn; gm::tile_order(idx, nM, 4, pm, pn);
        u.A = A + (size_t)pm * 256 * lda; u.lda = lda; u.B = W + (size_t)pn * 256 * lda; u.ldb = lda; u.nt = nt; u.x0 = pm; u.x1 = pn; u.x2 = 0; u.x3 = 0; return true;
    }
};
struct EpiResid {
    const float *src_lat, *src_ctx; const bf16* src16; bf16* dst; const float* gate; float ascale;
    __device__ __forceinline__ void operator()(AccRef acc, const gm::Unit& u, int wr, int wc, int fr, int fq) const {
        const int pm = u.x0, pn = u.x1; const bool lat = pm < TLAT;
        const int b = lat ? (pm >> 3) : 32;
        const int col0 = pn * 256 + wc * 32 + fq * 8;
        f32x4 g[2][2];
#pragma unroll
        for (int bj = 0; bj < 2; ++bj) { g[bj][0] = *(const f32x4*)(gate + (size_t)b * 6144 + col0 + bj * 128) * ascale; g[bj][1] = *(const f32x4*)(gate + (size_t)b * 6144 + col0 + bj * 128 + 4) * ascale; }
        if (src16) {
            u32x4 xr[2][4][2];
#pragma unroll
            for (int ai = 0; ai < 2; ++ai)
#pragma unroll
                for (int m = 0; m < 4; ++m)
#pragma unroll
                    for (int bj = 0; bj < 2; ++bj) xr[ai][m][bj] = *(const u32x4*)(src16 + (size_t)(pm * 256 + wr * 64 + fr + ai * 128 + m * 16) * D + col0 + bj * 128);
#pragma unroll
            for (int ai = 0; ai < 2; ++ai)
#pragma unroll
                for (int m = 0; m < 4; ++m) { const size_t off = (size_t)(pm * 256 + wr * 64 + fr + ai * 128 + m * 16) * D + col0;
#pragma unroll
                    for (int bj = 0; bj < 2; ++bj) { const u32x4 w = xr[ai][m][bj];
                        const f32x4 x0 = (f32x4){__uint_as_float(w.x << 16), __uint_as_float(w.x & 0xffff0000u), __uint_as_float(w.y << 16), __uint_as_float(w.y & 0xffff0000u)};
                        const f32x4 x1 = (f32x4){__uint_as_float(w.z << 16), __uint_as_float(w.z & 0xffff0000u), __uint_as_float(w.w << 16), __uint_as_float(w.w & 0xffff0000u)};
                        *(u32x4*)(dst + off + bj * 128) = pack8(x0 + g[bj][0] * acc[ai][bj][m][0], x1 + g[bj][1] * acc[ai][bj][m][1]); } }
        } else {
            const float* sp = lat ? src_lat : src_ctx - (size_t)MLAT * D;
#pragma unroll
            for (int ai = 0; ai < 2; ++ai) {
                f32x4 xf[4][2][2];
#pragma unroll
                for (int m = 0; m < 4; ++m)
#pragma unroll
                    for (int bj = 0; bj < 2; ++bj) { const float* q = sp + (size_t)(pm * 256 + wr * 64 + fr + ai * 128 + m * 16) * D + col0 + bj * 128; xf[m][bj][0] = *(const f32x4*)q; xf[m][bj][1] = *(const f32x4*)(q + 4); }
#pragma unroll
                for (int m = 0; m < 4; ++m) { const size_t off = (size_t)(pm * 256 + wr * 64 + fr + ai * 128 + m * 16) * D + col0;
#pragma unroll
                    for (int bj = 0; bj < 2; ++bj) *(u32x4*)(dst + off + bj * 128) = pack8(xf[m][bj][0] + g[bj][0] * acc[ai][bj][m][0], xf[m][bj][1] + g[bj][1] * acc[ai][bj][m][1]); }
            }
        }
    }
};

struct SchedUp {
    const char* A; const char* W; int nM, nN, G, c; unsigned ld; int nt;
    __device__ __forceinline__ bool next(int i, gm::Unit& u) const {
        int idx; if (!gm::flat_index(i, G, c, nM * nN, idx)) return false;
        int pm, pn; gm::tile_order(idx, nM, nN, pm, pn);
        u.A = A + (size_t)pm * 256 * ld; u.lda = ld; u.B = W + (size_t)pn * 256 * ld; u.ldb = ld; u.nt = nt; u.x0 = pm; u.x1 = pn; u.x2 = 0; u.x3 = 0; return true;
    }
};
__device__ __forceinline__ f32x4 swiglu4s(const f32x4 a, const f32x4 b, float cexp, float cout) {
    const f32x4 t = a * cexp; f32x4 e;
#pragma unroll
    for (int j = 0; j < 4; ++j) e[j] = __builtin_amdgcn_exp2f(t[j]);
    const f32x4 d = e + 1.0f; f32x4 r;
#pragma unroll
    for (int j = 0; j < 4; ++j) r[j] = __builtin_amdgcn_rcpf(d[j]);
    return (a * b) * (r * cout); }
__device__ __forceinline__ f32x4 swiglu4(const f32x4 a, const f32x4 b) { return swiglu4s(a, b, -1.4426950408889634f, 1.0f); }
struct EpiSwiglu {
    bf16* ACT; int ld;
    __device__ __forceinline__ void operator()(AccRef acc, const gm::Unit& u, int wr, int wc, int fr, int fq) const {
        const int row0 = u.x0 * 256 + wr * 64 + fr, col = u.x1 * 128 + wc * 32 + fq * 8;
#pragma unroll
        for (int ai = 0; ai < 2; ++ai)
#pragma unroll
            for (int m = 0; m < 4; ++m)
                *(u32x4*)(ACT + (size_t)(row0 + ai * 128 + m * 16) * ld + col) = pack8(swiglu4(acc[ai][0][m][0], acc[ai][1][m][0]), swiglu4(acc[ai][0][m][1], acc[ai][1][m][1]));
    }
};

struct SchedDftC {
    const char *WC, *HF; int G, c, total;
    __device__ __forceinline__ bool next(int i, gm::Unit& u) const {
        int idx; if (!gm::flat_index(i, G, c, total, idx)) return false;
        u.lda = 512; u.ldb = 2048; u.nt = 4; u.x3 = 0;
        if (idx < 1024) { const int bg = idx >> 3, kt = idx & 7, b = bg >> 2, g = bg & 3, ty = kt < 4 ? 0 : 1;
            u.A = WC + (size_t)ty * 256 * 512; u.B = HF + ((size_t)(b * SEQ + kt * 256) * D + g * 256) * 2; u.x0 = bg; u.x1 = kt; u.x2 = 0; return true; }
        const int j = idx - 1024, bg = j >> 1, ty = j & 1, b = bg >> 2, g = bg & 3;
        u.A = WC + (size_t)ty * 256 * 512; u.B = HF + ((size_t)(MLAT + b * LC) * D + g * 256) * 2; u.x0 = bg; u.x1 = 0; u.x2 = 1 + ty; return true;
    }
};
__device__ __forceinline__ unsigned pk4_fp8(float a, float b, float c, float d);
__device__ __forceinline__ u32x2 pack8_fp8(const f32x4 a, const f32x4 b) { u32x2 w; w.x = pk4_fp8(a[0], a[1], a[2], a[3]); w.y = pk4_fp8(b[0], b[1], b[2], b[3]); return w; }
struct EpiDftC {
    bf16 *Z, *ZC;
    __device__ __forceinline__ void operator()(AccRef acc, const gm::Unit& u, int wr, int wc, int fr, int fq) const {
        const int bg = u.x0, cl = wc * 32 + fq * 8;
        if (MK_FP8_DFT) {
            unsigned char* z8 = (unsigned char*)Z; unsigned char* zc8 = (unsigned char*)ZC;
#pragma unroll
            for (int ai = 0; ai < 2; ++ai)
#pragma unroll
                for (int m = 0; m < 4; ++m) { const int f = wr * 64 + fr + ai * 128 + m * 16;
                    if (u.x2 == 0) {
#pragma unroll
                        for (int bj = 0; bj < 2; ++bj) *(u32x2*)(z8 + ((size_t)bg * 256 + f) * 2048 + u.x1 * 256 + bj * 128 + cl) = pack8_fp8(acc[ai][bj][m][0], acc[ai][bj][m][1]); }
                    else if (u.x2 == 1) *(u32x2*)(zc8 + ((size_t)bg * 256 + f) * 256 + cl) = pack8_fp8(acc[ai][0][m][0], acc[ai][0][m][1]);
                    else *(u32x2*)(zc8 + ((size_t)bg * 256 + f) * 256 + 128 + cl) = pack8_fp8(acc[ai][1][m][0], acc[ai][1][m][1]); }
        } else
        if (u.x2 == 0) {
#pragma unroll
            for (int ai = 0; ai < 2; ++ai)
#pragma unroll
                for (int m = 0; m < 4; ++m) { const int f = wr * 64 + fr + ai * 128 + m * 16;
#pragma unroll
                    for (int bj = 0; bj < 2; ++bj) *(u32x4*)(Z + ((size_t)bg * 256 + f) * 2048 + u.x1 * 256 + bj * 128 + cl) = pack8(acc[ai][bj][m][0], acc[ai][bj][m][1]); }
        } else {
            if (u.x2 == 1) {
#pragma unroll
                for (int ai = 0; ai < 2; ++ai)
#pragma unroll
                    for (int m = 0; m < 4; ++m) { const int f = wr * 64 + fr + ai * 128 + m * 16;
                        *(u32x4*)(ZC + ((size_t)bg * 256 + f) * 256 + cl) = pack8(acc[ai][0][m][0], acc[ai][0][m][1]); }
            } else {
#pragma unroll
                for (int ai = 0; ai < 2; ++ai)
#pragma unroll
                    for (int m = 0; m < 4; ++m) { const int f = wr * 64 + fr + ai * 128 + m * 16;
                        *(u32x4*)(ZC + ((size_t)bg * 256 + f) * 256 + 128 + cl) = pack8(acc[ai][1][m][0], acc[ai][1][m][1]); }
            }
        }
    }
};

struct SchedDftS {
    const char *WL, *WX, *Z, *ZC; int G, c, total;
    __device__ __forceinline__ bool next(int i, gm::Unit& u) const {
        int idx; if (!gm::flat_index(i, G, c, total, idx)) return false;
        u.x3 = 0;
        if (idx < 1024) { const int bg = idx >> 3, kt = idx & 7;
            constexpr unsigned P = MK_FP8_DFT ? 2048u : 4096u;
            u.A = WL + (size_t)kt * 256 * P; u.lda = P; u.B = Z + (size_t)bg * 256 * P; u.ldb = P; u.nt = 32 / (MK_FP8_DFT ? 2 : 1); u.x0 = bg; u.x1 = kt; u.x2 = 0; return true; }
        const int bg = idx - 1024; constexpr unsigned PX = MK_FP8_DFT ? 256u : 512u;
        u.A = WX; u.lda = PX; u.B = ZC + (size_t)bg * 256 * PX; u.ldb = PX; u.nt = 4 / (MK_FP8_DFT ? 2 : 1); u.x0 = bg; u.x1 = 0; u.x2 = 1; return true;
    }
};
struct EpiDftS {
    bf16* F; const float* AMID;
    __device__ __forceinline__ void operator()(AccRef acc, const gm::Unit& u, int wr, int wc, int fr, int fq) const {
        const int bg = u.x0, b = bg >> 2, g = bg & 3, cl = wc * 32 + fq * 8; const bool cx = u.x2 != 0;
        constexpr float TS = MK_FP8_DFT ? (1.0f / 16.0f) : 1.0f;
        const float scale = cx ? (1.0f / 256.0f) : 0.0013810679320049757f;
        const size_t rbase = cx ? (size_t)(MLAT + b * LC) : (size_t)b * SEQ + u.x1 * 256;
        const float* am = AMID + (size_t)(cx ? 32 + b : b) * D + g * 256;
        f32x4 a4[2][2];
#pragma unroll
        for (int bj = 0; bj < 2; ++bj) { a4[bj][0] = *(const f32x4*)(am + bj * 128 + cl); a4[bj][1] = *(const f32x4*)(am + bj * 128 + cl + 4); }
#pragma unroll
        for (int ai = 0; ai < 2; ++ai)
#pragma unroll
            for (int m = 0; m < 4; ++m) { const int k = wr * 64 + fr + ai * 128 + m * 16; const float sg = (k & 1) ? -1.0f : 1.0f;
#pragma unroll
                for (int bj = 0; bj < 2; ++bj)
                    *(u32x4*)(F + (rbase + k) * D + g * 256 + bj * 128 + cl) = pack8((acc[ai][bj][m][0] * TS + a4[bj][0] * sg) * scale, (acc[ai][bj][m][1] * TS + a4[bj][1] * sg) * scale); }
    }
};

constexpr float W8_SCALE = 32.0f, A8_SCALE = 4.0f;
__device__ __forceinline__ unsigned pk4_fp8(float a, float b, float c, float d) {
    a = __builtin_amdgcn_fmed3f(a, -448.f, 448.f); b = __builtin_amdgcn_fmed3f(b, -448.f, 448.f); c = __builtin_amdgcn_fmed3f(c, -448.f, 448.f); d = __builtin_amdgcn_fmed3f(d, -448.f, 448.f);
    int w = 0; w = __builtin_amdgcn_cvt_pk_fp8_f32(a, b, w, false); w = __builtin_amdgcn_cvt_pk_fp8_f32(c, d, w, true); return (unsigned)w; }
struct MoeInfo { int cnt[8]; int tb[9]; };
__device__ __forceinline__ void moe_info(const unsigned* cntw, MoeInfo& mi) {
    mi.tb[0] = 0;
#pragma unroll
    for (int e = 0; e < 8; ++e) { mi.cnt[e] = (int)__builtin_amdgcn_readfirstlane(__hip_atomic_load(cntw + 64 * e, __ATOMIC_RELAXED, __HIP_MEMORY_SCOPE_AGENT)); mi.tb[e + 1] = mi.tb[e] + ((mi.cnt[e] + 255) >> 8); }
}
__device__ __forceinline__ void moe_find(const MoeInfo& mi, int gt, int& e, int& rt, int& cnt) {
    e = 0; rt = gt; cnt = mi.cnt[0];
#pragma unroll
    for (int k = 1; k < 8; ++k) if (gt >= mi.tb[k]) { e = k; rt = gt - mi.tb[k]; cnt = mi.cnt[k]; }
}
struct SchedMoeUp {
    const char *H2, *W13; const int* list; MoeInfo mi; int G, c;
    __device__ __forceinline__ bool next(int i, gm::Unit& u) const {
        int idx; if (!gm::flat_index(i, G, c, mi.tb[8] * 28, idx)) return false;
        int gt, pn; gm::tile_order(idx, mi.tb[8], 28, gt, pn);
        int e, rt, cnt; moe_find(mi, gt, e, rt, cnt);
        u.A = H2; u.lda = 2048; u.B = W13 + ((size_t)e * 7168 + (size_t)pn * 256) * 2048; u.ldb = 2048; u.nt = 16; u.x0 = gt; u.x1 = pn; u.x2 = e * 65536 * 2 + cnt; u.x3 = rt * 256; return true;
    }
    __device__ __forceinline__ int gather_row(const gm::Unit& u, int lr) const {
        const int e = u.x2 >> 17, cnt = u.x2 & 0x1ffff; int j = u.x3 + lr; j = j < cnt ? j : cnt - 1;
        return list[(size_t)e * MALL + j];
    }
};
struct SchedMoeUp8 {
    const char *H2, *W13; const int* list; MoeInfo mi; int G, c;
    __device__ __forceinline__ bool next(int i, gm::Unit& u) const {
        int idx; if (!gm::flat_index(i, G, c, mi.tb[8] * 28, idx)) return false;
        int gt, pn; gm::tile_order(idx, mi.tb[8], 28, gt, pn);
        int e, rt, cnt; moe_find(mi, gt, e, rt, cnt);
        u.A = H2; u.lda = 1024; u.B = W13 + ((size_t)e * 7168 + (size_t)pn * 256) * 1024; u.ldb = 1024; u.nt = 8; u.x0 = gt; u.x1 = pn; u.x2 = e * 65536 * 2 + cnt; u.x3 = rt * 256; return true;
    }
    __device__ __forceinline__ int gather_row(const gm::Unit& u, int lr) const {
        const int e = u.x2 >> 17, cnt = u.x2 & 0x1ffff; int j = u.x3 + lr; j = j < cnt ? j : cnt - 1;
        return list[(size_t)e * MALL + j];
    }
};
struct EpiSwiglu8 {
    unsigned char* ACT8; int ld;
    __device__ __forceinline__ void operator()(AccRef acc, const gm::Unit& u, int wr, int wc, int fr, int fq) const {
        const int row0 = u.x0 * 256 + wr * 64 + fr, col = u.x1 * 128 + wc * 32 + fq * 8;
#pragma unroll 1
        for (int rep_ = 0; rep_ < 1 + (int)((MK_DUP >> 24) & 1u); ++rep_)
#pragma unroll
        for (int ai = 0; ai < 2; ++ai)
#pragma unroll
            for (int m = 0; m < 4; ++m) {
                constexpr float CE = -1.4426950408889634f / W8_SCALE, CO = A8_SCALE / (W8_SCALE * W8_SCALE);
                const f32x4 v0 = swiglu4s(acc[ai][0][m][0], acc[ai][1][m][0], CE, CO), v1 = swiglu4s(acc[ai][0][m][1], acc[ai][1][m][1], CE, CO);
                u32x2 w; w.x = pk4_fp8(v0[0], v0[1], v0[2], v0[3]); w.y = pk4_fp8(v1[0], v1[1], v1[2], v1[3]);
                *(u32x2*)(ACT8 + (size_t)(row0 + ai * 128 + m * 16) * ld + col) = w; }
    }
};
struct SchedMoeDown8 {
    const char *Ab, *W2; MoeInfo mi; int G, c;
    __device__ __forceinline__ bool next(int i, gm::Unit& u) const {
        int idx; if (!gm::flat_index(i, G, c, mi.tb[8] * 4, idx)) return false;
        int gt, pn; gm::tile_order(idx, mi.tb[8], 4, gt, pn);
        int e, rt, cnt; moe_find(mi, gt, e, rt, cnt);
        u.A = Ab + (size_t)gt * 256 * 3584; u.lda = 3584; u.B = W2 + ((size_t)e * 1024 + (size_t)pn * 256) * 3584; u.ldb = 3584; u.nt = 28; u.x0 = gt; u.x1 = pn; u.x2 = e * 65536 * 2 + cnt; u.x3 = rt * 256; return true;
    }
};
struct SchedMoeUpDense {
    const char *H2, *W13; MoeInfo mi; int G, c;
    __device__ __forceinline__ bool next(int i, gm::Unit& u) const {
        int idx; if (!gm::flat_index(i, G, c, mi.tb[8] * 28, idx)) return false;
        int gt, pn; gm::tile_order(idx, mi.tb[8], 28, gt, pn);
        int e, rt, cnt; moe_find(mi, gt, e, rt, cnt);
        u.A = H2 + (size_t)(gt & 255) * 256 * 2048; u.lda = 2048; u.B = W13 + ((size_t)e * 7168 + (size_t)pn * 256) * 2048; u.ldb = 2048; u.nt = 16; u.x0 = gt; u.x1 = pn; u.x2 = 0; u.x3 = 0; return true;
    }
};
struct SchedMoeDown {
    const char *Ab, *W2; MoeInfo mi; int G, c;
    __device__ __forceinline__ bool next(int i, gm::Unit& u) const {
        int idx; if (!gm::flat_index(i, G, c, mi.tb[8] * 4, idx)) return false;
        int gt, pn; gm::tile_order(idx, mi.tb[8], 4, gt, pn);
        int e, rt, cnt; moe_find(mi, gt, e, rt, cnt);
        u.A = Ab + (size_t)gt * 256 * 7168; u.lda = 7168; u.B = W2 + ((size_t)e * 1024 + (size_t)pn * 256) * 7168; u.ldb = 7168; u.nt = 56; u.x0 = gt; u.x1 = pn; u.x2 = e * 65536 * 2 + cnt; u.x3 = rt * 256; return true;
    }
};
struct EpiMoeDown {
    bf16* x16; const float* gate; const int* list; const float* glist; float ascale; bf16* dst16;
    __device__ __forceinline__ void operator()(AccRef acc, const gm::Unit& u, int wr, int wc, int fr, int fq) const {
        const int e = u.x2 >> 17, cnt = u.x2 & 0x1ffff, col0 = u.x1 * 256 + wc * 32 + fq * 8;
        int tok[2][4]; float gv[2][4];
#pragma unroll
        for (int ai = 0; ai < 2; ++ai)
#pragma unroll
            for (int m = 0; m < 4; ++m) { int j = u.x3 + wr * 64 + fr + ai * 128 + m * 16; const bool ok = j < cnt; j = ok ? j : cnt - 1;
                const int t = list[(size_t)e * MALL + j]; tok[ai][m] = ok ? t : -1 - t; gv[ai][m] = glist[(size_t)e * MALL + j] * ascale; }
        u32x4 xr[2][4][2];
#pragma unroll
        for (int ai = 0; ai < 2; ++ai)
#pragma unroll
            for (int m = 0; m < 4; ++m) { const int t = tok[ai][m] < 0 ? -1 - tok[ai][m] : tok[ai][m];
#pragma unroll
                for (int bj = 0; bj < 2; ++bj) xr[ai][m][bj] = *(const u32x4*)(x16 + (size_t)t * D + col0 + bj * 128); }
#pragma unroll
        for (int ai = 0; ai < 2; ++ai)
#pragma unroll
            for (int m = 0; m < 4; ++m) { const int t = tok[ai][m];
                if (t >= 0) { const int b = t < MLAT ? (t >> 11) : 32; const float* gp = gate + (size_t)b * 6144 + col0;
#pragma unroll
                    for (int bj = 0; bj < 2; ++bj) {
                        const f32x4 g0 = *(const f32x4*)(gp + bj * 128) * gv[ai][m], g1 = *(const f32x4*)(gp + bj * 128 + 4) * gv[ai][m];
                        const u32x4 w = xr[ai][m][bj];
                        const f32x4 x0 = (f32x4){__uint_as_float(w.x << 16), __uint_as_float(w.x & 0xffff0000u), __uint_as_float(w.y << 16), __uint_as_float(w.y & 0xffff0000u)};
                        const f32x4 x1 = (f32x4){__uint_as_float(w.z << 16), __uint_as_float(w.z & 0xffff0000u), __uint_as_float(w.w << 16), __uint_as_float(w.w & 0xffff0000u)};
                        *(u32x4*)(dst16 + (size_t)t * D + col0 + bj * 128) = pack8(x0 + g0 * acc[ai][bj][m][0], x1 + g1 * acc[ai][bj][m][1]); } } }
    }
};

struct ModP { f32x4 gm[4]; f32x4 sh[4]; };
__device__ __forceinline__ void load_modp(ModP& p, const float* g, const float* modrow, int off_sh, int off_sc, int lane) {
#pragma unroll
    for (int j = 0; j < 4; ++j) { const int c = 4 * lane + 256 * j;
        const f32x4 g4 = *(const f32x4*)(g + c), sc = *(const f32x4*)(modrow + off_sc + c);
        p.gm[j] = g4 * (sc + 1.0f); p.sh[j] = *(const f32x4*)(modrow + off_sh + c); }
}
struct XSrc { const float* lat; const float* ctx; const bf16* x16; };
__device__ __forceinline__ void load_xrow(const XSrc& xs, int row, int lane, f32x4 (&v)[4]) {
    if (xs.x16) { const u32x2* p = (const u32x2*)(xs.x16 + (size_t)row * D);
#pragma unroll
        for (int j = 0; j < 4; ++j) { const u32x2 w = p[lane + 64 * j]; v[j] = (f32x4){__uint_as_float(w.x << 16), __uint_as_float(w.x & 0xffff0000u), __uint_as_float(w.y << 16), __uint_as_float(w.y & 0xffff0000u)}; } }
    else { const f32x4* p = (const f32x4*)(row < MLAT ? xs.lat + (size_t)row * D : xs.ctx + (size_t)(row - MLAT) * D);
#pragma unroll
        for (int j = 0; j < 4; ++j) v[j] = p[lane + 64 * j]; }
}
struct XRaw { u32x2 w[4]; f32x4 f[4]; };
__device__ __forceinline__ void load_xraw(const XSrc& xs, int row, int lane, XRaw& r) {
    if (xs.x16) { const u32x2* p = (const u32x2*)(xs.x16 + (size_t)row * D);
#pragma unroll
        for (int j = 0; j < 4; ++j) r.w[j] = p[lane + 64 * j]; }
    else { const f32x4* p = (const f32x4*)(row < MLAT ? xs.lat + (size_t)row * D : xs.ctx + (size_t)(row - MLAT) * D);
#pragma unroll
        for (int j = 0; j < 4; ++j) r.f[j] = p[lane + 64 * j]; }
}
__device__ __forceinline__ void mod_row_raw(const XSrc& xs, const XRaw& r, const ModP& p, f32x4 (&h)[4]) {
    f32x4 v[4]; float ss = 0.f;
    if (xs.x16) {
#pragma unroll
        for (int j = 0; j < 4; ++j) { const u32x2 w = r.w[j]; v[j] = (f32x4){__uint_as_float(w.x << 16), __uint_as_float(w.x & 0xffff0000u), __uint_as_float(w.y << 16), __uint_as_float(w.y & 0xffff0000u)}; } }
    else {
#pragma unroll
        for (int j = 0; j < 4; ++j) v[j] = r.f[j]; }
#pragma unroll
    for (int j = 0; j < 4; ++j) ss += (v[j][0] * v[j][0] + v[j][1] * v[j][1]) + (v[j][2] * v[j][2] + v[j][3] * v[j][3]);
    ss = wave_sum(ss);
    const float rr = 1.0f / sqrtf(ss * (1.0f / D) + EPS);
#pragma unroll
    for (int j = 0; j < 4; ++j) h[j] = (v[j] * rr) * p.gm[j] + p.sh[j];
}
__device__ __forceinline__ void mod_row(const XSrc& xs, int row, const ModP& p, int lane, f32x4 (&h)[4]) {
    f32x4 v[4]; float ss = 0.f; load_xrow(xs, row, lane, v);
#pragma unroll
    for (int j = 0; j < 4; ++j) { ss += (v[j][0] * v[j][0] + v[j][1] * v[j][1]) + (v[j][2] * v[j][2] + v[j][3] * v[j][3]); }
    ss = wave_sum(ss);
    const float r = 1.0f / sqrtf(ss * (1.0f / D) + EPS);
#pragma unroll
    for (int j = 0; j < 4; ++j) h[j] = (v[j] * r) * p.gm[j] + p.sh[j];
}
__device__ __forceinline__ void store_row_bf16(bf16* dst, const f32x4 (&h)[4], int lane) {
#pragma unroll
    for (int j = 0; j < 4; ++j) { u32x2 w; w.x = pkbf(h[j][0], h[j][1]); w.y = pkbf(h[j][2], h[j][3]); ((u32x2*)dst)[lane + 64 * j] = w; }
}

__device__ __forceinline__ void phase_mod_plain(const XSrc& xs, const float* g, const float* modbase, int off_sh, int off_sc, bf16* H, bool out8, int nrows, int gw, int NGW, int lane) {
    const int rpw = (nrows + NGW - 1) / NGW; const int r0 = gw * rpw; int r1 = r0 + rpw; if (r1 > nrows) r1 = nrows;
    int curb = -1; ModP p; XRaw cur, nxt; nxt = XRaw{};
    if (r0 < r1) load_xraw(xs, r0, lane, cur);
    for (int row = r0; row < r1; ++row) {
        if (row + 1 < r1) load_xraw(xs, row + 1, lane, nxt);
        const int b = row < MLAT ? (row >> 11) : 32;
        if (b != curb) { load_modp(p, g, modbase + (size_t)b * 6144, off_sh, off_sc, lane); curb = b; }
        f32x4 h[4]; mod_row_raw(xs, cur, p, h); cur = nxt;
        if (out8) { unsigned char* o8 = (unsigned char*)H + (size_t)row * D;
#pragma unroll
            for (int j = 0; j < 4; ++j) ((unsigned*)o8)[lane + 64 * j] = pk4_fp8(h[j][0], h[j][1], h[j][2], h[j][3]); }
        else store_row_bf16(H + (size_t)row * D, h, lane);
    }
}

__device__ __forceinline__ void phase_mod_fold(const XSrc& xs, const float* g, const float* modbase, bf16* HF, float* HMID, bool with_ctx, int gw, int NGW, int lane) {
    constexpr int IL = SEQ / 2 + 1, IC = LC / 2 + 1;
    const int nitems = NB * IL + (with_ctx ? NB * IC : 0);
    const int ipw = (nitems + NGW - 1) / NGW; const int i0 = gw * ipw; int i1 = i0 + ipw; if (i1 > nitems) i1 = nitems;
    int curb = -1; ModP p;
    for (int it = i0; it < i1; ++it) {
        const bool cx = it >= NB * IL; const int j = cx ? it - NB * IL : it;
        const int b = cx ? j / IC : j / IL, n = cx ? j % IC : j % IL, Ls = cx ? LC : SEQ;
        const int mb = cx ? 32 : b, key = cx ? 64 : b;
        if (key != curb) { load_modp(p, g, modbase + (size_t)mb * 6144, 0, 1024, lane); curb = key; }
        const int rbase = cx ? MLAT + b * LC : b * SEQ;
        bf16* hf = HF + (size_t)rbase * D;
        f32x4 h1[4]; mod_row(xs, rbase + n, p, lane, h1);
        if (n == 0) { store_row_bf16(hf, h1, lane); f32x4 z[4];
#pragma unroll
            for (int q = 0; q < 4; ++q) z[q] = (f32x4){0.f, 0.f, 0.f, 0.f};
            store_row_bf16(hf + (size_t)(Ls / 2) * D, z, lane); }
        else if (n == Ls / 2) { float* hm = HMID + (size_t)(cx ? 32 + b : b) * D;
#pragma unroll
            for (int q = 0; q < 4; ++q) ((f32x4*)hm)[lane + 64 * q] = h1[q]; }
        else { f32x4 h2[4]; mod_row(xs, rbase + Ls - n, p, lane, h2); f32x4 s[4], d[4];
#pragma unroll
            for (int q = 0; q < 4; ++q) { s[q] = h1[q] + h2[q]; d[q] = h1[q] - h2[q]; }
            store_row_bf16(hf + (size_t)n * D, s, lane); store_row_bf16(hf + (size_t)(Ls / 2 + n) * D, d, lane); }
    }
}

template <bool ROUTER>
__device__ __forceinline__ void phase_mod2(const XSrc& xs, const float* g, const float* modbase, bf16* H2, bool out8, int nrows,
                                           const float* router_w, unsigned* gcnt, int* list, float* glist, LAS unsigned char* lds, int vcu, int G, int wave, int lane, int tid) {
    const int rpb = nrows / G, rpw = rpb / 8;
    const int r0 = vcu * rpb + wave * rpw;
    LAS float* rwT = (LAS float*)lds; LAS int* bcnt = (LAS int*)(lds + 32768); LAS int* bbase = (LAS int*)(lds + 32768 + 64);
    if constexpr (ROUTER) {
        for (int i = tid; i < 8192; i += 512) { const int c = i >> 3, e = i & 7; rwT[e * 1024 + c] = router_w[i]; }
        if (tid < 16) bcnt[tid] = 0;
        __syncthreads();
    }
    int curb = -1; ModP p; int me0 = -1, me1 = -1; float mp0 = 0.f, mp1 = 0.f; XRaw cur, nxt; nxt = XRaw{};
    load_xraw(xs, r0, lane, cur);
    for (int rr = 0; rr < rpw; ++rr) {
        const int row = r0 + rr; const int b = row < MLAT ? (row >> 11) : 32;
        if (rr + 1 < rpw) load_xraw(xs, row + 1, lane, nxt);
        if (b != curb) { load_modp(p, g, modbase + (size_t)b * 6144, 3072, 4096, lane); curb = b; }
        f32x4 h[4]; mod_row_raw(xs, cur, p, h); cur = nxt;
        if (out8) { unsigned char* o8 = (unsigned char*)H2 + (size_t)row * D;
#pragma unroll
            for (int j = 0; j < 4; ++j) ((unsigned*)o8)[lane + 64 * j] = pk4_fp8(h[j][0], h[j][1], h[j][2], h[j][3]); }
        else store_row_bf16(H2 + (size_t)row * D, h, lane);
        if constexpr (ROUTER) {
            asm volatile("" ::: "memory");
            float lg[8];
#pragma unroll
            for (int e = 0; e < 8; ++e) { float s = 0.f;
#pragma unroll
                for (int j = 0; j < 4; ++j) { const f32x4 w = *(const LAS f32x4*)(rwT + e * 1024 + 4 * lane + 256 * j); s += (h[j][0] * w[0] + h[j][1] * w[1]) + (h[j][2] * w[2] + h[j][3] * w[3]); }
                lg[e] = s; }
            {
                const bool b5 = (lane & 32) != 0, b4 = (lane & 16) != 0, b3 = (lane & 8) != 0;
                float v4[4], v2[2];
#pragma unroll
                for (int j = 0; j < 4; ++j) { const float snd = b5 ? lg[j] : lg[4 + j], kp = b5 ? lg[4 + j] : lg[j]; v4[j] = kp + __shfl_xor(snd, 32); }
#pragma unroll
                for (int j = 0; j < 2; ++j) { const float snd = b4 ? v4[j] : v4[2 + j], kp = b4 ? v4[2 + j] : v4[j]; v2[j] = kp + __shfl_xor(snd, 16); }
                float v1; { const float snd = b3 ? v2[0] : v2[1], kp = b3 ? v2[1] : v2[0]; v1 = kp + __shfl_xor(snd, 8); }
                v1 += __shfl_xor(v1, 4); v1 += __shfl_xor(v1, 2); v1 += __shfl_xor(v1, 1);
#pragma unroll
                for (int e = 0; e < 8; ++e) lg[e] = __uint_as_float((unsigned)__builtin_amdgcn_readlane((int)__float_as_uint(v1), e * 8));
            }
            int e0 = 0; float v0 = lg[0];
#pragma unroll
            for (int e = 1; e < 8; ++e) if (lg[e] > v0) { v0 = lg[e]; e0 = e; }
            int e1 = -1; float v1 = -3.0e38f;
#pragma unroll
            for (int e = 0; e < 8; ++e) if (e != e0 && lg[e] > v1) { v1 = lg[e]; e1 = e; }
            const float p0 = 1.0f / (1.0f + __expf(v1 - v0));
            if (lane == rr) { me0 = e0; me1 = e1; mp0 = p0; mp1 = 1.0f - p0; }
        }
    }
    if constexpr (ROUTER) {
        int rank0 = 0, rank1 = 0, mycnt = 0;
        const unsigned long long lt = (lane == 0) ? 0ull : (~0ull >> (64 - lane));
#pragma unroll
        for (int e = 0; e < 8; ++e) {
            const unsigned long long m0 = __ballot(me0 == e), m1 = __ballot(me1 == e);
            if (me0 == e) rank0 = __popcll(m0 & lt);
            if (me1 == e) rank1 = __popcll(m1 & lt);
            if (lane == e) mycnt = __popcll(m0);
            if (lane == 8 + e) mycnt = __popcll(m1);
        }
        int woff = 0;
        if (lane < 16) woff = __hip_atomic_fetch_add(bcnt + lane, mycnt, __ATOMIC_RELAXED, __HIP_MEMORY_SCOPE_WORKGROUP);
        __syncthreads();
        if (tid < 16) bbase[tid] = (int)__hip_atomic_fetch_add(gcnt + 64 * tid, (unsigned)bcnt[tid], __ATOMIC_RELAXED, __HIP_MEMORY_SCOPE_AGENT);
        __syncthreads();
        const int w0 = __shfl(woff, me0 < 0 ? 0 : me0), w1 = __shfl(woff, me1 < 0 ? 8 : 8 + me1);
        if (me0 >= 0) { const int row = r0 + lane;
            const int p0 = bbase[me0] + w0 + rank0, p1 = bbase[8 + me1] + w1 + rank1;
            list[(size_t)me0 * MALL + p0] = row; glist[(size_t)me0 * MALL + p0] = mp0;
            list[(size_t)(8 + me1) * MALL + p1] = row; glist[(size_t)(8 + me1) * MALL + p1] = mp1; }
        __syncthreads();
    }
}

__device__ __forceinline__ void phase_final(const bf16* x16, float* out, const float* g, int gw, int NGW, int lane) {
    const int rpw = (MLAT + NGW - 1) / NGW; const int r0 = gw * rpw; int r1 = r0 + rpw; if (r1 > MLAT) r1 = MLAT;
    f32x4 g4[4];
#pragma unroll
    for (int j = 0; j < 4; ++j) g4[j] = *(const f32x4*)(g + 4 * lane + 256 * j);
    XSrc xs{nullptr, nullptr, x16};
    for (int row = r0; row < r1; ++row) { f32x4 v[4]; float ss = 0.f; load_xrow(xs, row, lane, v);
#pragma unroll
        for (int j = 0; j < 4; ++j) ss += (v[j][0] * v[j][0] + v[j][1] * v[j][1]) + (v[j][2] * v[j][2] + v[j][3] * v[j][3]);
        ss = wave_sum(ss); const float r = 1.0f / sqrtf(ss * (1.0f / D) + EPS);
#pragma unroll
        for (int j = 0; j < 4; ++j) ((f32x4*)(out + (size_t)row * D))[lane + 64 * j] = (v[j] * r) * g4[j]; }
}

__device__ __forceinline__ void phase_pool(const bf16* POOL, bf16* MIXCAT, int nrows, int gw, int NGW, int lane) {
    const int rs = lane >> 4, cb = lane & 15;
    for (int it = gw; it < (nrows / 64) * 4; it += NGW) { const int seg = it >> 2, g = it & 3, w = 2 << g, hw = w >> 1;
        const int row0 = seg * 64 + rs * 16;
        const int Ls = row0 < MLAT ? SEQ : LC, sb = row0 < MLAT ? (row0 & ~(SEQ - 1)) : (MLAT + ((row0 - MLAT) & ~(LC - 1))), t0 = row0 - sb;
        const bf16* src = POOL + (size_t)sb * 512 + g * 128 + cb * 8; bf16* dstp = MIXCAT + (size_t)sb * D + 512 + g * 128 + cb * 8;
        float s[8];
#pragma unroll
        for (int k = 0; k < 8; ++k) s[k] = 0.f;
        for (int j = 0; j < w; ++j) { const int tt = t0 - hw + j;
            if (tt >= 0 && tt < Ls) { const u32x4 v = *(const u32x4*)(src + (size_t)tt * 512);
#pragma unroll
                for (int k = 0; k < 4; ++k) { s[2 * k] += __uint_as_float(v[k] << 16); s[2 * k + 1] += __uint_as_float(v[k] & 0xffff0000u); } } }
#pragma unroll 4
        for (int q = 0; q < 16; ++q) { const int t = t0 + q;
            int lo = t - hw; if (lo < 0) lo = 0; int hi = t + hw; if (hi > Ls) hi = Ls;
            const u32x4 self = *(const u32x4*)(src + (size_t)t * 512);
            const int tin = t + hw, tout = t - hw;
            u32x4 vin = (u32x4){0u, 0u, 0u, 0u}, vout = (u32x4){0u, 0u, 0u, 0u};
            if (q < 15) { if (tin < Ls) vin = *(const u32x4*)(src + (size_t)tin * 512); if (tout >= 0) vout = *(const u32x4*)(src + (size_t)tout * 512); }
            const float inv = 1.0f / (float)(hi - lo); u32x4 o;
#pragma unroll
            for (int k = 0; k < 4; ++k) o[k] = pkbf(s[2 * k] * inv - __uint_as_float(self[k] << 16), s[2 * k + 1] * inv - __uint_as_float(self[k] & 0xffff0000u));
            *(u32x4*)(dstp + (size_t)t * D) = o;
#pragma unroll
            for (int k = 0; k < 4; ++k) { s[2 * k] += __uint_as_float(vin[k] << 16) - __uint_as_float(vout[k] << 16); s[2 * k + 1] += __uint_as_float(vin[k] & 0xffff0000u) - __uint_as_float(vout[k] & 0xffff0000u); } }
    }
}

__device__ __forceinline__ void phase_amid(const float* HMID_, float* AMID_, LAS unsigned char* lds, int G, int bid, int tid) {
    LAS float* ct = (LAS float*)lds;
    if (tid < 256) ct[tid] = cospif((float)tid * (1.0f / 128.0f));
    __syncthreads();
    for (int o = bid * 512 + tid; o < 64 * 1024; o += G * 512) { const int r = o >> 10, gq = (o >> 8) & 3, m = o & 255;
        const float* hp = HMID_ + (size_t)r * D + gq * 256; float s = 0.f;
#pragma unroll 4
        for (int c = 0; c < 256; ++c) s += hp[c] * ct[(m * c) & 255];
        AMID_[o] = s; }
    __syncthreads();
}

constexpr int AT_KP = 208, AT_VP = 136, AT_VOFF = 64 * AT_KP, AT_BUF = 22528;
__device__ __forceinline__ f32x16 mfma32(bf16x8 a, bf16x8 b, f32x16 c) { return __builtin_amdgcn_mfma_f32_32x32x16_bf16(a, b, c, 0, 0, 0); }
__device__ __forceinline__ bf16x8 pack_s(const f32x16& x, int s) {
    u32x4 p; p.x = pkbf(x[8 * s], x[8 * s + 1]); p.y = pkbf(x[8 * s + 2], x[8 * s + 3]); p.z = pkbf(x[8 * s + 4], x[8 * s + 5]); p.w = pkbf(x[8 * s + 6], x[8 * s + 7]);
    return __builtin_bit_cast(bf16x8, p);
}
#define AT_MX3(a, b, c) __builtin_fmaxf(__builtin_fmaxf((a), (b)), (c))
#define AT_SOFTMAX(S0, S1, M, L, O0, O1, FIRST) do { \
        float ma_ = AT_MX3(S0[0], S0[1], S0[2]), mb_ = AT_MX3(S0[3], S0[4], S0[5]), mc_ = AT_MX3(S1[0], S1[1], S1[2]), md_ = AT_MX3(S1[3], S1[4], S1[5]); \
        ma_ = AT_MX3(ma_, S0[6], S0[7]); mb_ = AT_MX3(mb_, S0[8], S0[9]); mc_ = AT_MX3(mc_, S1[6], S1[7]); md_ = AT_MX3(md_, S1[8], S1[9]); \
        ma_ = AT_MX3(ma_, S0[10], S0[11]); mb_ = AT_MX3(mb_, S0[12], S0[13]); mc_ = AT_MX3(mc_, S1[10], S1[11]); md_ = AT_MX3(md_, S1[12], S1[13]); \
        ma_ = AT_MX3(ma_, S0[14], S0[15]); mc_ = AT_MX3(mc_, S1[14], S1[15]); \
        float mx = __builtin_fmaxf(__builtin_fmaxf(ma_, mb_), __builtin_fmaxf(mc_, md_)); \
        mx = __builtin_fmaxf(mx, __shfl_xor(mx, 32)); \
        if (FIRST) { M += mx; _Pragma("unroll") for (int i_ = 0; i_ < 16; ++i_) { S0[i_] -= mx; S1[i_] -= mx; } } \
        else if (__any(mx > 8.0f)) { const float dl_ = __builtin_fmaxf(mx, 0.f), alpha_ = __builtin_amdgcn_exp2f(-dl_); M += dl_; L *= alpha_; \
            _Pragma("unroll") for (int i_ = 0; i_ < 16; ++i_) { S0[i_] -= dl_; S1[i_] -= dl_; O0[i_] *= alpha_; O1[i_] *= alpha_; } } \
        float pa_ = 0.f, pb_ = 0.f, pc_ = 0.f, pd_ = 0.f; \
        _Pragma("unroll") for (int i_ = 0; i_ < 16; i_ += 2) { S0[i_] = __builtin_amdgcn_exp2f(S0[i_]); S0[i_ + 1] = __builtin_amdgcn_exp2f(S0[i_ + 1]); S1[i_] = __builtin_amdgcn_exp2f(S1[i_]); S1[i_ + 1] = __builtin_amdgcn_exp2f(S1[i_ + 1]); \
            pa_ += S0[i_]; pb_ += S0[i_ + 1]; pc_ += S1[i_]; pd_ += S1[i_ + 1]; } \
        L += (pa_ + pb_) + (pc_ + pd_); } while (0)
__device__ __forceinline__ void attn_store(bf16* op, const f32x16& o0, const f32x16& o1, float inv) {
#pragma unroll
    for (int gq = 0; gq < 4; ++gq) {
        u32x2 w0, w1; w0.x = pkbf(o0[4 * gq] * inv, o0[4 * gq + 1] * inv); w0.y = pkbf(o0[4 * gq + 2] * inv, o0[4 * gq + 3] * inv);
        w1.x = pkbf(o1[4 * gq] * inv, o1[4 * gq + 1] * inv); w1.y = pkbf(o1[4 * gq + 2] * inv, o1[4 * gq + 3] * inv);
        *(u32x2*)(op + 8 * gq) = w0; *(u32x2*)(op + 32 + 8 * gq) = w1; }
}
__device__ __forceinline__ void attn_unit(LAS unsigned char* lds, const bf16* Q, const bf16* KN, const bf16* KR, const bf16* VT, bf16* O,
                                          int b, int hp, int qrow0, int key_lo, int ntiles, int tid) {
    const int lane = tid & 63, r = lane & 31, hh = lane >> 5, wid = __builtin_amdgcn_readfirstlane(tid >> 6), gsel = wid >> 2, wq = wid & 3, gt = tid & 255;
    const int h = hp * 2 + gsel;
    LAS unsigned char* gl = lds + gsel * (2 * AT_BUF);
    const int qrA = qrow0 + wq * 64 + r;
    bf16x8 qa[6];
    LAS unsigned char* qbl = lds + ATQ_OFF + wid * 6656 + r * AT_KP + hh * 16;
#pragma unroll
    for (int c = 0; c < 6; ++c) { qa[c] = *(const bf16x8*)(Q + (size_t)qrA * QW + h * 96 + 16 * c + 8 * hh);
        *(LAS bf16x8*)(qbl + c * 32) = *(const bf16x8*)(Q + (size_t)(qrA + 32) * QW + h * 96 + 16 * c + 8 * hh); }
    f32x16 oA0, oA1, oB0, oB1;
#pragma unroll
    for (int i = 0; i < 16; ++i) { oA0[i] = 0.f; oA1[i] = 0.f; oB0[i] = 0.f; oB1[i] = 0.f; }
    float mA = 0.f, lA = 0.f, mB = 0.f, lB = 0.f;
    const int kkey = gt >> 3, kpc = gt & 7, rkey = gt >> 2, rpc = gt & 3;
    const bf16* vsrc = VT + ((size_t)b * 512 + h * 64 + kkey) * NKEY + kpc * 8;
    u32x4 rk0, rk1, rr, rv0, rv1;
#define AT_LOAD(t) do { const int key0 = key_lo + (t) * 64; const size_t krow = key0 < SEQ ? (size_t)b * SEQ + key0 : (size_t)MLAT + (size_t)b * LC + (key0 - SEQ); \
        rk0 = *(const u32x4*)(KN + (krow + kkey) * 512 + h * 64 + kpc * 8); rk1 = *(const u32x4*)(KN + (krow + kkey + 32) * 512 + h * 64 + kpc * 8); \
        rr = *(const u32x4*)(KR + (krow + rkey) * 32 + rpc * 8); \
        rv0 = *(const u32x4*)(vsrc + key0); rv1 = *(const u32x4*)(vsrc + (size_t)32 * NKEY + key0); } while (0)
#define AT_STORE(bufp) do { *(LAS u32x4*)((bufp) + kkey * AT_KP + kpc * 16) = rk0; *(LAS u32x4*)((bufp) + (kkey + 32) * AT_KP + kpc * 16) = rk1; \
        *(LAS u32x4*)((bufp) + rkey * AT_KP + 128 + rpc * 16) = rr; \
        *(LAS u32x2*)((bufp) + AT_VOFF + kkey * AT_VP + kpc * 16) = (u32x2){rv0.x, rv0.y}; *(LAS u32x2*)((bufp) + AT_VOFF + kkey * AT_VP + kpc * 16 + 8) = (u32x2){rv0.z, rv0.w}; \
        *(LAS u32x2*)((bufp) + AT_VOFF + (kkey + 32) * AT_VP + kpc * 16) = (u32x2){rv1.x, rv1.y}; *(LAS u32x2*)((bufp) + AT_VOFF + (kkey + 32) * AT_VP + kpc * 16 + 8) = (u32x2){rv1.z, rv1.w}; } while (0)
    AT_LOAD(0);
    AT_STORE(gl);
    __syncthreads();
    if (gsel == 1) __syncthreads();
    for (int t = 0; t < ntiles; ++t) {
        LAS unsigned char* buf = gl + (t & 1) * AT_BUF;
        f32x16 sA0, sA1, sB0, sB1;
        const LAS unsigned char* kb = buf + r * AT_KP + hh * 16;
#pragma unroll 1
        for (int rep_ = 0; rep_ < 1 + (int)((MK_DUP >> 25) & 1u); ++rep_) {
#pragma unroll
        for (int i = 0; i < 16; ++i) { sA0[i] = -mA; sA1[i] = -mA; sB0[i] = -mB; sB1[i] = -mB; }
#pragma unroll
        for (int c = 0; c < 6; ++c) {
            const bf16x8 a0 = *(const LAS bf16x8*)(kb + c * 32), a1 = *(const LAS bf16x8*)(kb + 32 * AT_KP + c * 32);
            const bf16x8 qbc = *(const LAS bf16x8*)(qbl + c * 32);
            sA0 = mfma32(a0, qa[c], sA0); sA1 = mfma32(a1, qa[c], sA1); sB0 = mfma32(a0, qbc, sB0); sB1 = mfma32(a1, qbc, sB1);
        }
        asm volatile("" ::: "memory"); }
        AT_SOFTMAX(sA0, sA1, mA, lA, oA0, oA1, t == 0);
        bf16x8 pA[4];
        pA[0] = pack_s(sA0, 0); pA[1] = pack_s(sA0, 1); pA[2] = pack_s(sA1, 0); pA[3] = pack_s(sA1, 1);
        AT_SOFTMAX(sB0, sB1, mB, lB, oB0, oB1, t == 0);
        bf16x8 pB[4];
        pB[0] = pack_s(sB0, 0); pB[1] = pack_s(sB0, 1); pB[2] = pack_s(sB1, 0); pB[3] = pack_s(sB1, 1);
        __syncthreads();
        __builtin_amdgcn_sched_barrier(0);
        if (t + 1 < ntiles) AT_LOAD(t + 1);
        const LAS unsigned char* vb = buf + AT_VOFF + r * AT_VP + hh * 8;
#pragma unroll
        for (int ks = 0; ks < 4; ++ks) {
            const s16x4 l0 = *(const LAS s16x4*)(vb + ks * 32), h0 = *(const LAS s16x4*)(vb + ks * 32 + 16);
            const s16x4 l1 = *(const LAS s16x4*)(vb + 32 * AT_VP + ks * 32), h1 = *(const LAS s16x4*)(vb + 32 * AT_VP + ks * 32 + 16);
            const bf16x8 v0 = __builtin_shufflevector(l0, h0, 0, 1, 2, 3, 4, 5, 6, 7), v1 = __builtin_shufflevector(l1, h1, 0, 1, 2, 3, 4, 5, 6, 7);
            oA0 = mfma32(v0, pA[ks], oA0); oA1 = mfma32(v1, pA[ks], oA1); oB0 = mfma32(v0, pB[ks], oB0); oB1 = mfma32(v1, pB[ks], oB1);
        }
        if (t + 1 < ntiles) { LAS unsigned char* nb = gl + ((t + 1) & 1) * AT_BUF; AT_STORE(nb); }
        __syncthreads();
    }
    if (gsel == 0) __syncthreads();
    lA += __shfl_xor(lA, 32); lB += __shfl_xor(lB, 32);
    attn_store(O + (size_t)qrA * D + h * 64 + 4 * hh, oA0, oA1, 1.0f / lA);
    attn_store(O + (size_t)(qrA + 32) * D + h * 64 + 4 * hh, oB0, oB1, 1.0f / lB);
#undef AT_LOAD
#undef AT_STORE
}
__device__ __forceinline__ void tr_item(const float* W, int N, int k0, int n0, bf16* dst, size_t drow0, int dld, const float* kscale, float cscale, LAS float* scr, int lane) {
#pragma unroll 1
    for (int ib = 0; ib < 32; ib += 16) { float wv[16];
#pragma unroll
        for (int ii = 0; ii < 16; ++ii) wv[ii] = W[(size_t)(k0 + 2 * (ib + ii) + (lane >> 5)) * N + n0 + (lane & 31)];
#pragma unroll
        for (int ii = 0; ii < 16; ++ii) { const int kk = 2 * (ib + ii) + (lane >> 5); float v = wv[ii] * cscale; if (kscale) v *= kscale[k0 + kk]; scr[kk * 33 + (lane & 31)] = v; } }
    asm volatile("s_waitcnt lgkmcnt(0)" ::: "memory");
    const int c = lane & 7;
#pragma unroll
    for (int j = 0; j < 4; ++j) { const int n = (lane >> 3) + 8 * j; const LAS float* s = scr + (8 * c) * 33 + n;
        u32x4 o; o.x = pkbf(s[0 * 33], s[1 * 33]); o.y = pkbf(s[2 * 33], s[3 * 33]); o.z = pkbf(s[4 * 33], s[5 * 33]); o.w = pkbf(s[6 * 33], s[7 * 33]);
        *(u32x4*)(dst + (drow0 + n) * (size_t)dld + k0 + 8 * c) = o; }
    asm volatile("s_waitcnt lgkmcnt(0)" ::: "memory");
}
__device__ __forceinline__ void tr_item8(const float* W, int N, int k0, int n0, unsigned char* dst, size_t drow0, int dld, float cscale, LAS float* scr, int lane) {
#pragma unroll 1
    for (int ib = 0; ib < 32; ib += 16) { float wv[16];
#pragma unroll
        for (int ii = 0; ii < 16; ++ii) wv[ii] = W[(size_t)(k0 + 2 * (ib + ii) + (lane >> 5)) * N + n0 + (lane & 31)];
#pragma unroll
        for (int ii = 0; ii < 16; ++ii) { const int kk = 2 * (ib + ii) + (lane >> 5); scr[kk * 33 + (lane & 31)] = wv[ii] * cscale; } }
    asm volatile("s_waitcnt lgkmcnt(0)" ::: "memory");
    const int c = lane & 7;
#pragma unroll
    for (int j = 0; j < 4; ++j) { const int n = (lane >> 3) + 8 * j; const LAS float* sp = scr + (8 * c) * 33 + n;
        u32x2 o; o.x = pk4_fp8(sp[0 * 33], sp[1 * 33], sp[2 * 33], sp[3 * 33]); o.y = pk4_fp8(sp[4 * 33], sp[5 * 33], sp[6 * 33], sp[7 * 33]);
        *(u32x2*)(dst + (drow0 + n) * (size_t)dld + k0 + 8 * c) = o; }
    asm volatile("s_waitcnt lgkmcnt(0)" ::: "memory");
}
__device__ __forceinline__ void tr_matrix(const float* W, int K, int N, bf16* dst, int dld, int mode, bf16* dst2, const float* kscale, float cscale, LAS float* scr, int gw, int NGW, int lane) {
    const int nblk = N / 32, nit = (K / 64) * nblk;
    for (int it = gw; it < nit; it += NGW) { const int kb = it / nblk, nb = it % nblk, n0 = 32 * nb; size_t dr; bf16* d = dst;
        if (mode == 0) dr = n0;
        else if (mode == 1) dr = n0 < 416 ? n0 : n0 + 96;
        else if (mode == 2) { const int hq = n0 >> 7, w = n0 & 127; if (w < 64) dr = hq * 64 + w; else { dr = hq * 64 + w - 64; d = dst2; } }
        else if (mode == 3) dr = (size_t)(n0 >> 7) * 256 + (n0 & 127);
        else dr = (size_t)(n0 >> 7) * 256 + 128 + (n0 & 127);
        tr_item(W, N, 64 * kb, n0, d, dr, dld, kscale, cscale, scr, lane); }
}
__device__ __forceinline__ void tr_matrix8(const float* W, int K, int N, unsigned char* dst, int dld, int mode, LAS float* scr, int gw, int NGW, int lane) {
    const int nblk = N / 32, nit = (K / 64) * nblk;
    for (int it = gw; it < nit; it += NGW) { const int kb = it / nblk, nb = it % nblk, n0 = 32 * nb; size_t dr;
        if (mode == 0) dr = n0; else if (mode == 1) dr = n0 < 416 ? n0 : n0 + 96; else if (mode == 3) dr = (size_t)(n0 >> 7) * 256 + (n0 & 127); else dr = (size_t)(n0 >> 7) * 256 + 128 + (n0 & 127);
        tr_item8(W, N, 64 * kb, n0, dst, dr, dld, W8_SCALE, scr, lane); }
}
__device__ __forceinline__ void split8(const float* v, bf16x8& hi, bf16x8& lo) {
    u32x4 h, l;
#pragma unroll
    for (int q = 0; q < 4; ++q) { const unsigned ph = pkbf(v[2 * q], v[2 * q + 1]); const float h0 = __uint_as_float(ph << 16), h1 = __uint_as_float(ph & 0xffff0000u);
        h[q] = ph; l[q] = pkbf(v[2 * q] - h0, v[2 * q + 1] - h1); }
    hi = __builtin_bit_cast(bf16x8, h); lo = __builtin_bit_cast(bf16x8, l);
}
__device__ __forceinline__ f32x16 mfma32m(bf16x8 a, bf16x8 b, f32x16 c) { return __builtin_amdgcn_mfma_f32_32x32x16_bf16(a, b, c, 0, 0, 0); }
__device__ __forceinline__ void mod_partial_item(const float* c, const float* cctx, const float* ada_w, float* MODP, int item, LAS float* st, int tid) {
    const int lane = tid & 63, wave = __builtin_amdgcn_readfirstlane(tid >> 6);
    const int li = item / 192, kc = (item / 12) % 16, cg = item % 12;
    for (int idx = tid; idx < 36 * 64; idx += 512) { const int r = idx >> 6, k = idx & 63; float v = 0.f;
        if (r < 33) { const float x = r < 32 ? c[(size_t)r * D + kc * 64 + k] : cctx[kc * 64 + k]; v = silu_f(x); }
        st[k * 36 + r] = v; }
    __syncthreads();
    const int m = lane & 31, kg = lane >> 5;
    bf16x8 ah[2][4], al[2][4];
#pragma unroll
    for (int ks = 0; ks < 4; ++ks) { float v0[8], v1[8];
#pragma unroll
        for (int j = 0; j < 8; ++j) { const int k = ks * 16 + kg * 8 + j; v0[j] = st[k * 36 + m]; const float x = st[k * 36 + 32]; v1[j] = m == 0 ? x : 0.f; }
        split8(v0, ah[0][ks], al[0][ks]); split8(v1, ah[1][ks], al[1][ks]); }
#pragma unroll 1
    for (int cb = 0; cb < 2; ++cb) {
        const int col = cg * 512 + wave * 64 + cb * 32 + m;
        const float* wp = ada_w + ((size_t)li * D + kc * 64 + kg * 8) * 6144 + col;
        float w[32];
#pragma unroll
        for (int ks = 0; ks < 4; ++ks)
#pragma unroll
            for (int j = 0; j < 8; ++j) w[ks * 8 + j] = wp[(size_t)(ks * 16 + j) * 6144];
        f32x16 a0, a1;
#pragma unroll
        for (int i = 0; i < 16; ++i) { a0[i] = 0.f; a1[i] = 0.f; }
#pragma unroll
        for (int ks = 0; ks < 4; ++ks) { bf16x8 bh, bl; split8(&w[ks * 8], bh, bl);
            a0 = mfma32m(ah[0][ks], bh, a0); a0 = mfma32m(ah[0][ks], bl, a0); a0 = mfma32m(al[0][ks], bh, a0);
            a1 = mfma32m(ah[1][ks], bh, a1); a1 = mfma32m(ah[1][ks], bl, a1); a1 = mfma32m(al[1][ks], bh, a1); }
        float* mp = MODP + (((size_t)kc * 4 + li) * 33) * 6144 + col;
#pragma unroll
        for (int i = 0; i < 16; ++i) mp[(size_t)(8 * (i >> 2) + 4 * kg + (i & 3)) * 6144] = a0[i];
        if (kg == 0) mp[(size_t)32 * 6144] = a1[0];
    }
    __syncthreads();
}

constexpr int NPH = 43;
struct Args { const float* in[N_IN]; float* out; unsigned char* ws; int ph_lo, ph_hi; };
#define AIN(i) ((const float*)(const GAS float*)a.in[i])
#define AOUT ((float*)(GAS float*)a.out)

__device__ __forceinline__ void moe_convert(const float* w1, const float* w3, const float* w2, bf16* W13, bf16* W2, LAS float* scr, int gw, int NGW, int lane) {
    constexpr int PER = 1792, TOT = 8 * 3 * PER;
    for (int it = gw; it < TOT; it += NGW) { const int ex = it / (3 * PER), rem = it % (3 * PER), which = rem / PER, j = rem % PER;
        if (which < 2) { const int nblk = DFFE / 32, kb = j / nblk, nb = j % nblk, n0 = 32 * nb;
            const float* W = (which ? w3 : w1) + (size_t)ex * D * DFFE;
            tr_item(W, DFFE, 64 * kb, n0, W13 + (size_t)ex * 7168 * 1024, (size_t)(n0 >> 7) * 256 + which * 128 + (n0 & 127), 1024, nullptr, 1.0f, scr, lane); }
        else { const int nblk = D / 32, kb = j / nblk, nb = j % nblk, n0 = 32 * nb;
            tr_item(w2 + (size_t)ex * DFFE * D, D, 64 * kb, n0, W2 + (size_t)ex * 1024 * DFFE, n0, DFFE, nullptr, 1.0f, scr, lane); } }
}

constexpr int MOE_CV_ITEMS = 8 * 3 * 1792;
constexpr int BG0_MIXIN_E = 1024 * 6, BG0_MIXOUT_E = BG0_MIXIN_E + 1024 * 6, BG0_UP_E = BG0_MIXOUT_E + 512 * 6, BG0_END = BG0_UP_E + 1024 * 14;
constexpr int BG1_DFTS_E = 1024 * 7, BG1_FNET_E = BG1_DFTS_E + 1024 * 6, BG1_MD0_E = BG1_FNET_E + 8064, BG1_MIXIN = BG1_MD0_E + 8064, BG1_END = BG1_MIXIN + 1792 * 6;
static_assert(BG0_END <= MOE_CV_ITEMS && BG1_END <= MOE_CV_ITEMS, "background plan");
__device__ __forceinline__ void moe_convert8(const float* w1, const float* w3, const float* w2, unsigned char* W13, unsigned char* W2, LAS float* scr, int gw, int NGW, int lane, int lo = 0, int hi = MOE_CV_ITEMS) {
    constexpr int PER = 1792;
    for (int it = lo + gw; it < hi; it += NGW) { const int ex = it / (3 * PER), rem = it % (3 * PER), which = rem / PER, j = rem % PER;
        if (which < 2) { const int nblk = DFFE / 32, kb = j / nblk, nb = j % nblk, n0 = 32 * nb;
            const float* W = (which ? w3 : w1) + (size_t)ex * D * DFFE;
            tr_item8(W, DFFE, 64 * kb, n0, W13 + (size_t)ex * 7168 * 1024, (size_t)(n0 >> 7) * 256 + which * 128 + (n0 & 127), 1024, W8_SCALE, scr, lane); }
        else { const int nblk = D / 32, kb = j / nblk, nb = j % nblk, n0 = 32 * nb;
            tr_item8(w2 + (size_t)ex * DFFE * D, D, 64 * kb, n0, W2 + (size_t)ex * 1024 * DFFE, n0, DFFE, W8_SCALE, scr, lane); } }
}

__global__ void __launch_bounds__(512, 2) fwd(Args a) {
    extern __shared__ __attribute__((aligned(16))) unsigned char lds_raw[];
    LAS unsigned char* lds = (LAS unsigned char*)lds_raw;
    volatile LAS unsigned* MISC = (volatile LAS unsigned*)(lds + MISC_OFF);
    const int G = gridDim.x, bid = blockIdx.x, NGW = G * 8;
    unsigned* ctl = (unsigned*)(GAS unsigned*)(a.ws + WS_CTL);
#define WSP_DECL GAS unsigned char* wsg_ = (GAS unsigned char*)a.ws; asm volatile("" : "+s"(wsg_)); unsigned char* wsp = (unsigned char*)wsg_; int tid = threadIdx.x; asm volatile("" : "+v"(tid)); const int lane = tid & 63, wave = __builtin_amdgcn_readfirstlane(tid >> 6), gw = bid * 8 + wave; (void)lane; (void)gw
#define MOD ((float*)(wsp + WS_MOD))
#define ROPEC ((float*)(wsp + WS_ROPE))
#define ROPES (ROPEC + 512)
#define SSQQ ((float*)(wsp + WS_SSQQ))
#define SSQK ((float*)(wsp + WS_SSQK))
#define HMID ((float*)(wsp + WS_HMID))
#define AMID ((float*)(wsp + WS_AMID))
#define LIST ((int*)(wsp + WS_LIST))
#define GLIST ((float*)(wsp + WS_GLIST))
#define WMIXIN ((bf16*)(wsp + WS_WMIXIN))
#define WUQ ((bf16*)(wsp + WS_WUQ))
#define WUK ((bf16*)(wsp + WS_WUK))
#define WUV ((bf16*)(wsp + WS_WUV))
#define WMIXOUT ((bf16*)(wsp + WS_WMIXOUT))
#define WFFN13 ((bf16*)(wsp + WS_WFFN13))
#define WFFN2 ((bf16*)(wsp + WS_WFFN2))
#define WFNET ((bf16*)(wsp + WS_WFNET))
#define WDFTC ((bf16*)(wsp + WS_WDFTC))
#define WDFTL ((bf16*)(wsp + WS_WDFTL))
#define WDFTX ((bf16*)(wsp + WS_WDFTX))
#define WMOE13 ((bf16*)(wsp + WS_WMOE13))
#define WMOE2 ((bf16*)(wsp + WS_WMOE2))
#define WMOE13_8(q) ((unsigned char*)WMOE13 + (BG_ON ? (size_t)(q) * 8 * 7168 * 1024 : (size_t)0))
#define WMOE2_8(q) ((unsigned char*)WMOE2 + (BG_ON ? (size_t)(q) * 8 * 1024 * 3584 : (size_t)0))
#define BG_FILL(T_, q_, lo_, hi_) do { if (BG_ON) { const int lo__ = (lo_), hi__ = (hi_); if (lo__ < hi__) { const int r__ = (T_) % G; \
    if (r__ == 0 || bid >= r__) { const int q__ = (q_); __syncthreads(); \
        moe_convert8(AIN(I_MW1) + (size_t)q__ * 8 * D * DFFE, AIN(I_MW3) + (size_t)q__ * 8 * D * DFFE, AIN(I_MW2) + (size_t)q__ * 8 * DFFE * D, WMOE13_8(q__), WMOE2_8(q__), (LAS float*)(lds + wave * 8448), \
                     (r__ == 0 ? bid : bid - r__) * 8 + wave, (r__ == 0 ? G : G - r__) * 8, lane, lo__, hi__); } } } } while (0)
#define XCUR ((bf16*)(wsp + WS_XCUR))
#define RA ((bf16*)(wsp + WS_RA))
#define CQ ((bf16*)(wsp + WS_RB + RB_CQ))
#define CKV ((bf16*)(wsp + WS_RB + RB_CKV))
#define KR ((bf16*)(wsp + WS_RB + RB_KR))
#define POOL ((bf16*)(wsp + WS_RB + RB_POOL))
#define QB ((bf16*)(wsp + WS_RB + RB_Q))
#define KN ((bf16*)(wsp + WS_RB + RB_KN))
#define VT ((bf16*)(wsp + WS_RB + RB_VT))
#define ZB ((bf16*)(wsp + WS_RB + RB_Z))
#define ZC ((bf16*)(wsp + WS_RB + RB_ZC))
#define ACT ((bf16*)(wsp + WS_RB + RB_ACT))

    const int lo = a.ph_lo, hi = a.ph_hi;
    if (threadIdx.x < 64) MISC[threadIdx.x] = 0u;
    __syncthreads();
    XcdBarrier bar; bar.bar = ctl + CW_BAR; bar.x = 0; bar.st = MISC + 8;
    if (hi - lo > 1) bar = xcd_barrier_post(ctl + CW_BAR, MISC + 8);
#ifndef MK_EN
#define MK_EN 0xFFFFFFFFu
#endif
#define EN(b) (((MK_EN) >> (b)) & 1u)
#ifndef MK_DUP
#define MK_DUP 0u
#endif
#define REP(b) _Pragma("unroll 1") for (int _rep = 0; _rep < ((((MK_DUP) >> (b)) & 1u) ? 2 : 1); ++_rep)
#define IN(p) (lo <= (p) && (p) < hi)
#define SEAM(p) do { if (hi > (p) + 1) { xcd_barrier<false>(bar); if ((MK_DUP >> 12) & 1u) xcd_barrier<false>(bar); } } while (0)
#define SEAM0(p) do { if (hi > (p) + 1) xcd_barrier<true>(bar); } while (0)

    if (EN(0) && IN(0)) REP(11) { WSP_DECL;
        LAS float* scr = (LAS float*)(lds + wave * 8448);
        for (int item = bid; item < 4 * 16 * 12; item += G) mod_partial_item(AIN(I_C), AIN(I_CCTX), AIN(I_ADAW), (float*)(wsp + WS_RB), item, (LAS float*)(lds + 67584), tid);
        int gwr = gw;
#define ADV(nit) gwr = (gwr - ((nit) % NGW) + NGW) % NGW
#pragma unroll 1
        for (int e = 0; e < 2; ++e) {
            if (MK_FP8_MIXIN) tr_matrix8(AIN(I_MIXIN) + (size_t)e * D * 928, D, 928, (unsigned char*)(WMIXIN + (size_t)e * 1024 * 1024), 1024, 1, scr, gwr, NGW, lane);
            else tr_matrix(AIN(I_MIXIN) + (size_t)e * D * 928, D, 928, WMIXIN + (size_t)e * 1024 * 1024, 1024, 1, nullptr, nullptr, 1.0f, scr, gwr, NGW, lane); ADV(464);
            tr_matrix(AIN(I_WUQ) + (size_t)e * 256 * 768, 256, 768, WUQ + (size_t)e * 768 * 256, 256, 0, nullptr, AIN(I_CQG) + e * 256, QSCALE, scr, gwr, NGW, lane); ADV(96);
            tr_matrix(AIN(I_WUKV) + (size_t)e * 128 * 1024, 128, 1024, WUK + (size_t)e * 512 * 128, 128, 2, WUV + (size_t)e * 512 * 128, AIN(I_CKVG) + e * 128, 1.0f, scr, gwr, NGW, lane); ADV(64);
            tr_matrix(AIN(I_MIXOUT) + (size_t)e * 1024 * 1024, 512, 1024, WMIXOUT + (size_t)e * 1024 * 1024, 1024, 0, nullptr, nullptr, 1.0f, scr, gwr, NGW, lane); ADV(256);
            if (FP8_FFN(2 * e)) {
                tr_matrix8(AIN(I_FW1) + (size_t)e * D * DFF, D, DFF, (unsigned char*)(WFFN13 + (size_t)e * 5632 * 1024), 1024, 3, scr, gwr, NGW, lane); ADV(1408);
                tr_matrix8(AIN(I_FW3) + (size_t)e * D * DFF, D, DFF, (unsigned char*)(WFFN13 + (size_t)e * 5632 * 1024), 1024, 4, scr, gwr, NGW, lane); ADV(1408);
                tr_matrix8(AIN(I_FW2) + (size_t)e * DFF * D, DFF, D, (unsigned char*)(WFFN2 + (size_t)e * 1024 * DFF), DFF, 0, scr, gwr, NGW, lane); ADV(1408);
            } else {
            tr_matrix(AIN(I_FW1) + (size_t)e * D * DFF, D, DFF, WFFN13 + (size_t)e * 5632 * 1024, 1024, 3, nullptr, nullptr, 1.0f, scr, gwr, NGW, lane); ADV(1408);
            tr_matrix(AIN(I_FW3) + (size_t)e * D * DFF, D, DFF, WFFN13 + (size_t)e * 5632 * 1024, 1024, 4, nullptr, nullptr, 1.0f, scr, gwr, NGW, lane); ADV(1408);
            tr_matrix(AIN(I_FW2) + (size_t)e * DFF * D, DFF, D, WFFN2 + (size_t)e * 1024 * DFF, DFF, 0, nullptr, nullptr, 1.0f, scr, gwr, NGW, lane); ADV(1408);
            }
            tr_matrix(AIN(I_FNET) + (size_t)e * D * D, D, D, WFNET + (size_t)e * 1024 * 1024, 1024, 0, nullptr, nullptr, 1.0f, scr, gwr, NGW, lane); ADV(512);
            if (MK_FP8_MIXIN) { for (int i = gw * 64 + lane; i < 96 * 1024 / 16; i += NGW * 64) *(u32x4*)((unsigned char*)(WMIXIN + (size_t)e * 1024 * 1024) + 416 * 1024 + (size_t)i * 16) = (u32x4){0u, 0u, 0u, 0u}; }
            else for (int i = gw * 64 + lane; i < 96 * 1024 / 8; i += NGW * 64) *(u32x4*)(WMIXIN + (size_t)e * 1024 * 1024 + 416 * 1024 + (size_t)i * 8) = (u32x4){0u, 0u, 0u, 0u};
            for (int it = (gw - e * 1024 + NGW) % NGW; it < 4 * 16 * 16; it += NGW) {        const int gq = it >> 8, ic = (it >> 4) & 15, nb = it & 15, n = nb * 64 + lane;
                const float* pw = AIN(I_POOLW) + ((size_t)(e * 4 + gq) * 128 + ic * 8) * 128; const float* ps = AIN(I_POOLS) + e * 512 + gq * 128;
                const float* mw = AIN(I_MIXOUT) + ((size_t)e * 1024 + 512 + gq * 128) * 1024 + n;
                float acc[8];
#pragma unroll
                for (int q = 0; q < 8; ++q) acc[q] = 0.f;
#pragma unroll 1
                for (int jb = 0; jb < 128; jb += 16) { float wv[16];
#pragma unroll
                    for (int jj = 0; jj < 16; ++jj) wv[jj] = mw[(size_t)(jb + jj) * 1024];
#pragma unroll
                    for (int jj = 0; jj < 16; ++jj) { const float w = wv[jj] * ps[jb + jj];
#pragma unroll
                        for (int q = 0; q < 8; ++q) acc[q] += pw[q * 128 + jb + jj] * w; } }
                u32x4 o; o.x = pkbf(acc[0], acc[1]); o.y = pkbf(acc[2], acc[3]); o.z = pkbf(acc[4], acc[5]); o.w = pkbf(acc[6], acc[7]);
                *(u32x4*)(WMIXOUT + (size_t)e * 1024 * 1024 + (size_t)n * 1024 + 512 + gq * 128 + ic * 8) = o; }
        }
#undef ADV
        const int gt = bid * 512 + tid, NT = G * 512;
        for (int i = gt; i < 2 * 65536; i += NT) { const int ty = i >> 16, m = (i >> 8) & 255, c = i & 255; const float x = (float)((m * c) & 255) * (1.0f / 128.0f);
            WDFTC[i] = (bf16)(pkbf(ty ? sinpif(x) : cospif(x), 0.f) & 0xffffu); }
        if (MK_FP8_DFT) {
            for (int i4 = gt; i4 < 2048 * 2048 / 4; i4 += NT) { float v[4];
#pragma unroll
                for (int q = 0; q < 4; ++q) { const int i = i4 * 4 + q, k = i >> 11, kk = i & 2047;
                    if (kk < 1024) v[q] = __builtin_amdgcn_cosf((float)((k * kk) & 2047) * (1.0f / 2048.0f)); else if (kk == 1024) v[q] = 0.f; else v[q] = -__builtin_amdgcn_sinf((float)((k * (kk - 1024)) & 2047) * (1.0f / 2048.0f)); }
                ((unsigned*)WDFTL)[i4] = pk4_fp8(v[0] * 16.f, v[1] * 16.f, v[2] * 16.f, v[3] * 16.f); }
            for (int i4 = gt; i4 < 65536 / 4; i4 += NT) { float v[4];
#pragma unroll
                for (int q = 0; q < 4; ++q) { const int i = i4 * 4 + q, k = i >> 8, kk = i & 255;
                    if (kk < 128) v[q] = __builtin_amdgcn_cosf((float)((k * kk) & 255) * (1.0f / 256.0f)); else if (kk == 128) v[q] = 0.f; else v[q] = -__builtin_amdgcn_sinf((float)((k * (kk - 128)) & 255) * (1.0f / 256.0f)); }
                ((unsigned*)WDFTX)[i4] = pk4_fp8(v[0] * 16.f, v[1] * 16.f, v[2] * 16.f, v[3] * 16.f); }
        } else {
        for (int i4 = gt; i4 < 2048 * 2048 / 4; i4 += NT) { float v[4];
#pragma unroll
            for (int q = 0; q < 4; ++q) { const int i = i4 * 4 + q, k = i >> 11, kk = i & 2047;
                if (kk < 1024) v[q] = __builtin_amdgcn_cosf((float)((k * kk) & 2047) * (1.0f / 2048.0f)); else if (kk == 1024) v[q] = 0.f; else v[q] = -__builtin_amdgcn_sinf((float)((k * (kk - 1024)) & 2047) * (1.0f / 2048.0f)); }
            u32x2 w; w.x = pkbf(v[0], v[1]); w.y = pkbf(v[2], v[3]); ((u32x2*)WDFTL)[i4] = w; }
        for (int i4 = gt; i4 < 65536 / 4; i4 += NT) { float v[4];
#pragma unroll
            for (int q = 0; q < 4; ++q) { const int i = i4 * 4 + q, k = i >> 8, kk = i & 255;
                if (kk < 128) v[q] = __builtin_amdgcn_cosf((float)((k * kk) & 255) * (1.0f / 256.0f)); else if (kk == 128) v[q] = 0.f; else v[q] = -__builtin_amdgcn_sinf((float)((k * (kk - 128)) & 255) * (1.0f / 256.0f)); }
            u32x2 w; w.x = pkbf(v[0], v[1]); w.y = pkbf(v[2], v[3]); ((u32x2*)WDFTX)[i4] = w; }
        }
        if (gt < 512) { const int pos = gt >> 3, j = gt & 7; const double inv = pow(10000.0, -(double)j / 8.0), ang = (double)pos * inv; ROPEC[gt] = (float)cos(ang); ROPES[gt] = (float)sin(ang); }
    }
    if (lo == 0) SEAM0(0);
    if (IN(1)) { WSP_DECL; const float* MODP = (const float*)(wsp + WS_RB);
        for (int o = bid * 512 + tid; o < 4 * 33 * 6144; o += G * 512) { float sacc = 0.f;
#pragma unroll
            for (int kc = 0; kc < 16; ++kc) sacc += MODP[(size_t)kc * (4 * 33 * 6144) + o];
            const int li = o / (33 * 6144), col = o % 6144;
            MOD[o] = sacc + AIN(I_ADAB)[(size_t)li * 6144 + col]; }
        SEAM(1);
    }

#pragma unroll 1
    for (int i = 0; i < DEPTH; ++i) {
        const int pb = 2 + 10 * i; const bool even = !(i & 1); const int e = i >> 1; const bool ctxn = i < 2;
#define modbase (MOD + (size_t)i * 33 * 6144)
#define XS_MIX (XSrc{AIN(I_X), AIN(I_CTX), (i == 0) ? (const bf16*)nullptr : (const bf16*)XCUR})
#define XS_CUR (XSrc{nullptr, nullptr, (const bf16*)XCUR})
        const int nrows = ctxn ? MALL : MLAT;
        if (EN(1) && IN(pb + 0)) { WSP_DECL;
            if (even) { REP(5) phase_mod_plain(XS_MIX, AIN(I_NMG) + i * D, modbase, 0, 1024, RA, MK_FP8_MIXIN != 0, MALL, gw, NGW, lane); }
            else REP(6) { phase_mod_fold(XS_MIX, AIN(I_NMG) + i * D, modbase, RA, HMID, i == 1, gw, NGW, lane);
                   if (FP8_MOE(i)) moe_convert8(AIN(I_MW1) + (size_t)e * 8 * D * DFFE, AIN(I_MW3) + (size_t)e * 8 * D * DFFE, AIN(I_MW2) + (size_t)e * 8 * DFFE * D, WMOE13_8(e), WMOE2_8(e), (LAS float*)(lds + wave * 8448), gw, NGW, lane, BG_ON ? (e == 0 ? BG0_END : BG1_END) : 0, MOE_CV_ITEMS);
                   else moe_convert(AIN(I_MW1) + (size_t)e * 8 * D * DFFE, AIN(I_MW3) + (size_t)e * 8 * D * DFFE, AIN(I_MW2) + (size_t)e * 8 * DFFE * D, WMOE13, WMOE2, (LAS float*)(lds + wave * 8448), gw, NGW, lane); }
            SEAM(pb + 0);
        }
        if (IN(pb + 1)) { WSP_DECL;
            if (even) { if (EN(2)) { SchedMixIn S{(const char*)RA, (const char*)(WMIXIN + (size_t)e * 1024 * 1024), G, bid, 1024 + (i == 0 ? 128 : 32), i == 0};
                        EpiMixIn E{CQ, CKV, KR, POOL, SSQQ, SSQK, ROPEC, ROPES};
                        REP(16) gm::gemm_phase<EpiMixIn, SchedMixIn, false, MK_FP8_MIXIN != 0>(lds, S, E);
                        BG_FILL(1024 + (i == 0 ? 128 : 32), i == 0 ? 0 : 1, i == 0 ? 0 : BG1_MIXIN, i == 0 ? BG0_MIXIN_E : BG1_END); } }
            else if (EN(3)) { phase_amid(HMID, AMID, lds, G, bid, tid);
                   SchedDftC S{(const char*)WDFTC, (const char*)RA, G, bid, 1024 + (i == 1 ? 256 : 0)}; EpiDftC E{ZB, ZC};
                   REP(17) gm::gemm_phase<EpiDftC, SchedDftC, false>(lds, S, E); }
            SEAM(pb + 1);
        }
        if (IN(pb + 2)) { WSP_DECL;
            if (even) { if (EN(4)) { REP(14) phase_pool(POOL, RA, nrows, gw, NGW, lane);
                        const int nq = (i == 0) ? TALL : TLAT;
                        SchedE3 S{(const char*)CQ, (const char*)CKV, (const char*)(WUQ + (size_t)e * 768 * 256), (const char*)(WUK + (size_t)e * 512 * 128), (const char*)(WUV + (size_t)e * 512 * 128), G, bid, nq, nq * 3 + 1152};
                        EpiE3 E{QB, KN, VT, SSQQ, SSQK, ROPEC, ROPES};
                        REP(15) gm::gemm_phase<EpiE3, SchedE3, false>(lds, S, E); } }
            else if (EN(5)) { SchedDftS S{(const char*)WDFTL, (const char*)WDFTX, (const char*)ZB, (const char*)ZC, G, bid, 1024 + (i == 1 ? 128 : 0)}; EpiDftS E{RA, AMID};
                   REP(18) gm::gemm_phase<EpiDftS, SchedDftS, false, MK_FP8_DFT != 0>(lds, S, E);
                   BG_FILL(1024 + (i == 1 ? 128 : 0), 1, 0, i == 1 ? BG1_DFTS_E : 0); }
            SEAM(pb + 2);
        }
        if (EN(6) && even && IN(pb + 3)) { WSP_DECL;
            const int total = 1024 + (i == 0 ? 128 : 0);
            REP(2) for (int it = 0;; ++it) { const int u = it * G + bid; if (u >= total) break;
                const bool cx = u >= 1024; const int bhp = cx ? u - 1024 : (u & 127), qt = cx ? 0 : (u >> 7), b = bhp >> 2, hp = bhp & 3;
                attn_unit(lds, QB, KN, KR, VT, RA, b, hp, cx ? MLAT + b * LC : b * SEQ + qt * 256, cx ? SEQ : 0, cx ? 4 : 36, tid); }
            SEAM(pb + 3);
        }
        if (EN(7) && IN(pb + 4)) { WSP_DECL;
            SchedResid S{(const char*)RA, (const char*)(even ? WMIXOUT + (size_t)e * 1024 * 1024 : WFNET + (size_t)e * 1024 * 1024), 2048u, 16, nrows / 256, G, bid};
            if ((MK_DUP >> 8) & 1u) { EpiResid Ed{AIN(I_X), AIN(I_CTX), (i == 0) ? (const bf16*)nullptr : (const bf16*)XCUR, (bf16*)AOUT, modbase + 2048, 1.0f}; gm::gemm_phase<EpiResid, SchedResid, false>(lds, S, Ed); }
            EpiResid E{AIN(I_X), AIN(I_CTX), (i == 0) ? (const bf16*)nullptr : (const bf16*)XCUR, XCUR, modbase + 2048, 1.0f};
            gm::gemm_phase<EpiResid, SchedResid, false>(lds, S, E);
            BG_FILL((nrows / 256) * 4, i == 0 ? 0 : 1, i == 0 ? BG0_MIXIN_E : BG1_DFTS_E, i == 0 ? BG0_MIXOUT_E : (i == 1 ? BG1_FNET_E : 0));
            SEAM(pb + 4);
        }
        if (EN(8) && IN(pb + 5)) { WSP_DECL;
            if (even) REP(7) phase_mod2<false>(XS_CUR, AIN(I_NFG) + i * D, modbase, RA, FP8_FFN(i), nrows, nullptr, nullptr, nullptr, nullptr, lds, bid, G, wave, lane, tid);
            else phase_mod2<true>(XS_CUR, AIN(I_NFG) + i * D, modbase, RA, FP8_MOE(i), nrows, AIN(I_ROUTER) + (size_t)e * D * 8, (unsigned*)(wsp + WS_CTL) + CW_CNT + e * 16 * 64, LIST, GLIST, lds, bid, G, wave, lane, tid);
            SEAM(pb + 5);
        }
        if (even) {
            if (EN(9) && IN(pb + 6)) { WSP_DECL;
                if (FP8_FFN(i)) { SchedUp S{(const char*)RA, (const char*)(WFFN13 + (size_t)e * 5632 * 1024), nrows / 256, 22, G, bid, 1024u, 8}; EpiSwiglu8 E{(unsigned char*)ACT, DFF};
                    REP(1) gm::gemm_phase<EpiSwiglu8, SchedUp, false, true>(lds, S, E); }
                else { SchedUp S{(const char*)RA, (const char*)(WFFN13 + (size_t)e * 5632 * 1024), nrows / 256, 22, G, bid, 2048u, 16}; EpiSwiglu E{ACT, DFF};
                    REP(1) gm::gemm_phase<EpiSwiglu, SchedUp, false>(lds, S, E); }
                BG_FILL((nrows / 256) * 22, 0, BG0_MIXOUT_E, i == 0 ? BG0_UP_E : 0);
                SEAM(pb + 6); }
            if (EN(10) && IN(pb + 7)) { WSP_DECL;
                if (FP8_FFN(i)) { SchedResid S{(const char*)ACT, (const char*)(WFFN2 + (size_t)e * 1024 * DFF), (unsigned)DFF, DFF / 128, nrows / 256, G, bid};
                    if ((MK_DUP >> 9) & 1u) { EpiResid Ed{nullptr, nullptr, (const bf16*)XCUR, (bf16*)AOUT, modbase + 5 * 1024, 1.0f / (W8_SCALE * A8_SCALE)}; gm::gemm_phase<EpiResid, SchedResid, false, true>(lds, S, Ed); }
                    EpiResid E{nullptr, nullptr, (const bf16*)XCUR, XCUR, modbase + 5 * 1024, 1.0f / (W8_SCALE * A8_SCALE)};
                    gm::gemm_phase<EpiResid, SchedResid, false, true>(lds, S, E); }
                else { SchedResid S{(const char*)ACT, (const char*)(WFFN2 + (size_t)e * 1024 * DFF), (unsigned)(DFF * 2), DFF / 64, nrows / 256, G, bid};
                    if ((MK_DUP >> 9) & 1u) { EpiResid Ed{nullptr, nullptr, (const bf16*)XCUR, (bf16*)AOUT, modbase + 5 * 1024, 1.0f}; gm::gemm_phase<EpiResid, SchedResid, false>(lds, S, Ed); }
                    EpiResid E{nullptr, nullptr, (const bf16*)XCUR, XCUR, modbase + 5 * 1024, 1.0f};
                    gm::gemm_phase<EpiResid, SchedResid, false>(lds, S, E); }
                BG_FILL((nrows / 256) * 4, 0, BG0_UP_E, i == 0 ? BG0_END : 0);
                SEAM(pb + 7); }
        } else {
#pragma unroll 1
            for (int s = 0; s < 2; ++s) {
                const int cwo = CW_CNT + (e * 16 + s * 8) * 64;
                if (EN(11) && IN(pb + 6 + 2 * s)) { WSP_DECL;
                    if (FP8_MOE(i)) { SchedMoeUp8 S; S.H2 = (const char*)RA; S.W13 = (const char*)WMOE13_8(e); S.list = LIST + (size_t)s * 8 * MALL; moe_info((const unsigned*)(wsp + WS_CTL) + cwo, S.mi); S.G = G; S.c = bid;
                        EpiSwiglu8 E{(unsigned char*)ACT, DFFE};
                        REP(0) gm::gemm_phase<EpiSwiglu8, SchedMoeUp8, true, true>(lds, S, E); }
                    else { SchedMoeUp S; S.H2 = (const char*)RA; S.W13 = (const char*)WMOE13; S.list = LIST + (size_t)s * 8 * MALL; moe_info((const unsigned*)(wsp + WS_CTL) + cwo, S.mi); S.G = G; S.c = bid;
                        EpiSwiglu E{ACT, DFFE};
                        REP(0) gm::gemm_phase<EpiSwiglu, SchedMoeUp, true>(lds, S, E); }
                    SEAM(pb + 6 + 2 * s); }
                if (EN(12) && IN(pb + 7 + 2 * s)) { WSP_DECL;
                    if (FP8_MOE(i)) { SchedMoeDown8 S; S.Ab = (const char*)ACT; S.W2 = (const char*)WMOE2_8(e); moe_info((const unsigned*)(wsp + WS_CTL) + cwo, S.mi); S.G = G; S.c = bid;
                        if ((MK_DUP >> 10) & 1u) { EpiMoeDown Ed{XCUR, modbase + 5 * 1024, LIST + (size_t)s * 8 * MALL, GLIST + (size_t)s * 8 * MALL, 1.0f / (W8_SCALE * A8_SCALE), (bf16*)AOUT}; gm::gemm_phase<EpiMoeDown, SchedMoeDown8, false, true>(lds, S, Ed); }
                        EpiMoeDown E{XCUR, modbase + 5 * 1024, LIST + (size_t)s * 8 * MALL, GLIST + (size_t)s * 8 * MALL, 1.0f / (W8_SCALE * A8_SCALE), XCUR};
                        gm::gemm_phase<EpiMoeDown, SchedMoeDown8, false, true>(lds, S, E);
                        BG_FILL(S.mi.tb[8] * 4, 1, s == 0 ? BG1_FNET_E : BG1_MD0_E, i == 1 ? (s == 0 ? BG1_MD0_E : BG1_MIXIN) : 0); }
                    else { SchedMoeDown S; S.Ab = (const char*)ACT; S.W2 = (const char*)WMOE2; moe_info((const unsigned*)(wsp + WS_CTL) + cwo, S.mi); S.G = G; S.c = bid;
                        EpiMoeDown E{XCUR, modbase + 5 * 1024, LIST + (size_t)s * 8 * MALL, GLIST + (size_t)s * 8 * MALL, 1.0f, XCUR};
                        gm::gemm_phase<EpiMoeDown, SchedMoeDown, false>(lds, S, E); }
                    SEAM(pb + 7 + 2 * s); }
            }
        }
    }
    if (EN(13) && IN(NPH - 1)) { WSP_DECL; phase_final(XCUR, AOUT, AIN(I_FINALG), gw, NGW, lane); }
#undef IN
#undef SEAM
}

extern "C" void kernel_launch(void* const* d_in, const int* in_sizes, int n_in, void* d_out, int out_size, void* d_ws, size_t ws_size, hipStream_t stream) {
    static int grid = 0;
    if (grid == 0) {
        if (n_in != N_IN || out_size != MLAT * D || ws_size < WS_END) { fprintf(stderr, "kernel_launch: unexpected problem (n_in %d, out %d, ws %zu < %zu)\n", n_in, out_size, ws_size, (size_t)WS_END); grid = -1; return; }
        int dev = 0, cus = 0, per_cu = 0;
        if (hipGetDevice(&dev) != hipSuccess || hipDeviceGetAttribute(&cus, hipDeviceAttributeMultiprocessorCount, dev) != hipSuccess) { grid = -1; return; }
        if (hipFuncSetAttribute((const void*)fwd, hipFuncAttributeMaxDynamicSharedMemorySize, LDS_BYTES) != hipSuccess) { fprintf(stderr, "kernel_launch: hipFuncSetAttribute failed\n"); grid = -1; return; }
        if (hipOccupancyMaxActiveBlocksPerMultiprocessor(&per_cu, (const void*)fwd, 512, LDS_BYTES) != hipSuccess || per_cu < 1) fprintf(stderr, "kernel_launch: occupancy query reports %d\n", per_cu);
        (void)hipGetLastError();
        grid = cus;
        if (grid != 256) fprintf(stderr, "kernel_launch: %d CUs (built for 256)\n", grid);
    }
    if (grid < 0) return;
    (void)hipMemsetAsync((char*)d_ws + WS_CTL, 0, CTL_BYTES, stream);
    Args a{};
    for (int i = 0; i < N_IN; ++i) a.in[i] = (const float*)d_in[i];
    a.out = (float*)d_out; a.ws = (unsigned char*)d_ws;
#if MK_PER_PHASE
    for (int p = 0; p < NPH; ++p) {
        const int k = (p - 2) % 10, layer = (p - 2) / 10;
        if (p >= 2 && p < NPH - 1) { const bool even = !(layer & 1); if (even && k >= 8) continue; if (!even && k == 3) continue; }
        a.ph_lo = p; a.ph_hi = p + 1;
        hipLaunchKernelGGL(fwd, dim3(grid), dim3(512), LDS_BYTES, stream, a);
    }
#else
    a.ph_lo = 0; a.ph_hi = NPH;
    hipLaunchKernelGGL(fwd, dim3(grid), dim3(512), LDS_BYTES, stream, a);
#endif
}
```

```cpp
#include <hip/hip_runtime.h>
#include <cstdio>
#include <cstdint>

#ifndef MK_FP8_L1
#define MK_FP8_L1 1
#endif
#define FP8_MOE(i) ((i) == 3 || MK_FP8_L1)
#ifndef MK_BG
#define MK_BG 1
#endif
#define BG_ON (MK_BG && MK_FP8_L1)
#ifndef MK_FP8_DFT
#define MK_FP8_DFT 1
#endif
#ifndef MK_FP8_MIXIN
#define MK_FP8_MIXIN 0
#endif
#ifndef MK_FP8_FFN
#define MK_FP8_FFN 2
#endif
#define FP8_FFN(i) (((MK_FP8_FFN) >> ((i) >> 1)) & 1)
#ifndef MK_DUP
#define MK_DUP 0u
#endif
#ifndef MK_PER_PHASE
#define MK_PER_PHASE 0
#endif

#define LAS __attribute__((address_space(3)))
#define GAS __attribute__((address_space(1)))
typedef unsigned short bf16;
typedef short bf16x8 __attribute__((ext_vector_type(8)));
typedef short s16x4 __attribute__((ext_vector_type(4)));
typedef float f32x4 __attribute__((ext_vector_type(4)));
typedef float f32x2 __attribute__((ext_vector_type(2)));
typedef float f32x16 __attribute__((ext_vector_type(16)));
typedef unsigned u32x4 __attribute__((ext_vector_type(4)));
typedef unsigned u32x2 __attribute__((ext_vector_type(2)));
typedef __bf16 bf16x2_t __attribute__((ext_vector_type(2)));

constexpr int NB = 32, SEQ = 2048, LC = 256, D = 1024, DEPTH = 4;
constexpr int MLAT = NB * SEQ, MCTX = NB * LC, MALL = MLAT + MCTX;
constexpr int TLAT = MLAT / 256, TCTX = MCTX / 256, TALL = MALL / 256;
constexpr int HEADS = 8, QKN = 64, QKR = 32, VD = 64, QLORA = 256, KVLORA = 128;
constexpr int QW = HEADS * (QKN + QKR);
constexpr int NKEY = SEQ + LC;
constexpr int DFF = 2816, DFFE = 3584, NEXP = 8;
constexpr float EPS = 1e-6f;
constexpr float QSCALE = 0.10206207261596577f * 1.4426950408889634f;

enum { I_X = 0, I_C, I_CTX, I_CCTX, I_ADAW, I_ADAB, I_NMG, I_NFG, I_MIXIN, I_CQG, I_CKVG, I_WUQ, I_WUKV, I_POOLW, I_POOLS, I_MIXOUT,
       I_FW1, I_FW3, I_FW2, I_FNET, I_ROUTER, I_MW1, I_MW3, I_MW2, I_FINALG, N_IN };

constexpr size_t al(size_t x) { return (x + 4095) & ~(size_t)4095; }
constexpr size_t WS_CTL = 0, CTL_BYTES = 1u << 20;
constexpr size_t WS_MOD = WS_CTL + CTL_BYTES;
constexpr size_t WS_ROPE = al(WS_MOD + (size_t)DEPTH * 33 * 6 * D * 4);
constexpr size_t WS_SSQQ = al(WS_ROPE + 64 * 16 * 4);
constexpr size_t WS_SSQK = al(WS_SSQQ + (size_t)MALL * 16);
constexpr size_t WS_HMID = al(WS_SSQK + (size_t)MALL * 16);
constexpr size_t WS_AMID = al(WS_HMID + 64 * D * 4);
constexpr size_t WS_LIST = al(WS_AMID + 64 * D * 4);
constexpr size_t WS_GLIST = al(WS_LIST + (size_t)2 * 8 * MALL * 4);
constexpr size_t WS_WMIXIN = al(WS_GLIST + (size_t)2 * 8 * MALL * 4);
constexpr size_t WS_WUQ = al(WS_WMIXIN + (size_t)2 * 1024 * 1024 * 2);
constexpr size_t WS_WUK = al(WS_WUQ + (size_t)2 * 768 * 256 * 2);
constexpr size_t WS_WUV = al(WS_WUK + (size_t)2 * 512 * 128 * 2);
constexpr size_t WS_WMIXOUT = al(WS_WUV + (size_t)2 * 512 * 128 * 2);
constexpr size_t WS_WFFN13 = al(WS_WMIXOUT + (size_t)2 * 1024 * 1024 * 2);
constexpr size_t WS_WFFN2 = al(WS_WFFN13 + (size_t)2 * 5632 * 1024 * 2);
constexpr size_t WS_WFNET = al(WS_WFFN2 + (size_t)2 * 1024 * 2816 * 2);
constexpr size_t WS_WDFTC = al(WS_WFNET + (size_t)2 * 1024 * 1024 * 2);
constexpr size_t WS_WDFTL = al(WS_WDFTC + (size_t)2 * 256 * 256 * 2);
constexpr size_t WS_WDFTX = al(WS_WDFTL + (size_t)2048 * 2048 * 2);
constexpr size_t WS_WMOE13 = al(WS_WDFTX + (size_t)256 * 256 * 2);
constexpr size_t WS_WMOE2 = al(WS_WMOE13 + (size_t)8 * 7168 * 1024 * 2);
constexpr size_t WS_XCUR = al(WS_WMOE2 + (size_t)8 * 1024 * 3584 * 2);
constexpr size_t WS_RA = al(WS_XCUR + (size_t)MALL * D * 2);
constexpr size_t WS_RB = al(WS_RA + (size_t)MALL * D * 2);
constexpr size_t RB_CQ = 0;
constexpr size_t RB_CKV = al(RB_CQ + (size_t)MALL * 256 * 2);
constexpr size_t RB_KR = al(RB_CKV + (size_t)MALL * 128 * 2);
constexpr size_t RB_POOL = al(RB_KR + (size_t)MALL * 32 * 2);
constexpr size_t RB_Q = al(RB_POOL + (size_t)MALL * 512 * 2);
constexpr size_t RB_KN = al(RB_Q + (size_t)MALL * 768 * 2);
constexpr size_t RB_VT = al(RB_KN + (size_t)MALL * 512 * 2);
constexpr size_t RB_EVEN_END = al(RB_VT + (size_t)NB * 512 * NKEY * 2);
constexpr size_t RB_Z = 0;
constexpr size_t RB_ZC = al(RB_Z + (size_t)NB * 4 * 256 * 2048 * 2);
constexpr size_t RB_ACT = 0;
constexpr size_t RB_SIZE = al((size_t)(MALL + 2048) * DFFE * 2);
static_assert(RB_EVEN_END <= RB_SIZE && (size_t)MALL * DFF * 2 <= RB_SIZE && RB_ZC + (size_t)NB * 4 * 256 * 256 * 2 <= RB_SIZE, "region B");
constexpr size_t WS_G16 = WS_RB + RB_SIZE;
constexpr size_t WS_END = al(WS_G16 + (size_t)DEPTH * 33 * 1024 * 2);
static_assert(WS_END < 1150000000ull, "workspace budget");

constexpr int CW_TMO = 0;
constexpr int CW_BAR = 4096;
constexpr int CW_CNT = 16384;

constexpr int STAGE_BYTES = 131072;
constexpr int ATQ_OFF = 90112;
constexpr int MISC_OFF = 143360;
constexpr int LDS_BYTES = 147456;

__device__ __forceinline__ unsigned pkbf(float lo, float hi) { f32x2 v = {lo, hi}; bf16x2_t b = __builtin_convertvector(v, bf16x2_t); return __builtin_bit_cast(unsigned, b); }
__device__ __forceinline__ float bf2f(unsigned short b) { return __uint_as_float(((unsigned)b) << 16); }
__device__ __forceinline__ float wave_sum(float v) {
#pragma unroll
    for (int o = 1; o < 64; o <<= 1) v += __shfl_xor(v, o);
    return v;
}
__device__ __forceinline__ float silu_f(float x) { return x / (1.0f + __expf(-x)); }

#define XB_TMO      128
#define XB_XCNT(j)  (256  + 64 * (j))
#define XB_XSUB(j)  (1280 + 64 * (j))
#define XB_XGEN(j)  (2304 + 64 * (j))
#define XB_TOP      3328
#define XB_TOPGEN   3392
#define XCD_BAR_WORDS 3456
#define XB_SPIN_CAP (1u << 22)

__device__ __forceinline__ unsigned xb_ld(unsigned* p)              { return __hip_atomic_load(p, __ATOMIC_RELAXED, __HIP_MEMORY_SCOPE_AGENT); }
__device__ __forceinline__ unsigned xb_add(unsigned* p, unsigned v) { return __hip_atomic_fetch_add(p, v, __ATOMIC_RELAXED, __HIP_MEMORY_SCOPE_AGENT); }
__device__ __forceinline__ unsigned xb_xcc_id() { return (unsigned)__builtin_amdgcn_s_getreg((3 << 11) | 20) & 0xFu; }
#define XB_SPIN(cond, bar) do { unsigned _sp = 0; while (cond) { __builtin_amdgcn_s_sleep(1); \
    if ((++_sp & 255u) == 0u) { if (xb_ld(&(bar)[XB_TMO])) break; if (_sp > XB_SPIN_CAP) { atomicAdd(&(bar)[XB_TMO], 1u); break; } } } } while (0)

struct XcdBarrier { unsigned* bar; unsigned x; volatile LAS unsigned* st; };

__device__ __forceinline__ XcdBarrier xcd_barrier_post(unsigned* bar, volatile LAS unsigned* st) {
    XcdBarrier b; b.bar = bar; b.x = xb_xcc_id(); b.st = st;
    if (threadIdx.x == 0) (void)xb_add(&bar[XB_XCNT(b.x)], 1u);
    return b;
}
__device__ __forceinline__ void xcd_barrier_complete(unsigned* bar, unsigned x, unsigned& nloc, unsigned& nx) {
    const unsigned G = gridDim.x * gridDim.y * gridDim.z;
    unsigned sum, cnt, mine, sp = 0u;
    for (;;) {
        sum = 0u; cnt = 0u; mine = 0u;
#pragma unroll
        for (unsigned j = 0; j < 16; ++j) { const unsigned c = xb_ld(&bar[XB_XCNT(j)]); sum += c; cnt += (c > 0u) ? 1u : 0u; mine = (j == x) ? c : mine; }
        if (sum == G) break;
        __builtin_amdgcn_s_sleep(1);
        if ((++sp & 255u) == 0u) { if (xb_ld(&bar[XB_TMO])) break; if (sp > XB_SPIN_CAP) { atomicAdd(&bar[XB_TMO], 1u); break; } }
    }
    nloc = mine > 0u ? mine : 1u; nx = cnt > 0u ? cnt : 1u;
}
template <bool FIRST>
__device__ __forceinline__ void xcd_barrier(const XcdBarrier& b) {
    asm volatile("s_waitcnt vmcnt(0)" ::: "memory");
    __syncthreads();
    if (threadIdx.x == 0) {
        unsigned* bar = b.bar; asm volatile("" : "+s"(bar));
        __builtin_amdgcn_s_waitcnt(0);
        unsigned nloc = b.st[0], nx = b.st[1];
        if constexpr (FIRST) { if (nloc == 0u) { xcd_barrier_complete(bar, b.x, nloc, nx); b.st[0] = nloc; b.st[1] = nx; } }
        const unsigned old = xb_add(&bar[XB_XSUB(b.x)], 1u);
        const unsigned gen = old / nloc;
        if (old + 1u == (gen + 1u) * nloc) {
            __builtin_amdgcn_fence(__ATOMIC_RELEASE, "agent");
            asm volatile("s_waitcnt vmcnt(0)" ::: "memory");
            const unsigned og = xb_add(&bar[XB_TOP], 1u);
            const unsigned tg = og / nx;
            if (og + 1u == (tg + 1u) * nx) xb_add(&bar[XB_TOPGEN], 1u);
            else XB_SPIN(xb_ld(&bar[XB_TOPGEN]) == tg, bar);
            __builtin_amdgcn_fence(__ATOMIC_ACQUIRE, "agent");
            xb_add(&bar[XB_XGEN(b.x)], 1u);
            asm volatile("s_waitcnt vmcnt(0)" ::: "memory");
        } else {
            XB_SPIN(xb_ld(&bar[XB_XGEN(b.x)]) == gen, bar);
            __builtin_amdgcn_fence(__ATOMIC_ACQUIRE, "agent");
            asm volatile("s_waitcnt vmcnt(0)" ::: "memory");
        }
    }
    __syncthreads();
}

namespace gm {
constexpr int BK = 64, HALF = 128, HTB = HALF * BK * 2;
__device__ __forceinline__ int lds_byte(int r, int c) { const int st = (r >> 4) * 2 + (c >> 5), rr = r & 15, cc = c & 31, ob = rr * 64 + cc * 2; return st * 1024 + (ob ^ (((ob >> 9) & 1) << 5)); }
__device__ __forceinline__ void stage_rc(int b, int& R, int& C) { const int st = b / 1024, sb = b % 1024, swz = sb ^ (((sb >> 9) & 1) << 5); R = (st >> 1) * 16 + swz / 64; C = (st & 1) * 32 + (swz % 64) / 2; }
__device__ __forceinline__ int perm32(int rho) { const int n = rho >> 4, i = rho & 15; return 8 * (i >> 2) + 4 * n + (i & 3); }

struct Unit { const char* A; const char* B; unsigned lda, ldb; int nt; int x0, x1, x2, x3; };
typedef int v8i_t __attribute__((ext_vector_type(8))); typedef int v4i_t __attribute__((ext_vector_type(4)));


__device__ __forceinline__ bool flat_index(int i, int G, int c, int total, int& idx) {
    const long Lx = (long)i * G + c; if (Lx >= total) return false;
    int wgid = (int)Lx; const int q = total / 8, r = total % 8, xcd = wgid % 8, off = wgid / 8;
    idx = (xcd < r ? xcd * (q + 1) : r * (q + 1) + (xcd - r) * q) + off; return true;
}
__device__ __forceinline__ void tile_order(int idx, int nM, int nN, int& pm, int& pn) {
    const int nig = 8 * nN, gid = idx / nig, fm = gid * 8, gsz = (nM - fm) < 8 ? (nM - fm) : 8;
    pm = fm + ((idx % nig) % gsz); pn = (idx % nig) / gsz;
}

template <class Epi, class Sched, bool GATHER, bool FP8 = false>
__device__ __forceinline__ void gemm_phase(LAS unsigned char* lds, const Sched& S, const Epi& E) {
    int tid = threadIdx.x; asm volatile("" : "+v"(tid));
    const int wid = __builtin_amdgcn_readfirstlane(tid >> 6), lane = tid & 63, wr = wid >> 2, wc = wid & 3, fr = lane & 15, fq = lane >> 4;
    const unsigned ldsw = (unsigned)wid * 1024u;
    const int aoff = lds_byte(wr * 64 + fr, fq * 8), boff = lds_byte(wc * 32 + fr, fq * 8);
#define G_SA(b, h) (((b) * 2 + (h)) * HTB)
#define G_SB(b, h) ((4 + (b) * 2 + (h)) * HTB)
#define G_LD(ptr, dst) __builtin_amdgcn_global_load_lds((const unsigned*)(ptr), (LAS unsigned*)(dst), 16, 0, 0)
#define G_STAGE_B(bufoff, P, hh, kb) do { const char* _p0 = P##p + (size_t)(kb) + ((hh) ? (size_t)P##s * 128u : (size_t)0); const char* _p1 = _p0 + (size_t)P##s * 64u; \
        asm volatile("" : "+s"(_p0), "+s"(_p1)); \
        G_LD(_p0 + P##v, lds + (bufoff) + ldsw); G_LD(_p1 + P##v, lds + (bufoff) + ldsw + 8192); } while (0)
#define G_STAGE_A(bufoff, P, hh, kb) do { if constexpr (GATHER) { const char* _p = P##p + (size_t)(kb); asm volatile("" : "+s"(_p)); \
        G_LD(_p + P##g[(hh) * 2], lds + (bufoff) + ldsw); G_LD(_p + P##g[(hh) * 2 + 1], lds + (bufoff) + ldsw + 8192); } else { G_STAGE_B(bufoff, P, hh, kb); } } while (0)
#define G_LDA(dst, b, h) do { _Pragma("unroll") for (int m = 0; m < 4; ++m) { const v4i_t _l = *(const LAS v4i_t*)(lds + G_SA(b, h) + aoff + m * 2048), _h = *(const LAS v4i_t*)(lds + G_SA(b, h) + aoff + m * 2048 + 1024); \
        dst[m] = __builtin_shufflevector(_l, _h, 0, 1, 2, 3, 4, 5, 6, 7); } } while (0)
#define G_LDB(dst, b, h) do { _Pragma("unroll") for (int n = 0; n < 2; ++n) { const v4i_t _l = *(const LAS v4i_t*)(lds + G_SB(b, h) + boff + n * 2048), _h = *(const LAS v4i_t*)(lds + G_SB(b, h) + boff + n * 2048 + 1024); \
        dst[n] = __builtin_shufflevector(_l, _h, 0, 1, 2, 3, 4, 5, 6, 7); } } while (0)
#define G_LO(x) __builtin_bit_cast(bf16x8, (v4i_t)__builtin_shufflevector(x, x, 0, 1, 2, 3))
#define G_HI(x) __builtin_bit_cast(bf16x8, (v4i_t)__builtin_shufflevector(x, x, 4, 5, 6, 7))
#define G_MMA(ai, bj, At, Bt) do { __builtin_amdgcn_s_setprio(1); \
        if constexpr (FP8) { _Pragma("unroll") for (int m = 0; m < 4; ++m) _Pragma("unroll") for (int n = 0; n < 2; ++n) \
            asm volatile("v_mfma_f32_16x16x128_f8f6f4 %0, %1, %2, %0" : "+v"(acc[ai][bj][m][n]) : "v"(Bt[n]), "v"(At[m])); } \
        else { _Pragma("unroll") for (int m = 0; m < 4; ++m) _Pragma("unroll") for (int n = 0; n < 2; ++n) { \
            acc[ai][bj][m][n] = __builtin_amdgcn_mfma_f32_16x16x32_bf16(G_LO(Bt[n]), G_LO(At[m]), acc[ai][bj][m][n], 0, 0, 0); \
            acc[ai][bj][m][n] = __builtin_amdgcn_mfma_f32_16x16x32_bf16(G_HI(Bt[n]), G_HI(At[m]), acc[ai][bj][m][n], 0, 0, 0); } } \
        __builtin_amdgcn_s_setprio(0); } while (0)
#define G_MMA0(ai, bj, At, Bt) do { __builtin_amdgcn_s_setprio(1);     \
        if constexpr (FP8) { _Pragma("unroll") for (int m = 0; m < 4; ++m) _Pragma("unroll") for (int n = 0; n < 2; ++n) \
            asm volatile("v_mfma_f32_16x16x128_f8f6f4 %0, %1, %2, 0" : "=&v"(acc[ai][bj][m][n]) : "v"(Bt[n]), "v"(At[m])); } \
        else { _Pragma("unroll") for (int m = 0; m < 4; ++m) _Pragma("unroll") for (int n = 0; n < 2; ++n) { \
            acc[ai][bj][m][n] = __builtin_amdgcn_mfma_f32_16x16x32_bf16(G_LO(Bt[n]), G_LO(At[m]), (f32x4){0.f, 0.f, 0.f, 0.f}, 0, 0, 0); \
            acc[ai][bj][m][n] = __builtin_amdgcn_mfma_f32_16x16x32_bf16(G_HI(Bt[n]), G_HI(At[m]), acc[ai][bj][m][n], 0, 0, 0); } } \
        __builtin_amdgcn_s_setprio(0); } while (0)
#define G_WAIT_V(n) asm volatile("s_waitcnt vmcnt(" #n ")" ::: "memory")
#define G_WAIT_L(n) asm volatile("s_waitcnt lgkmcnt(" #n ")" ::: "memory")
#define G_BAR __builtin_amdgcn_s_barrier()
#define G_SCHED __builtin_amdgcn_sched_barrier(0)
#define G_SETUP(P_A, P_B, U) do { int _t = threadIdx.x; asm volatile("" : "+v"(_t)); int R0, C0; stage_rc(_t * 16, R0, C0); const int Rb0 = (R0 & ~31) + perm32(R0 & 31);     \
        P_A##p = (U).A; P_A##s = (U).lda; P_B##p = (U).B; P_B##s = (U).ldb; P_B##v = (unsigned)Rb0 * (U).ldb + (unsigned)C0 * 2u; \
        if constexpr (GATHER) { _Pragma("unroll") for (int _q = 0; _q < 4; ++_q) P_A##g[_q] = (unsigned)S.gather_row((U), R0 + 64 * _q) * (U).lda + (unsigned)C0 * 2u; P_A##v = 0u; } \
        else { P_A##v = (unsigned)R0 * (U).lda + (unsigned)C0 * 2u; } } while (0)
    Unit cur, nxt; int ui = 0;
    if (!S.next(0, cur)) return;
    f32x4 acc[2][2][4][2];
    v8i_t At[4], B0[2], B1[2];
    const char *cAp, *cBp, *nAp, *nBp; unsigned cAs, cBs, nAs, nBs, cAv, cBv, nAv, nBv; unsigned cAg[4], nAg[4];
#pragma unroll
    for (int q = 0; q < 4; ++q) { cAg[q] = 0u; nAg[q] = 0u; }
    G_SETUP(cA, cB, cur);
    G_STAGE_B(G_SB(0, 0), cB, 0, 0); G_STAGE_B(G_SB(0, 1), cB, 1, 0); G_STAGE_A(G_SA(0, 0), cA, 0, 0); G_STAGE_A(G_SA(0, 1), cA, 1, 0);
    if (wr == 1) G_BAR;
    G_WAIT_V(2); G_BAR;
    G_STAGE_B(G_SB(1, 0), cB, 0, 128); G_STAGE_A(G_SA(1, 0), cA, 0, 128); G_STAGE_B(G_SB(1, 1), cB, 1, 128);
    G_WAIT_V(6); G_BAR;
    for (;;) {
        const bool has_next = S.next(ui + 1, nxt);
        if (has_next) { G_SETUP(nA, nB, nxt); } else { nAp = cAp; nBp = cBp; nAs = cAs; nBs = cBs; nAv = cAv; nBv = cBv;
#pragma unroll
            for (int q = 0; q < 4; ++q) nAg[q] = cAg[q]; }
        int nt = cur.nt; asm volatile("" : "+s"(nt));
#define G_KSTEP(MM) { \
            const bool last = (t == nt - 2); \
            const size_t k1 = (size_t)(t + 1) * 128; \
              \
            G_LDB(B0, 0, 0); G_LDB(B1, 0, 1); G_SCHED; G_LDA(At, 0, 0); G_STAGE_A(G_SA(1, 1), cA, 1, k1); \
            G_WAIT_V(8); G_WAIT_L(0); G_BAR; MM(0, 0, At, B0); MM(0, 1, At, B1); G_BAR; G_SCHED; \
              \
            G_LDA(At, 0, 1); \
            if (last) { G_STAGE_B(G_SB(0, 0), nB, 0, 0); G_STAGE_B(G_SB(0, 1), nB, 1, 0); G_STAGE_A(G_SA(0, 0), nA, 0, 0); } \
            else { const size_t k2 = (size_t)(t + 2) * 128; G_STAGE_B(G_SB(0, 0), cB, 0, k2); G_STAGE_B(G_SB(0, 1), cB, 1, k2); G_STAGE_A(G_SA(0, 0), cA, 0, k2); } \
            G_WAIT_V(8); G_WAIT_L(0); G_BAR; MM(1, 0, At, B0); MM(1, 1, At, B1); G_BAR; G_SCHED; \
              \
            G_LDB(B0, 1, 0); G_LDB(B1, 1, 1); G_SCHED; G_LDA(At, 1, 0); \
            if (last) { G_STAGE_A(G_SA(0, 1), nA, 1, 0); } else { const size_t k2 = (size_t)(t + 2) * 128; G_STAGE_A(G_SA(0, 1), cA, 1, k2); } \
            G_WAIT_V(8); G_WAIT_L(0); G_BAR; G_MMA(0, 0, At, B0); G_MMA(0, 1, At, B1); G_BAR; G_SCHED; \
              \
            G_LDA(At, 1, 1); \
            if (last) { G_STAGE_B(G_SB(1, 0), nB, 0, 128); G_STAGE_B(G_SB(1, 1), nB, 1, 128); G_STAGE_A(G_SA(1, 0), nA, 0, 128); } \
            else { const size_t k3 = (size_t)(t + 3) * 128; G_STAGE_B(G_SB(1, 0), cB, 0, k3); G_STAGE_B(G_SB(1, 1), cB, 1, k3); G_STAGE_A(G_SA(1, 0), cA, 0, k3); } \
            G_WAIT_V(8); G_WAIT_L(0); G_BAR; G_MMA(1, 0, At, B0); G_MMA(1, 1, At, B1); G_BAR; G_SCHED; \
        }
        { const int t = 0; G_KSTEP(G_MMA0) }
        for (int t = 2; t < nt; t += 2) G_KSTEP(G_MMA)
#undef G_KSTEP
        if (wr == 0) G_BAR;
        if constexpr (FP8) asm volatile("s_nop 15\n\ts_nop 15" ::: "memory");
        { int _t = threadIdx.x; asm volatile("" : "+v"(_t)); const int _w = __builtin_amdgcn_readfirstlane(_t >> 6), _l = _t & 63;
          E(acc, cur, _w >> 2, _w & 3, _l & 15, _l >> 4); }
        if (!has_next) break;
        cur = nxt; cAp = nAp; cBp = nBp; cAs = nAs; cBs = nBs; cAv = nAv; cBv = nBv;
#pragma unroll
        for (int q = 0; q < 4; ++q) cAg[q] = nAg[q];
        ++ui;
        if (wr == 1) G_BAR;
    }
    G_WAIT_V(0);
    G_BAR;
#undef G_SA
#undef G_SB
#undef G_LD
#undef G_STAGE_A
#undef G_STAGE_B
#undef G_LDA
#undef G_LDB
#undef G_MMA
#undef G_MMA0
#undef G_WAIT_V
#undef G_WAIT_L
#undef G_BAR
#undef G_SCHED
#undef G_SETUP
}
}

typedef const f32x4 (&AccRef)[2][2][4][2];
__device__ __forceinline__ u32x4 pack8(const f32x4 a, const f32x4 b) { u32x4 w; w.x = pkbf(a[0], a[1]); w.y = pkbf(a[2], a[3]); w.z = pkbf(b[0], b[1]); w.w = pkbf(b[2], b[3]); return w; }

__device__ __forceinline__ void rope8(f32x4& v0, f32x4& v1, int fq, int t, const float* ropeC, const float* ropeS) {
    const int pos = (fq < 2) ? (t >> 6) : (t & 63);
    const f32x4 c0 = *(const f32x4*)(ropeC + pos * 8), c1 = *(const f32x4*)(ropeC + pos * 8 + 4);
    const f32x4 s0 = *(const f32x4*)(ropeS + pos * 8), s1 = *(const f32x4*)(ropeS + pos * 8 + 4);
    f32x4 p0, p1;
#pragma unroll
    for (int j = 0; j < 4; ++j) { p0[j] = __shfl_xor(v0[j], 16); p1[j] = __shfl_xor(v1[j], 16); }
    const float sg = (fq & 1) ? 1.0f : -1.0f;
    v0 = v0 * c0 + (p0 * s0) * sg; v1 = v1 * c1 + (p1 * s1) * sg;
}

struct SchedMixIn {
    const char* H; const char* W; int G, c, total; bool ctx_full;
    __device__ __forceinline__ bool next(int i, gm::Unit& u) const {
        int idx; if (!gm::flat_index(i, G, c, total, idx)) return false;
        int pm, pn;
        if (idx < 1024) gm::tile_order(idx, 256, 4, pm, pn);
        else { const int j = idx - 1024; if (ctx_full) { gm::tile_order(j, 32, 4, pm, pn); pm += 256; } else { pm = 256 + j; pn = 1; } }
        constexpr unsigned P = MK_FP8_MIXIN ? 1024u : 2048u;
        u.A = H + (size_t)pm * 256 * P; u.lda = P; u.B = W + (size_t)pn * 256 * P; u.ldb = P; u.nt = 16 / (MK_FP8_MIXIN ? 2 : 1); u.x0 = pm; u.x1 = pn; u.x2 = 0; u.x3 = 0; return true;
    }
};
struct EpiMixIn {
    bf16 *CQ, *CKV, *KR, *POOL; float *SSQQ, *SSQK; const float *ropeC, *ropeS;
    __device__ __forceinline__ void operator()(AccRef accr, const gm::Unit& u, int wr, int wc, int fr, int fq) const {
        const int pn = u.x1, row0 = u.x0 * 256 + wr * 64 + fr, cl = wc * 32 + fq * 8;
        constexpr float WS = MK_FP8_MIXIN ? (1.0f / 32.0f) : 1.0f;
        f32x4 acc[2][2][4][2];
#pragma unroll
        for (int a_ = 0; a_ < 2; ++a_)
#pragma unroll
            for (int b_ = 0; b_ < 2; ++b_)
#pragma unroll
                for (int m_ = 0; m_ < 4; ++m_)
#pragma unroll
                    for (int n_ = 0; n_ < 2; ++n_) acc[a_][b_][m_][n_] = accr[a_][b_][m_][n_] * WS;
        if (pn == 0) {
#pragma unroll
            for (int ai = 0; ai < 2; ++ai)
#pragma unroll
                for (int m = 0; m < 4; ++m) { const int row = row0 + ai * 128 + m * 16; float ss = 0.f;
#pragma unroll
                    for (int bj = 0; bj < 2; ++bj) { const f32x4 a = acc[ai][bj][m][0], b = acc[ai][bj][m][1];
                        ss += (a[0] * a[0] + a[1] * a[1]) + (a[2] * a[2] + a[3] * a[3]) + (b[0] * b[0] + b[1] * b[1]) + (b[2] * b[2] + b[3] * b[3]);
                        *(u32x4*)(CQ + (size_t)row * 256 + bj * 128 + cl) = pack8(a, b); }
                    ss += __shfl_xor(ss, 16); ss += __shfl_xor(ss, 32);
                    if (fq == 0) SSQQ[(size_t)row * 4 + wc] = ss; }
        } else if (pn == 1) {
            const bool lat = u.x0 < TLAT;
#pragma unroll
            for (int ai = 0; ai < 2; ++ai)
#pragma unroll
                for (int m = 0; m < 4; ++m) { const int row = row0 + ai * 128 + m * 16;
                    const f32x4 a = acc[ai][0][m][0], b = acc[ai][0][m][1];
                    float ss = (a[0] * a[0] + a[1] * a[1]) + (a[2] * a[2] + a[3] * a[3]) + (b[0] * b[0] + b[1] * b[1]) + (b[2] * b[2] + b[3] * b[3]);
                    *(u32x4*)(CKV + (size_t)row * 128 + cl) = pack8(a, b);
                    ss += __shfl_xor(ss, 16); ss += __shfl_xor(ss, 32);
                    if (fq == 0) SSQK[(size_t)row * 4 + wc] = ss;
                    if (wc == 0) { f32x4 r0 = acc[ai][1][m][0], r1 = acc[ai][1][m][1];
                        if (lat) rope8(r0, r1, fq, row & (SEQ - 1), ropeC, ropeS);
                        *(u32x4*)(KR + (size_t)row * 32 + fq * 8) = pack8(r0, r1); } }
        } else {
#pragma unroll
            for (int ai = 0; ai < 2; ++ai)
#pragma unroll
                for (int m = 0; m < 4; ++m) { const int row = row0 + ai * 128 + m * 16;
#pragma unroll
                    for (int bj = 0; bj < 2; ++bj) *(u32x4*)(POOL + (size_t)row * 512 + (pn - 2) * 256 + bj * 128 + cl) = pack8(acc[ai][bj][m][0], acc[ai][bj][m][1]); }
        }
    }
};

struct SchedE3 {
    const char *CQ, *CKV, *WUQ, *WUK, *WUV; int G, c, nq, total;
    __device__ __forceinline__ bool next(int i, gm::Unit& u) const {
        int idx; if (!gm::flat_index(i, G, c, total, idx)) return false;
        int pm, pn; u.x3 = 0;
        if (idx < nq * 3) { gm::tile_order(idx, nq, 3, pm, pn);
            u.A = CQ + (size_t)pm * 256 * 512; u.lda = 512; u.B = WUQ + (size_t)pn * 256 * 512; u.ldb = 512; u.nt = 4; u.x0 = pm; u.x1 = pn; u.x2 = 0; return true; }
        int j = idx - nq * 3;
        if (j < 576) { gm::tile_order(j, 288, 2, pm, pn);
            u.A = CKV + (size_t)pm * 256 * 256; u.lda = 256; u.B = WUK + (size_t)pn * 256 * 256; u.ldb = 256; u.nt = 2; u.x0 = pm; u.x1 = pn; u.x2 = 1; return true; }
        j -= 576; pm = j & 1; pn = j >> 1;
        u.A = WUV + (size_t)pm * 256 * 256; u.lda = 256; u.B = CKV + (size_t)pn * 256 * 256; u.ldb = 256; u.nt = 2; u.x0 = pm; u.x1 = pn; u.x2 = 2; return true;
    }
};
struct EpiE3 {
    bf16 *Q, *KN, *VT; const float *SSQQ, *SSQK, *ropeC, *ropeS;
    __device__ __forceinline__ void operator()(AccRef acc, const gm::Unit& u, int wr, int wc, int fr, int fq) const {
        const int pm = u.x0, pn = u.x1, ty = u.x2, cl = wc * 32 + fq * 8;
        if (ty == 0) {
            const bool lat = pm < TLAT;
            float rq[2][4];
#pragma unroll
            for (int ai = 0; ai < 2; ++ai)
#pragma unroll
                for (int m = 0; m < 4; ++m) { const f32x4 sq = *(const f32x4*)(SSQQ + (size_t)(pm * 256 + wr * 64 + fr + ai * 128 + m * 16) * 4);
                    rq[ai][m] = __builtin_amdgcn_rsqf(((sq[0] + sq[1]) + (sq[2] + sq[3])) * (1.0f / 256.0f) + EPS); }
#pragma unroll
            for (int ai = 0; ai < 2; ++ai)
#pragma unroll
                for (int m = 0; m < 4; ++m) { const int row = pm * 256 + wr * 64 + fr + ai * 128 + m * 16;
#pragma unroll
                    for (int bj = 0; bj < 2; ++bj) { f32x4 a = acc[ai][bj][m][0] * rq[ai][m], b = acc[ai][bj][m][1] * rq[ai][m];
                        const int g32 = 8 * pn + 4 * bj + wc;
                        if (lat && (g32 % 3) == 2) rope8(a, b, fq, row & (SEQ - 1), ropeC, ropeS);
                        *(u32x4*)(Q + (size_t)row * QW + pn * 256 + bj * 128 + cl) = pack8(a, b); } }
        } else if (ty == 1) {
            float rk[2][4];
#pragma unroll
            for (int ai = 0; ai < 2; ++ai)
#pragma unroll
                for (int m = 0; m < 4; ++m) { const f32x4 sq = *(const f32x4*)(SSQK + (size_t)(pm * 256 + wr * 64 + fr + ai * 128 + m * 16) * 4);
                    rk[ai][m] = __builtin_amdgcn_rsqf(((sq[0] + sq[1]) + (sq[2] + sq[3])) * (1.0f / 128.0f) + EPS); }
#pragma unroll
            for (int ai = 0; ai < 2; ++ai)
#pragma unroll
                for (int m = 0; m < 4; ++m) { const int row = pm * 256 + wr * 64 + fr + ai * 128 + m * 16;
#pragma unroll
                    for (int bj = 0; bj < 2; ++bj) *(u32x4*)(KN + (size_t)row * 512 + pn * 256 + bj * 128 + cl) = pack8(acc[ai][bj][m][0] * rk[ai][m], acc[ai][bj][m][1] * rk[ai][m]); }
        } else {
            const int b = pn < TLAT ? (pn >> 3) : (pn - TLAT), key0 = pn < TLAT ? ((pn & 7) * 256) : SEQ;
            f32x4 s0[2], s1[2];
#pragma unroll
            for (int bj = 0; bj < 2; ++bj)
#pragma unroll
                for (int j = 0; j < 8; ++j) { const f32x4 sq = *(const f32x4*)(SSQK + ((size_t)pn * 256 + bj * 128 + cl + j) * 4);
                    const float rk = __builtin_amdgcn_rsqf(((sq[0] + sq[1]) + (sq[2] + sq[3])) * (1.0f / 128.0f) + EPS);
                    if (j < 4) s0[bj][j] = rk; else s1[bj][j - 4] = rk; }
#pragma unroll
            for (int bj = 0; bj < 2; ++bj)
#pragma unroll
                for (int ai = 0; ai < 2; ++ai)
#pragma unroll
                    for (int m = 0; m < 4; ++m) { const int f = pm * 256 + wr * 64 + fr + ai * 128 + m * 16;
                        *(u32x4*)(VT + ((size_t)b * 512 + f) * NKEY + key0 + bj * 128 + cl) = pack8(acc[ai][bj][m][0] * s0[bj], acc[ai][bj][m][1] * s1[bj]); }
        }
    }
};

struct SchedResid {
    const char* A; const char* W; unsigned lda; int nt, nM, G, c;
    __device__ __forceinline__ bool next(int i, gm::Unit& u) const {
        int idx; if (!gm::flat_index(i, G, c, nM * 4, idx)) return false;
        int pm, pn; gm::tile_order(idx, nM, 4, pm, pn);
        u.A = A + (size_t)pm * 256 * lda; u.lda = lda; u.B = W + (size_t)pn * 256 * lda; u.ldb = lda; u.nt = nt; u.x0 = pm; u.x1 = pn; u.x2 = 0; u.x3 = 0; return true;
    }
};
struct EpiResid {
    const float *src_lat, *src_ctx; const bf16* src16; bf16* dst; const float* gate; float ascale;
    __device__ __forceinline__ void operator()(AccRef acc, const gm::Unit& u, int wr, int wc, int fr, int fq) const {
        const int pm = u.x0, pn = u.x1; const bool lat = pm < TLAT;
        const int b = lat ? (pm >> 3) : 32;
        const int col0 = pn * 256 + wc * 32 + fq * 8;
        f32x4 g[2][2];
#pragma unroll
        for (int bj = 0; bj < 2; ++bj) { g[bj][0] = *(const f32x4*)(gate + (size_t)b * 6144 + col0 + bj * 128) * ascale; g[bj][1] = *(const f32x4*)(gate + (size_t)b * 6144 + col0 + bj * 128 + 4) * ascale; }
        if (src16) {
            u32x4 xr[2][4][2];
#pragma unroll
            for (int ai = 0; ai < 2; ++ai)
#pragma unroll
                for (int m = 0; m < 4; ++m)
#pragma unroll
                    for (int bj = 0; bj < 2; ++bj) xr[ai][m][bj] = *(const u32x4*)(src16 + (size_t)(pm * 256 + wr * 64 + fr + ai * 128 + m * 16) * D + col0 + bj * 128);
#pragma unroll
            for (int ai = 0; ai < 2; ++ai)
#pragma unroll
                for (int m = 0; m < 4; ++m) { const size_t off = (size_t)(pm * 256 + wr * 64 + fr + ai * 128 + m * 16) * D + col0;
#pragma unroll
                    for (int bj = 0; bj < 2; ++bj) { const u32x4 w = xr[ai][m][bj];
                        const f32x4 x0 = (f32x4){__uint_as_float(w.x << 16), __uint_as_float(w.x & 0xffff0000u), __uint_as_float(w.y << 16), __uint_as_float(w.y & 0xffff0000u)};
                        const f32x4 x1 = (f32x4){__uint_as_float(w.z << 16), __uint_as_float(w.z & 0xffff0000u), __uint_as_float(w.w << 16), __uint_as_float(w.w & 0xffff0000u)};
                        *(u32x4*)(dst + off + bj * 128) = pack8(x0 + g[bj][0] * acc[ai][bj][m][0], x1 + g[bj][1] * acc[ai][bj][m][1]); } }
        } else {
            const float* sp = lat ? src_lat : src_ctx - (size_t)MLAT * D;
#pragma unroll
            for (int ai = 0; ai < 2; ++ai) {
                f32x4 xf[4][2][2];
#pragma unroll
                for (int m = 0; m < 4; ++m)
#pragma unroll
                    for (int bj = 0; bj < 2; ++bj) { const float* q = sp + (size_t)(pm * 256 + wr * 64 + fr + ai * 128 + m * 16) * D + col0 + bj * 128; xf[m][bj][0] = *(const f32x4*)q; xf[m][bj][1] = *(const f32x4*)(q + 4); }
                asm volatile("" ::: "memory");
#pragma unroll
                for (int m = 0; m < 4; ++m) { const size_t off = (size_t)(pm * 256 + wr * 64 + fr + ai * 128 + m * 16) * D + col0;
#pragma unroll
                    for (int bj = 0; bj < 2; ++bj) *(u32x4*)(dst + off + bj * 128) = pack8(xf[m][bj][0] + g[bj][0] * acc[ai][bj][m][0], xf[m][bj][1] + g[bj][1] * acc[ai][bj][m][1]); }
            }
        }
    }
};

struct SchedUp {
    const char* A; const char* W; int nM, nN, G, c; unsigned ld; int nt;
    __device__ __forceinline__ bool next(int i, gm::Unit& u) const {
        int idx; if (!gm::flat_index(i, G, c, nM * nN, idx)) return false;
        int pm, pn; gm::tile_order(idx, nM, nN, pm, pn);
        u.A = A + (size_t)pm * 256 * ld; u.lda = ld; u.B = W + (size_t)pn * 256 * ld; u.ldb = ld; u.nt = nt; u.x0 = pm; u.x1 = pn; u.x2 = 0; u.x3 = 0; return true;
    }
};
__device__ __forceinline__ f32x4 swiglu4s(const f32x4 a, const f32x4 b, float cexp, float cout) {
    const float lc = -__builtin_log2f(cout), ic = 1.0f / cout;
    f32x4 e;
#pragma unroll
    for (int j = 0; j < 4; ++j) e[j] = __builtin_amdgcn_exp2f(__builtin_fmaf(a[j], cexp, lc));
    const f32x4 d = e + ic; f32x4 r;
#pragma unroll
    for (int j = 0; j < 4; ++j) r[j] = __builtin_amdgcn_rcpf(d[j]);
    return (a * b) * r; }
__device__ __forceinline__ f32x4 swiglu4(const f32x4 a, const f32x4 b) { return swiglu4s(a, b, -1.4426950408889634f, 1.0f); }
struct EpiSwiglu {
    bf16* ACT; int ld;
    __device__ __forceinline__ void operator()(AccRef acc, const gm::Unit& u, int wr, int wc, int fr, int fq) const {
        const int row0 = u.x0 * 256 + wr * 64 + fr, col = u.x1 * 128 + wc * 32 + fq * 8;
#pragma unroll
        for (int ai = 0; ai < 2; ++ai)
#pragma unroll
            for (int m = 0; m < 4; ++m)
                *(u32x4*)(ACT + (size_t)(row0 + ai * 128 + m * 16) * ld + col) = pack8(swiglu4(acc[ai][0][m][0], acc[ai][1][m][0]), swiglu4(acc[ai][0][m][1], acc[ai][1][m][1]));
    }
};

struct SchedDftC {
    const char *WC, *HF; int G, c, total;
    __device__ __forceinline__ bool next(int i, gm::Unit& u) const {
        int idx; if (!gm::flat_index(i, G, c, total, idx)) return false;
        u.lda = 512; u.ldb = 2048; u.nt = 4; u.x3 = 0;
        if (idx < 1024) { const int bg = idx >> 3, kt = idx & 7, b = bg >> 2, g = bg & 3, ty = kt < 4 ? 0 : 1;
            u.A = WC + (size_t)ty * 256 * 512; u.B = HF + ((size_t)(b * SEQ + kt * 256) * D + g * 256) * 2; u.x0 = bg; u.x1 = kt; u.x2 = 0; return true; }
        const int j = idx - 1024, bg = j >> 1, ty = j & 1, b = bg >> 2, g = bg & 3;
        u.A = WC + (size_t)ty * 256 * 512; u.B = HF + ((size_t)(MLAT + b * LC) * D + g * 256) * 2; u.x0 = bg; u.x1 = 0; u.x2 = 1 + ty; return true;
    }
};
__device__ __forceinline__ unsigned pk4_fp8(float a, float b, float c, float d);
__device__ __forceinline__ u32x2 pack8_fp8(const f32x4 a, const f32x4 b) { u32x2 w; w.x = pk4_fp8(a[0], a[1], a[2], a[3]); w.y = pk4_fp8(b[0], b[1], b[2], b[3]); return w; }
struct EpiDftC {
    bf16 *Z, *ZC;
    __device__ __forceinline__ void operator()(AccRef acc, const gm::Unit& u, int wr, int wc, int fr, int fq) const {
        const int bg = u.x0, cl = wc * 32 + fq * 8;
        if (MK_FP8_DFT) {
            unsigned char* z8 = (unsigned char*)Z; unsigned char* zc8 = (unsigned char*)ZC;
#pragma unroll
            for (int ai = 0; ai < 2; ++ai)
#pragma unroll
                for (int m = 0; m < 4; ++m) { const int f = wr * 64 + fr + ai * 128 + m * 16;
                    if (u.x2 == 0) {
#pragma unroll
                        for (int bj = 0; bj < 2; ++bj) *(u32x2*)(z8 + ((size_t)bg * 256 + f) * 2048 + u.x1 * 256 + bj * 128 + cl) = pack8_fp8(acc[ai][bj][m][0], acc[ai][bj][m][1]); }
                    else if (u.x2 == 1) *(u32x2*)(zc8 + ((size_t)bg * 256 + f) * 256 + cl) = pack8_fp8(acc[ai][0][m][0], acc[ai][0][m][1]);
                    else *(u32x2*)(zc8 + ((size_t)bg * 256 + f) * 256 + 128 + cl) = pack8_fp8(acc[ai][1][m][0], acc[ai][1][m][1]); }
        } else
        if (u.x2 == 0) {
#pragma unroll
            for (int ai = 0; ai < 2; ++ai)
#pragma unroll
                for (int m = 0; m < 4; ++m) { const int f = wr * 64 + fr + ai * 128 + m * 16;
#pragma unroll
                    for (int bj = 0; bj < 2; ++bj) *(u32x4*)(Z + ((size_t)bg * 256 + f) * 2048 + u.x1 * 256 + bj * 128 + cl) = pack8(acc[ai][bj][m][0], acc[ai][bj][m][1]); }
        } else {
            if (u.x2 == 1) {
#pragma unroll
                for (int ai = 0; ai < 2; ++ai)
#pragma unroll
                    for (int m = 0; m < 4; ++m) { const int f = wr * 64 + fr + ai * 128 + m * 16;
                        *(u32x4*)(ZC + ((size_t)bg * 256 + f) * 256 + cl) = pack8(acc[ai][0][m][0], acc[ai][0][m][1]); }
            } else {
#pragma unroll
                for (int ai = 0; ai < 2; ++ai)
#pragma unroll
                    for (int m = 0; m < 4; ++m) { const int f = wr * 64 + fr + ai * 128 + m * 16;
                        *(u32x4*)(ZC + ((size_t)bg * 256 + f) * 256 + 128 + cl) = pack8(acc[ai][1][m][0], acc[ai][1][m][1]); }
            }
        }
    }
};

struct SchedDftS {
    const char *WL, *WX, *Z, *ZC; int G, c, total;
    __device__ __forceinline__ bool next(int i, gm::Unit& u) const {
        int idx; if (!gm::flat_index(i, G, c, total, idx)) return false;
        u.x3 = 0;
        if (idx < 1024) { const int bg = idx >> 3, kt = idx & 7;
            constexpr unsigned P = MK_FP8_DFT ? 2048u : 4096u;
            u.A = WL + (size_t)kt * 256 * P; u.lda = P; u.B = Z + (size_t)bg * 256 * P; u.ldb = P; u.nt = 32 / (MK_FP8_DFT ? 2 : 1); u.x0 = bg; u.x1 = kt; u.x2 = 0; return true; }
        const int bg = idx - 1024; constexpr unsigned PX = MK_FP8_DFT ? 256u : 512u;
        u.A = WX; u.lda = PX; u.B = ZC + (size_t)bg * 256 * PX; u.ldb = PX; u.nt = 4 / (MK_FP8_DFT ? 2 : 1); u.x0 = bg; u.x1 = 0; u.x2 = 1; return true;
    }
};
struct EpiDftS {
    bf16* F; const float* AMID;
    __device__ __forceinline__ void operator()(AccRef acc, const gm::Unit& u, int wr, int wc, int fr, int fq) const {
        const int bg = u.x0, b = bg >> 2, g = bg & 3, cl = wc * 32 + fq * 8; const bool cx = u.x2 != 0;
        constexpr float TS = MK_FP8_DFT ? (1.0f / 16.0f) : 1.0f;
        const float scale = cx ? (1.0f / 256.0f) : 0.0013810679320049757f;
        const size_t rbase = cx ? (size_t)(MLAT + b * LC) : (size_t)b * SEQ + u.x1 * 256;
        const float* am = AMID + (size_t)(cx ? 32 + b : b) * D + g * 256;
        f32x4 a4[2][2];
#pragma unroll
        for (int bj = 0; bj < 2; ++bj) { a4[bj][0] = *(const f32x4*)(am + bj * 128 + cl); a4[bj][1] = *(const f32x4*)(am + bj * 128 + cl + 4); }
#pragma unroll
        for (int ai = 0; ai < 2; ++ai)
#pragma unroll
            for (int m = 0; m < 4; ++m) { const int k = wr * 64 + fr + ai * 128 + m * 16; const float sg = (k & 1) ? -1.0f : 1.0f;
#pragma unroll
                for (int bj = 0; bj < 2; ++bj)
                    *(u32x4*)(F + (rbase + k) * D + g * 256 + bj * 128 + cl) = pack8((acc[ai][bj][m][0] * TS + a4[bj][0] * sg) * scale, (acc[ai][bj][m][1] * TS + a4[bj][1] * sg) * scale); }
    }
};

constexpr float W8_SCALE = 32.0f, A8_SCALE = 4.0f;
__device__ __forceinline__ unsigned pk4_fp8(float a, float b, float c, float d) {
    a = __builtin_amdgcn_fmed3f(a, -448.f, 448.f); b = __builtin_amdgcn_fmed3f(b, -448.f, 448.f); c = __builtin_amdgcn_fmed3f(c, -448.f, 448.f); d = __builtin_amdgcn_fmed3f(d, -448.f, 448.f);
    int w = 0; w = __builtin_amdgcn_cvt_pk_fp8_f32(a, b, w, false); w = __builtin_amdgcn_cvt_pk_fp8_f32(c, d, w, true); return (unsigned)w; }
struct MoeInfo { int cnt[8]; int tb[9]; };
__device__ __forceinline__ void moe_info(const unsigned* cntw, MoeInfo& mi) {
    mi.tb[0] = 0;
#pragma unroll
    for (int e = 0; e < 8; ++e) { mi.cnt[e] = (int)__builtin_amdgcn_readfirstlane(__hip_atomic_load(cntw + 64 * e, __ATOMIC_RELAXED, __HIP_MEMORY_SCOPE_AGENT)); mi.tb[e + 1] = mi.tb[e] + ((mi.cnt[e] + 255) >> 8); }
}
__device__ __forceinline__ void moe_find(const MoeInfo& mi, int gt, int& e, int& rt, int& cnt) {
    e = 0; rt = gt; cnt = mi.cnt[0];
#pragma unroll
    for (int k = 1; k < 8; ++k) if (gt >= mi.tb[k]) { e = k; rt = gt - mi.tb[k]; cnt = mi.cnt[k]; }
}
struct SchedMoeUp {
    const char *H2, *W13; const int* list; MoeInfo mi; int G, c;
    __device__ __forceinline__ bool next(int i, gm::Unit& u) const {
        int idx; if (!gm::flat_index(i, G, c, mi.tb[8] * 28, idx)) return false;
        int gt, pn; gm::tile_order(idx, mi.tb[8], 28, gt, pn);
        int e, rt, cnt; moe_find(mi, gt, e, rt, cnt);
        u.A = H2; u.lda = 2048; u.B = W13 + ((size_t)e * 7168 + (size_t)pn * 256) * 2048; u.ldb = 2048; u.nt = 16; u.x0 = gt; u.x1 = pn; u.x2 = e * 65536 * 2 + cnt; u.x3 = rt * 256; return true;
    }
    __device__ __forceinline__ int gather_row(const gm::Unit& u, int lr) const {
        const int e = u.x2 >> 17, cnt = u.x2 & 0x1ffff; int j = u.x3 + lr; j = j < cnt ? j : cnt - 1;
        return list[(size_t)e * MALL + j];
    }
};
struct SchedMoeUp8 {
    const char *H2, *W13; const int* list; MoeInfo mi; int G, c;
    __device__ __forceinline__ bool next(int i, gm::Unit& u) const {
        int idx; if (!gm::flat_index(i, G, c, mi.tb[8] * 28, idx)) return false;
        int gt, pn; gm::tile_order(idx, mi.tb[8], 28, gt, pn);
        int e, rt, cnt; moe_find(mi, gt, e, rt, cnt);
        u.A = H2; u.lda = 1024; u.B = W13 + ((size_t)e * 7168 + (size_t)pn * 256) * 1024; u.ldb = 1024; u.nt = 8; u.x0 = gt; u.x1 = pn; u.x2 = e * 65536 * 2 + cnt; u.x3 = rt * 256; return true;
    }
    __device__ __forceinline__ int gather_row(const gm::Unit& u, int lr) const {
        const int e = u.x2 >> 17, cnt = u.x2 & 0x1ffff; int j = u.x3 + lr; j = j < cnt ? j : cnt - 1;
        return list[(size_t)e * MALL + j];
    }
};
struct EpiSwiglu8 {
    unsigned char* ACT8; int ld;
    __device__ __forceinline__ void operator()(AccRef acc, const gm::Unit& u, int wr, int wc, int fr, int fq) const {
        const int row0 = u.x0 * 256 + wr * 64 + fr, col = u.x1 * 128 + wc * 32 + fq * 8;
#pragma unroll 1
        for (int rep_ = 0; rep_ < 1 + (int)((MK_DUP >> 24) & 1u); ++rep_)
#pragma unroll
        for (int ai = 0; ai < 2; ++ai)
#pragma unroll
            for (int m = 0; m < 4; ++m) {
                constexpr float CE = -1.4426950408889634f / W8_SCALE, CO = A8_SCALE / (W8_SCALE * W8_SCALE);
                const f32x4 v0 = swiglu4s(acc[ai][0][m][0], acc[ai][1][m][0], CE, CO), v1 = swiglu4s(acc[ai][0][m][1], acc[ai][1][m][1], CE, CO);
                u32x2 w; w.x = pk4_fp8(v0[0], v0[1], v0[2], v0[3]); w.y = pk4_fp8(v1[0], v1[1], v1[2], v1[3]);
                *(u32x2*)(ACT8 + (size_t)(row0 + ai * 128 + m * 16) * ld + col) = w; }
    }
};
struct SchedMoeDown8 {
    const char *Ab, *W2; MoeInfo mi; int G, c;
    __device__ __forceinline__ bool next(int i, gm::Unit& u) const {
        int idx; if (!gm::flat_index(i, G, c, mi.tb[8] * 4, idx)) return false;
        int gt, pn; gm::tile_order(idx, mi.tb[8], 4, gt, pn);
        int e, rt, cnt; moe_find(mi, gt, e, rt, cnt);
        u.A = Ab + (size_t)gt * 256 * 3584; u.lda = 3584; u.B = W2 + ((size_t)e * 1024 + (size_t)pn * 256) * 3584; u.ldb = 3584; u.nt = 28; u.x0 = gt; u.x1 = pn; u.x2 = e * 65536 * 2 + cnt; u.x3 = rt * 256; return true;
    }
};
struct SchedMoeUpDense {
    const char *H2, *W13; MoeInfo mi; int G, c;
    __device__ __forceinline__ bool next(int i, gm::Unit& u) const {
        int idx; if (!gm::flat_index(i, G, c, mi.tb[8] * 28, idx)) return false;
        int gt, pn; gm::tile_order(idx, mi.tb[8], 28, gt, pn);
        int e, rt, cnt; moe_find(mi, gt, e, rt, cnt);
        u.A = H2 + (size_t)(gt & 255) * 256 * 2048; u.lda = 2048; u.B = W13 + ((size_t)e * 7168 + (size_t)pn * 256) * 2048; u.ldb = 2048; u.nt = 16; u.x0 = gt; u.x1 = pn; u.x2 = 0; u.x3 = 0; return true;
    }
};
struct SchedMoeDown {
    const char *Ab, *W2; MoeInfo mi; int G, c;
    __device__ __forceinline__ bool next(int i, gm::Unit& u) const {
        int idx; if (!gm::flat_index(i, G, c, mi.tb[8] * 4, idx)) return false;
        int gt, pn; gm::tile_order(idx, mi.tb[8], 4, gt, pn);
        int e, rt, cnt; moe_find(mi, gt, e, rt, cnt);
        u.A = Ab + (size_t)gt * 256 * 7168; u.lda = 7168; u.B = W2 + ((size_t)e * 1024 + (size_t)pn * 256) * 7168; u.ldb = 7168; u.nt = 56; u.x0 = gt; u.x1 = pn; u.x2 = e * 65536 * 2 + cnt; u.x3 = rt * 256; return true;
    }
};
struct EpiMoeDown {
    bf16* x16; const bf16* gate16; const int* list; const float* glist; float ascale; bf16* dst16;
    __device__ __forceinline__ void operator()(AccRef acc, const gm::Unit& u, int wr, int wc, int fr, int fq) const {
        const int e = u.x2 >> 17, cnt = u.x2 & 0x1ffff, col0 = u.x1 * 256 + wc * 32 + fq * 8;
        int tok[2][4]; float gv[2][4];
#pragma unroll
        for (int ai = 0; ai < 2; ++ai)
#pragma unroll
            for (int m = 0; m < 4; ++m) { int j = u.x3 + wr * 64 + fr + ai * 128 + m * 16; const bool ok = j < cnt; j = ok ? j : cnt - 1;
                const int t = list[(size_t)e * MALL + j]; tok[ai][m] = ok ? t : -1 - t; gv[ai][m] = glist[(size_t)e * MALL + j] * ascale; }
#pragma unroll
        for (int bj = 0; bj < 2; ++bj)
#pragma unroll
        for (int ai = 0; ai < 2; ++ai) {
            u32x4 xr[4], gr[4];
#pragma unroll
            for (int m = 0; m < 4; ++m) { const int t = tok[ai][m] < 0 ? -1 - tok[ai][m] : tok[ai][m]; const int b = t < MLAT ? (t >> 11) : 32;
                xr[m] = *(const u32x4*)(x16 + (size_t)t * D + col0 + bj * 128); gr[m] = *(const u32x4*)(gate16 + (size_t)b * 1024 + col0 + bj * 128); }
            asm volatile("" ::: "memory");
#pragma unroll
            for (int m = 0; m < 4; ++m) { const int t = tok[ai][m];
                if (t >= 0) { const u32x4 w = xr[m], q = gr[m]; const float s = gv[ai][m];
                    const f32x4 x0 = (f32x4){__uint_as_float(w.x << 16), __uint_as_float(w.x & 0xffff0000u), __uint_as_float(w.y << 16), __uint_as_float(w.y & 0xffff0000u)};
                    const f32x4 x1 = (f32x4){__uint_as_float(w.z << 16), __uint_as_float(w.z & 0xffff0000u), __uint_as_float(w.w << 16), __uint_as_float(w.w & 0xffff0000u)};
                    const f32x4 g0 = (f32x4){__uint_as_float(q.x << 16), __uint_as_float(q.x & 0xffff0000u), __uint_as_float(q.y << 16), __uint_as_float(q.y & 0xffff0000u)} * s;
                    const f32x4 g1 = (f32x4){__uint_as_float(q.z << 16), __uint_as_float(q.z & 0xffff0000u), __uint_as_float(q.w << 16), __uint_as_float(q.w & 0xffff0000u)} * s;
                    *(u32x4*)(dst16 + (size_t)t * D + col0 + bj * 128) = pack8(x0 + g0 * acc[ai][bj][m][0], x1 + g1 * acc[ai][bj][m][1]); } }
        }
    }
};

struct ModP { f32x4 gm[4]; f32x4 sh[4]; };
__device__ __forceinline__ void load_modp(ModP& p, const float* g, const float* modrow, int off_sh, int off_sc, int lane) {
#pragma unroll
    for (int j = 0; j < 4; ++j) { const int c = 4 * lane + 256 * j;
        const f32x4 g4 = *(const f32x4*)(g + c), sc = *(const f32x4*)(modrow + off_sc + c);
        p.gm[j] = g4 * (sc + 1.0f); p.sh[j] = *(const f32x4*)(modrow + off_sh + c); }
}
struct XSrc { const float* lat; const float* ctx; const bf16* x16; };
__device__ __forceinline__ void load_xrow(const XSrc& xs, int row, int lane, f32x4 (&v)[4]) {
    if (xs.x16) { const u32x2* p = (const u32x2*)(xs.x16 + (size_t)row * D);
#pragma unroll
        for (int j = 0; j < 4; ++j) { const u32x2 w = p[lane + 64 * j]; v[j] = (f32x4){__uint_as_float(w.x << 16), __uint_as_float(w.x & 0xffff0000u), __uint_as_float(w.y << 16), __uint_as_float(w.y & 0xffff0000u)}; } }
    else { const f32x4* p = (const f32x4*)(row < MLAT ? xs.lat + (size_t)row * D : xs.ctx + (size_t)(row - MLAT) * D);
#pragma unroll
        for (int j = 0; j < 4; ++j) v[j] = p[lane + 64 * j]; }
}
struct XRaw { u32x2 w[4]; f32x4 f[4]; };
__device__ __forceinline__ void load_xraw(const XSrc& xs, int row, int lane, XRaw& r) {
    if (xs.x16) { const u32x2* p = (const u32x2*)(xs.x16 + (size_t)row * D);
#pragma unroll
        for (int j = 0; j < 4; ++j) r.w[j] = p[lane + 64 * j]; }
    else { const f32x4* p = (const f32x4*)(row < MLAT ? xs.lat + (size_t)row * D : xs.ctx + (size_t)(row - MLAT) * D);
#pragma unroll
        for (int j = 0; j < 4; ++j) r.f[j] = p[lane + 64 * j]; }
}
__device__ __forceinline__ void mod_row_raw(const XSrc& xs, const XRaw& r, const ModP& p, f32x4 (&h)[4]) {
    f32x4 v[4]; float ss = 0.f;
    if (xs.x16) {
#pragma unroll
        for (int j = 0; j < 4; ++j) { const u32x2 w = r.w[j]; v[j] = (f32x4){__uint_as_float(w.x << 16), __uint_as_float(w.x & 0xffff0000u), __uint_as_float(w.y << 16), __uint_as_float(w.y & 0xffff0000u)}; } }
    else {
#pragma unroll
        for (int j = 0; j < 4; ++j) v[j] = r.f[j]; }
#pragma unroll
    for (int j = 0; j < 4; ++j) ss += (v[j][0] * v[j][0] + v[j][1] * v[j][1]) + (v[j][2] * v[j][2] + v[j][3] * v[j][3]);
    ss = wave_sum(ss);
    const float rr = 1.0f / sqrtf(ss * (1.0f / D) + EPS);
#pragma unroll
    for (int j = 0; j < 4; ++j) h[j] = (v[j] * rr) * p.gm[j] + p.sh[j];
}
__device__ __forceinline__ void mod_row(const XSrc& xs, int row, const ModP& p, int lane, f32x4 (&h)[4]) {
    f32x4 v[4]; float ss = 0.f; load_xrow(xs, row, lane, v);
#pragma unroll
    for (int j = 0; j < 4; ++j) { ss += (v[j][0] * v[j][0] + v[j][1] * v[j][1]) + (v[j][2] * v[j][2] + v[j][3] * v[j][3]); }
    ss = wave_sum(ss);
    const float r = 1.0f / sqrtf(ss * (1.0f / D) + EPS);
#pragma unroll
    for (int j = 0; j < 4; ++j) h[j] = (v[j] * r) * p.gm[j] + p.sh[j];
}
__device__ __forceinline__ void store_row_bf16(bf16* dst, const f32x4 (&h)[4], int lane) {
#pragma unroll
    for (int j = 0; j < 4; ++j) { u32x2 w; w.x = pkbf(h[j][0], h[j][1]); w.y = pkbf(h[j][2], h[j][3]); ((u32x2*)dst)[lane + 64 * j] = w; }
}

__device__ __forceinline__ void phase_mod_plain(const XSrc& xs, const float* g, const float* modbase, int off_sh, int off_sc, bf16* H, bool out8, int nrows, int gw, int NGW, int lane) {
    const int rpw = (nrows + NGW - 1) / NGW; const int r0 = gw * rpw; int r1 = r0 + rpw; if (r1 > nrows) r1 = nrows;
    int curb = -1; ModP p; XRaw cur, nxt; nxt = XRaw{};
    if (r0 < r1) load_xraw(xs, r0, lane, cur);
    for (int row = r0; row < r1; ++row) {
        if (row + 1 < r1) load_xraw(xs, row + 1, lane, nxt);
        const int b = row < MLAT ? (row >> 11) : 32;
        if (b != curb) { load_modp(p, g, modbase + (size_t)b * 6144, off_sh, off_sc, lane); curb = b; }
        f32x4 h[4]; mod_row_raw(xs, cur, p, h); cur = nxt;
        if (out8) { unsigned char* o8 = (unsigned char*)H + (size_t)row * D;
#pragma unroll
            for (int j = 0; j < 4; ++j) ((unsigned*)o8)[lane + 64 * j] = pk4_fp8(h[j][0], h[j][1], h[j][2], h[j][3]); }
        else store_row_bf16(H + (size_t)row * D, h, lane);
    }
}

__device__ __forceinline__ void phase_mod_fold(const XSrc& xs, const float* g, const float* modbase, bf16* HF, float* HMID, bool with_ctx, int gw, int NGW, int lane) {
    constexpr int IL = SEQ / 2 + 1, IC = LC / 2 + 1;
    const int nitems = NB * IL + (with_ctx ? NB * IC : 0);
    const int ipw = (nitems + NGW - 1) / NGW; const int i0 = gw * ipw; int i1 = i0 + ipw; if (i1 > nitems) i1 = nitems;
    int curb = -1; ModP p;
    for (int it = i0; it < i1; ++it) {
        const bool cx = it >= NB * IL; const int j = cx ? it - NB * IL : it;
        const int b = cx ? j / IC : j / IL, n = cx ? j % IC : j % IL, Ls = cx ? LC : SEQ;
        const int mb = cx ? 32 : b, key = cx ? 64 : b;
        if (key != curb) { load_modp(p, g, modbase + (size_t)mb * 6144, 0, 1024, lane); curb = key; }
        const int rbase = cx ? MLAT + b * LC : b * SEQ;
        bf16* hf = HF + (size_t)rbase * D;
        f32x4 h1[4]; mod_row(xs, rbase + n, p, lane, h1);
        if (n == 0) { store_row_bf16(hf, h1, lane); f32x4 z[4];
#pragma unroll
            for (int q = 0; q < 4; ++q) z[q] = (f32x4){0.f, 0.f, 0.f, 0.f};
            store_row_bf16(hf + (size_t)(Ls / 2) * D, z, lane); }
        else if (n == Ls / 2) { float* hm = HMID + (size_t)(cx ? 32 + b : b) * D;
#pragma unroll
            for (int q = 0; q < 4; ++q) ((f32x4*)hm)[lane + 64 * q] = h1[q]; }
        else { f32x4 h2[4]; mod_row(xs, rbase + Ls - n, p, lane, h2); f32x4 s[4], d[4];
#pragma unroll
            for (int q = 0; q < 4; ++q) { s[q] = h1[q] + h2[q]; d[q] = h1[q] - h2[q]; }
            store_row_bf16(hf + (size_t)n * D, s, lane); store_row_bf16(hf + (size_t)(Ls / 2 + n) * D, d, lane); }
    }
}

template <bool ROUTER>
__device__ __forceinline__ void phase_mod2(const XSrc& xs, const float* g, const float* modbase, bf16* H2, bool out8, int nrows,
                                           const float* router_w, unsigned* gcnt, int* list, float* glist, LAS unsigned char* lds, int vcu, int G, int wave, int lane, int tid) {
    const int rpb = nrows / G, rpw = rpb / 8;
    const int r0 = vcu * rpb + wave * rpw;
    LAS float* rwT = (LAS float*)lds; LAS int* bcnt = (LAS int*)(lds + 32768); LAS int* bbase = (LAS int*)(lds + 32768 + 64);
    if constexpr (ROUTER) {
        for (int i = tid; i < 8192; i += 512) { const int c = i >> 3, e = i & 7; rwT[e * 1024 + c] = router_w[i]; }
        if (tid < 16) bcnt[tid] = 0;
        __syncthreads();
    }
    int curb = -1; ModP p; int me0 = -1, me1 = -1; float mp0 = 0.f, mp1 = 0.f; XRaw cur, nxt; nxt = XRaw{};
    load_xraw(xs, r0, lane, cur);
    for (int rr = 0; rr < rpw; ++rr) {
        const int row = r0 + rr; const int b = row < MLAT ? (row >> 11) : 32;
        if (rr + 1 < rpw) load_xraw(xs, row + 1, lane, nxt);
        if (b != curb) { load_modp(p, g, modbase + (size_t)b * 6144, 3072, 4096, lane); curb = b; }
        f32x4 h[4]; mod_row_raw(xs, cur, p, h); cur = nxt;
        if (out8) { unsigned char* o8 = (unsigned char*)H2 + (size_t)row * D;
#pragma unroll
            for (int j = 0; j < 4; ++j) ((unsigned*)o8)[lane + 64 * j] = pk4_fp8(h[j][0], h[j][1], h[j][2], h[j][3]); }
        else store_row_bf16(H2 + (size_t)row * D, h, lane);
        if constexpr (ROUTER) {
            asm volatile("" ::: "memory");
            float lg[8];
#pragma unroll
            for (int e = 0; e < 8; ++e) { float s = 0.f;
#pragma unroll
                for (int j = 0; j < 4; ++j) { const f32x4 w = *(const LAS f32x4*)(rwT + e * 1024 + 4 * lane + 256 * j); s += (h[j][0] * w[0] + h[j][1] * w[1]) + (h[j][2] * w[2] + h[j][3] * w[3]); }
                lg[e] = s; }
            {
                const bool b5 = (lane & 32) != 0, b4 = (lane & 16) != 0, b3 = (lane & 8) != 0;
                float v4[4], v2[2];
#pragma unroll
                for (int j = 0; j < 4; ++j) { const float snd = b5 ? lg[j] : lg[4 + j], kp = b5 ? lg[4 + j] : lg[j]; v4[j] = kp + __shfl_xor(snd, 32); }
#pragma unroll
                for (int j = 0; j < 2; ++j) { const float snd = b4 ? v4[j] : v4[2 + j], kp = b4 ? v4[2 + j] : v4[j]; v2[j] = kp + __shfl_xor(snd, 16); }
                float v1; { const float snd = b3 ? v2[0] : v2[1], kp = b3 ? v2[1] : v2[0]; v1 = kp + __shfl_xor(snd, 8); }
                v1 += __shfl_xor(v1, 4); v1 += __shfl_xor(v1, 2); v1 += __shfl_xor(v1, 1);
#pragma unroll
                for (int e = 0; e < 8; ++e) lg[e] = __uint_as_float((unsigned)__builtin_amdgcn_readlane((int)__float_as_uint(v1), e * 8));
            }
            int e0 = 0; float v0 = lg[0];
#pragma unroll
            for (int e = 1; e < 8; ++e) if (lg[e] > v0) { v0 = lg[e]; e0 = e; }
            int e1 = -1; float v1 = -3.0e38f;
#pragma unroll
            for (int e = 0; e < 8; ++e) if (e != e0 && lg[e] > v1) { v1 = lg[e]; e1 = e; }
            const float p0 = 1.0f / (1.0f + __expf(v1 - v0));
            if (lane == rr) { me0 = e0; me1 = e1; mp0 = p0; mp1 = 1.0f - p0; }
        }
    }
    if constexpr (ROUTER) {
        int rank0 = 0, rank1 = 0, mycnt = 0;
        const unsigned long long lt = (lane == 0) ? 0ull : (~0ull >> (64 - lane));
#pragma unroll
        for (int e = 0; e < 8; ++e) {
            const unsigned long long m0 = __ballot(me0 == e), m1 = __ballot(me1 == e);
            if (me0 == e) rank0 = __popcll(m0 & lt);
            if (me1 == e) rank1 = __popcll(m1 & lt);
            if (lane == e) mycnt = __popcll(m0);
            if (lane == 8 + e) mycnt = __popcll(m1);
        }
        int woff = 0;
        if (lane < 16) woff = __hip_atomic_fetch_add(bcnt + lane, mycnt, __ATOMIC_RELAXED, __HIP_MEMORY_SCOPE_WORKGROUP);
        __syncthreads();
        if (tid < 16) bbase[tid] = (int)__hip_atomic_fetch_add(gcnt + 64 * tid, (unsigned)bcnt[tid], __ATOMIC_RELAXED, __HIP_MEMORY_SCOPE_AGENT);
        __syncthreads();
        const int w0 = __shfl(woff, me0 < 0 ? 0 : me0), w1 = __shfl(woff, me1 < 0 ? 8 : 8 + me1);
        if (me0 >= 0) { const int row = r0 + lane;
            const int p0 = bbase[me0] + w0 + rank0, p1 = bbase[8 + me1] + w1 + rank1;
            list[(size_t)me0 * MALL + p0] = row; glist[(size_t)me0 * MALL + p0] = mp0;
            list[(size_t)(8 + me1) * MALL + p1] = row; glist[(size_t)(8 + me1) * MALL + p1] = mp1; }
        __syncthreads();
    }
}

__device__ __forceinline__ void phase_final(const bf16* x16, float* out, const float* g, int gw, int NGW, int lane) {
    const int rpw = (MLAT + NGW - 1) / NGW; const int r0 = gw * rpw; int r1 = r0 + rpw; if (r1 > MLAT) r1 = MLAT;
    f32x4 g4[4];
#pragma unroll
    for (int j = 0; j < 4; ++j) g4[j] = *(const f32x4*)(g + 4 * lane + 256 * j);
    XSrc xs{nullptr, nullptr, x16};
    for (int row = r0; row < r1; ++row) { f32x4 v[4]; float ss = 0.f; load_xrow(xs, row, lane, v);
#pragma unroll
        for (int j = 0; j < 4; ++j) ss += (v[j][0] * v[j][0] + v[j][1] * v[j][1]) + (v[j][2] * v[j][2] + v[j][3] * v[j][3]);
        ss = wave_sum(ss); const float r = 1.0f / sqrtf(ss * (1.0f / D) + EPS);
#pragma unroll
        for (int j = 0; j < 4; ++j) ((f32x4*)(out + (size_t)row * D))[lane + 64 * j] = (v[j] * r) * g4[j]; }
}

__device__ __forceinline__ void phase_pool(const bf16* POOL, bf16* MIXCAT, int nrows, int gw, int NGW, int lane) {
    const int rs = lane >> 4, cb = lane & 15;
    for (int it = gw; it < (nrows / 64) * 4; it += NGW) { const int seg = it >> 2, g = it & 3, w = 2 << g, hw = w >> 1;
        const int row0 = seg * 64 + rs * 16;
        const int Ls = row0 < MLAT ? SEQ : LC, sb = row0 < MLAT ? (row0 & ~(SEQ - 1)) : (MLAT + ((row0 - MLAT) & ~(LC - 1))), t0 = row0 - sb;
        const bf16* src = POOL + (size_t)sb * 512 + g * 128 + cb * 8; bf16* dstp = MIXCAT + (size_t)sb * D + 512 + g * 128 + cb * 8;
        float s[8];
#pragma unroll
        for (int k = 0; k < 8; ++k) s[k] = 0.f;
        for (int j = 0; j < w; ++j) { const int tt = t0 - hw + j;
            if (tt >= 0 && tt < Ls) { const u32x4 v = *(const u32x4*)(src + (size_t)tt * 512);
#pragma unroll
                for (int k = 0; k < 4; ++k) { s[2 * k] += __uint_as_float(v[k] << 16); s[2 * k + 1] += __uint_as_float(v[k] & 0xffff0000u); } } }
#pragma unroll 4
        for (int q = 0; q < 16; ++q) { const int t = t0 + q;
            int lo = t - hw; if (lo < 0) lo = 0; int hi = t + hw; if (hi > Ls) hi = Ls;
            const u32x4 self = *(const u32x4*)(src + (size_t)t * 512);
            const int tin = t + hw, tout = t - hw;
            u32x4 vin = (u32x4){0u, 0u, 0u, 0u}, vout = (u32x4){0u, 0u, 0u, 0u};
            if (q < 15) { if (tin < Ls) vin = *(const u32x4*)(src + (size_t)tin * 512); if (tout >= 0) vout = *(const u32x4*)(src + (size_t)tout * 512); }
            const float inv = 1.0f / (float)(hi - lo); u32x4 o;
#pragma unroll
            for (int k = 0; k < 4; ++k) o[k] = pkbf(s[2 * k] * inv - __uint_as_float(self[k] << 16), s[2 * k + 1] * inv - __uint_as_float(self[k] & 0xffff0000u));
            *(u32x4*)(dstp + (size_t)t * D) = o;
#pragma unroll
            for (int k = 0; k < 4; ++k) { s[2 * k] += __uint_as_float(vin[k] << 16) - __uint_as_float(vout[k] << 16); s[2 * k + 1] += __uint_as_float(vin[k] & 0xffff0000u) - __uint_as_float(vout[k] & 0xffff0000u); } }
    }
}

__device__ __forceinline__ void phase_amid(const float* HMID_, float* AMID_, LAS unsigned char* lds, int G, int bid, int tid) {
    LAS float* ct = (LAS float*)lds;
    if (tid < 256) ct[tid] = cospif((float)tid * (1.0f / 128.0f));
    __syncthreads();
    for (int o = bid * 512 + tid; o < 64 * 1024; o += G * 512) { const int r = o >> 10, gq = (o >> 8) & 3, m = o & 255;
        const float* hp = HMID_ + (size_t)r * D + gq * 256; float s = 0.f;
#pragma unroll 4
        for (int c = 0; c < 256; ++c) s += hp[c] * ct[(m * c) & 255];
        AMID_[o] = s; }
    __syncthreads();
}

constexpr int AT_KP = 208, AT_VP = 136, AT_VOFF = 64 * AT_KP, AT_BUF = 22528;
__device__ __forceinline__ f32x16 mfma32(bf16x8 a, bf16x8 b, f32x16 c) { return __builtin_amdgcn_mfma_f32_32x32x16_bf16(a, b, c, 0, 0, 0); }
__device__ __forceinline__ bf16x8 pack_s(const f32x16& x, int s) {
    u32x4 p; p.x = pkbf(x[8 * s], x[8 * s + 1]); p.y = pkbf(x[8 * s + 2], x[8 * s + 3]); p.z = pkbf(x[8 * s + 4], x[8 * s + 5]); p.w = pkbf(x[8 * s + 6], x[8 * s + 7]);
    return __builtin_bit_cast(bf16x8, p);
}
#define AT_MX3(a, b, c) __builtin_fmaxf(__builtin_fmaxf((a), (b)), (c))
#define AT_SOFTMAX(S0, S1, M, L, O0, O1, FIRST) do { \
        float ma_ = AT_MX3(S0[0], S0[1], S0[2]), mb_ = AT_MX3(S0[3], S0[4], S0[5]), mc_ = AT_MX3(S1[0], S1[1], S1[2]), md_ = AT_MX3(S1[3], S1[4], S1[5]); \
        ma_ = AT_MX3(ma_, S0[6], S0[7]); mb_ = AT_MX3(mb_, S0[8], S0[9]); mc_ = AT_MX3(mc_, S1[6], S1[7]); md_ = AT_MX3(md_, S1[8], S1[9]); \
        ma_ = AT_MX3(ma_, S0[10], S0[11]); mb_ = AT_MX3(mb_, S0[12], S0[13]); mc_ = AT_MX3(mc_, S1[10], S1[11]); md_ = AT_MX3(md_, S1[12], S1[13]); \
        ma_ = AT_MX3(ma_, S0[14], S0[15]); mc_ = AT_MX3(mc_, S1[14], S1[15]); \
        float mx = __builtin_fmaxf(__builtin_fmaxf(ma_, mb_), __builtin_fmaxf(mc_, md_)); \
        mx = __builtin_fmaxf(mx, __shfl_xor(mx, 32)); \
        if (FIRST) { M += mx; _Pragma("unroll") for (int i_ = 0; i_ < 16; ++i_) { S0[i_] -= mx; S1[i_] -= mx; } } \
        else if (__any(mx > 8.0f)) { const float dl_ = __builtin_fmaxf(mx, 0.f), alpha_ = __builtin_amdgcn_exp2f(-dl_); M += dl_; L *= alpha_; \
            _Pragma("unroll") for (int i_ = 0; i_ < 16; ++i_) { S0[i_] -= dl_; S1[i_] -= dl_; O0[i_] *= alpha_; O1[i_] *= alpha_; } } \
        float pa_ = 0.f, pb_ = 0.f, pc_ = 0.f, pd_ = 0.f; \
        _Pragma("unroll") for (int i_ = 0; i_ < 16; i_ += 2) { S0[i_] = __builtin_amdgcn_exp2f(S0[i_]); S0[i_ + 1] = __builtin_amdgcn_exp2f(S0[i_ + 1]); S1[i_] = __builtin_amdgcn_exp2f(S1[i_]); S1[i_ + 1] = __builtin_amdgcn_exp2f(S1[i_ + 1]); \
            pa_ += S0[i_]; pb_ += S0[i_ + 1]; pc_ += S1[i_]; pd_ += S1[i_ + 1]; } \
        L += (pa_ + pb_) + (pc_ + pd_); } while (0)
__device__ __forceinline__ void attn_store(bf16* op, const f32x16& o0, const f32x16& o1, float inv) {
#pragma unroll
    for (int gq = 0; gq < 4; ++gq) {
        u32x2 w0, w1; w0.x = pkbf(o0[4 * gq] * inv, o0[4 * gq + 1] * inv); w0.y = pkbf(o0[4 * gq + 2] * inv, o0[4 * gq + 3] * inv);
        w1.x = pkbf(o1[4 * gq] * inv, o1[4 * gq + 1] * inv); w1.y = pkbf(o1[4 * gq + 2] * inv, o1[4 * gq + 3] * inv);
        *(u32x2*)(op + 8 * gq) = w0; *(u32x2*)(op + 32 + 8 * gq) = w1; }
}
__device__ __forceinline__ void attn_unit(LAS unsigned char* lds, const bf16* Q, const bf16* KN, const bf16* KR, const bf16* VT, bf16* O,
                                          int b, int hp, int qrow0, int key_lo, int ntiles, int tid) {
    const int lane = tid & 63, r = lane & 31, hh = lane >> 5, wid = __builtin_amdgcn_readfirstlane(tid >> 6), gsel = wid >> 2, wq = wid & 3, gt = tid & 255;
    const int h = hp * 2 + gsel;
    LAS unsigned char* gl = lds + gsel * (2 * AT_BUF);
    const int qrA = qrow0 + wq * 64 + r;
    bf16x8 qa[6];
    LAS unsigned char* qbl = lds + ATQ_OFF + wid * 6656 + r * AT_KP + hh * 16;
#pragma unroll
    for (int c = 0; c < 6; ++c) { qa[c] = *(const bf16x8*)(Q + (size_t)qrA * QW + h * 96 + 16 * c + 8 * hh);
        *(LAS bf16x8*)(qbl + c * 32) = *(const bf16x8*)(Q + (size_t)(qrA + 32) * QW + h * 96 + 16 * c + 8 * hh); }
    f32x16 oA0, oA1, oB0, oB1;
#pragma unroll
    for (int i = 0; i < 16; ++i) { oA0[i] = 0.f; oA1[i] = 0.f; oB0[i] = 0.f; oB1[i] = 0.f; }
    float mA = 0.f, lA = 0.f, mB = 0.f, lB = 0.f;
    const int kkey = gt >> 3, kpc = gt & 7, rkey = gt >> 2, rpc = gt & 3;
    const bf16* vsrc = VT + ((size_t)b * 512 + h * 64 + kkey) * NKEY + kpc * 8;
    u32x4 rk0, rk1, rr, rv0, rv1;
#define AT_LOAD(t) do { const int key0 = key_lo + (t) * 64; const size_t krow = key0 < SEQ ? (size_t)b * SEQ + key0 : (size_t)MLAT + (size_t)b * LC + (key0 - SEQ); \
        rk0 = *(const u32x4*)(KN + (krow + kkey) * 512 + h * 64 + kpc * 8); rk1 = *(const u32x4*)(KN + (krow + kkey + 32) * 512 + h * 64 + kpc * 8); \
        rr = *(const u32x4*)(KR + (krow + rkey) * 32 + rpc * 8); \
        rv0 = *(const u32x4*)(vsrc + key0); rv1 = *(const u32x4*)(vsrc + (size_t)32 * NKEY + key0); } while (0)
#define AT_STORE(bufp) do { *(LAS u32x4*)((bufp) + kkey * AT_KP + kpc * 16) = rk0; *(LAS u32x4*)((bufp) + (kkey + 32) * AT_KP + kpc * 16) = rk1; \
        *(LAS u32x4*)((bufp) + rkey * AT_KP + 128 + rpc * 16) = rr; \
        *(LAS u32x2*)((bufp) + AT_VOFF + kkey * AT_VP + kpc * 16) = (u32x2){rv0.x, rv0.y}; *(LAS u32x2*)((bufp) + AT_VOFF + kkey * AT_VP + kpc * 16 + 8) = (u32x2){rv0.z, rv0.w}; \
        *(LAS u32x2*)((bufp) + AT_VOFF + (kkey + 32) * AT_VP + kpc * 16) = (u32x2){rv1.x, rv1.y}; *(LAS u32x2*)((bufp) + AT_VOFF + (kkey + 32) * AT_VP + kpc * 16 + 8) = (u32x2){rv1.z, rv1.w}; } while (0)
    AT_LOAD(0);
    AT_STORE(gl);
    __syncthreads();
    if (gsel == 1) __syncthreads();
    for (int t = 0; t < ntiles; ++t) {
        LAS unsigned char* buf = gl + (t & 1) * AT_BUF;
        f32x16 sA0, sA1, sB0, sB1;
        const LAS unsigned char* kb = buf + r * AT_KP + hh * 16;
#pragma unroll 1
        for (int rep_ = 0; rep_ < 1 + (int)((MK_DUP >> 25) & 1u); ++rep_) {
#pragma unroll
        for (int i = 0; i < 16; ++i) { sA0[i] = -mA; sA1[i] = -mA; sB0[i] = -mB; sB1[i] = -mB; }
#pragma unroll
        for (int c = 0; c < 6; ++c) {
            const bf16x8 a0 = *(const LAS bf16x8*)(kb + c * 32), a1 = *(const LAS bf16x8*)(kb + 32 * AT_KP + c * 32);
            const bf16x8 qbc = *(const LAS bf16x8*)(qbl + c * 32);
            sA0 = mfma32(a0, qa[c], sA0); sA1 = mfma32(a1, qa[c], sA1); sB0 = mfma32(a0, qbc, sB0); sB1 = mfma32(a1, qbc, sB1);
        }
        asm volatile("" ::: "memory"); }
        AT_SOFTMAX(sA0, sA1, mA, lA, oA0, oA1, t == 0);
        bf16x8 pA[4];
        pA[0] = pack_s(sA0, 0); pA[1] = pack_s(sA0, 1); pA[2] = pack_s(sA1, 0); pA[3] = pack_s(sA1, 1);
        AT_SOFTMAX(sB0, sB1, mB, lB, oB0, oB1, t == 0);
        bf16x8 pB[4];
        pB[0] = pack_s(sB0, 0); pB[1] = pack_s(sB0, 1); pB[2] = pack_s(sB1, 0); pB[3] = pack_s(sB1, 1);
        __syncthreads();
        __builtin_amdgcn_sched_barrier(0);
        if (t + 1 < ntiles) AT_LOAD(t + 1);
        const LAS unsigned char* vb = buf + AT_VOFF + r * AT_VP + hh * 8;
#pragma unroll
        for (int ks = 0; ks < 4; ++ks) {
            const s16x4 l0 = *(const LAS s16x4*)(vb + ks * 32), h0 = *(const LAS s16x4*)(vb + ks * 32 + 16);
            const s16x4 l1 = *(const LAS s16x4*)(vb + 32 * AT_VP + ks * 32), h1 = *(const LAS s16x4*)(vb + 32 * AT_VP + ks * 32 + 16);
            const bf16x8 v0 = __builtin_shufflevector(l0, h0, 0, 1, 2, 3, 4, 5, 6, 7), v1 = __builtin_shufflevector(l1, h1, 0, 1, 2, 3, 4, 5, 6, 7);
            oA0 = mfma32(v0, pA[ks], oA0); oA1 = mfma32(v1, pA[ks], oA1); oB0 = mfma32(v0, pB[ks], oB0); oB1 = mfma32(v1, pB[ks], oB1);
        }
        if (t + 1 < ntiles) { LAS unsigned char* nb = gl + ((t + 1) & 1) * AT_BUF; AT_STORE(nb); }
        __syncthreads();
    }
    if (gsel == 0) __syncthreads();
    lA += __shfl_xor(lA, 32); lB += __shfl_xor(lB, 32);
    attn_store(O + (size_t)qrA * D + h * 64 + 4 * hh, oA0, oA1, 1.0f / lA);
    attn_store(O + (size_t)(qrA + 32) * D + h * 64 + 4 * hh, oB0, oB1, 1.0f / lB);
#undef AT_LOAD
#undef AT_STORE
}
__device__ __forceinline__ void tr_item(const float* W, int N, int k0, int n0, bf16* dst, size_t drow0, int dld, const float* kscale, float cscale, LAS float* scr, int lane) {
#pragma unroll 1
    for (int ib = 0; ib < 32; ib += 16) { float wv[16];
#pragma unroll
        for (int ii = 0; ii < 16; ++ii) wv[ii] = W[(size_t)(k0 + 2 * (ib + ii) + (lane >> 5)) * N + n0 + (lane & 31)];
#pragma unroll
        for (int ii = 0; ii < 16; ++ii) { const int kk = 2 * (ib + ii) + (lane >> 5); float v = wv[ii] * cscale; if (kscale) v *= kscale[k0 + kk]; scr[kk * 33 + (lane & 31)] = v; } }
    asm volatile("s_waitcnt lgkmcnt(0)" ::: "memory");
    const int c = lane & 7;
#pragma unroll
    for (int j = 0; j < 4; ++j) { const int n = (lane >> 3) + 8 * j; const LAS float* s = scr + (8 * c) * 33 + n;
        u32x4 o; o.x = pkbf(s[0 * 33], s[1 * 33]); o.y = pkbf(s[2 * 33], s[3 * 33]); o.z = pkbf(s[4 * 33], s[5 * 33]); o.w = pkbf(s[6 * 33], s[7 * 33]);
        *(u32x4*)(dst + (drow0 + n) * (size_t)dld + k0 + 8 * c) = o; }
    asm volatile("s_waitcnt lgkmcnt(0)" ::: "memory");
}
__device__ __forceinline__ void tr_item8(const float* W, int N, int k0, int n0, unsigned char* dst, size_t drow0, int dld, float cscale, LAS float* scr, int lane) {
#pragma unroll 1
    for (int ib = 0; ib < 32; ib += 16) { float wv[16];
#pragma unroll
        for (int ii = 0; ii < 16; ++ii) wv[ii] = W[(size_t)(k0 + 2 * (ib + ii) + (lane >> 5)) * N + n0 + (lane & 31)];
#pragma unroll
        for (int ii = 0; ii < 16; ++ii) { const int kk = 2 * (ib + ii) + (lane >> 5); scr[kk * 33 + (lane & 31)] = wv[ii] * cscale; } }
    asm volatile("s_waitcnt lgkmcnt(0)" ::: "memory");
    const int c = lane & 7;
#pragma unroll
    for (int j = 0; j < 4; ++j) { const int n = (lane >> 3) + 8 * j; const LAS float* sp = scr + (8 * c) * 33 + n;
        u32x2 o; o.x = pk4_fp8(sp[0 * 33], sp[1 * 33], sp[2 * 33], sp[3 * 33]); o.y = pk4_fp8(sp[4 * 33], sp[5 * 33], sp[6 * 33], sp[7 * 33]);
        *(u32x2*)(dst + (drow0 + n) * (size_t)dld + k0 + 8 * c) = o; }
    asm volatile("s_waitcnt lgkmcnt(0)" ::: "memory");
}
__device__ __forceinline__ void tr_matrix(const float* W, int K, int N, bf16* dst, int dld, int mode, bf16* dst2, const float* kscale, float cscale, LAS float* scr, int gw, int NGW, int lane) {
    const int nblk = N / 32, nit = (K / 64) * nblk;
    for (int it = gw; it < nit; it += NGW) { const int kb = it / nblk, nb = it % nblk, n0 = 32 * nb; size_t dr; bf16* d = dst;
        if (mode == 0) dr = n0;
        else if (mode == 1) dr = n0 < 416 ? n0 : n0 + 96;
        else if (mode == 2) { const int hq = n0 >> 7, w = n0 & 127; if (w < 64) dr = hq * 64 + w; else { dr = hq * 64 + w - 64; d = dst2; } }
        else if (mode == 3) dr = (size_t)(n0 >> 7) * 256 + (n0 & 127);
        else dr = (size_t)(n0 >> 7) * 256 + 128 + (n0 & 127);
        tr_item(W, N, 64 * kb, n0, d, dr, dld, kscale, cscale, scr, lane); }
}
__device__ __forceinline__ void tr_matrix8(const float* W, int K, int N, unsigned char* dst, int dld, int mode, LAS float* scr, int gw, int NGW, int lane) {
    const int nblk = N / 32, nit = (K / 64) * nblk;
    for (int it = gw; it < nit; it += NGW) { const int kb = it / nblk, nb = it % nblk, n0 = 32 * nb; size_t dr;
        if (mode == 0) dr = n0; else if (mode == 1) dr = n0 < 416 ? n0 : n0 + 96; else if (mode == 3) dr = (size_t)(n0 >> 7) * 256 + (n0 & 127); else dr = (size_t)(n0 >> 7) * 256 + 128 + (n0 & 127);
        tr_item8(W, N, 64 * kb, n0, dst, dr, dld, W8_SCALE, scr, lane); }
}
__device__ __forceinline__ void split8(const float* v, bf16x8& hi, bf16x8& lo) {
    u32x4 h, l;
#pragma unroll
    for (int q = 0; q < 4; ++q) { const unsigned ph = pkbf(v[2 * q], v[2 * q + 1]); const float h0 = __uint_as_float(ph << 16), h1 = __uint_as_float(ph & 0xffff0000u);
        h[q] = ph; l[q] = pkbf(v[2 * q] - h0, v[2 * q + 1] - h1); }
    hi = __builtin_bit_cast(bf16x8, h); lo = __builtin_bit_cast(bf16x8, l);
}
__device__ __forceinline__ f32x16 mfma32m(bf16x8 a, bf16x8 b, f32x16 c) { return __builtin_amdgcn_mfma_f32_32x32x16_bf16(a, b, c, 0, 0, 0); }
__device__ __forceinline__ void mod_partial_item(const float* c, const float* cctx, const float* ada_w, float* MODP, int item, LAS float* st, int tid) {
    const int lane = tid & 63, wave = __builtin_amdgcn_readfirstlane(tid >> 6);
    const int li = item / 192, kc = (item / 12) % 16, cg = item % 12;
    for (int idx = tid; idx < 36 * 64; idx += 512) { const int r = idx >> 6, k = idx & 63; float v = 0.f;
        if (r < 33) { const float x = r < 32 ? c[(size_t)r * D + kc * 64 + k] : cctx[kc * 64 + k]; v = silu_f(x); }
        st[k * 36 + r] = v; }
    __syncthreads();
    const int m = lane & 31, kg = lane >> 5;
    bf16x8 ah[2][4], al[2][4];
#pragma unroll
    for (int ks = 0; ks < 4; ++ks) { float v0[8], v1[8];
#pragma unroll
        for (int j = 0; j < 8; ++j) { const int k = ks * 16 + kg * 8 + j; v0[j] = st[k * 36 + m]; const float x = st[k * 36 + 32]; v1[j] = m == 0 ? x : 0.f; }
        split8(v0, ah[0][ks], al[0][ks]); split8(v1, ah[1][ks], al[1][ks]); }
#pragma unroll 1
    for (int cb = 0; cb < 2; ++cb) {
        const int col = cg * 512 + wave * 64 + cb * 32 + m;
        const float* wp = ada_w + ((size_t)li * D + kc * 64 + kg * 8) * 6144 + col;
        float w[32];
#pragma unroll
        for (int ks = 0; ks < 4; ++ks)
#pragma unroll
            for (int j = 0; j < 8; ++j) w[ks * 8 + j] = wp[(size_t)(ks * 16 + j) * 6144];
        f32x16 a0, a1;
#pragma unroll
        for (int i = 0; i < 16; ++i) { a0[i] = 0.f; a1[i] = 0.f; }
#pragma unroll
        for (int ks = 0; ks < 4; ++ks) { bf16x8 bh, bl; split8(&w[ks * 8], bh, bl);
            a0 = mfma32m(ah[0][ks], bh, a0); a0 = mfma32m(ah[0][ks], bl, a0); a0 = mfma32m(al[0][ks], bh, a0);
            a1 = mfma32m(ah[1][ks], bh, a1); a1 = mfma32m(ah[1][ks], bl, a1); a1 = mfma32m(al[1][ks], bh, a1); }
        float* mp = MODP + (((size_t)kc * 4 + li) * 33) * 6144 + col;
#pragma unroll
        for (int i = 0; i < 16; ++i) mp[(size_t)(8 * (i >> 2) + 4 * kg + (i & 3)) * 6144] = a0[i];
        if (kg == 0) mp[(size_t)32 * 6144] = a1[0];
    }
    __syncthreads();
}

constexpr int NPH = 43;
struct Args { const float* in[N_IN]; float* out; unsigned char* ws; int ph_lo, ph_hi; };
#define AIN(i) ((const float*)(const GAS float*)a.in[i])
#define AOUT ((float*)(GAS float*)a.out)

__device__ __forceinline__ void moe_convert(const float* w1, const float* w3, const float* w2, bf16* W13, bf16* W2, LAS float* scr, int gw, int NGW, int lane) {
    constexpr int PER = 1792, TOT = 8 * 3 * PER;
    for (int it = gw; it < TOT; it += NGW) { const int ex = it / (3 * PER), rem = it % (3 * PER), which = rem / PER, j = rem % PER;
        if (which < 2) { const int nblk = DFFE / 32, kb = j / nblk, nb = j % nblk, n0 = 32 * nb;
            const float* W = (which ? w3 : w1) + (size_t)ex * D * DFFE;
            tr_item(W, DFFE, 64 * kb, n0, W13 + (size_t)ex * 7168 * 1024, (size_t)(n0 >> 7) * 256 + which * 128 + (n0 & 127), 1024, nullptr, 1.0f, scr, lane); }
        else { const int nblk = D / 32, kb = j / nblk, nb = j % nblk, n0 = 32 * nb;
            tr_item(w2 + (size_t)ex * DFFE * D, D, 64 * kb, n0, W2 + (size_t)ex * 1024 * DFFE, n0, DFFE, nullptr, 1.0f, scr, lane); } }
}

constexpr int MOE_CV_ITEMS = 8 * 3 * 1792;
constexpr int BG0_MIXIN_E = 1024 * 6, BG0_MIXOUT_E = BG0_MIXIN_E + 1024 * 6, BG0_UP_E = BG0_MIXOUT_E + 512 * 6, BG0_END = BG0_UP_E + 1024 * 14;
constexpr int BG1_DFTS_E = 1024 * 7, BG1_FNET_E = BG1_DFTS_E + 1024 * 6, BG1_MD0_E = BG1_FNET_E + 8064, BG1_MIXIN = BG1_MD0_E + 8064, BG1_END = BG1_MIXIN + 1792 * 6;
static_assert(BG0_END <= MOE_CV_ITEMS && BG1_END <= MOE_CV_ITEMS, "background plan");
__device__ __forceinline__ void moe_convert8(const float* w1, const float* w3, const float* w2, unsigned char* W13, unsigned char* W2, LAS float* scr, int gw, int NGW, int lane, int lo = 0, int hi = MOE_CV_ITEMS) {
    constexpr int PER = 1792;
    for (int it = lo + gw; it < hi; it += NGW) { const int ex = it / (3 * PER), rem = it % (3 * PER), which = rem / PER, j = rem % PER;
        if (which < 2) { const int nblk = DFFE / 32, kb = j / nblk, nb = j % nblk, n0 = 32 * nb;
            const float* W = (which ? w3 : w1) + (size_t)ex * D * DFFE;
            tr_item8(W, DFFE, 64 * kb, n0, W13 + (size_t)ex * 7168 * 1024, (size_t)(n0 >> 7) * 256 + which * 128 + (n0 & 127), 1024, W8_SCALE, scr, lane); }
        else { const int nblk = D / 32, kb = j / nblk, nb = j % nblk, n0 = 32 * nb;
            tr_item8(w2 + (size_t)ex * DFFE * D, D, 64 * kb, n0, W2 + (size_t)ex * 1024 * DFFE, n0, DFFE, W8_SCALE, scr, lane); } }
}

__global__ void __launch_bounds__(512, 2) fwd(Args a) {
    extern __shared__ __attribute__((aligned(16))) unsigned char lds_raw[];
    LAS unsigned char* lds = (LAS unsigned char*)lds_raw;
    volatile LAS unsigned* MISC = (volatile LAS unsigned*)(lds + MISC_OFF);
    const int G = gridDim.x, bid = blockIdx.x, NGW = G * 8;
    unsigned* ctl = (unsigned*)(GAS unsigned*)(a.ws + WS_CTL);
#define WSP_DECL GAS unsigned char* wsg_ = (GAS unsigned char*)a.ws; asm volatile("" : "+s"(wsg_)); unsigned char* wsp = (unsigned char*)wsg_; int tid = threadIdx.x; asm volatile("" : "+v"(tid)); const int lane = tid & 63, wave = __builtin_amdgcn_readfirstlane(tid >> 6), gw = bid * 8 + wave; (void)lane; (void)gw
#define MOD ((float*)(wsp + WS_MOD))
#define ROPEC ((float*)(wsp + WS_ROPE))
#define ROPES (ROPEC + 512)
#define SSQQ ((float*)(wsp + WS_SSQQ))
#define SSQK ((float*)(wsp + WS_SSQK))
#define HMID ((float*)(wsp + WS_HMID))
#define AMID ((float*)(wsp + WS_AMID))
#define LIST ((int*)(wsp + WS_LIST))
#define GLIST ((float*)(wsp + WS_GLIST))
#define WMIXIN ((bf16*)(wsp + WS_WMIXIN))
#define WUQ ((bf16*)(wsp + WS_WUQ))
#define WUK ((bf16*)(wsp + WS_WUK))
#define WUV ((bf16*)(wsp + WS_WUV))
#define WMIXOUT ((bf16*)(wsp + WS_WMIXOUT))
#define WFFN13 ((bf16*)(wsp + WS_WFFN13))
#define WFFN2 ((bf16*)(wsp + WS_WFFN2))
#define WFNET ((bf16*)(wsp + WS_WFNET))
#define WDFTC ((bf16*)(wsp + WS_WDFTC))
#define WDFTL ((bf16*)(wsp + WS_WDFTL))
#define WDFTX ((bf16*)(wsp + WS_WDFTX))
#define WMOE13 ((bf16*)(wsp + WS_WMOE13))
#define WMOE2 ((bf16*)(wsp + WS_WMOE2))
#define WMOE13_8(q) ((unsigned char*)WMOE13 + (BG_ON ? (size_t)(q) * 8 * 7168 * 1024 : (size_t)0))
#define WMOE2_8(q) ((unsigned char*)WMOE2 + (BG_ON ? (size_t)(q) * 8 * 1024 * 3584 : (size_t)0))
#define BG_FILL(T_, q_, lo_, hi_) do { if (BG_ON) { const int lo__ = (lo_), hi__ = (hi_); if (lo__ < hi__) { const int r__ = (T_) % G; \
    if (r__ == 0 || bid >= r__) { const int q__ = (q_); __syncthreads(); \
        moe_convert8(AIN(I_MW1) + (size_t)q__ * 8 * D * DFFE, AIN(I_MW3) + (size_t)q__ * 8 * D * DFFE, AIN(I_MW2) + (size_t)q__ * 8 * DFFE * D, WMOE13_8(q__), WMOE2_8(q__), (LAS float*)(lds + wave * 8448), \
                     (r__ == 0 ? bid : bid - r__) * 8 + wave, (r__ == 0 ? G : G - r__) * 8, lane, lo__, hi__); } } } } while (0)
#define XCUR ((bf16*)(wsp + WS_XCUR))
#define RA ((bf16*)(wsp + WS_RA))
#define CQ ((bf16*)(wsp + WS_RB + RB_CQ))
#define CKV ((bf16*)(wsp + WS_RB + RB_CKV))
#define KR ((bf16*)(wsp + WS_RB + RB_KR))
#define POOL ((bf16*)(wsp + WS_RB + RB_POOL))
#define QB ((bf16*)(wsp + WS_RB + RB_Q))
#define KN ((bf16*)(wsp + WS_RB + RB_KN))
#define VT ((bf16*)(wsp + WS_RB + RB_VT))
#define ZB ((bf16*)(wsp + WS_RB + RB_Z))
#define ZC ((bf16*)(wsp + WS_RB + RB_ZC))
#define ACT ((bf16*)(wsp + WS_RB + RB_ACT))

    const int lo = a.ph_lo, hi = a.ph_hi;
    if (threadIdx.x < 64) MISC[threadIdx.x] = 0u;
    __syncthreads();
    XcdBarrier bar; bar.bar = ctl + CW_BAR; bar.x = 0; bar.st = MISC + 8;
    if (hi - lo > 1) bar = xcd_barrier_post(ctl + CW_BAR, MISC + 8);
#ifndef MK_EN
#define MK_EN 0xFFFFFFFFu
#endif
#define EN(b) (((MK_EN) >> (b)) & 1u)
#ifndef MK_DUP
#define MK_DUP 0u
#endif
#define REP(b) _Pragma("unroll 1") for (int _rep = 0; _rep < ((((MK_DUP) >> (b)) & 1u) ? 2 : 1); ++_rep)
#define IN(p) (lo <= (p) && (p) < hi)
#define SEAM(p) do { if (hi > (p) + 1) { xcd_barrier<false>(bar); if ((MK_DUP >> 12) & 1u) xcd_barrier<false>(bar); } } while (0)
#define SEAM0(p) do { if (hi > (p) + 1) xcd_barrier<true>(bar); } while (0)

    if (EN(0) && IN(0)) REP(11) { WSP_DECL;
        LAS float* scr = (LAS float*)(lds + wave * 8448);
        for (int item = bid; item < 4 * 16 * 12; item += G) mod_partial_item(AIN(I_C), AIN(I_CCTX), AIN(I_ADAW), (float*)(wsp + WS_RB), item, (LAS float*)(lds + 67584), tid);
        int gwr = gw;
#define ADV(nit) gwr = (gwr - ((nit) % NGW) + NGW) % NGW
#pragma unroll 1
        for (int e = 0; e < 2; ++e) {
            if (MK_FP8_MIXIN) tr_matrix8(AIN(I_MIXIN) + (size_t)e * D * 928, D, 928, (unsigned char*)(WMIXIN + (size_t)e * 1024 * 1024), 1024, 1, scr, gwr, NGW, lane);
            else tr_matrix(AIN(I_MIXIN) + (size_t)e * D * 928, D, 928, WMIXIN + (size_t)e * 1024 * 1024, 1024, 1, nullptr, nullptr, 1.0f, scr, gwr, NGW, lane); ADV(464);
            tr_matrix(AIN(I_WUQ) + (size_t)e * 256 * 768, 256, 768, WUQ + (size_t)e * 768 * 256, 256, 0, nullptr, AIN(I_CQG) + e * 256, QSCALE, scr, gwr, NGW, lane); ADV(96);
            tr_matrix(AIN(I_WUKV) + (size_t)e * 128 * 1024, 128, 1024, WUK + (size_t)e * 512 * 128, 128, 2, WUV + (size_t)e * 512 * 128, AIN(I_CKVG) + e * 128, 1.0f, scr, gwr, NGW, lane); ADV(64);
            tr_matrix(AIN(I_MIXOUT) + (size_t)e * 1024 * 1024, 512, 1024, WMIXOUT + (size_t)e * 1024 * 1024, 1024, 0, nullptr, nullptr, 1.0f, scr, gwr, NGW, lane); ADV(256);
            if (FP8_FFN(2 * e)) {
                tr_matrix8(AIN(I_FW1) + (size_t)e * D * DFF, D, DFF, (unsigned char*)(WFFN13 + (size_t)e * 5632 * 1024), 1024, 3, scr, gwr, NGW, lane); ADV(1408);
                tr_matrix8(AIN(I_FW3) + (size_t)e * D * DFF, D, DFF, (unsigned char*)(WFFN13 + (size_t)e * 5632 * 1024), 1024, 4, scr, gwr, NGW, lane); ADV(1408);
                tr_matrix8(AIN(I_FW2) + (size_t)e * DFF * D, DFF, D, (unsigned char*)(WFFN2 + (size_t)e * 1024 * DFF), DFF, 0, scr, gwr, NGW, lane); ADV(1408);
            } else {
            tr_matrix(AIN(I_FW1) + (size_t)e * D * DFF, D, DFF, WFFN13 + (size_t)e * 5632 * 1024, 1024, 3, nullptr, nullptr, 1.0f, scr, gwr, NGW, lane); ADV(1408);
            tr_matrix(AIN(I_FW3) + (size_t)e * D * DFF, D, DFF, WFFN13 + (size_t)e * 5632 * 1024, 1024, 4, nullptr, nullptr, 1.0f, scr, gwr, NGW, lane); ADV(1408);
            tr_matrix(AIN(I_FW2) + (size_t)e * DFF * D, DFF, D, WFFN2 + (size_t)e * 1024 * DFF, DFF, 0, nullptr, nullptr, 1.0f, scr, gwr, NGW, lane); ADV(1408);
            }
            tr_matrix(AIN(I_FNET) + (size_t)e * D * D, D, D, WFNET + (size_t)e * 1024 * 1024, 1024, 0, nullptr, nullptr, 1.0f, scr, gwr, NGW, lane); ADV(512);
            if (MK_FP8_MIXIN) { for (int i = gw * 64 + lane; i < 96 * 1024 / 16; i += NGW * 64) *(u32x4*)((unsigned char*)(WMIXIN + (size_t)e * 1024 * 1024) + 416 * 1024 + (size_t)i * 16) = (u32x4){0u, 0u, 0u, 0u}; }
            else for (int i = gw * 64 + lane; i < 96 * 1024 / 8; i += NGW * 64) *(u32x4*)(WMIXIN + (size_t)e * 1024 * 1024 + 416 * 1024 + (size_t)i * 8) = (u32x4){0u, 0u, 0u, 0u};
            for (int it = (gw - e * 1024 + NGW) % NGW; it < 4 * 16 * 16; it += NGW) {        const int gq = it >> 8, ic = (it >> 4) & 15, nb = it & 15, n = nb * 64 + lane;
                const float* pw = AIN(I_POOLW) + ((size_t)(e * 4 + gq) * 128 + ic * 8) * 128; const float* ps = AIN(I_POOLS) + e * 512 + gq * 128;
                const float* mw = AIN(I_MIXOUT) + ((size_t)e * 1024 + 512 + gq * 128) * 1024 + n;
                float acc[8];
#pragma unroll
                for (int q = 0; q < 8; ++q) acc[q] = 0.f;
#pragma unroll 1
                for (int jb = 0; jb < 128; jb += 16) { float wv[16];
#pragma unroll
                    for (int jj = 0; jj < 16; ++jj) wv[jj] = mw[(size_t)(jb + jj) * 1024];
#pragma unroll
                    for (int jj = 0; jj < 16; ++jj) { const float w = wv[jj] * ps[jb + jj];
#pragma unroll
                        for (int q = 0; q < 8; ++q) acc[q] += pw[q * 128 + jb + jj] * w; } }
                u32x4 o; o.x = pkbf(acc[0], acc[1]); o.y = pkbf(acc[2], acc[3]); o.z = pkbf(acc[4], acc[5]); o.w = pkbf(acc[6], acc[7]);
                *(u32x4*)(WMIXOUT + (size_t)e * 1024 * 1024 + (size_t)n * 1024 + 512 + gq * 128 + ic * 8) = o; }
        }
#undef ADV
        const int gt = bid * 512 + tid, NT = G * 512;
        for (int i = gt; i < 2 * 65536; i += NT) { const int ty = i >> 16, m = (i >> 8) & 255, c = i & 255; const float x = (float)((m * c) & 255) * (1.0f / 128.0f);
            WDFTC[i] = (bf16)(pkbf(ty ? sinpif(x) : cospif(x), 0.f) & 0xffffu); }
        if (MK_FP8_DFT) {
            for (int i4 = gt; i4 < 2048 * 2048 / 4; i4 += NT) { float v[4];
#pragma unroll
                for (int q = 0; q < 4; ++q) { const int i = i4 * 4 + q, k = i >> 11, kk = i & 2047;
                    if (kk < 1024) v[q] = __builtin_amdgcn_cosf((float)((k * kk) & 2047) * (1.0f / 2048.0f)); else if (kk == 1024) v[q] = 0.f; else v[q] = -__builtin_amdgcn_sinf((float)((k * (kk - 1024)) & 2047) * (1.0f / 2048.0f)); }
                ((unsigned*)WDFTL)[i4] = pk4_fp8(v[0] * 16.f, v[1] * 16.f, v[2] * 16.f, v[3] * 16.f); }
            for (int i4 = gt; i4 < 65536 / 4; i4 += NT) { float v[4];
#pragma unroll
                for (int q = 0; q < 4; ++q) { const int i = i4 * 4 + q, k = i >> 8, kk = i & 255;
                    if (kk < 128) v[q] = __builtin_amdgcn_cosf((float)((k * kk) & 255) * (1.0f / 256.0f)); else if (kk == 128) v[q] = 0.f; else v[q] = -__builtin_amdgcn_sinf((float)((k * (kk - 128)) & 255) * (1.0f / 256.0f)); }
                ((unsigned*)WDFTX)[i4] = pk4_fp8(v[0] * 16.f, v[1] * 16.f, v[2] * 16.f, v[3] * 16.f); }
        } else {
        for (int i4 = gt; i4 < 2048 * 2048 / 4; i4 += NT) { float v[4];
#pragma unroll
            for (int q = 0; q < 4; ++q) { const int i = i4 * 4 + q, k = i >> 11, kk = i & 2047;
                if (kk < 1024) v[q] = __builtin_amdgcn_cosf((float)((k * kk) & 2047) * (1.0f / 2048.0f)); else if (kk == 1024) v[q] = 0.f; else v[q] = -__builtin_amdgcn_sinf((float)((k * (kk - 1024)) & 2047) * (1.0f / 2048.0f)); }
            u32x2 w; w.x = pkbf(v[0], v[1]); w.y = pkbf(v[2], v[3]); ((u32x2*)WDFTL)[i4] = w; }
        for (int i4 = gt; i4 < 65536 / 4; i4 += NT) { float v[4];
#pragma unroll
            for (int q = 0; q < 4; ++q) { const int i = i4 * 4 + q, k = i >> 8, kk = i & 255;
                if (kk < 128) v[q] = __builtin_amdgcn_cosf((float)((k * kk) & 255) * (1.0f / 256.0f)); else if (kk == 128) v[q] = 0.f; else v[q] = -__builtin_amdgcn_sinf((float)((k * (kk - 128)) & 255) * (1.0f / 256.0f)); }
            u32x2 w; w.x = pkbf(v[0], v[1]); w.y = pkbf(v[2], v[3]); ((u32x2*)WDFTX)[i4] = w; }
        }
        if (gt < 512) { const int pos = gt >> 3, j = gt & 7; const double inv = pow(10000.0, -(double)j / 8.0), ang = (double)pos * inv; ROPEC[gt] = (float)cos(ang); ROPES[gt] = (float)sin(ang); }
    }
    if (lo == 0) SEAM0(0);
    if (IN(1)) { WSP_DECL; const float* MODP = (const float*)(wsp + WS_RB);
        for (int o = bid * 512 + tid; o < 4 * 33 * 6144; o += G * 512) { float sacc = 0.f;
#pragma unroll
            for (int kc = 0; kc < 16; ++kc) sacc += MODP[(size_t)kc * (4 * 33 * 6144) + o];
            const int li = o / (33 * 6144), col = o % 6144;
            const float mv = sacc + AIN(I_ADAB)[(size_t)li * 6144 + col];
            MOD[o] = mv;
            if (col >= 5120) ((bf16*)(wsp + WS_G16))[(size_t)(o / 6144) * 1024 + (col - 5120)] = (bf16)(pkbf(mv, 0.f) & 0xffffu); }
        SEAM(1);
    }

#pragma unroll 1
    for (int i = 0; i < DEPTH; ++i) {
        const int pb = 2 + 10 * i; const bool even = !(i & 1); const int e = i >> 1; const bool ctxn = i < 2;
#define modbase (MOD + (size_t)i * 33 * 6144)
#define XS_MIX (XSrc{AIN(I_X), AIN(I_CTX), (i == 0) ? (const bf16*)nullptr : (const bf16*)XCUR})
#define XS_CUR (XSrc{nullptr, nullptr, (const bf16*)XCUR})
        const int nrows = ctxn ? MALL : MLAT;
        if (EN(1) && IN(pb + 0)) { WSP_DECL;
            if (even) { REP(5) phase_mod_plain(XS_MIX, AIN(I_NMG) + i * D, modbase, 0, 1024, RA, MK_FP8_MIXIN != 0, MALL, gw, NGW, lane); }
            else REP(6) { phase_mod_fold(XS_MIX, AIN(I_NMG) + i * D, modbase, RA, HMID, i == 1, gw, NGW, lane);
                   if (FP8_MOE(i)) moe_convert8(AIN(I_MW1) + (size_t)e * 8 * D * DFFE, AIN(I_MW3) + (size_t)e * 8 * D * DFFE, AIN(I_MW2) + (size_t)e * 8 * DFFE * D, WMOE13_8(e), WMOE2_8(e), (LAS float*)(lds + wave * 8448), gw, NGW, lane, BG_ON ? (e == 0 ? BG0_END : BG1_END) : 0, MOE_CV_ITEMS);
                   else moe_convert(AIN(I_MW1) + (size_t)e * 8 * D * DFFE, AIN(I_MW3) + (size_t)e * 8 * D * DFFE, AIN(I_MW2) + (size_t)e * 8 * DFFE * D, WMOE13, WMOE2, (LAS float*)(lds + wave * 8448), gw, NGW, lane); }
            SEAM(pb + 0);
        }
        if (IN(pb + 1)) { WSP_DECL;
            if (even) { if (EN(2)) { SchedMixIn S{(const char*)RA, (const char*)(WMIXIN + (size_t)e * 1024 * 1024), G, bid, 1024 + (i == 0 ? 128 : 32), i == 0};
                        EpiMixIn E{CQ, CKV, KR, POOL, SSQQ, SSQK, ROPEC, ROPES};
                        REP(16) gm::gemm_phase<EpiMixIn, SchedMixIn, false, MK_FP8_MIXIN != 0>(lds, S, E);
                        BG_FILL(1024 + (i == 0 ? 128 : 32), i == 0 ? 0 : 1, i == 0 ? 0 : BG1_MIXIN, i == 0 ? BG0_MIXIN_E : BG1_END); } }
            else if (EN(3)) { phase_amid(HMID, AMID, lds, G, bid, tid);
                   SchedDftC S{(const char*)WDFTC, (const char*)RA, G, bid, 1024 + (i == 1 ? 256 : 0)}; EpiDftC E{ZB, ZC};
                   REP(17) gm::gemm_phase<EpiDftC, SchedDftC, false>(lds, S, E); }
            SEAM(pb + 1);
        }
        if (IN(pb + 2)) { WSP_DECL;
            if (even) { if (EN(4)) { REP(14) phase_pool(POOL, RA, nrows, gw, NGW, lane);
                        const int nq = (i == 0) ? TALL : TLAT;
                        SchedE3 S{(const char*)CQ, (const char*)CKV, (const char*)(WUQ + (size_t)e * 768 * 256), (const char*)(WUK + (size_t)e * 512 * 128), (const char*)(WUV + (size_t)e * 512 * 128), G, bid, nq, nq * 3 + 1152};
                        EpiE3 E{QB, KN, VT, SSQQ, SSQK, ROPEC, ROPES};
                        REP(15) gm::gemm_phase<EpiE3, SchedE3, false>(lds, S, E); } }
            else if (EN(5)) { SchedDftS S{(const char*)WDFTL, (const char*)WDFTX, (const char*)ZB, (const char*)ZC, G, bid, 1024 + (i == 1 ? 128 : 0)}; EpiDftS E{RA, AMID};
                   REP(18) gm::gemm_phase<EpiDftS, SchedDftS, false, MK_FP8_DFT != 0>(lds, S, E);
                   BG_FILL(1024 + (i == 1 ? 128 : 0), 1, 0, i == 1 ? BG1_DFTS_E : 0); }
            SEAM(pb + 2);
        }
        if (EN(6) && even && IN(pb + 3)) { WSP_DECL;
            const int total = 1024 + (i == 0 ? 128 : 0);
            REP(2) for (int it = 0;; ++it) { const int u = it * G + bid; if (u >= total) break;
                const bool cx = u >= 1024; const int bhp = cx ? u - 1024 : (u & 127), qt = cx ? 0 : (u >> 7), b = bhp >> 2, hp = bhp & 3;
                attn_unit(lds, QB, KN, KR, VT, RA, b, hp, cx ? MLAT + b * LC : b * SEQ + qt * 256, cx ? SEQ : 0, cx ? 4 : 36, tid); }
            SEAM(pb + 3);
        }
        if (EN(7) && IN(pb + 4)) { WSP_DECL;
            SchedResid S{(const char*)RA, (const char*)(even ? WMIXOUT + (size_t)e * 1024 * 1024 : WFNET + (size_t)e * 1024 * 1024), 2048u, 16, nrows / 256, G, bid};
            if ((MK_DUP >> 8) & 1u) { EpiResid Ed{AIN(I_X), AIN(I_CTX), (i == 0) ? (const bf16*)nullptr : (const bf16*)XCUR, (bf16*)AOUT, modbase + 2048, 1.0f}; gm::gemm_phase<EpiResid, SchedResid, false>(lds, S, Ed); }
            EpiResid E{AIN(I_X), AIN(I_CTX), (i == 0) ? (const bf16*)nullptr : (const bf16*)XCUR, XCUR, modbase + 2048, 1.0f};
            gm::gemm_phase<EpiResid, SchedResid, false>(lds, S, E);
            BG_FILL((nrows / 256) * 4, i == 0 ? 0 : 1, i == 0 ? BG0_MIXIN_E : BG1_DFTS_E, i == 0 ? BG0_MIXOUT_E : (i == 1 ? BG1_FNET_E : 0));
            SEAM(pb + 4);
        }
        if (EN(8) && IN(pb + 5)) { WSP_DECL;
            if (even) REP(7) phase_mod2<false>(XS_CUR, AIN(I_NFG) + i * D, modbase, RA, FP8_FFN(i), nrows, nullptr, nullptr, nullptr, nullptr, lds, bid, G, wave, lane, tid);
            else phase_mod2<true>(XS_CUR, AIN(I_NFG) + i * D, modbase, RA, FP8_MOE(i), nrows, AIN(I_ROUTER) + (size_t)e * D * 8, (unsigned*)(wsp + WS_CTL) + CW_CNT + e * 16 * 64, LIST, GLIST, lds, bid, G, wave, lane, tid);
            SEAM(pb + 5);
        }
        if (even) {
            if (EN(9) && IN(pb + 6)) { WSP_DECL;
                if (FP8_FFN(i)) { SchedUp S{(const char*)RA, (const char*)(WFFN13 + (size_t)e * 5632 * 1024), nrows / 256, 22, G, bid, 1024u, 8}; EpiSwiglu8 E{(unsigned char*)ACT, DFF};
                    REP(1) gm::gemm_phase<EpiSwiglu8, SchedUp, false, true>(lds, S, E); }
                else { SchedUp S{(const char*)RA, (const char*)(WFFN13 + (size_t)e * 5632 * 1024), nrows / 256, 22, G, bid, 2048u, 16}; EpiSwiglu E{ACT, DFF};
                    REP(1) gm::gemm_phase<EpiSwiglu, SchedUp, false>(lds, S, E); }
                BG_FILL((nrows / 256) * 22, 0, BG0_MIXOUT_E, i == 0 ? BG0_UP_E : 0);
                SEAM(pb + 6); }
            if (EN(10) && IN(pb + 7)) { WSP_DECL;
                if (FP8_FFN(i)) { SchedResid S{(const char*)ACT, (const char*)(WFFN2 + (size_t)e * 1024 * DFF), (unsigned)DFF, DFF / 128, nrows / 256, G, bid};
                    if ((MK_DUP >> 9) & 1u) { EpiResid Ed{nullptr, nullptr, (const bf16*)XCUR, (bf16*)AOUT, modbase + 5 * 1024, 1.0f / (W8_SCALE * A8_SCALE)}; gm::gemm_phase<EpiResid, SchedResid, false, true>(lds, S, Ed); }
                    EpiResid E{nullptr, nullptr, (const bf16*)XCUR, XCUR, modbase + 5 * 1024, 1.0f / (W8_SCALE * A8_SCALE)};
                    gm::gemm_phase<EpiResid, SchedResid, false, true>(lds, S, E); }
                else { SchedResid S{(const char*)ACT, (const char*)(WFFN2 + (size_t)e * 1024 * DFF), (unsigned)(DFF * 2), DFF / 64, nrows / 256, G, bid};
                    if ((MK_DUP >> 9) & 1u) { EpiResid Ed{nullptr, nullptr, (const bf16*)XCUR, (bf16*)AOUT, modbase + 5 * 1024, 1.0f}; gm::gemm_phase<EpiResid, SchedResid, false>(lds, S, Ed); }
                    EpiResid E{nullptr, nullptr, (const bf16*)XCUR, XCUR, modbase + 5 * 1024, 1.0f};
                    gm::gemm_phase<EpiResid, SchedResid, false>(lds, S, E); }
                BG_FILL((nrows / 256) * 4, 0, BG0_UP_E, i == 0 ? BG0_END : 0);
                SEAM(pb + 7); }
        } else {
#pragma unroll 1
            for (int s = 0; s < 2; ++s) {
                const int cwo = CW_CNT + (e * 16 + s * 8) * 64;
                if (EN(11) && IN(pb + 6 + 2 * s)) { WSP_DECL;
                    if (FP8_MOE(i)) { SchedMoeUp8 S; S.H2 = (const char*)RA; S.W13 = (const char*)WMOE13_8(e); S.list = LIST + (size_t)s * 8 * MALL; moe_info((const unsigned*)(wsp + WS_CTL) + cwo, S.mi); S.G = G; S.c = bid;
                        EpiSwiglu8 E{(unsigned char*)ACT, DFFE};
                        REP(0) gm::gemm_phase<EpiSwiglu8, SchedMoeUp8, true, true>(lds, S, E); }
                    else { SchedMoeUp S; S.H2 = (const char*)RA; S.W13 = (const char*)WMOE13; S.list = LIST + (size_t)s * 8 * MALL; moe_info((const unsigned*)(wsp + WS_CTL) + cwo, S.mi); S.G = G; S.c = bid;
                        EpiSwiglu E{ACT, DFFE};
                        REP(0) gm::gemm_phase<EpiSwiglu, SchedMoeUp, true>(lds, S, E); }
                    SEAM(pb + 6 + 2 * s); }
                if (EN(12) && IN(pb + 7 + 2 * s)) { WSP_DECL;
                    if (FP8_MOE(i)) { SchedMoeDown8 S; S.Ab = (const char*)ACT; S.W2 = (const char*)WMOE2_8(e); moe_info((const unsigned*)(wsp + WS_CTL) + cwo, S.mi); S.G = G; S.c = bid;
                        if ((MK_DUP >> 10) & 1u) { EpiMoeDown Ed{XCUR, (const bf16*)(wsp + WS_G16) + (size_t)i * 33 * 1024, LIST + (size_t)s * 8 * MALL, GLIST + (size_t)s * 8 * MALL, 1.0f / (W8_SCALE * A8_SCALE), (bf16*)AOUT}; gm::gemm_phase<EpiMoeDown, SchedMoeDown8, false, true>(lds, S, Ed); }
                        EpiMoeDown E{XCUR, (const bf16*)(wsp + WS_G16) + (size_t)i * 33 * 1024, LIST + (size_t)s * 8 * MALL, GLIST + (size_t)s * 8 * MALL, 1.0f / (W8_SCALE * A8_SCALE), XCUR};
                        gm::gemm_phase<EpiMoeDown, SchedMoeDown8, false, true>(lds, S, E);
                        BG_FILL(S.mi.tb[8] * 4, 1, s == 0 ? BG1_FNET_E : BG1_MD0_E, i == 1 ? (s == 0 ? BG1_MD0_E : BG1_MIXIN) : 0); }
                    else { SchedMoeDown S; S.Ab = (const char*)ACT; S.W2 = (const char*)WMOE2; moe_info((const unsigned*)(wsp + WS_CTL) + cwo, S.mi); S.G = G; S.c = bid;
                        EpiMoeDown E{XCUR, (const bf16*)(wsp + WS_G16) + (size_t)i * 33 * 1024, LIST + (size_t)s * 8 * MALL, GLIST + (size_t)s * 8 * MALL, 1.0f, XCUR};
                        gm::gemm_phase<EpiMoeDown, SchedMoeDown, false>(lds, S, E); }
                    SEAM(pb + 7 + 2 * s); }
            }
        }
    }
    if (EN(13) && IN(NPH - 1)) { WSP_DECL; phase_final(XCUR, AOUT, AIN(I_FINALG), gw, NGW, lane); }
#undef IN
#undef SEAM
}

extern "C" void kernel_launch(void* const* d_in, const int* in_sizes, int n_in, void* d_out, int out_size, void* d_ws, size_t ws_size, hipStream_t stream) {
    static int grid = 0;
    if (grid == 0) {
        if (n_in != N_IN || out_size != MLAT * D || ws_size < WS_END) { fprintf(stderr, "kernel_launch: unexpected problem (n_in %d, out %d, ws %zu < %zu)\n", n_in, out_size, ws_size, (size_t)WS_END); grid = -1; return; }
        int dev = 0, cus = 0, per_cu = 0;
        if (hipGetDevice(&dev) != hipSuccess || hipDeviceGetAttribute(&cus, hipDeviceAttributeMultiprocessorCount, dev) != hipSuccess) { grid = -1; return; }
        if (hipFuncSetAttribute((const void*)fwd, hipFuncAttributeMaxDynamicSharedMemorySize, LDS_BYTES) != hipSuccess) { fprintf(stderr, "kernel_launch: hipFuncSetAttribute failed\n"); grid = -1; return; }
        if (hipOccupancyMaxActiveBlocksPerMultiprocessor(&per_cu, (const void*)fwd, 512, LDS_BYTES) != hipSuccess || per_cu < 1) fprintf(stderr, "kernel_launch: occupancy query reports %d\n", per_cu);
        (void)hipGetLastError();
        grid = cus;
        if (grid != 256) fprintf(stderr, "kernel_launch: %d CUs (built for 256)\n", grid);
    }
    if (grid < 0) return;
    (void)hipMemsetAsync((char*)d_ws + WS_CTL, 0, CTL_BYTES, stream);
    Args a{};
    for (int i = 0; i < N_IN; ++i) a.in[i] = (const float*)d_in[i];
    a.out = (float*)d_out; a.ws = (unsigned char*)d_ws;
#if MK_PER_PHASE
    for (int p = 0; p < NPH; ++p) {
        const int k = (p - 2) % 10, layer = (p - 2) / 10;
        if (p >= 2 && p < NPH - 1) { const bool even = !(layer & 1); if (even && k >= 8) continue; if (!even && k == 3) continue; }
        a.ph_lo = p; a.ph_hi = p + 1;
        hipLaunchKernelGGL(fwd, dim3(grid), dim3(512), LDS_BYTES, stream, a);
    }
#else
    a.ph_lo = 0; a.ph_hi = NPH;
    hipLaunchKernelGGL(fwd, dim3(grid), dim3(512), LDS_BYTES, stream, a);
#endif
}
```

```cpp
#include <hip/hip_runtime.h>
#include <cstdio>
#include <cstdint>

#ifndef MK_FP8_L1
#define MK_FP8_L1 1
#endif
#define FP8_MOE(i) ((i) == 3 || MK_FP8_L1)
#ifndef MK_BG
#define MK_BG 1
#endif
#define BG_ON (MK_BG && MK_FP8_L1)
#ifndef MK_QK8
#define MK_QK8 1
#endif
#ifndef MK_PV8
#define MK_PV8 1
#endif
#ifndef MK_NT
#define MK_NT 1
#endif
#ifndef MK_MOE_CHAIN
#define MK_MOE_CHAIN 1
#endif
#define MOE_CHAIN_ON (MK_MOE_CHAIN && MK_FP8_L1)
#define MOE_SKIP 3
#ifndef MK_WPROBE
#define MK_WPROBE 0
#endif
#ifndef WP_KMASK
#define WP_KMASK 0x3ff
#define WP_LMASK 0x1f
#define WP_MULT 10
#endif
#define WP_SEL(p) ((p) < 2 ? (((WP_LMASK >> 4) & 1) && ((WP_KMASK >> (p)) & 1)) : (p) >= 42 ? (((WP_LMASK >> 4) & 1) && ((WP_KMASK >> 2) & 1)) : (((WP_LMASK >> (((p) - 2) / 10)) & 1) && ((WP_KMASK >> (((p) - 2) % 10)) & 1)))
#ifndef MK_FP8_DFT
#define MK_FP8_DFT 1
#endif
#ifndef MK_FP8_MIXIN
#define MK_FP8_MIXIN 0
#endif
#ifndef MK_FP8_FFN
#define MK_FP8_FFN 2
#endif
#define FP8_FFN(i) (((MK_FP8_FFN) >> ((i) >> 1)) & 1)
#ifndef MK_DUP
#define MK_DUP 0u
#endif
#ifndef MK_PER_PHASE
#define MK_PER_PHASE 0
#endif

#define LAS __attribute__((address_space(3)))
#define GAS __attribute__((address_space(1)))
typedef unsigned short bf16;
typedef short bf16x8 __attribute__((ext_vector_type(8)));
typedef short s16x4 __attribute__((ext_vector_type(4)));
typedef float f32x4 __attribute__((ext_vector_type(4)));
typedef float f32x2 __attribute__((ext_vector_type(2)));
typedef float f32x16 __attribute__((ext_vector_type(16)));
typedef unsigned u32x4 __attribute__((ext_vector_type(4)));
typedef unsigned u32x2 __attribute__((ext_vector_type(2)));
typedef __bf16 bf16x2_t __attribute__((ext_vector_type(2)));

constexpr int NB = 32, SEQ = 2048, LC = 256, D = 1024, DEPTH = 4;
constexpr int MLAT = NB * SEQ, MCTX = NB * LC, MALL = MLAT + MCTX;
constexpr int TLAT = MLAT / 256, TCTX = MCTX / 256, TALL = MALL / 256;
constexpr int HEADS = 8, QKN = 64, QKR = 32, VD = 64, QLORA = 256, KVLORA = 128;
constexpr int QW = HEADS * (QKN + QKR);
constexpr int NKEY = SEQ + LC;
constexpr int DFF = 2816, DFFE = 3584, NEXP = 8;
constexpr float EPS = 1e-6f;
constexpr float QSCALE = 0.10206207261596577f * 1.4426950408889634f;

enum { I_X = 0, I_C, I_CTX, I_CCTX, I_ADAW, I_ADAB, I_NMG, I_NFG, I_MIXIN, I_CQG, I_CKVG, I_WUQ, I_WUKV, I_POOLW, I_POOLS, I_MIXOUT,
       I_FW1, I_FW3, I_FW2, I_FNET, I_ROUTER, I_MW1, I_MW3, I_MW2, I_FINALG, N_IN };

constexpr size_t al(size_t x) { return (x + 4095) & ~(size_t)4095; }
constexpr size_t WS_CTL = 0, CTL_BYTES = 1u << 20;
constexpr size_t WS_MOD = WS_CTL + CTL_BYTES;
constexpr size_t WS_ROPE = al(WS_MOD + (size_t)DEPTH * 33 * 6 * D * 4);
constexpr size_t WS_SSQQ = al(WS_ROPE + 64 * 16 * 4);
constexpr size_t WS_SSQK = al(WS_SSQQ + (size_t)MALL * 16);
constexpr size_t WS_HMID = al(WS_SSQK + (size_t)MALL * 16);
constexpr size_t WS_AMID = al(WS_HMID + 64 * D * 4);
constexpr size_t WS_LIST = al(WS_AMID + 64 * D * 4);
constexpr size_t WS_GLIST = al(WS_LIST + (size_t)2 * 8 * MALL * 4);
constexpr size_t WS_WMIXIN = al(WS_GLIST + (size_t)2 * 8 * MALL * 4);
constexpr size_t WS_WUQ = al(WS_WMIXIN + (size_t)2 * 1024 * 1024 * 2);
constexpr size_t WS_WUK = al(WS_WUQ + (size_t)2 * 768 * 256 * 2);
constexpr size_t WS_WUV = al(WS_WUK + (size_t)2 * 512 * 128 * 2);
constexpr size_t WS_WMIXOUT = al(WS_WUV + (size_t)2 * 512 * 128 * 2);
constexpr size_t WS_WFFN13 = al(WS_WMIXOUT + (size_t)2 * 1024 * 1024 * 2);
constexpr size_t WS_WFFN2 = al(WS_WFFN13 + (size_t)2 * 5632 * 1024 * 2);
constexpr size_t WS_WFNET = al(WS_WFFN2 + (size_t)2 * 1024 * 2816 * 2);
constexpr size_t WS_WDFTC = al(WS_WFNET + (size_t)2 * 1024 * 1024 * 2);
constexpr size_t WS_WDFTL = al(WS_WDFTC + (size_t)2 * 256 * 256 * 2);
constexpr size_t WS_WDFTX = al(WS_WDFTL + (size_t)2048 * 2048 * 2);
constexpr size_t WS_WMOE13 = al(WS_WDFTX + (size_t)256 * 256 * 2);
constexpr size_t WS_WMOE2 = al(WS_WMOE13 + (size_t)8 * 7168 * 1024 * 2);
constexpr size_t WS_XCUR = al(WS_WMOE2 + (size_t)8 * 1024 * 3584 * 2);
constexpr size_t WS_RA = al(WS_XCUR + (size_t)MALL * D * 2);
constexpr size_t WS_RB = al(WS_RA + (size_t)MALL * D * 2);
constexpr size_t RB_CQ = 0;
constexpr size_t RB_CKV = al(RB_CQ + (size_t)MALL * 256 * 2);
constexpr size_t RB_KR = al(RB_CKV + (size_t)MALL * 128 * 2);
constexpr size_t RB_POOL = al(RB_KR + (size_t)MALL * 32 * 2);
constexpr size_t RB_Q = al(RB_POOL + (size_t)MALL * 512 * 2);
constexpr size_t RB_KN = al(RB_Q + (size_t)MALL * 768 * 2);
constexpr size_t RB_VT = al(RB_KN + (size_t)MALL * 512 * 2);
constexpr size_t RB_EVEN_END = al(RB_VT + (size_t)NB * 512 * NKEY * 2);
constexpr size_t RB_Z = 0;
constexpr size_t RB_ZC = al(RB_Z + (size_t)NB * 4 * 256 * 2048 * 2);
constexpr size_t RB_ACT = 0;
constexpr size_t RB_SIZE = al((size_t)(MALL + 2048) * DFFE * 2);
static_assert(RB_EVEN_END <= RB_SIZE && (size_t)MALL * DFF * 2 <= RB_SIZE && RB_ZC + (size_t)NB * 4 * 256 * 256 * 2 <= RB_SIZE, "region B");
constexpr size_t WS_G16 = WS_RB + RB_SIZE;
constexpr size_t WS_END = al(WS_G16 + (size_t)DEPTH * 33 * 1024 * 2);
static_assert(WS_END < 1150000000ull, "workspace budget");

constexpr int CW_TMO = 0;
constexpr int CW_BAR = 4096;
constexpr int CW_CNT = 16384;

constexpr int STAGE_BYTES = 131072;
constexpr int ATQ_OFF = 90112;
constexpr int MISC_OFF = 143360;
constexpr int LDS_BYTES = 147456;

__device__ __forceinline__ unsigned pkbf(float lo, float hi) { f32x2 v = {lo, hi}; bf16x2_t b = __builtin_convertvector(v, bf16x2_t); return __builtin_bit_cast(unsigned, b); }
#if MK_NT
#define NTLD(ptr) __builtin_nontemporal_load(ptr)
#define NTST(ptr, v) __builtin_nontemporal_store((v), (ptr))
#else
#define NTLD(ptr) (*(ptr))
#define NTST(ptr, v) (*(ptr) = (v))
#endif
__device__ __forceinline__ unsigned pk4_fp8(float a, float b, float c, float d);
__device__ __forceinline__ float bf2f(unsigned short b) { return __uint_as_float(((unsigned)b) << 16); }
__device__ __forceinline__ float wave_sum(float v) {
#pragma unroll
    for (int o = 1; o < 64; o <<= 1) v += __shfl_xor(v, o);
    return v;
}
__device__ __forceinline__ float silu_f(float x) { return x / (1.0f + __expf(-x)); }

#define XB_TMO      128
#define XB_XCNT(j)  (256  + 64 * (j))
#define XB_XSUB(j)  (1280 + 64 * (j))
#define XB_XGEN(j)  (2304 + 64 * (j))
#define XB_TOP      3328
#define XB_TOPGEN   3392
#define XCD_BAR_WORDS 3456
#define XB_SPIN_CAP (1u << 22)

__device__ __forceinline__ unsigned xb_ld(unsigned* p)              { return __hip_atomic_load(p, __ATOMIC_RELAXED, __HIP_MEMORY_SCOPE_AGENT); }
__device__ __forceinline__ unsigned xb_add(unsigned* p, unsigned v) { return __hip_atomic_fetch_add(p, v, __ATOMIC_RELAXED, __HIP_MEMORY_SCOPE_AGENT); }
__device__ __forceinline__ unsigned xb_xcc_id() { return (unsigned)__builtin_amdgcn_s_getreg((3 << 11) | 20) & 0xFu; }
#define XB_SPIN(cond, bar) do { unsigned _sp = 0; while (cond) { __builtin_amdgcn_s_sleep(1); \
    if ((++_sp & 255u) == 0u) { if (xb_ld(&(bar)[XB_TMO])) break; if (_sp > XB_SPIN_CAP) { atomicAdd(&(bar)[XB_TMO], 1u); break; } } } } while (0)

struct XcdBarrier { unsigned* bar; unsigned x; volatile LAS unsigned* st; };

__device__ __forceinline__ XcdBarrier xcd_barrier_post(unsigned* bar, volatile LAS unsigned* st) {
    XcdBarrier b; b.bar = bar; b.x = xb_xcc_id(); b.st = st;
    if (threadIdx.x == 0) (void)xb_add(&bar[XB_XCNT(b.x)], 1u);
    return b;
}
__device__ __forceinline__ void xcd_barrier_complete(unsigned* bar, unsigned x, unsigned& nloc, unsigned& nx) {
    const unsigned G = gridDim.x * gridDim.y * gridDim.z;
    unsigned sum, cnt, mine, sp = 0u;
    for (;;) {
        sum = 0u; cnt = 0u; mine = 0u;
#pragma unroll
        for (unsigned j = 0; j < 16; ++j) { const unsigned c = xb_ld(&bar[XB_XCNT(j)]); sum += c; cnt += (c > 0u) ? 1u : 0u; mine = (j == x) ? c : mine; }
        if (sum == G) break;
        __builtin_amdgcn_s_sleep(1);
        if ((++sp & 255u) == 0u) { if (xb_ld(&bar[XB_TMO])) break; if (sp > XB_SPIN_CAP) { atomicAdd(&bar[XB_TMO], 1u); break; } }
    }
    nloc = mine > 0u ? mine : 1u; nx = cnt > 0u ? cnt : 1u;
}
template <bool FIRST>
__device__ __forceinline__ void xcd_barrier(const XcdBarrier& b) {
    asm volatile("s_waitcnt vmcnt(0)" ::: "memory");
    __syncthreads();
    if (threadIdx.x == 0) {
        unsigned* bar = b.bar; asm volatile("" : "+s"(bar));
        __builtin_amdgcn_s_waitcnt(0);
        unsigned nloc = b.st[0], nx = b.st[1];
        if constexpr (FIRST) { if (nloc == 0u) { xcd_barrier_complete(bar, b.x, nloc, nx); b.st[0] = nloc; b.st[1] = nx; } }
        const unsigned old = xb_add(&bar[XB_XSUB(b.x)], 1u);
        const unsigned gen = old / nloc;
        if (old + 1u == (gen + 1u) * nloc) {
            __builtin_amdgcn_fence(__ATOMIC_RELEASE, "agent");
            asm volatile("s_waitcnt vmcnt(0)" ::: "memory");
            const unsigned og = xb_add(&bar[XB_TOP], 1u);
            const unsigned tg = og / nx;
            if (og + 1u == (tg + 1u) * nx) xb_add(&bar[XB_TOPGEN], 1u);
            else XB_SPIN(xb_ld(&bar[XB_TOPGEN]) == tg, bar);
            xb_add(&bar[XB_XGEN(b.x)], 1u);
            __builtin_amdgcn_fence(__ATOMIC_ACQUIRE, "agent");
            asm volatile("s_waitcnt vmcnt(0)" ::: "memory");
        } else {
            XB_SPIN(xb_ld(&bar[XB_XGEN(b.x)]) == gen, bar);
            __builtin_amdgcn_fence(__ATOMIC_ACQUIRE, "agent");
            asm volatile("s_waitcnt vmcnt(0)" ::: "memory");
        }
    }
    __syncthreads();
}

namespace gm {
constexpr int BK = 64, HALF = 128, HTB = HALF * BK * 2;
__device__ __forceinline__ int lds_byte(int r, int c) { const int st = (r >> 4) * 2 + (c >> 5), rr = r & 15, cc = c & 31, ob = rr * 64 + cc * 2; return st * 1024 + (ob ^ (((ob >> 9) & 1) << 5)); }
__device__ __forceinline__ void stage_rc(int b, int& R, int& C) { const int st = b / 1024, sb = b % 1024, swz = sb ^ (((sb >> 9) & 1) << 5); R = (st >> 1) * 16 + swz / 64; C = (st & 1) * 32 + (swz % 64) / 2; }
__device__ __forceinline__ int perm32(int rho) { const int n = rho >> 4, i = rho & 15; return 8 * (i >> 2) + 4 * n + (i & 3); }

struct Unit { const char* A; const char* B; unsigned lda, ldb; int nt; int x0, x1, x2, x3; };
typedef int v8i_t __attribute__((ext_vector_type(8))); typedef int v4i_t __attribute__((ext_vector_type(4)));


__device__ __forceinline__ bool flat_index(int i, int G, int c, int total, int& idx) {
    const long Lx = (long)i * G + c; if (Lx >= total) return false;
    int wgid = (int)Lx; const int q = total / 8, r = total % 8, xcd = wgid % 8, off = wgid / 8;
    idx = (xcd < r ? xcd * (q + 1) : r * (q + 1) + (xcd - r) * q) + off; return true;
}
__device__ __forceinline__ bool flat_pos(int pos, int total, int& idx) {
    if (pos >= total) return false;
    const int wgid = pos, q = total / 8, r = total % 8, xcd = wgid % 8, off = wgid / 8;
    idx = (xcd < r ? xcd * (q + 1) : r * (q + 1) + (xcd - r) * q) + off; return true;
}
__device__ __forceinline__ void tile_order(int idx, int nM, int nN, int& pm, int& pn) {
    const int nig = 8 * nN, gid = idx / nig, fm = gid * 8, gsz = (nM - fm) < 8 ? (nM - fm) : 8;
    pm = fm + ((idx % nig) % gsz); pn = (idx % nig) / gsz;
}

template <class Epi, class Sched, bool GATHER, bool FP8 = false>
__device__ __forceinline__ void gemm_phase(LAS unsigned char* lds, const Sched& S, const Epi& E) {
    int tid = threadIdx.x; asm volatile("" : "+v"(tid));
    const int wid = __builtin_amdgcn_readfirstlane(tid >> 6), lane = tid & 63, wr = wid >> 2, wc = wid & 3, fr = lane & 15, fq = lane >> 4;
    const unsigned ldsw = (unsigned)wid * 1024u;
    const int aoff = lds_byte(wr * 64 + fr, fq * 8), boff = lds_byte(wc * 32 + fr, fq * 8);
#define G_SA(b, h) (((b) * 2 + (h)) * HTB)
#define G_SB(b, h) ((4 + (b) * 2 + (h)) * HTB)
#define G_LD(ptr, dst) __builtin_amdgcn_global_load_lds((const unsigned*)(ptr), (LAS unsigned*)(dst), 16, 0, 0)
#define G_STAGE_B(bufoff, P, hh, kb) do { const char* _p0 = P##p + (size_t)(kb) + ((hh) ? (size_t)P##s * 128u : (size_t)0); const char* _p1 = _p0 + (size_t)P##s * 64u; \
        asm volatile("" : "+s"(_p0), "+s"(_p1)); \
        G_LD(_p0 + P##v, lds + (bufoff) + ldsw); G_LD(_p1 + P##v, lds + (bufoff) + ldsw + 8192); } while (0)
#define G_STAGE_A(bufoff, P, hh, kb) do { if constexpr (GATHER) { const char* _p = P##p + (size_t)(kb); asm volatile("" : "+s"(_p)); \
        G_LD(_p + P##g[(hh) * 2], lds + (bufoff) + ldsw); G_LD(_p + P##g[(hh) * 2 + 1], lds + (bufoff) + ldsw + 8192); } else { G_STAGE_B(bufoff, P, hh, kb); } } while (0)
#define G_LDA(dst, b, h) do { _Pragma("unroll") for (int m = 0; m < 4; ++m) { const v4i_t _l = *(const LAS v4i_t*)(lds + G_SA(b, h) + aoff + m * 2048), _h = *(const LAS v4i_t*)(lds + G_SA(b, h) + aoff + m * 2048 + 1024); \
        dst[m] = __builtin_shufflevector(_l, _h, 0, 1, 2, 3, 4, 5, 6, 7); } } while (0)
#define G_LDB(dst, b, h) do { _Pragma("unroll") for (int n = 0; n < 2; ++n) { const v4i_t _l = *(const LAS v4i_t*)(lds + G_SB(b, h) + boff + n * 2048), _h = *(const LAS v4i_t*)(lds + G_SB(b, h) + boff + n * 2048 + 1024); \
        dst[n] = __builtin_shufflevector(_l, _h, 0, 1, 2, 3, 4, 5, 6, 7); } } while (0)
#define G_LO(x) __builtin_bit_cast(bf16x8, (v4i_t)__builtin_shufflevector(x, x, 0, 1, 2, 3))
#define G_HI(x) __builtin_bit_cast(bf16x8, (v4i_t)__builtin_shufflevector(x, x, 4, 5, 6, 7))
#define G_MMA(ai, bj, At, Bt) do { __builtin_amdgcn_s_setprio(1); \
        if constexpr (FP8) { _Pragma("unroll") for (int m = 0; m < 4; ++m) _Pragma("unroll") for (int n = 0; n < 2; ++n) \
            asm volatile("v_mfma_f32_16x16x128_f8f6f4 %0, %1, %2, %0" : "+v"(acc[ai][bj][m][n]) : "v"(Bt[n]), "v"(At[m])); } \
        else { _Pragma("unroll") for (int m = 0; m < 4; ++m) _Pragma("unroll") for (int n = 0; n < 2; ++n) { \
            acc[ai][bj][m][n] = __builtin_amdgcn_mfma_f32_16x16x32_bf16(G_LO(Bt[n]), G_LO(At[m]), acc[ai][bj][m][n], 0, 0, 0); \
            acc[ai][bj][m][n] = __builtin_amdgcn_mfma_f32_16x16x32_bf16(G_HI(Bt[n]), G_HI(At[m]), acc[ai][bj][m][n], 0, 0, 0); } } \
        __builtin_amdgcn_s_setprio(0); } while (0)
#define G_MMA0(ai, bj, At, Bt) do { __builtin_amdgcn_s_setprio(1);     \
        if constexpr (FP8) { _Pragma("unroll") for (int m = 0; m < 4; ++m) _Pragma("unroll") for (int n = 0; n < 2; ++n) \
            asm volatile("v_mfma_f32_16x16x128_f8f6f4 %0, %1, %2, 0" : "=&v"(acc[ai][bj][m][n]) : "v"(Bt[n]), "v"(At[m])); } \
        else { _Pragma("unroll") for (int m = 0; m < 4; ++m) _Pragma("unroll") for (int n = 0; n < 2; ++n) { \
            acc[ai][bj][m][n] = __builtin_amdgcn_mfma_f32_16x16x32_bf16(G_LO(Bt[n]), G_LO(At[m]), (f32x4){0.f, 0.f, 0.f, 0.f}, 0, 0, 0); \
            acc[ai][bj][m][n] = __builtin_amdgcn_mfma_f32_16x16x32_bf16(G_HI(Bt[n]), G_HI(At[m]), acc[ai][bj][m][n], 0, 0, 0); } } \
        __builtin_amdgcn_s_setprio(0); } while (0)
#define G_WAIT_V(n) asm volatile("s_waitcnt vmcnt(" #n ")" ::: "memory")
#define G_WAIT_L(n) asm volatile("s_waitcnt lgkmcnt(" #n ")" ::: "memory")
#define G_BAR __builtin_amdgcn_s_barrier()
#define G_SCHED __builtin_amdgcn_sched_barrier(0)
#define G_SETUP(P_A, P_B, U) do { int _t = threadIdx.x; asm volatile("" : "+v"(_t)); int R0, C0; stage_rc(_t * 16, R0, C0); const int Rb0 = (R0 & ~31) + perm32(R0 & 31);     \
        P_A##p = (U).A; P_A##s = (U).lda; P_B##p = (U).B; P_B##s = (U).ldb; P_B##v = (unsigned)Rb0 * (U).ldb + (unsigned)C0 * 2u; \
        if constexpr (GATHER) { _Pragma("unroll") for (int _q = 0; _q < 4; ++_q) P_A##g[_q] = (unsigned)S.gather_row((U), R0 + 64 * _q) * (U).lda + (unsigned)C0 * 2u; P_A##v = 0u; } \
        else { P_A##v = (unsigned)R0 * (U).lda + (unsigned)C0 * 2u; } } while (0)
    Unit cur, nxt; int ui = 0;
    if (!S.next(0, cur)) return;
    f32x4 acc[2][2][4][2];
    v8i_t At[4], B0[2], B1[2];
    const char *cAp, *cBp, *nAp, *nBp; unsigned cAs, cBs, nAs, nBs, cAv, cBv, nAv, nBv; unsigned cAg[4], nAg[4];
#pragma unroll
    for (int q = 0; q < 4; ++q) { cAg[q] = 0u; nAg[q] = 0u; }
    G_SETUP(cA, cB, cur);
    G_STAGE_B(G_SB(0, 0), cB, 0, 0); G_STAGE_B(G_SB(0, 1), cB, 1, 0); G_STAGE_A(G_SA(0, 0), cA, 0, 0); G_STAGE_A(G_SA(0, 1), cA, 1, 0);
    if (wr == 1) G_BAR;
    G_WAIT_V(2); G_BAR;
    G_STAGE_B(G_SB(1, 0), cB, 0, 128); G_STAGE_A(G_SA(1, 0), cA, 0, 128); G_STAGE_B(G_SB(1, 1), cB, 1, 128);
    G_WAIT_V(6); G_BAR;
    for (;;) {
        const bool has_next = S.next(ui + 1, nxt);
        if (has_next) { G_SETUP(nA, nB, nxt); } else { nAp = cAp; nBp = cBp; nAs = cAs; nBs = cBs; nAv = cAv; nBv = cBv;
#pragma unroll
            for (int q = 0; q < 4; ++q) nAg[q] = cAg[q]; }
        int nt = cur.nt; asm volatile("" : "+s"(nt));
#define G_KSTEP(MM) { \
            const bool last = (t == nt - 2); \
            const size_t k1 = (size_t)(t + 1) * 128; \
              \
            G_LDB(B0, 0, 0); G_LDB(B1, 0, 1); G_SCHED; G_LDA(At, 0, 0); G_STAGE_A(G_SA(1, 1), cA, 1, k1); \
            G_WAIT_V(8); G_WAIT_L(0); G_BAR; MM(0, 0, At, B0); MM(0, 1, At, B1); G_BAR; G_SCHED; \
              \
            G_LDA(At, 0, 1); \
            if (last) { G_STAGE_B(G_SB(0, 0), nB, 0, 0); G_STAGE_B(G_SB(0, 1), nB, 1, 0); G_STAGE_A(G_SA(0, 0), nA, 0, 0); } \
            else { const size_t k2 = (size_t)(t + 2) * 128; G_STAGE_B(G_SB(0, 0), cB, 0, k2); G_STAGE_B(G_SB(0, 1), cB, 1, k2); G_STAGE_A(G_SA(0, 0), cA, 0, k2); } \
            G_WAIT_V(8); G_WAIT_L(0); G_BAR; MM(1, 0, At, B0); MM(1, 1, At, B1); G_BAR; G_SCHED; \
              \
            G_LDB(B0, 1, 0); G_LDB(B1, 1, 1); G_SCHED; G_LDA(At, 1, 0); \
            if (last) { G_STAGE_A(G_SA(0, 1), nA, 1, 0); } else { const size_t k2 = (size_t)(t + 2) * 128; G_STAGE_A(G_SA(0, 1), cA, 1, k2); } \
            G_WAIT_V(8); G_WAIT_L(0); G_BAR; G_MMA(0, 0, At, B0); G_MMA(0, 1, At, B1); G_BAR; G_SCHED; \
              \
            G_LDA(At, 1, 1); \
            if (last) { G_STAGE_B(G_SB(1, 0), nB, 0, 128); G_STAGE_B(G_SB(1, 1), nB, 1, 128); G_STAGE_A(G_SA(1, 0), nA, 0, 128); } \
            else { const size_t k3 = (size_t)(t + 3) * 128; G_STAGE_B(G_SB(1, 0), cB, 0, k3); G_STAGE_B(G_SB(1, 1), cB, 1, k3); G_STAGE_A(G_SA(1, 0), cA, 0, k3); } \
            G_WAIT_V(8); G_WAIT_L(0); G_BAR; G_MMA(1, 0, At, B0); G_MMA(1, 1, At, B1); G_BAR; G_SCHED; \
        }
        { const int t = 0; G_KSTEP(G_MMA0) }
        for (int t = 2; t < nt; t += 2) G_KSTEP(G_MMA)
#undef G_KSTEP
        if (wr == 0) G_BAR;
        if constexpr (FP8) asm volatile("s_nop 15\n\ts_nop 15" ::: "memory");
        { int _t = threadIdx.x; asm volatile("" : "+v"(_t)); const int _w = __builtin_amdgcn_readfirstlane(_t >> 6), _l = _t & 63;
          E(acc, cur, _w >> 2, _w & 3, _l & 15, _l >> 4); }
        if (!has_next) break;
        cur = nxt; cAp = nAp; cBp = nBp; cAs = nAs; cBs = nBs; cAv = nAv; cBv = nBv;
#pragma unroll
        for (int q = 0; q < 4; ++q) cAg[q] = nAg[q];
        ++ui;
        if (wr == 1) G_BAR;
    }
    G_WAIT_V(0);
    G_BAR;
#undef G_SA
#undef G_SB
#undef G_LD
#undef G_STAGE_A
#undef G_STAGE_B
#undef G_LDA
#undef G_LDB
#undef G_MMA
#undef G_MMA0
#undef G_WAIT_V
#undef G_WAIT_L
#undef G_BAR
#undef G_SCHED
#undef G_SETUP
}
}

typedef const f32x4 (&AccRef)[2][2][4][2];
__device__ __forceinline__ u32x4 pack8(const f32x4 a, const f32x4 b) { u32x4 w; w.x = pkbf(a[0], a[1]); w.y = pkbf(a[2], a[3]); w.z = pkbf(b[0], b[1]); w.w = pkbf(b[2], b[3]); return w; }

__device__ __forceinline__ void rope8(f32x4& v0, f32x4& v1, int fq, int t, const float* ropeC, const float* ropeS) {
    const int pos = (fq < 2) ? (t >> 6) : (t & 63);
    const f32x4 c0 = *(const f32x4*)(ropeC + pos * 8), c1 = *(const f32x4*)(ropeC + pos * 8 + 4);
    const f32x4 s0 = *(const f32x4*)(ropeS + pos * 8), s1 = *(const f32x4*)(ropeS + pos * 8 + 4);
    f32x4 p0, p1;
#pragma unroll
    for (int j = 0; j < 4; ++j) { p0[j] = __shfl_xor(v0[j], 16); p1[j] = __shfl_xor(v1[j], 16); }
    const float sg = (fq & 1) ? 1.0f : -1.0f;
    v0 = v0 * c0 + (p0 * s0) * sg; v1 = v1 * c1 + (p1 * s1) * sg;
}

struct SchedMixIn {
    const char* H; const char* W; int G, c, total; bool ctx_full;
    __device__ __forceinline__ bool next(int i, gm::Unit& u) const {
        int idx; if (!gm::flat_index(i, G, c, total, idx)) return false;
        int pm, pn;
        if (idx < 1024) gm::tile_order(idx, 256, 4, pm, pn);
        else { const int j = idx - 1024; if (ctx_full) { gm::tile_order(j, 32, 4, pm, pn); pm += 256; } else { pm = 256 + j; pn = 1; } }
        constexpr unsigned P = MK_FP8_MIXIN ? 1024u : 2048u;
        u.A = H + (size_t)pm * 256 * P; u.lda = P; u.B = W + (size_t)pn * 256 * P; u.ldb = P; u.nt = 16 / (MK_FP8_MIXIN ? 2 : 1); u.x0 = pm; u.x1 = pn; u.x2 = 0; u.x3 = 0; return true;
    }
};
struct EpiMixIn {
    bf16 *CQ, *CKV, *KR, *POOL; float *SSQQ, *SSQK; const float *ropeC, *ropeS;
    __device__ __forceinline__ void operator()(AccRef accr, const gm::Unit& u, int wr, int wc, int fr, int fq) const {
        const int pn = u.x1, row0 = u.x0 * 256 + wr * 64 + fr, cl = wc * 32 + fq * 8;
        constexpr float WS = MK_FP8_MIXIN ? (1.0f / 32.0f) : 1.0f;
        f32x4 acc[2][2][4][2];
#pragma unroll
        for (int a_ = 0; a_ < 2; ++a_)
#pragma unroll
            for (int b_ = 0; b_ < 2; ++b_)
#pragma unroll
                for (int m_ = 0; m_ < 4; ++m_)
#pragma unroll
                    for (int n_ = 0; n_ < 2; ++n_) acc[a_][b_][m_][n_] = accr[a_][b_][m_][n_] * WS;
        if (pn == 0) {
#pragma unroll
            for (int ai = 0; ai < 2; ++ai)
#pragma unroll
                for (int m = 0; m < 4; ++m) { const int row = row0 + ai * 128 + m * 16; float ss = 0.f;
#pragma unroll
                    for (int bj = 0; bj < 2; ++bj) { const f32x4 a = acc[ai][bj][m][0], b = acc[ai][bj][m][1];
                        ss += (a[0] * a[0] + a[1] * a[1]) + (a[2] * a[2] + a[3] * a[3]) + (b[0] * b[0] + b[1] * b[1]) + (b[2] * b[2] + b[3] * b[3]);
                        *(u32x4*)(CQ + (size_t)row * 256 + bj * 128 + cl) = pack8(a, b); }
                    ss += __shfl_xor(ss, 16); ss += __shfl_xor(ss, 32);
                    if (fq == 0) SSQQ[(size_t)row * 4 + wc] = ss; }
        } else if (pn == 1) {
            const bool lat = u.x0 < TLAT;
#pragma unroll
            for (int ai = 0; ai < 2; ++ai)
#pragma unroll
                for (int m = 0; m < 4; ++m) { const int row = row0 + ai * 128 + m * 16;
                    const f32x4 a = acc[ai][0][m][0], b = acc[ai][0][m][1];
                    float ss = (a[0] * a[0] + a[1] * a[1]) + (a[2] * a[2] + a[3] * a[3]) + (b[0] * b[0] + b[1] * b[1]) + (b[2] * b[2] + b[3] * b[3]);
                    *(u32x4*)(CKV + (size_t)row * 128 + cl) = pack8(a, b);
                    ss += __shfl_xor(ss, 16); ss += __shfl_xor(ss, 32);
                    if (fq == 0) SSQK[(size_t)row * 4 + wc] = ss;
                    if (wc == 0) { f32x4 r0 = acc[ai][1][m][0], r1 = acc[ai][1][m][1];
                        if (lat) rope8(r0, r1, fq, row & (SEQ - 1), ropeC, ropeS);
                        *(u32x4*)(KR + (size_t)row * 32 + fq * 8) = pack8(r0, r1); } }
        } else {
#pragma unroll
            for (int ai = 0; ai < 2; ++ai)
#pragma unroll
                for (int m = 0; m < 4; ++m) { const int row = row0 + ai * 128 + m * 16;
#pragma unroll
                    for (int bj = 0; bj < 2; ++bj) *(u32x4*)(POOL + (size_t)row * 512 + (pn - 2) * 256 + bj * 128 + cl) = pack8(acc[ai][bj][m][0], acc[ai][bj][m][1]); }
        }
    }
};

struct SchedE3 {
    const char *CQ, *CKV, *WUQ, *WUK, *WUV; int G, c, nq, total;
    __device__ __forceinline__ bool next(int i, gm::Unit& u) const {
        int idx; if (!gm::flat_index(i, G, c, total, idx)) return false;
        int pm, pn; u.x3 = 0;
        if (idx < nq * 3) { gm::tile_order(idx, nq, 3, pm, pn);
            u.A = CQ + (size_t)pm * 256 * 512; u.lda = 512; u.B = WUQ + (size_t)pn * 256 * 512; u.ldb = 512; u.nt = 4; u.x0 = pm; u.x1 = pn; u.x2 = 0; return true; }
        int j = idx - nq * 3;
        if (j < 576) { gm::tile_order(j, 288, 2, pm, pn);
            u.A = CKV + (size_t)pm * 256 * 256; u.lda = 256; u.B = WUK + (size_t)pn * 256 * 256; u.ldb = 256; u.nt = 2; u.x0 = pm; u.x1 = pn; u.x2 = 1; return true; }
        j -= 576; pm = j & 1; pn = j >> 1;
        u.A = WUV + (size_t)pm * 256 * 256; u.lda = 256; u.B = CKV + (size_t)pn * 256 * 256; u.ldb = 256; u.nt = 2; u.x0 = pm; u.x1 = pn; u.x2 = 2; return true;
    }
};
struct EpiE3 {
    bf16 *Q, *KN, *VT; const float *SSQQ, *SSQK, *ropeC, *ropeS;
    __device__ __forceinline__ void operator()(AccRef acc, const gm::Unit& u, int wr, int wc, int fr, int fq) const {
        const int pm = u.x0, pn = u.x1, ty = u.x2, cl = wc * 32 + fq * 8;
        if (ty == 0) {
            const bool lat = pm < TLAT;
            float rq[2][4];
#pragma unroll
            for (int ai = 0; ai < 2; ++ai)
#pragma unroll
                for (int m = 0; m < 4; ++m) { const f32x4 sq = *(const f32x4*)(SSQQ + (size_t)(pm * 256 + wr * 64 + fr + ai * 128 + m * 16) * 4);
                    rq[ai][m] = __builtin_amdgcn_rsqf(((sq[0] + sq[1]) + (sq[2] + sq[3])) * (1.0f / 256.0f) + EPS); }
#pragma unroll
            for (int ai = 0; ai < 2; ++ai)
#pragma unroll
                for (int m = 0; m < 4; ++m) { const int row = pm * 256 + wr * 64 + fr + ai * 128 + m * 16;
#pragma unroll
                    for (int bj = 0; bj < 2; ++bj) { f32x4 a = acc[ai][bj][m][0] * rq[ai][m], b = acc[ai][bj][m][1] * rq[ai][m];
                        const int g32 = 8 * pn + 4 * bj + wc;
                        if (lat && (g32 % 3) == 2) rope8(a, b, fq, row & (SEQ - 1), ropeC, ropeS);
                        *(u32x4*)(Q + (size_t)row * QW + pn * 256 + bj * 128 + cl) = pack8(a, b); } }
        } else if (ty == 1) {
            float rk[2][4];
#pragma unroll
            for (int ai = 0; ai < 2; ++ai)
#pragma unroll
                for (int m = 0; m < 4; ++m) { const f32x4 sq = *(const f32x4*)(SSQK + (size_t)(pm * 256 + wr * 64 + fr + ai * 128 + m * 16) * 4);
                    rk[ai][m] = __builtin_amdgcn_rsqf(((sq[0] + sq[1]) + (sq[2] + sq[3])) * (1.0f / 128.0f) + EPS); }
#pragma unroll
            for (int ai = 0; ai < 2; ++ai)
#pragma unroll
                for (int m = 0; m < 4; ++m) { const int row = pm * 256 + wr * 64 + fr + ai * 128 + m * 16;
#pragma unroll
                    for (int bj = 0; bj < 2; ++bj) {
                        if (MK_QK8) { const f32x4 x0 = acc[ai][bj][m][0] * rk[ai][m], x1 = acc[ai][bj][m][1] * rk[ai][m]; u32x2 w; w.x = pk4_fp8(x0[0], x0[1], x0[2], x0[3]); w.y = pk4_fp8(x1[0], x1[1], x1[2], x1[3]);
                            *(u32x2*)((unsigned char*)KN + (size_t)row * 512 + pn * 256 + bj * 128 + cl) = w; }
                        else *(u32x4*)(KN + (size_t)row * 512 + pn * 256 + bj * 128 + cl) = pack8(acc[ai][bj][m][0] * rk[ai][m], acc[ai][bj][m][1] * rk[ai][m]); } }
        } else {
            const int b = pn < TLAT ? (pn >> 3) : (pn - TLAT), key0 = pn < TLAT ? ((pn & 7) * 256) : SEQ;
            f32x4 s0[2], s1[2];
#pragma unroll
            for (int bj = 0; bj < 2; ++bj)
#pragma unroll
                for (int j = 0; j < 8; ++j) { const f32x4 sq = *(const f32x4*)(SSQK + ((size_t)pn * 256 + bj * 128 + cl + j) * 4);
                    const float rk = __builtin_amdgcn_rsqf(((sq[0] + sq[1]) + (sq[2] + sq[3])) * (1.0f / 128.0f) + EPS);
                    if (j < 4) s0[bj][j] = rk; else s1[bj][j - 4] = rk; }
#pragma unroll
            for (int bj = 0; bj < 2; ++bj)
#pragma unroll
                for (int ai = 0; ai < 2; ++ai)
#pragma unroll
                    for (int m = 0; m < 4; ++m) { const int f = pm * 256 + wr * 64 + fr + ai * 128 + m * 16;
                        if (MK_PV8) {
                            const int kabs = key0 + bj * 128 + cl, k8 = (kabs & 63) >> 3; unsigned char* vp = (unsigned char*)VT + ((size_t)b * 512 + f) * NKEY + (kabs & ~63);
                            const f32x4 x0 = acc[ai][bj][m][0] * s0[bj], x1 = acc[ai][bj][m][1] * s1[bj];
                            *(unsigned*)(vp + 4 * k8) = pk4_fp8(x0[0], x0[1], x0[2], x0[3]); *(unsigned*)(vp + 32 + 4 * k8) = pk4_fp8(x1[0], x1[1], x1[2], x1[3]); }
                        else *(u32x4*)(VT + ((size_t)b * 512 + f) * NKEY + key0 + bj * 128 + cl) = pack8(acc[ai][bj][m][0] * s0[bj], acc[ai][bj][m][1] * s1[bj]); }
        }
    }
};

struct SchedResid {
    const char* A; const char* W; unsigned lda; int nt, nM, G, c;
    __device__ __forceinline__ bool next(int i, gm::Unit& u) const {
        int idx; if (!gm::flat_index(i, G, c, nM * 4, idx)) return false;
        int pm, pn; gm::tile_order(idx, nM, 4, pm, pn);
        u.A = A + (size_t)pm * 256 * lda; u.lda = lda; u.B = W + (size_t)pn * 256 * lda; u.ldb = lda; u.nt = nt; u.x0 = pm; u.x1 = pn; u.x2 = 0; u.x3 = 0; return true;
    }
};
struct EpiResid {
    const float *src_lat, *src_ctx; const bf16* src16; bf16* dst; const float* gate; float ascale;
    __device__ __forceinline__ void operator()(AccRef acc, const gm::Unit& u, int wr, int wc, int fr, int fq) const {
        const int pm = u.x0, pn = u.x1; const bool lat = pm < TLAT;
        const int b = lat ? (pm >> 3) : 32;
        const int col0 = pn * 256 + wc * 32 + fq * 8;
        f32x4 g[2][2];
#pragma unroll
        for (int bj = 0; bj < 2; ++bj) { g[bj][0] = *(const f32x4*)(gate + (size_t)b * 6144 + col0 + bj * 128) * ascale; g[bj][1] = *(const f32x4*)(gate + (size_t)b * 6144 + col0 + bj * 128 + 4) * ascale; }
        if (src16) {
            u32x4 xr[2][4][2];
#pragma unroll
            for (int ai = 0; ai < 2; ++ai)
#pragma unroll
                for (int m = 0; m < 4; ++m)
#pragma unroll
                    for (int bj = 0; bj < 2; ++bj) xr[ai][m][bj] = *(const u32x4*)(src16 + (size_t)(pm * 256 + wr * 64 + fr + ai * 128 + m * 16) * D + col0 + bj * 128);
#pragma unroll
            for (int ai = 0; ai < 2; ++ai)
#pragma unroll
                for (int m = 0; m < 4; ++m) { const size_t off = (size_t)(pm * 256 + wr * 64 + fr + ai * 128 + m * 16) * D + col0;
#pragma unroll
                    for (int bj = 0; bj < 2; ++bj) { const u32x4 w = xr[ai][m][bj];
                        const f32x4 x0 = (f32x4){__uint_as_float(w.x << 16), __uint_as_float(w.x & 0xffff0000u), __uint_as_float(w.y << 16), __uint_as_float(w.y & 0xffff0000u)};
                        const f32x4 x1 = (f32x4){__uint_as_float(w.z << 16), __uint_as_float(w.z & 0xffff0000u), __uint_as_float(w.w << 16), __uint_as_float(w.w & 0xffff0000u)};
                        *(u32x4*)(dst + off + bj * 128) = pack8(x0 + g[bj][0] * acc[ai][bj][m][0], x1 + g[bj][1] * acc[ai][bj][m][1]); } }
        } else {
            const float* sp = lat ? src_lat : src_ctx - (size_t)MLAT * D;
#pragma unroll
            for (int ai = 0; ai < 2; ++ai) {
                f32x4 xf[4][2][2];
#pragma unroll
                for (int m = 0; m < 4; ++m)
#pragma unroll
                    for (int bj = 0; bj < 2; ++bj) { const float* q = sp + (size_t)(pm * 256 + wr * 64 + fr + ai * 128 + m * 16) * D + col0 + bj * 128; xf[m][bj][0] = *(const f32x4*)q; xf[m][bj][1] = *(const f32x4*)(q + 4); }
                asm volatile("" ::: "memory");
#pragma unroll
                for (int m = 0; m < 4; ++m) { const size_t off = (size_t)(pm * 256 + wr * 64 + fr + ai * 128 + m * 16) * D + col0;
#pragma unroll
                    for (int bj = 0; bj < 2; ++bj) *(u32x4*)(dst + off + bj * 128) = pack8(xf[m][bj][0] + g[bj][0] * acc[ai][bj][m][0], xf[m][bj][1] + g[bj][1] * acc[ai][bj][m][1]); }
            }
        }
    }
};

struct SchedUp {
    const char* A; const char* W; int nM, nN, G, c; unsigned ld; int nt;
    __device__ __forceinline__ bool next(int i, gm::Unit& u) const {
        int idx; if (!gm::flat_index(i, G, c, nM * nN, idx)) return false;
        int pm, pn; gm::tile_order(idx, nM, nN, pm, pn);
        u.A = A + (size_t)pm * 256 * ld; u.lda = ld; u.B = W + (size_t)pn * 256 * ld; u.ldb = ld; u.nt = nt; u.x0 = pm; u.x1 = pn; u.x2 = 0; u.x3 = 0; return true;
    }
};
__device__ __forceinline__ f32x4 swiglu4s(const f32x4 a, const f32x4 b, float cexp, float cout) {
    const float lc = -__builtin_log2f(cout), ic = 1.0f / cout;
    f32x4 e;
#pragma unroll
    for (int j = 0; j < 4; ++j) e[j] = __builtin_amdgcn_exp2f(__builtin_fmaf(a[j], cexp, lc));
    const f32x4 d = e + ic; f32x4 r;
#pragma unroll
    for (int j = 0; j < 4; ++j) r[j] = __builtin_amdgcn_rcpf(d[j]);
    return (a * b) * r; }
__device__ __forceinline__ f32x4 swiglu4(const f32x4 a, const f32x4 b) { return swiglu4s(a, b, -1.4426950408889634f, 1.0f); }
struct EpiSwiglu {
    bf16* ACT; int ld;
    __device__ __forceinline__ void operator()(AccRef acc, const gm::Unit& u, int wr, int wc, int fr, int fq) const {
        const int row0 = u.x0 * 256 + wr * 64 + fr, col = u.x1 * 128 + wc * 32 + fq * 8;
#pragma unroll
        for (int ai = 0; ai < 2; ++ai)
#pragma unroll
            for (int m = 0; m < 4; ++m)
                *(u32x4*)(ACT + (size_t)(row0 + ai * 128 + m * 16) * ld + col) = pack8(swiglu4(acc[ai][0][m][0], acc[ai][1][m][0]), swiglu4(acc[ai][0][m][1], acc[ai][1][m][1]));
    }
};

struct SchedDftC {
    const char *WC, *HF; int G, c, total;
    __device__ __forceinline__ bool next(int i, gm::Unit& u) const {
        int idx; if (!gm::flat_index(i, G, c, total, idx)) return false;
        u.lda = 512; u.ldb = 2048; u.nt = 4; u.x3 = 0;
        if (idx < 1024) { const int bg = idx >> 3, kt = idx & 7, b = bg >> 2, g = bg & 3, ty = kt < 4 ? 0 : 1;
            u.A = WC + (size_t)ty * 256 * 512; u.B = HF + ((size_t)(b * SEQ + kt * 256) * D + g * 256) * 2; u.x0 = bg; u.x1 = kt; u.x2 = 0; return true; }
        const int j = idx - 1024, bg = j >> 1, ty = j & 1, b = bg >> 2, g = bg & 3;
        u.A = WC + (size_t)ty * 256 * 512; u.B = HF + ((size_t)(MLAT + b * LC) * D + g * 256) * 2; u.x0 = bg; u.x1 = 0; u.x2 = 1 + ty; return true;
    }
};
__device__ __forceinline__ unsigned pk4_fp8(float a, float b, float c, float d);
__device__ __forceinline__ u32x2 pack8_fp8(const f32x4 a, const f32x4 b) { u32x2 w; w.x = pk4_fp8(a[0], a[1], a[2], a[3]); w.y = pk4_fp8(b[0], b[1], b[2], b[3]); return w; }
struct EpiDftC {
    bf16 *Z, *ZC;
    __device__ __forceinline__ void operator()(AccRef acc, const gm::Unit& u, int wr, int wc, int fr, int fq) const {
        const int bg = u.x0, cl = wc * 32 + fq * 8;
        if (MK_FP8_DFT) {
            unsigned char* z8 = (unsigned char*)Z; unsigned char* zc8 = (unsigned char*)ZC;
#pragma unroll
            for (int ai = 0; ai < 2; ++ai)
#pragma unroll
                for (int m = 0; m < 4; ++m) { const int f = wr * 64 + fr + ai * 128 + m * 16;
                    if (u.x2 == 0) {
#pragma unroll
                        for (int bj = 0; bj < 2; ++bj) *(u32x2*)(z8 + ((size_t)bg * 256 + f) * 2048 + u.x1 * 256 + bj * 128 + cl) = pack8_fp8(acc[ai][bj][m][0], acc[ai][bj][m][1]); }
                    else if (u.x2 == 1) *(u32x2*)(zc8 + ((size_t)bg * 256 + f) * 256 + cl) = pack8_fp8(acc[ai][0][m][0], acc[ai][0][m][1]);
                    else *(u32x2*)(zc8 + ((size_t)bg * 256 + f) * 256 + 128 + cl) = pack8_fp8(acc[ai][1][m][0], acc[ai][1][m][1]); }
        } else
        if (u.x2 == 0) {
#pragma unroll
            for (int ai = 0; ai < 2; ++ai)
#pragma unroll
                for (int m = 0; m < 4; ++m) { const int f = wr * 64 + fr + ai * 128 + m * 16;
#pragma unroll
                    for (int bj = 0; bj < 2; ++bj) *(u32x4*)(Z + ((size_t)bg * 256 + f) * 2048 + u.x1 * 256 + bj * 128 + cl) = pack8(acc[ai][bj][m][0], acc[ai][bj][m][1]); }
        } else {
            if (u.x2 == 1) {
#pragma unroll
                for (int ai = 0; ai < 2; ++ai)
#pragma unroll
                    for (int m = 0; m < 4; ++m) { const int f = wr * 64 + fr + ai * 128 + m * 16;
                        *(u32x4*)(ZC + ((size_t)bg * 256 + f) * 256 + cl) = pack8(acc[ai][0][m][0], acc[ai][0][m][1]); }
            } else {
#pragma unroll
                for (int ai = 0; ai < 2; ++ai)
#pragma unroll
                    for (int m = 0; m < 4; ++m) { const int f = wr * 64 + fr + ai * 128 + m * 16;
                        *(u32x4*)(ZC + ((size_t)bg * 256 + f) * 256 + 128 + cl) = pack8(acc[ai][1][m][0], acc[ai][1][m][1]); }
            }
        }
    }
};

struct SchedDftS {
    const char *WL, *WX, *Z, *ZC; int G, c, total;
    __device__ __forceinline__ bool next(int i, gm::Unit& u) const {
        int idx; if (!gm::flat_index(i, G, c, total, idx)) return false;
        u.x3 = 0;
        if (idx < 1024) { const int bg = idx >> 3, kt = idx & 7;
            constexpr unsigned P = MK_FP8_DFT ? 2048u : 4096u;
            u.A = WL + (size_t)kt * 256 * P; u.lda = P; u.B = Z + (size_t)bg * 256 * P; u.ldb = P; u.nt = 32 / (MK_FP8_DFT ? 2 : 1); u.x0 = bg; u.x1 = kt; u.x2 = 0; return true; }
        const int bg = idx - 1024; constexpr unsigned PX = MK_FP8_DFT ? 256u : 512u;
        u.A = WX; u.lda = PX; u.B = ZC + (size_t)bg * 256 * PX; u.ldb = PX; u.nt = 4 / (MK_FP8_DFT ? 2 : 1); u.x0 = bg; u.x1 = 0; u.x2 = 1; return true;
    }
};
struct EpiDftS {
    bf16* F; const float* AMID;
    __device__ __forceinline__ void operator()(AccRef acc, const gm::Unit& u, int wr, int wc, int fr, int fq) const {
        const int bg = u.x0, b = bg >> 2, g = bg & 3, cl = wc * 32 + fq * 8; const bool cx = u.x2 != 0;
        constexpr float TS = MK_FP8_DFT ? (1.0f / 16.0f) : 1.0f;
        const float scale = cx ? (1.0f / 256.0f) : 0.0013810679320049757f;
        const size_t rbase = cx ? (size_t)(MLAT + b * LC) : (size_t)b * SEQ + u.x1 * 256;
        const float* am = AMID + (size_t)(cx ? 32 + b : b) * D + g * 256;
        f32x4 a4[2][2];
#pragma unroll
        for (int bj = 0; bj < 2; ++bj) { a4[bj][0] = *(const f32x4*)(am + bj * 128 + cl); a4[bj][1] = *(const f32x4*)(am + bj * 128 + cl + 4); }
#pragma unroll
        for (int ai = 0; ai < 2; ++ai)
#pragma unroll
            for (int m = 0; m < 4; ++m) { const int k = wr * 64 + fr + ai * 128 + m * 16; const float sg = (k & 1) ? -1.0f : 1.0f;
#pragma unroll
                for (int bj = 0; bj < 2; ++bj)
                    *(u32x4*)(F + (rbase + k) * D + g * 256 + bj * 128 + cl) = pack8((acc[ai][bj][m][0] * TS + a4[bj][0] * sg) * scale, (acc[ai][bj][m][1] * TS + a4[bj][1] * sg) * scale); }
    }
};

constexpr float W8_SCALE = 32.0f, A8_SCALE = 4.0f;
__device__ __forceinline__ unsigned pk4_fp8(float a, float b, float c, float d) {
    a = __builtin_amdgcn_fmed3f(a, -448.f, 448.f); b = __builtin_amdgcn_fmed3f(b, -448.f, 448.f); c = __builtin_amdgcn_fmed3f(c, -448.f, 448.f); d = __builtin_amdgcn_fmed3f(d, -448.f, 448.f);
    int w = 0; w = __builtin_amdgcn_cvt_pk_fp8_f32(a, b, w, false); w = __builtin_amdgcn_cvt_pk_fp8_f32(c, d, w, true); return (unsigned)w; }
struct MoeInfo { int cnt[8]; int nt; };
__device__ __forceinline__ void moe_info(const unsigned* cntw, MoeInfo& mi) {
    int t = 0;
#pragma unroll
    for (int e = 0; e < 8; ++e) { mi.cnt[e] = (int)__builtin_amdgcn_readfirstlane(__hip_atomic_load(cntw + 64 * e, __ATOMIC_RELAXED, __HIP_MEMORY_SCOPE_AGENT)); t += (mi.cnt[e] + 255) >> 8; }
    mi.nt = t;
}
__device__ __forceinline__ void moe_find(const MoeInfo& mi, int gt, int& e, int& rt, int& cnt) {
    e = 0; rt = gt; cnt = mi.cnt[0]; int tb = 0;
#pragma unroll
    for (int k = 1; k < 8; ++k) { tb += (mi.cnt[k - 1] + 255) >> 8; if (gt >= tb) { e = k; rt = gt - tb; cnt = mi.cnt[k]; } }
}
struct SchedMoeUp {
    const char *H2, *W13; const int* list; MoeInfo mi; int G, c;
    __device__ __forceinline__ bool next(int i, gm::Unit& u) const {
        int idx; if (!gm::flat_index(i, G, c, mi.nt * 28, idx)) return false;
        int gt, pn; gm::tile_order(idx, mi.nt, 28, gt, pn);
        int e, rt, cnt; moe_find(mi, gt, e, rt, cnt);
        u.A = H2; u.lda = 2048; u.B = W13 + ((size_t)e * 7168 + (size_t)pn * 256) * 2048; u.ldb = 2048; u.nt = 16; u.x0 = gt; u.x1 = pn; u.x2 = e * 65536 * 2 + cnt; u.x3 = rt * 256; return true;
    }
    __device__ __forceinline__ int gather_row(const gm::Unit& u, int lr) const {
        const int e = u.x2 >> 17, cnt = u.x2 & 0x1ffff; int j = u.x3 + lr; j = j < cnt ? j : cnt - 1;
        return list[(size_t)e * MALL + j];
    }
};
struct SchedMoeUp8 {
    const char *H2, *W13; const int* list; MoeInfo mi; int G, c;
    int rd;
    __device__ __forceinline__ bool next(int i, gm::Unit& u) const {
        const int F = G - rd; int pos;
        if (c < rd) pos = MOE_SKIP * F + i * G + c;
        else pos = i < MOE_SKIP ? i * F + (c - rd) : MOE_SKIP * F + (i - MOE_SKIP) * G + c;
        int idx; if (!gm::flat_pos(pos, mi.nt * 28, idx)) return false;
        int gt, pn; gm::tile_order(idx, mi.nt, 28, gt, pn);
        int e, rt, cnt; moe_find(mi, gt, e, rt, cnt);
        u.A = H2; u.lda = 1024; u.B = W13 + ((size_t)e * 7168 + (size_t)pn * 256) * 1024; u.ldb = 1024; u.nt = 8; u.x0 = gt; u.x1 = pn; u.x2 = e * 65536 * 2 + cnt; u.x3 = rt * 256; return true;
    }
    __device__ __forceinline__ int gather_row(const gm::Unit& u, int lr) const {
        const int e = u.x2 >> 17, cnt = u.x2 & 0x1ffff; int j = u.x3 + lr; j = j < cnt ? j : cnt - 1;
        return list[(size_t)e * MALL + j];
    }
};
struct EpiSwiglu8 {
    unsigned char* ACT8; int ld;
    __device__ __forceinline__ void operator()(AccRef acc, const gm::Unit& u, int wr, int wc, int fr, int fq) const {
        const int row0 = u.x0 * 256 + wr * 64 + fr, col = u.x1 * 128 + wc * 32 + fq * 8;
#pragma unroll 1
        for (int rep_ = 0; rep_ < 1 + (int)((MK_DUP >> 24) & 1u); ++rep_)
#pragma unroll
        for (int ai = 0; ai < 2; ++ai)
#pragma unroll
            for (int m = 0; m < 4; ++m) {
                constexpr float CE = -1.4426950408889634f / W8_SCALE, CO = A8_SCALE / (W8_SCALE * W8_SCALE);
                const f32x4 v0 = swiglu4s(acc[ai][0][m][0], acc[ai][1][m][0], CE, CO), v1 = swiglu4s(acc[ai][0][m][1], acc[ai][1][m][1], CE, CO);
                u32x2 w; w.x = pk4_fp8(v0[0], v0[1], v0[2], v0[3]); w.y = pk4_fp8(v1[0], v1[1], v1[2], v1[3]);
                *(u32x2*)(ACT8 + (size_t)(row0 + ai * 128 + m * 16) * ld + col) = w; }
    }
};
struct SchedMoeDown8 {
    const char *Ab, *W2; MoeInfo mi; int G, c;
    __device__ __forceinline__ bool next(int i, gm::Unit& u) const {
        int idx; if (!gm::flat_index(i, G, c, mi.nt * 4, idx)) return false;
        int gt, pn; gm::tile_order(idx, mi.nt, 4, gt, pn);
        int e, rt, cnt; moe_find(mi, gt, e, rt, cnt);
        u.A = Ab + (size_t)gt * 256 * 3584; u.lda = 3584; u.B = W2 + ((size_t)e * 1024 + (size_t)pn * 256) * 3584; u.ldb = 3584; u.nt = 28; u.x0 = gt; u.x1 = pn; u.x2 = e * 65536 * 2 + cnt; u.x3 = rt * 256; return true;
    }
};
struct SchedMoeUpDense {
    const char *H2, *W13; MoeInfo mi; int G, c;
    __device__ __forceinline__ bool next(int i, gm::Unit& u) const {
        int idx; if (!gm::flat_index(i, G, c, mi.nt * 28, idx)) return false;
        int gt, pn; gm::tile_order(idx, mi.nt, 28, gt, pn);
        int e, rt, cnt; moe_find(mi, gt, e, rt, cnt);
        u.A = H2 + (size_t)(gt & 255) * 256 * 2048; u.lda = 2048; u.B = W13 + ((size_t)e * 7168 + (size_t)pn * 256) * 2048; u.ldb = 2048; u.nt = 16; u.x0 = gt; u.x1 = pn; u.x2 = 0; u.x3 = 0; return true;
    }
};
struct SchedMoeDown {
    const char *Ab, *W2; MoeInfo mi; int G, c;
    __device__ __forceinline__ bool next(int i, gm::Unit& u) const {
        int idx; if (!gm::flat_index(i, G, c, mi.nt * 4, idx)) return false;
        int gt, pn; gm::tile_order(idx, mi.nt, 4, gt, pn);
        int e, rt, cnt; moe_find(mi, gt, e, rt, cnt);
        u.A = Ab + (size_t)gt * 256 * 7168; u.lda = 7168; u.B = W2 + ((size_t)e * 1024 + (size_t)pn * 256) * 7168; u.ldb = 7168; u.nt = 56; u.x0 = gt; u.x1 = pn; u.x2 = e * 65536 * 2 + cnt; u.x3 = rt * 256; return true;
    }
};
struct EpiMoeDown {
    bf16* x16; const bf16* gate16; const int* list; const float* glist; float ascale; bf16* dst16;
    __device__ __forceinline__ void operator()(AccRef acc, const gm::Unit& u, int wr, int wc, int fr, int fq) const {
        const int e = u.x2 >> 17, cnt = u.x2 & 0x1ffff, col0 = u.x1 * 256 + wc * 32 + fq * 8;
        int tok[2][4]; float gv[2][4];
#pragma unroll
        for (int ai = 0; ai < 2; ++ai)
#pragma unroll
            for (int m = 0; m < 4; ++m) { int j = u.x3 + wr * 64 + fr + ai * 128 + m * 16; const bool ok = j < cnt; j = ok ? j : cnt - 1;
                const int t = list[(size_t)e * MALL + j]; tok[ai][m] = ok ? t : -1 - t; gv[ai][m] = glist[(size_t)e * MALL + j] * ascale; }
#pragma unroll
        for (int bj = 0; bj < 2; ++bj)
#pragma unroll
        for (int ai = 0; ai < 2; ++ai) {
            u32x4 xr[4], gr[4];
#pragma unroll
            for (int m = 0; m < 4; ++m) { const int t = tok[ai][m] < 0 ? -1 - tok[ai][m] : tok[ai][m]; const int b = t < MLAT ? (t >> 11) : 32;
                xr[m] = *(const u32x4*)(x16 + (size_t)t * D + col0 + bj * 128); gr[m] = *(const u32x4*)(gate16 + (size_t)b * 1024 + col0 + bj * 128); }
            asm volatile("" ::: "memory");
#pragma unroll
            for (int m = 0; m < 4; ++m) { const int t = tok[ai][m];
                if (t >= 0) { const u32x4 w = xr[m], q = gr[m]; const float s = gv[ai][m];
                    const f32x4 x0 = (f32x4){__uint_as_float(w.x << 16), __uint_as_float(w.x & 0xffff0000u), __uint_as_float(w.y << 16), __uint_as_float(w.y & 0xffff0000u)};
                    const f32x4 x1 = (f32x4){__uint_as_float(w.z << 16), __uint_as_float(w.z & 0xffff0000u), __uint_as_float(w.w << 16), __uint_as_float(w.w & 0xffff0000u)};
                    const f32x4 g0 = (f32x4){__uint_as_float(q.x << 16), __uint_as_float(q.x & 0xffff0000u), __uint_as_float(q.y << 16), __uint_as_float(q.y & 0xffff0000u)} * s;
                    const f32x4 g1 = (f32x4){__uint_as_float(q.z << 16), __uint_as_float(q.z & 0xffff0000u), __uint_as_float(q.w << 16), __uint_as_float(q.w & 0xffff0000u)} * s;
                    *(u32x4*)(dst16 + (size_t)t * D + col0 + bj * 128) = pack8(x0 + g0 * acc[ai][bj][m][0], x1 + g1 * acc[ai][bj][m][1]); } }
        }
    }
};

struct ModP { f32x4 gm[4]; f32x4 sh[4]; };
__device__ __forceinline__ void load_modp(ModP& p, const float* g, const float* modrow, int off_sh, int off_sc, int lane) {
#pragma unroll
    for (int j = 0; j < 4; ++j) { const int c = 4 * lane + 256 * j;
        const f32x4 g4 = *(const f32x4*)(g + c), sc = *(const f32x4*)(modrow + off_sc + c);
        p.gm[j] = g4 * (sc + 1.0f); p.sh[j] = *(const f32x4*)(modrow + off_sh + c); }
}
struct XSrc { const float* lat; const float* ctx; const bf16* x16; };
__device__ __forceinline__ void load_xrow(const XSrc& xs, int row, int lane, f32x4 (&v)[4]) {
    if (xs.x16) { const u32x2* p = (const u32x2*)(xs.x16 + (size_t)row * D);
#pragma unroll
        for (int j = 0; j < 4; ++j) { const u32x2 w = NTLD(p + lane + 64 * j); v[j] = (f32x4){__uint_as_float(w.x << 16), __uint_as_float(w.x & 0xffff0000u), __uint_as_float(w.y << 16), __uint_as_float(w.y & 0xffff0000u)}; } }
    else { const f32x4* p = (const f32x4*)(row < MLAT ? xs.lat + (size_t)row * D : xs.ctx + (size_t)(row - MLAT) * D);
#pragma unroll
        for (int j = 0; j < 4; ++j) v[j] = NTLD(p + lane + 64 * j); }
}
struct XRaw { u32x2 w[4]; f32x4 f[4]; };
__device__ __forceinline__ void load_xraw(const XSrc& xs, int row, int lane, XRaw& r) {
    if (xs.x16) { const u32x2* p = (const u32x2*)(xs.x16 + (size_t)row * D);
#pragma unroll
        for (int j = 0; j < 4; ++j) r.w[j] = NTLD(p + lane + 64 * j); }
    else { const f32x4* p = (const f32x4*)(row < MLAT ? xs.lat + (size_t)row * D : xs.ctx + (size_t)(row - MLAT) * D);
#pragma unroll
        for (int j = 0; j < 4; ++j) r.f[j] = NTLD(p + lane + 64 * j); }
}
__device__ __forceinline__ void mod_row_raw(const XSrc& xs, const XRaw& r, const ModP& p, f32x4 (&h)[4]) {
    f32x4 v[4]; float ss = 0.f;
    if (xs.x16) {
#pragma unroll
        for (int j = 0; j < 4; ++j) { const u32x2 w = r.w[j]; v[j] = (f32x4){__uint_as_float(w.x << 16), __uint_as_float(w.x & 0xffff0000u), __uint_as_float(w.y << 16), __uint_as_float(w.y & 0xffff0000u)}; } }
    else {
#pragma unroll
        for (int j = 0; j < 4; ++j) v[j] = r.f[j]; }
#pragma unroll
    for (int j = 0; j < 4; ++j) ss += (v[j][0] * v[j][0] + v[j][1] * v[j][1]) + (v[j][2] * v[j][2] + v[j][3] * v[j][3]);
    ss = wave_sum(ss);
    const float rr = 1.0f / sqrtf(ss * (1.0f / D) + EPS);
#pragma unroll
    for (int j = 0; j < 4; ++j) h[j] = (v[j] * rr) * p.gm[j] + p.sh[j];
}
__device__ __forceinline__ void mod_row(const XSrc& xs, int row, const ModP& p, int lane, f32x4 (&h)[4]) {
    f32x4 v[4]; float ss = 0.f; load_xrow(xs, row, lane, v);
#pragma unroll
    for (int j = 0; j < 4; ++j) { ss += (v[j][0] * v[j][0] + v[j][1] * v[j][1]) + (v[j][2] * v[j][2] + v[j][3] * v[j][3]); }
    ss = wave_sum(ss);
    const float r = 1.0f / sqrtf(ss * (1.0f / D) + EPS);
#pragma unroll
    for (int j = 0; j < 4; ++j) h[j] = (v[j] * r) * p.gm[j] + p.sh[j];
}
__device__ __forceinline__ void store_row_bf16(bf16* dst, const f32x4 (&h)[4], int lane) {
#pragma unroll
    for (int j = 0; j < 4; ++j) { u32x2 w; w.x = pkbf(h[j][0], h[j][1]); w.y = pkbf(h[j][2], h[j][3]); ((u32x2*)dst)[lane + 64 * j] = w; }
}

__device__ __forceinline__ void phase_mod_plain(const XSrc& xs, const float* g, const float* modbase, int off_sh, int off_sc, bf16* H, bool out8, int nrows, int gw, int NGW, int lane) {
    const int rpw = (nrows + NGW - 1) / NGW; const int r0 = gw * rpw; int r1 = r0 + rpw; if (r1 > nrows) r1 = nrows;
    int curb = -1; ModP p; XRaw cur, nxt; nxt = XRaw{};
    if (r0 < r1) load_xraw(xs, r0, lane, cur);
    for (int row = r0; row < r1; ++row) {
        if (row + 1 < r1) load_xraw(xs, row + 1, lane, nxt);
        const int b = row < MLAT ? (row >> 11) : 32;
        if (b != curb) { load_modp(p, g, modbase + (size_t)b * 6144, off_sh, off_sc, lane); curb = b; }
        f32x4 h[4]; mod_row_raw(xs, cur, p, h); cur = nxt;
        if (out8) { unsigned char* o8 = (unsigned char*)H + (size_t)row * D;
#pragma unroll
            for (int j = 0; j < 4; ++j) ((unsigned*)o8)[lane + 64 * j] = pk4_fp8(h[j][0], h[j][1], h[j][2], h[j][3]); }
        else store_row_bf16(H + (size_t)row * D, h, lane);
    }
}

__device__ __forceinline__ void phase_mod_fold(const XSrc& xs, const float* g, const float* modbase, bf16* HF, float* HMID, bool with_ctx, int gw, int NGW, int lane) {
    constexpr int IL = SEQ / 2 + 1, IC = LC / 2 + 1;
    const int nitems = NB * IL + (with_ctx ? NB * IC : 0);
    const int ipw = (nitems + NGW - 1) / NGW; const int i0 = gw * ipw; int i1 = i0 + ipw; if (i1 > nitems) i1 = nitems;
    int curb = -1; ModP p;
    for (int it = i0; it < i1; ++it) {
        const bool cx = it >= NB * IL; const int j = cx ? it - NB * IL : it;
        const int b = cx ? j / IC : j / IL, n = cx ? j % IC : j % IL, Ls = cx ? LC : SEQ;
        const int mb = cx ? 32 : b, key = cx ? 64 : b;
        if (key != curb) { load_modp(p, g, modbase + (size_t)mb * 6144, 0, 1024, lane); curb = key; }
        const int rbase = cx ? MLAT + b * LC : b * SEQ;
        bf16* hf = HF + (size_t)rbase * D;
        f32x4 h1[4]; mod_row(xs, rbase + n, p, lane, h1);
        if (n == 0) { store_row_bf16(hf, h1, lane); f32x4 z[4];
#pragma unroll
            for (int q = 0; q < 4; ++q) z[q] = (f32x4){0.f, 0.f, 0.f, 0.f};
            store_row_bf16(hf + (size_t)(Ls / 2) * D, z, lane); }
        else if (n == Ls / 2) { float* hm = HMID + (size_t)(cx ? 32 + b : b) * D;
#pragma unroll
            for (int q = 0; q < 4; ++q) ((f32x4*)hm)[lane + 64 * q] = h1[q]; }
        else { f32x4 h2[4]; mod_row(xs, rbase + Ls - n, p, lane, h2); f32x4 s[4], d[4];
#pragma unroll
            for (int q = 0; q < 4; ++q) { s[q] = h1[q] + h2[q]; d[q] = h1[q] - h2[q]; }
            store_row_bf16(hf + (size_t)n * D, s, lane); store_row_bf16(hf + (size_t)(Ls / 2 + n) * D, d, lane); }
    }
}

constexpr int RW_REG = 8;
template <bool ROUTER>
__device__ __forceinline__ void phase_mod2(const XSrc& xs, const float* g, const float* modbase, bf16* H2, bool out8, int nrows,
                                           const float* router_w, unsigned* gcnt, int* list, float* glist, LAS unsigned char* lds, int vcu, int G, int wave, int lane, int tid) {
    const int rpb = nrows / G, rpw = rpb / 8;
    const int r0 = vcu * rpb + wave * rpw;
    LAS float* rwT = (LAS float*)lds; LAS int* bcnt = (LAS int*)(lds + 32768); LAS int* bbase = (LAS int*)(lds + 32768 + 64);
    if constexpr (ROUTER) {
        for (int i = tid; i < 8192; i += 512) { const int c = i >> 3, e = i & 7; rwT[e * 1024 + c] = router_w[i]; }
        if (tid < 16) bcnt[tid] = 0;
        __syncthreads();
    }
    int curb = -1; ModP p; int me0 = -1, me1 = -1; float mp0 = 0.f, mp1 = 0.f; XRaw cur, nxt; nxt = XRaw{};
    f32x4 rwr[RW_REG][4];
    if constexpr (ROUTER) {
#pragma unroll
        for (int e = 0; e < RW_REG; ++e)
#pragma unroll
            for (int j = 0; j < 4; ++j) rwr[e][j] = *(const LAS f32x4*)(rwT + e * 1024 + 4 * lane + 256 * j);
    }
    load_xraw(xs, r0, lane, cur);
    for (int rr = 0; rr < rpw; ++rr) {
        const int row = r0 + rr; const int b = row < MLAT ? (row >> 11) : 32;
        if (rr + 1 < rpw) load_xraw(xs, row + 1, lane, nxt);
        if (b != curb) { load_modp(p, g, modbase + (size_t)b * 6144, 3072, 4096, lane); curb = b; }
        f32x4 h[4]; mod_row_raw(xs, cur, p, h); cur = nxt;
        if (out8) { unsigned char* o8 = (unsigned char*)H2 + (size_t)row * D;
#pragma unroll
            for (int j = 0; j < 4; ++j) ((unsigned*)o8)[lane + 64 * j] = pk4_fp8(h[j][0], h[j][1], h[j][2], h[j][3]); }
        else store_row_bf16(H2 + (size_t)row * D, h, lane);
        if constexpr (ROUTER) {
            asm volatile("" ::: "memory");
            float lg[8];
#pragma unroll
            for (int e = 0; e < 8; ++e) { float s = 0.f;
#pragma unroll
                for (int j = 0; j < 4; ++j) { const f32x4 w = e < RW_REG ? rwr[e][j] : *(const LAS f32x4*)(rwT + e * 1024 + 4 * lane + 256 * j); s += (h[j][0] * w[0] + h[j][1] * w[1]) + (h[j][2] * w[2] + h[j][3] * w[3]); }
                lg[e] = s; }
            {
                const bool b5 = (lane & 32) != 0, b4 = (lane & 16) != 0, b3 = (lane & 8) != 0;
                float v4[4], v2[2];
#pragma unroll
                for (int j = 0; j < 4; ++j) { const float snd = b5 ? lg[j] : lg[4 + j], kp = b5 ? lg[4 + j] : lg[j]; v4[j] = kp + __shfl_xor(snd, 32); }
#pragma unroll
                for (int j = 0; j < 2; ++j) { const float snd = b4 ? v4[j] : v4[2 + j], kp = b4 ? v4[2 + j] : v4[j]; v2[j] = kp + __shfl_xor(snd, 16); }
                float v1; { const float snd = b3 ? v2[0] : v2[1], kp = b3 ? v2[1] : v2[0]; v1 = kp + __shfl_xor(snd, 8); }
                v1 += __shfl_xor(v1, 4); v1 += __shfl_xor(v1, 2); v1 += __shfl_xor(v1, 1);
#pragma unroll
                for (int e = 0; e < 8; ++e) lg[e] = __uint_as_float((unsigned)__builtin_amdgcn_readlane((int)__float_as_uint(v1), e * 8));
            }
            int e0 = 0; float v0 = lg[0];
#pragma unroll
            for (int e = 1; e < 8; ++e) if (lg[e] > v0) { v0 = lg[e]; e0 = e; }
            int e1 = -1; float v1 = -3.0e38f;
#pragma unroll
            for (int e = 0; e < 8; ++e) if (e != e0 && lg[e] > v1) { v1 = lg[e]; e1 = e; }
            const float p0 = 1.0f / (1.0f + __expf(v1 - v0));
            if (lane == rr) { me0 = e0; me1 = e1; mp0 = p0; mp1 = 1.0f - p0; }
        }
    }
    if constexpr (ROUTER) {
        int rank0 = 0, rank1 = 0, mycnt = 0;
        const unsigned long long lt = (lane == 0) ? 0ull : (~0ull >> (64 - lane));
#pragma unroll
        for (int e = 0; e < 8; ++e) {
            const unsigned long long m0 = __ballot(me0 == e), m1 = __ballot(me1 == e);
            if (me0 == e) rank0 = __popcll(m0 & lt);
            if (me1 == e) rank1 = __popcll(m1 & lt);
            if (lane == e) mycnt = __popcll(m0);
            if (lane == 8 + e) mycnt = __popcll(m1);
        }
        int woff = 0;
        if (lane < 16) woff = __hip_atomic_fetch_add(bcnt + lane, mycnt, __ATOMIC_RELAXED, __HIP_MEMORY_SCOPE_WORKGROUP);
        __syncthreads();
        if (tid < 16) bbase[tid] = (int)__hip_atomic_fetch_add(gcnt + 64 * tid, (unsigned)bcnt[tid], __ATOMIC_RELAXED, __HIP_MEMORY_SCOPE_AGENT);
        __syncthreads();
        const int w0 = __shfl(woff, me0 < 0 ? 0 : me0), w1 = __shfl(woff, me1 < 0 ? 8 : 8 + me1);
        if (me0 >= 0) { const int row = r0 + lane;
            const int p0 = bbase[me0] + w0 + rank0, p1 = bbase[8 + me1] + w1 + rank1;
            list[(size_t)me0 * MALL + p0] = row; glist[(size_t)me0 * MALL + p0] = mp0;
            list[(size_t)(8 + me1) * MALL + p1] = row; glist[(size_t)(8 + me1) * MALL + p1] = mp1; }
        __syncthreads();
    }
}

__device__ __forceinline__ void phase_final(const bf16* x16, float* out, const float* g, int gw, int NGW, int lane) {
    const int rpw = (MLAT + NGW - 1) / NGW; const int r0 = gw * rpw; int r1 = r0 + rpw; if (r1 > MLAT) r1 = MLAT;
    f32x4 g4[4];
#pragma unroll
    for (int j = 0; j < 4; ++j) g4[j] = *(const f32x4*)(g + 4 * lane + 256 * j);
    XSrc xs{nullptr, nullptr, x16};
    for (int row = r0; row < r1; ++row) { f32x4 v[4]; float ss = 0.f; load_xrow(xs, row, lane, v);
#pragma unroll
        for (int j = 0; j < 4; ++j) ss += (v[j][0] * v[j][0] + v[j][1] * v[j][1]) + (v[j][2] * v[j][2] + v[j][3] * v[j][3]);
        ss = wave_sum(ss); const float r = 1.0f / sqrtf(ss * (1.0f / D) + EPS);
#pragma unroll
        for (int j = 0; j < 4; ++j) NTST((f32x4*)(out + (size_t)row * D) + lane + 64 * j, (v[j] * r) * g4[j]); }
}

__device__ __forceinline__ void phase_pool(const bf16* POOL, bf16* MIXCAT, int nrows, int gw, int NGW, int lane) {
    const int rs = lane >> 4, cb = lane & 15;
    for (int it = gw; it < (nrows / 64) * 4; it += NGW) { const int seg = it >> 2, g = it & 3, w = 2 << g, hw = w >> 1;
        const int row0 = seg * 64 + rs * 16;
        const int Ls = row0 < MLAT ? SEQ : LC, sb = row0 < MLAT ? (row0 & ~(SEQ - 1)) : (MLAT + ((row0 - MLAT) & ~(LC - 1))), t0 = row0 - sb;
        const bf16* src = POOL + (size_t)sb * 512 + g * 128 + cb * 8; bf16* dstp = MIXCAT + (size_t)sb * D + 512 + g * 128 + cb * 8;
        float s[8];
#pragma unroll
        for (int k = 0; k < 8; ++k) s[k] = 0.f;
        for (int j = 0; j < w; ++j) { const int tt = t0 - hw + j;
            if (tt >= 0 && tt < Ls) { const u32x4 v = *(const u32x4*)(src + (size_t)tt * 512);
#pragma unroll
                for (int k = 0; k < 4; ++k) { s[2 * k] += __uint_as_float(v[k] << 16); s[2 * k + 1] += __uint_as_float(v[k] & 0xffff0000u); } } }
#pragma unroll 4
        for (int q = 0; q < 16; ++q) { const int t = t0 + q;
            int lo = t - hw; if (lo < 0) lo = 0; int hi = t + hw; if (hi > Ls) hi = Ls;
            const u32x4 self = *(const u32x4*)(src + (size_t)t * 512);
            const int tin = t + hw, tout = t - hw;
            u32x4 vin = (u32x4){0u, 0u, 0u, 0u}, vout = (u32x4){0u, 0u, 0u, 0u};
            if (q < 15) { if (tin < Ls) vin = *(const u32x4*)(src + (size_t)tin * 512); if (tout >= 0) vout = *(const u32x4*)(src + (size_t)tout * 512); }
            const float inv = 1.0f / (float)(hi - lo); u32x4 o;
#pragma unroll
            for (int k = 0; k < 4; ++k) o[k] = pkbf(s[2 * k] * inv - __uint_as_float(self[k] << 16), s[2 * k + 1] * inv - __uint_as_float(self[k] & 0xffff0000u));
            *(u32x4*)(dstp + (size_t)t * D) = o;
#pragma unroll
            for (int k = 0; k < 4; ++k) { s[2 * k] += __uint_as_float(vin[k] << 16) - __uint_as_float(vout[k] << 16); s[2 * k + 1] += __uint_as_float(vin[k] & 0xffff0000u) - __uint_as_float(vout[k] & 0xffff0000u); } }
    }
}

__device__ __forceinline__ void phase_amid(const float* HMID_, float* AMID_, LAS unsigned char* lds, int G, int bid, int tid) {
    LAS float* ct = (LAS float*)lds;
    if (tid < 256) ct[tid] = cospif((float)tid * (1.0f / 128.0f));
    __syncthreads();
    for (int o = bid * 512 + tid; o < 64 * 1024; o += G * 512) { const int r = o >> 10, gq = (o >> 8) & 3, m = o & 255;
        const float* hp = HMID_ + (size_t)r * D + gq * 256; float s = 0.f;
#pragma unroll 4
        for (int c = 0; c < 256; ++c) s += hp[c] * ct[(m * c) & 255];
        AMID_[o] = s; }
    __syncthreads();
}

constexpr int AT_KP = 208, AT_VP = 136, AT_VP8 = 80, AT_VOFF = 64 * AT_KP, AT_BUF = 22528;
__device__ __forceinline__ f32x16 mfma32(bf16x8 a, bf16x8 b, f32x16 c) { return __builtin_amdgcn_mfma_f32_32x32x16_bf16(a, b, c, 0, 0, 0); }
__device__ __forceinline__ bf16x8 pack_s(const f32x16& x, int s) {
    u32x4 p; p.x = pkbf(x[8 * s], x[8 * s + 1]); p.y = pkbf(x[8 * s + 2], x[8 * s + 3]); p.z = pkbf(x[8 * s + 4], x[8 * s + 5]); p.w = pkbf(x[8 * s + 6], x[8 * s + 7]);
    return __builtin_bit_cast(bf16x8, p);
}
__device__ __forceinline__ gm::v8i_t pack_p8(const f32x16& x0, const f32x16& x1) {
    gm::v8i_t p;
#pragma unroll
    for (int d = 0; d < 4; ++d) { int w = 0; w = __builtin_amdgcn_cvt_pk_fp8_f32(x0[4 * d], x0[4 * d + 1], w, false); w = __builtin_amdgcn_cvt_pk_fp8_f32(x0[4 * d + 2], x0[4 * d + 3], w, true); p[d] = w;
        int v = 0; v = __builtin_amdgcn_cvt_pk_fp8_f32(x1[4 * d], x1[4 * d + 1], v, false); v = __builtin_amdgcn_cvt_pk_fp8_f32(x1[4 * d + 2], x1[4 * d + 3], v, true); p[4 + d] = v; }
    return p;
}
#define AT_MX3(a, b, c) __builtin_fmaxf(__builtin_fmaxf((a), (b)), (c))
#define AT_SOFTMAX(S0, S1, M, L, O0, O1, FIRST) do { \
        float ma_ = AT_MX3(S0[0], S0[1], S0[2]), mb_ = AT_MX3(S0[3], S0[4], S0[5]), mc_ = AT_MX3(S1[0], S1[1], S1[2]), md_ = AT_MX3(S1[3], S1[4], S1[5]); \
        ma_ = AT_MX3(ma_, S0[6], S0[7]); mb_ = AT_MX3(mb_, S0[8], S0[9]); mc_ = AT_MX3(mc_, S1[6], S1[7]); md_ = AT_MX3(md_, S1[8], S1[9]); \
        ma_ = AT_MX3(ma_, S0[10], S0[11]); mb_ = AT_MX3(mb_, S0[12], S0[13]); mc_ = AT_MX3(mc_, S1[10], S1[11]); md_ = AT_MX3(md_, S1[12], S1[13]); \
        ma_ = AT_MX3(ma_, S0[14], S0[15]); mc_ = AT_MX3(mc_, S1[14], S1[15]); \
        float mx = __builtin_fmaxf(__builtin_fmaxf(ma_, mb_), __builtin_fmaxf(mc_, md_)); \
        mx = __builtin_fmaxf(mx, __shfl_xor(mx, 32)); \
        if (FIRST) { M += mx; _Pragma("unroll") for (int i_ = 0; i_ < 16; ++i_) { S0[i_] -= mx; S1[i_] -= mx; } } \
        else if (__any(mx > 8.0f)) { const float dl_ = __builtin_fmaxf(mx, 0.f), alpha_ = __builtin_amdgcn_exp2f(-dl_); M += dl_; L *= alpha_; \
            _Pragma("unroll") for (int i_ = 0; i_ < 16; ++i_) { S0[i_] -= dl_; S1[i_] -= dl_; O0[i_] *= alpha_; O1[i_] *= alpha_; } } \
        float pa_ = 0.f, pb_ = 0.f, pc_ = 0.f, pd_ = 0.f; \
        _Pragma("unroll") for (int i_ = 0; i_ < 16; i_ += 2) { S0[i_] = __builtin_amdgcn_exp2f(S0[i_]); S0[i_ + 1] = __builtin_amdgcn_exp2f(S0[i_ + 1]); S1[i_] = __builtin_amdgcn_exp2f(S1[i_]); S1[i_ + 1] = __builtin_amdgcn_exp2f(S1[i_ + 1]); \
            pa_ += S0[i_]; pb_ += S0[i_ + 1]; pc_ += S1[i_]; pd_ += S1[i_ + 1]; } \
        L += (pa_ + pb_) + (pc_ + pd_); } while (0)
__device__ __forceinline__ void attn_store(bf16* op, const f32x16& o0, const f32x16& o1, float inv) {
#pragma unroll
    for (int gq = 0; gq < 4; ++gq) {
        u32x2 w0, w1; w0.x = pkbf(o0[4 * gq] * inv, o0[4 * gq + 1] * inv); w0.y = pkbf(o0[4 * gq + 2] * inv, o0[4 * gq + 3] * inv);
        w1.x = pkbf(o1[4 * gq] * inv, o1[4 * gq + 1] * inv); w1.y = pkbf(o1[4 * gq + 2] * inv, o1[4 * gq + 3] * inv);
        *(u32x2*)(op + 8 * gq) = w0; *(u32x2*)(op + 32 + 8 * gq) = w1; }
}
__device__ __forceinline__ void attn_unit(LAS unsigned char* lds, const bf16* Q, const bf16* KN, const bf16* KR, const bf16* VT, bf16* O,
                                          int b, int hp, int qrow0, int key_lo, int ntiles, int tid) {
    const int lane = tid & 63, r = lane & 31, hh = lane >> 5, wid = __builtin_amdgcn_readfirstlane(tid >> 6), gsel = wid >> 2, wq = wid & 3, gt = tid & 255;
    const int h = hp * 2 + gsel;
    LAS unsigned char* gl = lds + gsel * (2 * AT_BUF);
    const int qrA = qrow0 + wq * 64 + r;
    bf16x8 qa[6];
    LAS unsigned char* qbl = lds + ATQ_OFF + wid * 6656 + r * AT_KP + hh * 16;
#pragma unroll
    for (int c = 0; c < 6; ++c) { qa[c] = *(const bf16x8*)(Q + (size_t)qrA * QW + h * 96 + 16 * c + 8 * hh);
        *(LAS bf16x8*)(qbl + c * 32) = *(const bf16x8*)(Q + (size_t)(qrA + 32) * QW + h * 96 + 16 * c + 8 * hh); }
    f32x16 oA0, oA1, oB0, oB1;
#pragma unroll
    for (int i = 0; i < 16; ++i) { oA0[i] = 0.f; oA1[i] = 0.f; oB0[i] = 0.f; oB1[i] = 0.f; }
    float mA = 0.f, lA = 0.f, mB = 0.f, lB = 0.f;
    const int kkey = gt >> 3, kpc = gt & 7, rkey = gt >> 2, rpc = gt & 3;
    const bf16* vsrc = VT + ((size_t)b * 512 + h * 64 + kkey) * NKEY + kpc * 8;
    const unsigned char* vsrc8 = (const unsigned char*)VT + ((size_t)b * 512 + h * 64 + (gt >> 2)) * NKEY + (gt & 3) * 16;
    u32x4 rk0, rk1, rr, rv0, rv1;
#define AT_LOAD(t) do { const int key0 = key_lo + (t) * 64; const size_t krow = key0 < SEQ ? (size_t)b * SEQ + key0 : (size_t)MLAT + (size_t)b * LC + (key0 - SEQ); \
        rk0 = *(const u32x4*)(KN + (krow + kkey) * 512 + h * 64 + kpc * 8); rk1 = *(const u32x4*)(KN + (krow + kkey + 32) * 512 + h * 64 + kpc * 8); \
        rr = *(const u32x4*)(KR + (krow + rkey) * 32 + rpc * 8); \
        if (MK_PV8) { rv0 = *(const u32x4*)(vsrc8 + key0); rv1 = rv0; } else { rv0 = *(const u32x4*)(vsrc + key0); rv1 = *(const u32x4*)(vsrc + (size_t)32 * NKEY + key0); } } while (0)
#define AT_STORE(bufp) do { *(LAS u32x4*)((bufp) + kkey * AT_KP + kpc * 16) = rk0; *(LAS u32x4*)((bufp) + (kkey + 32) * AT_KP + kpc * 16) = rk1; \
        *(LAS u32x4*)((bufp) + rkey * AT_KP + 128 + rpc * 16) = rr; \
        if (MK_PV8) { *(LAS u32x4*)((bufp) + AT_VOFF + (gt >> 2) * AT_VP8 + (gt & 3) * 16) = rv0; } else { \
        *(LAS u32x2*)((bufp) + AT_VOFF + kkey * AT_VP + kpc * 16) = (u32x2){rv0.x, rv0.y}; *(LAS u32x2*)((bufp) + AT_VOFF + kkey * AT_VP + kpc * 16 + 8) = (u32x2){rv0.z, rv0.w}; \
        *(LAS u32x2*)((bufp) + AT_VOFF + (kkey + 32) * AT_VP + kpc * 16) = (u32x2){rv1.x, rv1.y}; *(LAS u32x2*)((bufp) + AT_VOFF + (kkey + 32) * AT_VP + kpc * 16 + 8) = (u32x2){rv1.z, rv1.w}; } } while (0)
    AT_LOAD(0);
    AT_STORE(gl);
    __syncthreads();
    if (gsel == 1) __syncthreads();
    for (int t = 0; t < ntiles; ++t) {
        LAS unsigned char* buf = gl + (t & 1) * AT_BUF;
        f32x16 sA0, sA1, sB0, sB1;
        const LAS unsigned char* kb = buf + r * AT_KP + hh * 16;
#pragma unroll 1
        for (int rep_ = 0; rep_ < 1 + (int)((MK_DUP >> 25) & 1u); ++rep_) {
#pragma unroll
        for (int i = 0; i < 16; ++i) { sA0[i] = -mA; sA1[i] = -mA; sB0[i] = -mB; sB1[i] = -mB; }
#pragma unroll
        for (int c = 0; c < 6; ++c) {
            const bf16x8 a0 = *(const LAS bf16x8*)(kb + c * 32), a1 = *(const LAS bf16x8*)(kb + 32 * AT_KP + c * 32);
            const bf16x8 qbc = *(const LAS bf16x8*)(qbl + c * 32);
            sA0 = mfma32(a0, qa[c], sA0); sA1 = mfma32(a1, qa[c], sA1); sB0 = mfma32(a0, qbc, sB0); sB1 = mfma32(a1, qbc, sB1);
        }
        asm volatile("" ::: "memory"); }
        AT_SOFTMAX(sA0, sA1, mA, lA, oA0, oA1, t == 0);
        bf16x8 pA[4]; gm::v8i_t pA8;
        if (MK_PV8) pA8 = pack_p8(sA0, sA1); else { pA[0] = pack_s(sA0, 0); pA[1] = pack_s(sA0, 1); pA[2] = pack_s(sA1, 0); pA[3] = pack_s(sA1, 1); }
        AT_SOFTMAX(sB0, sB1, mB, lB, oB0, oB1, t == 0);
        bf16x8 pB[4]; gm::v8i_t pB8;
        if (MK_PV8) pB8 = pack_p8(sB0, sB1); else { pB[0] = pack_s(sB0, 0); pB[1] = pack_s(sB0, 1); pB[2] = pack_s(sB1, 0); pB[3] = pack_s(sB1, 1); }
        __syncthreads();
        __builtin_amdgcn_sched_barrier(0);
        if (t + 1 < ntiles) AT_LOAD(t + 1);
        if (MK_PV8) {
            const LAS unsigned char* vb8 = buf + AT_VOFF + r * AT_VP8 + hh * 32;
            const gm::v4i_t a0l = *(const LAS gm::v4i_t*)(vb8), a0h = *(const LAS gm::v4i_t*)(vb8 + 16), a1l = *(const LAS gm::v4i_t*)(vb8 + 32 * AT_VP8), a1h = *(const LAS gm::v4i_t*)(vb8 + 32 * AT_VP8 + 16);
            const gm::v8i_t va0 = __builtin_shufflevector(a0l, a0h, 0, 1, 2, 3, 4, 5, 6, 7), va1 = __builtin_shufflevector(a1l, a1h, 0, 1, 2, 3, 4, 5, 6, 7);
            asm volatile("s_nop 3\n\tv_mfma_f32_32x32x64_f8f6f4 %0, %1, %2, %0" : "+v"(oA0) : "v"(va0), "v"(pA8));
            asm volatile("v_mfma_f32_32x32x64_f8f6f4 %0, %1, %2, %0" : "+v"(oA1) : "v"(va1), "v"(pA8));
            asm volatile("v_mfma_f32_32x32x64_f8f6f4 %0, %1, %2, %0" : "+v"(oB0) : "v"(va0), "v"(pB8));
            asm volatile("v_mfma_f32_32x32x64_f8f6f4 %0, %1, %2, %0" : "+v"(oB1) : "v"(va1), "v"(pB8));
        } else {
        const LAS unsigned char* vb = buf + AT_VOFF + r * AT_VP + hh * 8;
#pragma unroll
        for (int ks = 0; ks < 4; ++ks) {
            const s16x4 l0 = *(const LAS s16x4*)(vb + ks * 32), h0 = *(const LAS s16x4*)(vb + ks * 32 + 16);
            const s16x4 l1 = *(const LAS s16x4*)(vb + 32 * AT_VP + ks * 32), h1 = *(const LAS s16x4*)(vb + 32 * AT_VP + ks * 32 + 16);
            const bf16x8 v0 = __builtin_shufflevector(l0, h0, 0, 1, 2, 3, 4, 5, 6, 7), v1 = __builtin_shufflevector(l1, h1, 0, 1, 2, 3, 4, 5, 6, 7);
            oA0 = mfma32(v0, pA[ks], oA0); oA1 = mfma32(v1, pA[ks], oA1); oB0 = mfma32(v0, pB[ks], oB0); oB1 = mfma32(v1, pB[ks], oB1);
        } }
        if (t + 1 < ntiles) { LAS unsigned char* nb = gl + ((t + 1) & 1) * AT_BUF; AT_STORE(nb); }
        __syncthreads();
    }
    if (MK_PV8) asm volatile("s_nop 15\n\ts_nop 15\n\ts_nop 15\n\ts_nop 15" ::: "memory");
    if (gsel == 0) __syncthreads();
    lA += __shfl_xor(lA, 32); lB += __shfl_xor(lB, 32);
    attn_store(O + (size_t)qrA * D + h * 64 + 4 * hh, oA0, oA1, 1.0f / lA);
    attn_store(O + (size_t)(qrA + 32) * D + h * 64 + 4 * hh, oB0, oB1, 1.0f / lB);
#undef AT_LOAD
#undef AT_STORE
}
#if MK_QK8 && MK_PV8
constexpr int AT_KP8 = 144;
__device__ __forceinline__ gm::v8i_t pack32_fp8(const u32x4 (&q)[4]) {
    gm::v8i_t p;
#pragma unroll
    for (int i = 0; i < 4; ++i) { const u32x4 w = q[i];
        int a = 0; a = __builtin_amdgcn_cvt_pk_fp8_f32(__uint_as_float(w.x << 16), __uint_as_float(w.x & 0xffff0000u), a, false); a = __builtin_amdgcn_cvt_pk_fp8_f32(__uint_as_float(w.y << 16), __uint_as_float(w.y & 0xffff0000u), a, true);
        int c = 0; c = __builtin_amdgcn_cvt_pk_fp8_f32(__uint_as_float(w.z << 16), __uint_as_float(w.z & 0xffff0000u), c, false); c = __builtin_amdgcn_cvt_pk_fp8_f32(__uint_as_float(w.w << 16), __uint_as_float(w.w & 0xffff0000u), c, true);
        p[2 * i] = a; p[2 * i + 1] = c; }
    return p;
}
__device__ __forceinline__ void attn_unit8(LAS unsigned char* lds, const bf16* Q, const bf16* KN, const bf16* KR, const bf16* VT, bf16* O,
                                           int b, int hp, int qrow0, int key_lo, int ntiles, int tid) {
    const int lane = tid & 63, r = lane & 31, hh = lane >> 5, wid = __builtin_amdgcn_readfirstlane(tid >> 6), gsel = wid >> 2, wq = wid & 3, gt = tid & 255;
    const int h = hp * 2 + gsel;
    LAS unsigned char* gl = lds + gsel * (2 * AT_BUF);
    const int qrA = qrow0 + wq * 64 + r;
    LAS unsigned char* qbl = lds + ATQ_OFF + wid * 6656 + lane * 16;
    gm::v8i_t qnA; bf16x8 qrA_[2];
    {   u32x4 t4[4];
#pragma unroll
        for (int i = 0; i < 4; ++i) t4[i] = *(const u32x4*)(Q + (size_t)qrA * QW + h * 96 + 32 * hh + 8 * i);
        qnA = pack32_fp8(t4);
#pragma unroll
        for (int c = 0; c < 2; ++c) qrA_[c] = *(const bf16x8*)(Q + (size_t)qrA * QW + h * 96 + 64 + 16 * c + 8 * hh);
#pragma unroll
        for (int i = 0; i < 4; ++i) t4[i] = *(const u32x4*)(Q + (size_t)(qrA + 32) * QW + h * 96 + 32 * hh + 8 * i);
        const gm::v8i_t qnB = pack32_fp8(t4);
        *(LAS gm::v4i_t*)(qbl) = __builtin_shufflevector(qnB, qnB, 0, 1, 2, 3); *(LAS gm::v4i_t*)(qbl + 1024) = __builtin_shufflevector(qnB, qnB, 4, 5, 6, 7);
#pragma unroll
        for (int c = 0; c < 2; ++c) *(LAS bf16x8*)(qbl + (2 + c) * 1024) = *(const bf16x8*)(Q + (size_t)(qrA + 32) * QW + h * 96 + 64 + 16 * c + 8 * hh); }
    f32x16 oA0, oA1, oB0, oB1;
#pragma unroll
    for (int i = 0; i < 16; ++i) { oA0[i] = 0.f; oA1[i] = 0.f; oB0[i] = 0.f; oB1[i] = 0.f; }
    float mA = 0.f, lA = 0.f, mB = 0.f, lB = 0.f;
    f32x16 nA;
#pragma unroll
    for (int i = 0; i < 16; ++i) nA[i] = 0.f;
    const int srow = gt >> 2, spc = gt & 3;
    const unsigned char* kn8 = (const unsigned char*)KN + h * 64 + spc * 16;
    const unsigned char* vsrc8 = (const unsigned char*)VT + ((size_t)b * 512 + h * 64 + srow) * NKEY + spc * 16;
    u32x4 rk0, rr, rv0;
#define AT_LOAD8(t) do { const int key0 = key_lo + (t) * 64; const size_t krow = key0 < SEQ ? (size_t)b * SEQ + key0 : (size_t)MLAT + (size_t)b * LC + (key0 - SEQ); \
        rk0 = *(const u32x4*)(kn8 + (krow + srow) * 512); rr = *(const u32x4*)(KR + (krow + srow) * 32 + spc * 8); rv0 = *(const u32x4*)(vsrc8 + key0); } while (0)
#define AT_STORE8(bufp) do { *(LAS u32x4*)((bufp) + srow * AT_KP8 + spc * 16) = rk0; *(LAS u32x4*)((bufp) + srow * AT_KP8 + 64 + spc * 16) = rr; \
        *(LAS u32x4*)((bufp) + AT_VOFF + srow * AT_VP8 + spc * 16) = rv0; } while (0)
    AT_LOAD8(0);
    AT_STORE8(gl);
    __syncthreads();
    if (gsel == 1) __syncthreads();
    for (int t = 0; t < ntiles; ++t) {
        LAS unsigned char* buf = gl + (t & 1) * AT_BUF;
        f32x16 sA0, sA1, sB0, sB1;
        const LAS unsigned char* kb = buf + r * AT_KP8;
        {
            const bf16x8 a0 = *(const LAS bf16x8*)(kb + 64 + hh * 16), a1 = *(const LAS bf16x8*)(kb + 32 * AT_KP8 + 64 + hh * 16);
            const bf16x8 qbc = *(const LAS bf16x8*)(qbl + 2 * 1024);
#pragma unroll
            for (int i = 0; i < 16; ++i) { sB0[i] = -mB; sB1[i] = -mB; }
            sA0 = mfma32(a0, qrA_[0], nA); sA1 = mfma32(a1, qrA_[0], nA); sB0 = mfma32(a0, qbc, sB0); sB1 = mfma32(a1, qbc, sB1); }
        {   const bf16x8 a0 = *(const LAS bf16x8*)(kb + 64 + 32 + hh * 16), a1 = *(const LAS bf16x8*)(kb + 32 * AT_KP8 + 64 + 32 + hh * 16);
            const bf16x8 qbc = *(const LAS bf16x8*)(qbl + 3 * 1024);
            sA0 = mfma32(a0, qrA_[1], sA0); sA1 = mfma32(a1, qrA_[1], sA1); sB0 = mfma32(a0, qbc, sB0); sB1 = mfma32(a1, qbc, sB1); }
        {   const gm::v4i_t k0l = *(const LAS gm::v4i_t*)(kb + hh * 32), k0h = *(const LAS gm::v4i_t*)(kb + hh * 32 + 16), k1l = *(const LAS gm::v4i_t*)(kb + 32 * AT_KP8 + hh * 32), k1h = *(const LAS gm::v4i_t*)(kb + 32 * AT_KP8 + hh * 32 + 16);
            const gm::v4i_t qbl_ = *(const LAS gm::v4i_t*)(qbl), qbh_ = *(const LAS gm::v4i_t*)(qbl + 1024);
            const gm::v8i_t k0 = __builtin_shufflevector(k0l, k0h, 0, 1, 2, 3, 4, 5, 6, 7), k1 = __builtin_shufflevector(k1l, k1h, 0, 1, 2, 3, 4, 5, 6, 7), qnB = __builtin_shufflevector(qbl_, qbh_, 0, 1, 2, 3, 4, 5, 6, 7);
            asm volatile("s_nop 15\n\tv_mfma_f32_32x32x64_f8f6f4 %0, %1, %2, %0" : "+v"(sA0) : "v"(k0), "v"(qnA));
            asm volatile("s_nop 15\n\tv_mfma_f32_32x32x64_f8f6f4 %0, %1, %2, %0" : "+v"(sA1) : "v"(k1), "v"(qnA));
            asm volatile("s_nop 15\n\tv_mfma_f32_32x32x64_f8f6f4 %0, %1, %2, %0" : "+v"(sB0) : "v"(k0), "v"(qnB));
            asm volatile("s_nop 15\n\tv_mfma_f32_32x32x64_f8f6f4 %0, %1, %2, %0" : "+v"(sB1) : "v"(k1), "v"(qnB));
            asm volatile("s_nop 15\n\ts_nop 15\n\ts_nop 15\n\ts_nop 15\n\ts_nop 15" : "+v"(sA0), "+v"(sA1), "+v"(sB0), "+v"(sB1)); }
        const float mAo = mA;
        AT_SOFTMAX(sA0, sA1, mA, lA, oA0, oA1, t == 0);
        const gm::v8i_t pA8 = pack_p8(sA0, sA1);
        AT_SOFTMAX(sB0, sB1, mB, lB, oB0, oB1, t == 0);
        const gm::v8i_t pB8 = pack_p8(sB0, sB1);
        if (__any(mA != mAo)) {
#pragma unroll
            for (int i = 0; i < 16; ++i) nA[i] = -mA; }
        __syncthreads();
        __builtin_amdgcn_sched_barrier(0);
        if (t + 1 < ntiles) AT_LOAD8(t + 1);
        {   const LAS unsigned char* vb8 = buf + AT_VOFF + r * AT_VP8 + hh * 32;
            const gm::v4i_t a0l = *(const LAS gm::v4i_t*)(vb8), a0h = *(const LAS gm::v4i_t*)(vb8 + 16), a1l = *(const LAS gm::v4i_t*)(vb8 + 32 * AT_VP8), a1h = *(const LAS gm::v4i_t*)(vb8 + 32 * AT_VP8 + 16);
            const gm::v8i_t va0 = __builtin_shufflevector(a0l, a0h, 0, 1, 2, 3, 4, 5, 6, 7), va1 = __builtin_shufflevector(a1l, a1h, 0, 1, 2, 3, 4, 5, 6, 7);
            asm volatile("s_nop 3\n\tv_mfma_f32_32x32x64_f8f6f4 %0, %1, %2, %0" : "+v"(oA0) : "v"(va0), "v"(pA8));
            asm volatile("v_mfma_f32_32x32x64_f8f6f4 %0, %1, %2, %0" : "+v"(oA1) : "v"(va1), "v"(pA8));
            asm volatile("v_mfma_f32_32x32x64_f8f6f4 %0, %1, %2, %0" : "+v"(oB0) : "v"(va0), "v"(pB8));
            asm volatile("v_mfma_f32_32x32x64_f8f6f4 %0, %1, %2, %0" : "+v"(oB1) : "v"(va1), "v"(pB8)); }
        if (t + 1 < ntiles) { LAS unsigned char* nb = gl + ((t + 1) & 1) * AT_BUF; AT_STORE8(nb); }
        __syncthreads();
    }
    asm volatile("s_nop 15\n\ts_nop 15\n\ts_nop 15\n\ts_nop 15\n\ts_nop 15" : "+v"(oA0), "+v"(oA1), "+v"(oB0), "+v"(oB1));
    if (gsel == 0) __syncthreads();
    lA += __shfl_xor(lA, 32); lB += __shfl_xor(lB, 32);
    attn_store(O + (size_t)qrA * D + h * 64 + 4 * hh, oA0, oA1, 1.0f / lA);
    attn_store(O + (size_t)(qrA + 32) * D + h * 64 + 4 * hh, oB0, oB1, 1.0f / lB);
#undef AT_LOAD8
#undef AT_STORE8
}
#endif
__device__ __forceinline__ void tr_item(const float* W, int N, int k0, int n0, bf16* dst, size_t drow0, int dld, const float* kscale, float cscale, LAS float* scr, int lane) {
#pragma unroll 1
    for (int ib = 0; ib < 32; ib += 16) { float wv[16];
#pragma unroll
        for (int ii = 0; ii < 16; ++ii) wv[ii] = W[(size_t)(k0 + 2 * (ib + ii) + (lane >> 5)) * N + n0 + (lane & 31)];
#pragma unroll
        for (int ii = 0; ii < 16; ++ii) { const int kk = 2 * (ib + ii) + (lane >> 5); float v = wv[ii] * cscale; if (kscale) v *= kscale[k0 + kk]; scr[kk * 33 + (lane & 31)] = v; } }
    asm volatile("s_waitcnt lgkmcnt(0)" ::: "memory");
    const int c = lane & 7;
#pragma unroll
    for (int j = 0; j < 4; ++j) { const int n = (lane >> 3) + 8 * j; const LAS float* s = scr + (8 * c) * 33 + n;
        u32x4 o; o.x = pkbf(s[0 * 33], s[1 * 33]); o.y = pkbf(s[2 * 33], s[3 * 33]); o.z = pkbf(s[4 * 33], s[5 * 33]); o.w = pkbf(s[6 * 33], s[7 * 33]);
        *(u32x4*)(dst + (drow0 + n) * (size_t)dld + k0 + 8 * c) = o; }
    asm volatile("s_waitcnt lgkmcnt(0)" ::: "memory");
}
__device__ __forceinline__ void tr_item8(const float* W, int N, int k0, int n0, unsigned char* dst, size_t drow0, int dld, float cscale, LAS float* scr, int lane) {
#pragma unroll 1
    for (int ib = 0; ib < 32; ib += 16) { float wv[16];
#pragma unroll
        for (int ii = 0; ii < 16; ++ii) wv[ii] = W[(size_t)(k0 + 2 * (ib + ii) + (lane >> 5)) * N + n0 + (lane & 31)];
#pragma unroll
        for (int ii = 0; ii < 16; ++ii) { const int kk = 2 * (ib + ii) + (lane >> 5); scr[kk * 33 + (lane & 31)] = wv[ii] * cscale; } }
    asm volatile("s_waitcnt lgkmcnt(0)" ::: "memory");
    const int c = lane & 7;
#pragma unroll
    for (int j = 0; j < 4; ++j) { const int n = (lane >> 3) + 8 * j; const LAS float* sp = scr + (8 * c) * 33 + n;
        u32x2 o; o.x = pk4_fp8(sp[0 * 33], sp[1 * 33], sp[2 * 33], sp[3 * 33]); o.y = pk4_fp8(sp[4 * 33], sp[5 * 33], sp[6 * 33], sp[7 * 33]);
        *(u32x2*)(dst + (drow0 + n) * (size_t)dld + k0 + 8 * c) = o; }
    asm volatile("s_waitcnt lgkmcnt(0)" ::: "memory");
}
__device__ __forceinline__ void tr_matrix(const float* W, int K, int N, bf16* dst, int dld, int mode, bf16* dst2, const float* kscale, float cscale, LAS float* scr, int gw, int NGW, int lane) {
    const int nblk = N / 32, nit = (K / 64) * nblk;
    for (int it = gw; it < nit; it += NGW) { const int kb = it / nblk, nb = it % nblk, n0 = 32 * nb; size_t dr; bf16* d = dst;
        if (mode == 0) dr = n0;
        else if (mode == 1) dr = n0 < 416 ? n0 : n0 + 96;
        else if (mode == 2) { const int hq = n0 >> 7, w = n0 & 127; if (w < 64) dr = hq * 64 + w; else { dr = hq * 64 + w - 64; d = dst2; } }
        else if (mode == 3) dr = (size_t)(n0 >> 7) * 256 + (n0 & 127);
        else dr = (size_t)(n0 >> 7) * 256 + 128 + (n0 & 127);
        tr_item(W, N, 64 * kb, n0, d, dr, dld, kscale, cscale, scr, lane); }
}
__device__ __forceinline__ void tr_matrix8(const float* W, int K, int N, unsigned char* dst, int dld, int mode, LAS float* scr, int gw, int NGW, int lane) {
    const int nblk = N / 32, nit = (K / 64) * nblk;
    for (int it = gw; it < nit; it += NGW) { const int kb = it / nblk, nb = it % nblk, n0 = 32 * nb; size_t dr;
        if (mode == 0) dr = n0; else if (mode == 1) dr = n0 < 416 ? n0 : n0 + 96; else if (mode == 3) dr = (size_t)(n0 >> 7) * 256 + (n0 & 127); else dr = (size_t)(n0 >> 7) * 256 + 128 + (n0 & 127);
        tr_item8(W, N, 64 * kb, n0, dst, dr, dld, W8_SCALE, scr, lane); }
}
__device__ __forceinline__ void split8(const float* v, bf16x8& hi, bf16x8& lo) {
    u32x4 h, l;
#pragma unroll
    for (int q = 0; q < 4; ++q) { const unsigned ph = pkbf(v[2 * q], v[2 * q + 1]); const float h0 = __uint_as_float(ph << 16), h1 = __uint_as_float(ph & 0xffff0000u);
        h[q] = ph; l[q] = pkbf(v[2 * q] - h0, v[2 * q + 1] - h1); }
    hi = __builtin_bit_cast(bf16x8, h); lo = __builtin_bit_cast(bf16x8, l);
}
__device__ __forceinline__ f32x16 mfma32m(bf16x8 a, bf16x8 b, f32x16 c) { return __builtin_amdgcn_mfma_f32_32x32x16_bf16(a, b, c, 0, 0, 0); }
__device__ __forceinline__ void mod_partial_item(const float* c, const float* cctx, const float* ada_w, float* MODP, int item, LAS float* st, int tid) {
    const int lane = tid & 63, wave = __builtin_amdgcn_readfirstlane(tid >> 6);
    const int li = item / 192, kc = (item / 12) % 16, cg = item % 12;
    for (int idx = tid; idx < 36 * 64; idx += 512) { const int r = idx >> 6, k = idx & 63; float v = 0.f;
        if (r < 33) { const float x = r < 32 ? c[(size_t)r * D + kc * 64 + k] : cctx[kc * 64 + k]; v = silu_f(x); }
        st[k * 36 + r] = v; }
    __syncthreads();
    const int m = lane & 31, kg = lane >> 5;
    bf16x8 ah[2][4], al[2][4];
#pragma unroll
    for (int ks = 0; ks < 4; ++ks) { float v0[8], v1[8];
#pragma unroll
        for (int j = 0; j < 8; ++j) { const int k = ks * 16 + kg * 8 + j; v0[j] = st[k * 36 + m]; const float x = st[k * 36 + 32]; v1[j] = m == 0 ? x : 0.f; }
        split8(v0, ah[0][ks], al[0][ks]); split8(v1, ah[1][ks], al[1][ks]); }
#pragma unroll 1
    for (int cb = 0; cb < 2; ++cb) {
        const int col = cg * 512 + wave * 64 + cb * 32 + m;
        const float* wp = ada_w + ((size_t)li * D + kc * 64 + kg * 8) * 6144 + col;
        float w[32];
#pragma unroll
        for (int ks = 0; ks < 4; ++ks)
#pragma unroll
            for (int j = 0; j < 8; ++j) w[ks * 8 + j] = wp[(size_t)(ks * 16 + j) * 6144];
        f32x16 a0, a1;
#pragma unroll
        for (int i = 0; i < 16; ++i) { a0[i] = 0.f; a1[i] = 0.f; }
#pragma unroll
        for (int ks = 0; ks < 4; ++ks) { bf16x8 bh, bl; split8(&w[ks * 8], bh, bl);
            a0 = mfma32m(ah[0][ks], bh, a0); a0 = mfma32m(ah[0][ks], bl, a0); a0 = mfma32m(al[0][ks], bh, a0);
            a1 = mfma32m(ah[1][ks], bh, a1); a1 = mfma32m(ah[1][ks], bl, a1); a1 = mfma32m(al[1][ks], bh, a1); }
        float* mp = MODP + (((size_t)kc * 4 + li) * 33) * 6144 + col;
#pragma unroll
        for (int i = 0; i < 16; ++i) mp[(size_t)(8 * (i >> 2) + 4 * kg + (i & 3)) * 6144] = a0[i];
        if (kg == 0) mp[(size_t)32 * 6144] = a1[0];
    }
    __syncthreads();
}

constexpr int NPH = 43;
struct Args { const float* in[N_IN]; float* out; unsigned char* ws; int ph_lo, ph_hi; };
#define AIN(i) ((const float*)(const GAS float*)a.in[i])
#define AOUT ((float*)(GAS float*)a.out)

__device__ __forceinline__ void moe_convert(const float* w1, const float* w3, const float* w2, bf16* W13, bf16* W2, LAS float* scr, int gw, int NGW, int lane) {
    constexpr int PER = 1792, TOT = 8 * 3 * PER;
    for (int it = gw; it < TOT; it += NGW) { const int ex = it / (3 * PER), rem = it % (3 * PER), which = rem / PER, j = rem % PER;
        if (which < 2) { const int nblk = DFFE / 32, kb = j / nblk, nb = j % nblk, n0 = 32 * nb;
            const float* W = (which ? w3 : w1) + (size_t)ex * D * DFFE;
            tr_item(W, DFFE, 64 * kb, n0, W13 + (size_t)ex * 7168 * 1024, (size_t)(n0 >> 7) * 256 + which * 128 + (n0 & 127), 1024, nullptr, 1.0f, scr, lane); }
        else { const int nblk = D / 32, kb = j / nblk, nb = j % nblk, n0 = 32 * nb;
            tr_item(w2 + (size_t)ex * DFFE * D, D, 64 * kb, n0, W2 + (size_t)ex * 1024 * DFFE, n0, DFFE, nullptr, 1.0f, scr, lane); } }
}

constexpr int MOE_CV_ITEMS = 8 * 3 * 1792;
constexpr int BG0_MIXIN_E = 1024 * 6, BG0_MIXOUT_E = BG0_MIXIN_E + 1024 * 6, BG0_UP_E = BG0_MIXOUT_E + 512 * 6, BG0_END = BG0_UP_E + 1024 * 14;
constexpr int BG1_DFTS_E = 1024 * 7, BG1_FNET_E = BG1_DFTS_E + 1024 * 6, BG1_MD0_E = BG1_FNET_E + (MOE_CHAIN_ON ? 0 : 8064), BG1_MIXIN = BG1_MD0_E + 8064, BG1_END = BG1_MIXIN + 1792 * 6;
static_assert(BG0_END <= MOE_CV_ITEMS && BG1_END <= MOE_CV_ITEMS, "background plan");
__device__ __forceinline__ void moe_convert8(const float* w1, const float* w3, const float* w2, unsigned char* W13, unsigned char* W2, LAS float* scr, int gw, int NGW, int lane, int lo = 0, int hi = MOE_CV_ITEMS) {
    constexpr int PER = 1792;
    for (int it = lo + gw; it < hi; it += NGW) { const int ex = it / (3 * PER), rem = it % (3 * PER), which = rem / PER, j = rem % PER;
        if (which < 2) { const int nblk = DFFE / 32, kb = j / nblk, nb = j % nblk, n0 = 32 * nb;
            const float* W = (which ? w3 : w1) + (size_t)ex * D * DFFE;
            tr_item8(W, DFFE, 64 * kb, n0, W13 + (size_t)ex * 7168 * 1024, (size_t)(n0 >> 7) * 256 + which * 128 + (n0 & 127), 1024, W8_SCALE, scr, lane); }
        else { const int nblk = D / 32, kb = j / nblk, nb = j % nblk, n0 = 32 * nb;
            tr_item8(w2 + (size_t)ex * DFFE * D, D, 64 * kb, n0, W2 + (size_t)ex * 1024 * DFFE, n0, DFFE, W8_SCALE, scr, lane); } }
}

__global__ void __launch_bounds__(512, 2) fwd(Args a) {
    extern __shared__ __attribute__((aligned(16))) unsigned char lds_raw[];
    LAS unsigned char* lds = (LAS unsigned char*)lds_raw;
    volatile LAS unsigned* MISC = (volatile LAS unsigned*)(lds + MISC_OFF);
    const int G = gridDim.x, bid = blockIdx.x, NGW = G * 8;
    unsigned* ctl = (unsigned*)(GAS unsigned*)(a.ws + WS_CTL);
#define WSP_DECL GAS unsigned char* wsg_ = (GAS unsigned char*)a.ws; asm volatile("" : "+s"(wsg_)); unsigned char* wsp = (unsigned char*)wsg_; int tid = threadIdx.x; asm volatile("" : "+v"(tid)); const int lane = tid & 63, wave = __builtin_amdgcn_readfirstlane(tid >> 6), gw = bid * 8 + wave; (void)lane; (void)gw
#define MOD ((float*)(wsp + WS_MOD))
#define ROPEC ((float*)(wsp + WS_ROPE))
#define ROPES (ROPEC + 512)
#define SSQQ ((float*)(wsp + WS_SSQQ))
#define SSQK ((float*)(wsp + WS_SSQK))
#define HMID ((float*)(wsp + WS_HMID))
#define AMID ((float*)(wsp + WS_AMID))
#define LIST ((int*)(wsp + WS_LIST))
#define GLIST ((float*)(wsp + WS_GLIST))
#define WMIXIN ((bf16*)(wsp + WS_WMIXIN))
#define WUQ ((bf16*)(wsp + WS_WUQ))
#define WUK ((bf16*)(wsp + WS_WUK))
#define WUV ((bf16*)(wsp + WS_WUV))
#define WMIXOUT ((bf16*)(wsp + WS_WMIXOUT))
#define WFFN13 ((bf16*)(wsp + WS_WFFN13))
#define WFFN2 ((bf16*)(wsp + WS_WFFN2))
#define WFNET ((bf16*)(wsp + WS_WFNET))
#define WDFTC ((bf16*)(wsp + WS_WDFTC))
#define WDFTL ((bf16*)(wsp + WS_WDFTL))
#define WDFTX ((bf16*)(wsp + WS_WDFTX))
#define WMOE13 ((bf16*)(wsp + WS_WMOE13))
#define WMOE2 ((bf16*)(wsp + WS_WMOE2))
#define WMOE13_8(q) ((unsigned char*)WMOE13 + (BG_ON ? (size_t)(q) * 8 * 7168 * 1024 : (size_t)0))
#define WMOE2_8(q) ((unsigned char*)WMOE2 + (BG_ON ? (size_t)(q) * 8 * 1024 * 3584 : (size_t)0))
#define BG_FILL(T_, q_, lo_, hi_) do { if (BG_ON) { const int lo__ = (lo_), hi__ = (hi_); if (lo__ < hi__) { const int r__ = (T_) % G; \
    if (r__ == 0 || bid >= r__) { const int q__ = (q_); __syncthreads(); \
        moe_convert8(AIN(I_MW1) + (size_t)q__ * 8 * D * DFFE, AIN(I_MW3) + (size_t)q__ * 8 * D * DFFE, AIN(I_MW2) + (size_t)q__ * 8 * DFFE * D, WMOE13_8(q__), WMOE2_8(q__), (LAS float*)(lds + wave * 8448), \
                     (r__ == 0 ? bid : bid - r__) * 8 + wave, (r__ == 0 ? G : G - r__) * 8, lane, lo__, hi__); } } } } while (0)
#define XCUR ((bf16*)(wsp + WS_XCUR))
#define RA ((bf16*)(wsp + WS_RA))
#define CQ ((bf16*)(wsp + WS_RB + RB_CQ))
#define CKV ((bf16*)(wsp + WS_RB + RB_CKV))
#define KR ((bf16*)(wsp + WS_RB + RB_KR))
#define POOL ((bf16*)(wsp + WS_RB + RB_POOL))
#define QB ((bf16*)(wsp + WS_RB + RB_Q))
#define KN ((bf16*)(wsp + WS_RB + RB_KN))
#define VT ((bf16*)(wsp + WS_RB + RB_VT))
#define ZB ((bf16*)(wsp + WS_RB + RB_Z))
#define ZC ((bf16*)(wsp + WS_RB + RB_ZC))
#define ACT ((bf16*)(wsp + WS_RB + RB_ACT))

    const int lo = a.ph_lo, hi = a.ph_hi;
    if (threadIdx.x < 64) MISC[threadIdx.x] = 0u;
    __syncthreads();
    XcdBarrier bar; bar.bar = ctl + CW_BAR; bar.x = 0; bar.st = MISC + 8;
    if (hi - lo > 1) bar = xcd_barrier_post(ctl + CW_BAR, MISC + 8);
#ifndef MK_EN
#define MK_EN 0xFFFFFFFFu
#endif
#define EN(b) (((MK_EN) >> (b)) & 1u)
#ifndef MK_DUP
#define MK_DUP 0u
#endif
#define REP(b) _Pragma("unroll 1") for (int _rep = 0; _rep < ((((MK_DUP) >> (b)) & 1u) ? 2 : 1); ++_rep)
#define IN(p) (lo <= (p) && (p) < hi)
#if MK_WPROBE
    unsigned wacc = 0u;
#define SEAM(p) do { if (hi > (p) + 1) { const unsigned long long t0_ = __builtin_amdgcn_s_memrealtime(); xcd_barrier<false>(bar); if (WP_SEL(p)) wacc += (unsigned)(__builtin_amdgcn_s_memrealtime() - t0_); } } while (0)
#define SEAM0(p) do { if (hi > (p) + 1) { const unsigned long long t0_ = __builtin_amdgcn_s_memrealtime(); xcd_barrier<true>(bar); if (WP_SEL(p)) wacc += (unsigned)(__builtin_amdgcn_s_memrealtime() - t0_); } } while (0)
#else
#define SEAM(p) do { if (hi > (p) + 1) { xcd_barrier<false>(bar); if ((MK_DUP >> 12) & 1u) xcd_barrier<false>(bar); } } while (0)
#define SEAM0(p) do { if (hi > (p) + 1) xcd_barrier<true>(bar); } while (0)
#endif

    if (EN(0) && IN(0)) REP(11) { WSP_DECL;
        LAS float* scr = (LAS float*)(lds + wave * 8448);
        for (int item = bid; item < 4 * 16 * 12; item += G) mod_partial_item(AIN(I_C), AIN(I_CCTX), AIN(I_ADAW), (float*)(wsp + WS_RB), item, (LAS float*)(lds + 67584), tid);
        int gwr = gw;
#define ADV(nit) gwr = (gwr - ((nit) % NGW) + NGW) % NGW
#pragma unroll 1
        for (int e = 0; e < 2; ++e) {
            if (MK_FP8_MIXIN) tr_matrix8(AIN(I_MIXIN) + (size_t)e * D * 928, D, 928, (unsigned char*)(WMIXIN + (size_t)e * 1024 * 1024), 1024, 1, scr, gwr, NGW, lane);
            else tr_matrix(AIN(I_MIXIN) + (size_t)e * D * 928, D, 928, WMIXIN + (size_t)e * 1024 * 1024, 1024, 1, nullptr, nullptr, 1.0f, scr, gwr, NGW, lane); ADV(464);
            tr_matrix(AIN(I_WUQ) + (size_t)e * 256 * 768, 256, 768, WUQ + (size_t)e * 768 * 256, 256, 0, nullptr, AIN(I_CQG) + e * 256, QSCALE, scr, gwr, NGW, lane); ADV(96);
            tr_matrix(AIN(I_WUKV) + (size_t)e * 128 * 1024, 128, 1024, WUK + (size_t)e * 512 * 128, 128, 2, WUV + (size_t)e * 512 * 128, AIN(I_CKVG) + e * 128, 1.0f, scr, gwr, NGW, lane); ADV(64);
            tr_matrix(AIN(I_MIXOUT) + (size_t)e * 1024 * 1024, 512, 1024, WMIXOUT + (size_t)e * 1024 * 1024, 1024, 0, nullptr, nullptr, 1.0f, scr, gwr, NGW, lane); ADV(256);
            if (FP8_FFN(2 * e)) {
                tr_matrix8(AIN(I_FW1) + (size_t)e * D * DFF, D, DFF, (unsigned char*)(WFFN13 + (size_t)e * 5632 * 1024), 1024, 3, scr, gwr, NGW, lane); ADV(1408);
                tr_matrix8(AIN(I_FW3) + (size_t)e * D * DFF, D, DFF, (unsigned char*)(WFFN13 + (size_t)e * 5632 * 1024), 1024, 4, scr, gwr, NGW, lane); ADV(1408);
                tr_matrix8(AIN(I_FW2) + (size_t)e * DFF * D, DFF, D, (unsigned char*)(WFFN2 + (size_t)e * 1024 * DFF), DFF, 0, scr, gwr, NGW, lane); ADV(1408);
            } else {
            tr_matrix(AIN(I_FW1) + (size_t)e * D * DFF, D, DFF, WFFN13 + (size_t)e * 5632 * 1024, 1024, 3, nullptr, nullptr, 1.0f, scr, gwr, NGW, lane); ADV(1408);
            tr_matrix(AIN(I_FW3) + (size_t)e * D * DFF, D, DFF, WFFN13 + (size_t)e * 5632 * 1024, 1024, 4, nullptr, nullptr, 1.0f, scr, gwr, NGW, lane); ADV(1408);
            tr_matrix(AIN(I_FW2) + (size_t)e * DFF * D, DFF, D, WFFN2 + (size_t)e * 1024 * DFF, DFF, 0, nullptr, nullptr, 1.0f, scr, gwr, NGW, lane); ADV(1408);
            }
            tr_matrix(AIN(I_FNET) + (size_t)e * D * D, D, D, WFNET + (size_t)e * 1024 * 1024, 1024, 0, nullptr, nullptr, 1.0f, scr, gwr, NGW, lane); ADV(512);
            if (MK_FP8_MIXIN) { for (int i = gw * 64 + lane; i < 96 * 1024 / 16; i += NGW * 64) *(u32x4*)((unsigned char*)(WMIXIN + (size_t)e * 1024 * 1024) + 416 * 1024 + (size_t)i * 16) = (u32x4){0u, 0u, 0u, 0u}; }
            else for (int i = gw * 64 + lane; i < 96 * 1024 / 8; i += NGW * 64) *(u32x4*)(WMIXIN + (size_t)e * 1024 * 1024 + 416 * 1024 + (size_t)i * 8) = (u32x4){0u, 0u, 0u, 0u};
            for (int it = (gw - e * 1024 + NGW) % NGW; it < 4 * 16 * 16; it += NGW) {        const int gq = it >> 8, ic = (it >> 4) & 15, nb = it & 15, n = nb * 64 + lane;
                const float* pw = AIN(I_POOLW) + ((size_t)(e * 4 + gq) * 128 + ic * 8) * 128; const float* ps = AIN(I_POOLS) + e * 512 + gq * 128;
                const float* mw = AIN(I_MIXOUT) + ((size_t)e * 1024 + 512 + gq * 128) * 1024 + n;
                float acc[8];
#pragma unroll
                for (int q = 0; q < 8; ++q) acc[q] = 0.f;
#pragma unroll 1
                for (int jb = 0; jb < 128; jb += 16) { float wv[16];
#pragma unroll
                    for (int jj = 0; jj < 16; ++jj) wv[jj] = mw[(size_t)(jb + jj) * 1024];
#pragma unroll
                    for (int jj = 0; jj < 16; ++jj) { const float w = wv[jj] * ps[jb + jj];
#pragma unroll
                        for (int q = 0; q < 8; ++q) acc[q] += pw[q * 128 + jb + jj] * w; } }
                u32x4 o; o.x = pkbf(acc[0], acc[1]); o.y = pkbf(acc[2], acc[3]); o.z = pkbf(acc[4], acc[5]); o.w = pkbf(acc[6], acc[7]);
                *(u32x4*)(WMIXOUT + (size_t)e * 1024 * 1024 + (size_t)n * 1024 + 512 + gq * 128 + ic * 8) = o; }
        }
#undef ADV
        const int gt = bid * 512 + tid, NT = G * 512;
        for (int i = gt; i < 2 * 65536; i += NT) { const int ty = i >> 16, m = (i >> 8) & 255, c = i & 255; const float x = (float)((m * c) & 255) * (1.0f / 128.0f);
            WDFTC[i] = (bf16)(pkbf(ty ? sinpif(x) : cospif(x), 0.f) & 0xffffu); }
        if (MK_FP8_DFT) {
            for (int i4 = gt; i4 < 2048 * 2048 / 4; i4 += NT) { float v[4];
#pragma unroll
                for (int q = 0; q < 4; ++q) { const int i = i4 * 4 + q, k = i >> 11, kk = i & 2047;
                    if (kk < 1024) v[q] = __builtin_amdgcn_cosf((float)((k * kk) & 2047) * (1.0f / 2048.0f)); else if (kk == 1024) v[q] = 0.f; else v[q] = -__builtin_amdgcn_sinf((float)((k * (kk - 1024)) & 2047) * (1.0f / 2048.0f)); }
                ((unsigned*)WDFTL)[i4] = pk4_fp8(v[0] * 16.f, v[1] * 16.f, v[2] * 16.f, v[3] * 16.f); }
            for (int i4 = gt; i4 < 65536 / 4; i4 += NT) { float v[4];
#pragma unroll
                for (int q = 0; q < 4; ++q) { const int i = i4 * 4 + q, k = i >> 8, kk = i & 255;
                    if (kk < 128) v[q] = __builtin_amdgcn_cosf((float)((k * kk) & 255) * (1.0f / 256.0f)); else if (kk == 128) v[q] = 0.f; else v[q] = -__builtin_amdgcn_sinf((float)((k * (kk - 128)) & 255) * (1.0f / 256.0f)); }
                ((unsigned*)WDFTX)[i4] = pk4_fp8(v[0] * 16.f, v[1] * 16.f, v[2] * 16.f, v[3] * 16.f); }
        } else {
        for (int i4 = gt; i4 < 2048 * 2048 / 4; i4 += NT) { float v[4];
#pragma unroll
            for (int q = 0; q < 4; ++q) { const int i = i4 * 4 + q, k = i >> 11, kk = i & 2047;
                if (kk < 1024) v[q] = __builtin_amdgcn_cosf((float)((k * kk) & 2047) * (1.0f / 2048.0f)); else if (kk == 1024) v[q] = 0.f; else v[q] = -__builtin_amdgcn_sinf((float)((k * (kk - 1024)) & 2047) * (1.0f / 2048.0f)); }
            u32x2 w; w.x = pkbf(v[0], v[1]); w.y = pkbf(v[2], v[3]); ((u32x2*)WDFTL)[i4] = w; }
        for (int i4 = gt; i4 < 65536 / 4; i4 += NT) { float v[4];
#pragma unroll
            for (int q = 0; q < 4; ++q) { const int i = i4 * 4 + q, k = i >> 8, kk = i & 255;
                if (kk < 128) v[q] = __builtin_amdgcn_cosf((float)((k * kk) & 255) * (1.0f / 256.0f)); else if (kk == 128) v[q] = 0.f; else v[q] = -__builtin_amdgcn_sinf((float)((k * (kk - 128)) & 255) * (1.0f / 256.0f)); }
            u32x2 w; w.x = pkbf(v[0], v[1]); w.y = pkbf(v[2], v[3]); ((u32x2*)WDFTX)[i4] = w; }
        }
        if (gt < 512) { const int pos = gt >> 3, j = gt & 7; const double inv = pow(10000.0, -(double)j / 8.0), ang = (double)pos * inv; ROPEC[gt] = (float)cos(ang); ROPES[gt] = (float)sin(ang); }
    }
    if (lo == 0) SEAM0(0);
    if (IN(1)) { WSP_DECL; const float* MODP = (const float*)(wsp + WS_RB);
        for (int o = bid * 512 + tid; o < 4 * 33 * 6144; o += G * 512) { float sacc = 0.f;
#pragma unroll
            for (int kc = 0; kc < 16; ++kc) sacc += MODP[(size_t)kc * (4 * 33 * 6144) + o];
            const int li = o / (33 * 6144), col = o % 6144;
            const float mv = sacc + AIN(I_ADAB)[(size_t)li * 6144 + col];
            MOD[o] = mv;
            if (col >= 5120) ((bf16*)(wsp + WS_G16))[(size_t)(o / 6144) * 1024 + (col - 5120)] = (bf16)(pkbf(mv, 0.f) & 0xffffu); }
        SEAM(1);
    }

#pragma unroll 1
    for (int i = 0; i < DEPTH; ++i) {
        const int pb = 2 + 10 * i; const bool even = !(i & 1); const int e = i >> 1; const bool ctxn = i < 2;
#define modbase (MOD + (size_t)i * 33 * 6144)
#define XS_MIX (XSrc{AIN(I_X), AIN(I_CTX), (i == 0) ? (const bf16*)nullptr : (const bf16*)XCUR})
#define XS_CUR (XSrc{nullptr, nullptr, (const bf16*)XCUR})
        const int nrows = ctxn ? MALL : MLAT;
        if (EN(1) && IN(pb + 0)) { WSP_DECL;
            if (even) { REP(5) phase_mod_plain(XS_MIX, AIN(I_NMG) + i * D, modbase, 0, 1024, RA, MK_FP8_MIXIN != 0, MALL, gw, NGW, lane); }
            else {
#pragma unroll 1
                for (int st = 0; st < 2; ++st) {
                    if ((st ^ (wave & 1)) == 0) { REP(6) phase_mod_fold(XS_MIX, AIN(I_NMG) + i * D, modbase, RA, HMID, i == 1, gw, NGW, lane); }
                    else if (FP8_MOE(i)) moe_convert8(AIN(I_MW1) + (size_t)e * 8 * D * DFFE, AIN(I_MW3) + (size_t)e * 8 * D * DFFE, AIN(I_MW2) + (size_t)e * 8 * DFFE * D, WMOE13_8(e), WMOE2_8(e), (LAS float*)(lds + wave * 8448), gw, NGW, lane, BG_ON ? (e == 0 ? BG0_END : BG1_END) : 0, MOE_CV_ITEMS);
                    else moe_convert(AIN(I_MW1) + (size_t)e * 8 * D * DFFE, AIN(I_MW3) + (size_t)e * 8 * D * DFFE, AIN(I_MW2) + (size_t)e * 8 * DFFE * D, WMOE13, WMOE2, (LAS float*)(lds + wave * 8448), gw, NGW, lane);
                }
            }
            SEAM(pb + 0);
        }
        if (IN(pb + 1)) { WSP_DECL;
            if (even) { if (EN(2)) { SchedMixIn S{(const char*)RA, (const char*)(WMIXIN + (size_t)e * 1024 * 1024), G, bid, 1024 + (i == 0 ? 128 : 32), i == 0};
                        EpiMixIn E{CQ, CKV, KR, POOL, SSQQ, SSQK, ROPEC, ROPES};
                        REP(16) gm::gemm_phase<EpiMixIn, SchedMixIn, false, MK_FP8_MIXIN != 0>(lds, S, E);
                        BG_FILL(1024 + (i == 0 ? 128 : 32), i == 0 ? 0 : 1, i == 0 ? 0 : BG1_MIXIN, i == 0 ? BG0_MIXIN_E : BG1_END); } }
            else if (EN(3)) { phase_amid(HMID, AMID, lds, G, bid, tid);
                   SchedDftC S{(const char*)WDFTC, (const char*)RA, G, bid, 1024 + (i == 1 ? 256 : 0)}; EpiDftC E{ZB, ZC};
                   REP(17) gm::gemm_phase<EpiDftC, SchedDftC, false>(lds, S, E); }
            SEAM(pb + 1);
        }
        if (IN(pb + 2)) { WSP_DECL;
            if (even) { if (EN(4)) { REP(14) phase_pool(POOL, RA, nrows, gw, NGW, lane);
                        const int nq = (i == 0) ? TALL : TLAT;
                        SchedE3 S{(const char*)CQ, (const char*)CKV, (const char*)(WUQ + (size_t)e * 768 * 256), (const char*)(WUK + (size_t)e * 512 * 128), (const char*)(WUV + (size_t)e * 512 * 128), G, bid, nq, nq * 3 + 1152};
                        EpiE3 E{QB, KN, VT, SSQQ, SSQK, ROPEC, ROPES};
                        REP(15) gm::gemm_phase<EpiE3, SchedE3, false>(lds, S, E); } }
            else if (EN(5)) { SchedDftS S{(const char*)WDFTL, (const char*)WDFTX, (const char*)ZB, (const char*)ZC, G, bid, 1024 + (i == 1 ? 128 : 0)}; EpiDftS E{RA, AMID};
                   REP(18) gm::gemm_phase<EpiDftS, SchedDftS, false, MK_FP8_DFT != 0>(lds, S, E);
                   BG_FILL(1024 + (i == 1 ? 128 : 0), 1, 0, i == 1 ? BG1_DFTS_E : 0); }
            SEAM(pb + 2);
        }
        if (EN(6) && even && IN(pb + 3)) { WSP_DECL;
            const int total = 1024 + (i == 0 ? 128 : 0);
            REP(2) for (int it = 0;; ++it) { const int u = it * G + bid; if (u >= total) break;
                const bool cx = u >= 1024; const int xl_ = bid >> 3;
                const int bhp = cx ? u - 1024 : (G == 256 ? ((bid & 7) + 8 * ((xl_ >> 3) + 4 * it)) : (u & 127)), qt = cx ? 0 : (G == 256 ? (xl_ & 7) : (u >> 7)), b = bhp >> 2, hp = bhp & 3;
#if MK_QK8 && MK_PV8
                attn_unit8(lds, QB, KN, KR, VT, RA, b, hp, cx ? MLAT + b * LC : b * SEQ + qt * 256, cx ? SEQ : 0, cx ? 4 : 36, tid); }
#else
                attn_unit(lds, QB, KN, KR, VT, RA, b, hp, cx ? MLAT + b * LC : b * SEQ + qt * 256, cx ? SEQ : 0, cx ? 4 : 36, tid); }
#endif
            SEAM(pb + 3);
        }
        if (EN(7) && IN(pb + 4)) { WSP_DECL;
            SchedResid S{(const char*)RA, (const char*)(even ? WMIXOUT + (size_t)e * 1024 * 1024 : WFNET + (size_t)e * 1024 * 1024), 2048u, 16, nrows / 256, G, bid};
            if ((MK_DUP >> 8) & 1u) { EpiResid Ed{AIN(I_X), AIN(I_CTX), (i == 0) ? (const bf16*)nullptr : (const bf16*)XCUR, (bf16*)AOUT, modbase + 2048, 1.0f}; gm::gemm_phase<EpiResid, SchedResid, false>(lds, S, Ed); }
            EpiResid E{AIN(I_X), AIN(I_CTX), (i == 0) ? (const bf16*)nullptr : (const bf16*)XCUR, XCUR, modbase + 2048, 1.0f};
            gm::gemm_phase<EpiResid, SchedResid, false>(lds, S, E);
            BG_FILL((nrows / 256) * 4, i == 0 ? 0 : 1, i == 0 ? BG0_MIXIN_E : BG1_DFTS_E, i == 0 ? BG0_MIXOUT_E : (i == 1 ? BG1_FNET_E : 0));
            SEAM(pb + 4);
        }
        if (EN(8) && IN(pb + 5)) { WSP_DECL;
            if (even) REP(7) phase_mod2<false>(XS_CUR, AIN(I_NFG) + i * D, modbase, RA, FP8_FFN(i), nrows, nullptr, nullptr, nullptr, nullptr, lds, bid, G, wave, lane, tid);
            else phase_mod2<true>(XS_CUR, AIN(I_NFG) + i * D, modbase, RA, FP8_MOE(i), nrows, AIN(I_ROUTER) + (size_t)e * D * 8, (unsigned*)(wsp + WS_CTL) + CW_CNT + e * 16 * 64, LIST, GLIST, lds, bid, G, wave, lane, tid);
            SEAM(pb + 5);
        }
        if (even) {
            if (EN(9) && IN(pb + 6)) { WSP_DECL;
                if (FP8_FFN(i)) { SchedUp S{(const char*)RA, (const char*)(WFFN13 + (size_t)e * 5632 * 1024), nrows / 256, 22, G, bid, 1024u, 8}; EpiSwiglu8 E{(unsigned char*)ACT, DFF};
                    REP(1) gm::gemm_phase<EpiSwiglu8, SchedUp, false, true>(lds, S, E); }
                else { SchedUp S{(const char*)RA, (const char*)(WFFN13 + (size_t)e * 5632 * 1024), nrows / 256, 22, G, bid, 2048u, 16}; EpiSwiglu E{ACT, DFF};
                    REP(1) gm::gemm_phase<EpiSwiglu, SchedUp, false>(lds, S, E); }
                BG_FILL((nrows / 256) * 22, 0, BG0_MIXOUT_E, i == 0 ? BG0_UP_E : 0);
                SEAM(pb + 6); }
            if (EN(10) && IN(pb + 7)) { WSP_DECL;
                if (FP8_FFN(i)) { SchedResid S{(const char*)ACT, (const char*)(WFFN2 + (size_t)e * 1024 * DFF), (unsigned)DFF, DFF / 128, nrows / 256, G, bid};
                    if ((MK_DUP >> 9) & 1u) { EpiResid Ed{nullptr, nullptr, (const bf16*)XCUR, (bf16*)AOUT, modbase + 5 * 1024, 1.0f / (W8_SCALE * A8_SCALE)}; gm::gemm_phase<EpiResid, SchedResid, false, true>(lds, S, Ed); }
                    EpiResid E{nullptr, nullptr, (const bf16*)XCUR, XCUR, modbase + 5 * 1024, 1.0f / (W8_SCALE * A8_SCALE)};
                    gm::gemm_phase<EpiResid, SchedResid, false, true>(lds, S, E); }
                else { SchedResid S{(const char*)ACT, (const char*)(WFFN2 + (size_t)e * 1024 * DFF), (unsigned)(DFF * 2), DFF / 64, nrows / 256, G, bid};
                    if ((MK_DUP >> 9) & 1u) { EpiResid Ed{nullptr, nullptr, (const bf16*)XCUR, (bf16*)AOUT, modbase + 5 * 1024, 1.0f}; gm::gemm_phase<EpiResid, SchedResid, false>(lds, S, Ed); }
                    EpiResid E{nullptr, nullptr, (const bf16*)XCUR, XCUR, modbase + 5 * 1024, 1.0f};
                    gm::gemm_phase<EpiResid, SchedResid, false>(lds, S, E); }
                BG_FILL((nrows / 256) * 4, 0, BG0_UP_E, i == 0 ? BG0_END : 0);
                SEAM(pb + 7); }
        } else {
#pragma unroll 1
            for (int s = 0; s < 2; ++s) {
                const int cwo = CW_CNT + (e * 16 + s * 8) * 64;
                if (EN(11) && IN(pb + 6 + 2 * s)) { WSP_DECL;
                    if (FP8_MOE(i)) { SchedMoeUp8 S; S.H2 = (const char*)RA; S.W13 = (const char*)WMOE13_8(e); S.list = LIST + (size_t)s * 8 * MALL; moe_info((const unsigned*)(wsp + WS_CTL) + cwo, S.mi); S.G = G; S.c = bid; S.rd = 0;
                        if (MOE_CHAIN_ON && s == 1) S.rd = (i == 1) ? 160 : 32;
                        EpiSwiglu8 E{(unsigned char*)ACT + (MOE_CHAIN_ON ? (size_t)s * (RB_SIZE / 2) : (size_t)0), DFFE};
                        REP(0) gm::gemm_phase<EpiSwiglu8, SchedMoeUp8, true, true>(lds, S, E); }
                    else { SchedMoeUp S; S.H2 = (const char*)RA; S.W13 = (const char*)WMOE13; S.list = LIST + (size_t)s * 8 * MALL; moe_info((const unsigned*)(wsp + WS_CTL) + cwo, S.mi); S.G = G; S.c = bid;
                        EpiSwiglu E{ACT, DFFE};
                        REP(0) gm::gemm_phase<EpiSwiglu, SchedMoeUp, true>(lds, S, E); }
                    SEAM(pb + 6 + 2 * s); }
                if (EN(12) && IN(pb + 7 + 2 * s)) { WSP_DECL;
                    if (FP8_MOE(i)) { SchedMoeDown8 S; S.Ab = (const char*)ACT + (MOE_CHAIN_ON ? (size_t)s * (RB_SIZE / 2) : (size_t)0); S.W2 = (const char*)WMOE2_8(e); moe_info((const unsigned*)(wsp + WS_CTL) + cwo, S.mi); S.G = G; S.c = bid;
                        if ((MK_DUP >> 10) & 1u) { EpiMoeDown Ed{XCUR, (const bf16*)(wsp + WS_G16) + (size_t)i * 33 * 1024, LIST + (size_t)s * 8 * MALL, GLIST + (size_t)s * 8 * MALL, 1.0f / (W8_SCALE * A8_SCALE), (bf16*)AOUT}; gm::gemm_phase<EpiMoeDown, SchedMoeDown8, false, true>(lds, S, Ed); }
                        EpiMoeDown E{XCUR, (const bf16*)(wsp + WS_G16) + (size_t)i * 33 * 1024, LIST + (size_t)s * 8 * MALL, GLIST + (size_t)s * 8 * MALL, 1.0f / (W8_SCALE * A8_SCALE), XCUR};
                        gm::gemm_phase<EpiMoeDown, SchedMoeDown8, false, true>(lds, S, E);
                        if (!(MOE_CHAIN_ON && s == 0)) BG_FILL(S.mi.nt * 4, 1, BG1_MD0_E, i == 1 ? BG1_MIXIN : 0); }
                    else { SchedMoeDown S; S.Ab = (const char*)ACT; S.W2 = (const char*)WMOE2; moe_info((const unsigned*)(wsp + WS_CTL) + cwo, S.mi); S.G = G; S.c = bid;
                        EpiMoeDown E{XCUR, (const bf16*)(wsp + WS_G16) + (size_t)i * 33 * 1024, LIST + (size_t)s * 8 * MALL, GLIST + (size_t)s * 8 * MALL, 1.0f, XCUR};
                        gm::gemm_phase<EpiMoeDown, SchedMoeDown, false>(lds, S, E); }
                    if (!(MOE_CHAIN_ON && s == 0)) SEAM(pb + 7 + 2 * s); else __syncthreads(); }
            }
        }
    }
    if (EN(13) && IN(NPH - 1)) { WSP_DECL; phase_final(XCUR, AOUT, AIN(I_FINALG), gw, NGW, lane); }
#if MK_WPROBE
    { if (threadIdx.x == 0) __hip_atomic_fetch_add(ctl + 32768, wacc, __ATOMIC_RELAXED, __HIP_MEMORY_SCOPE_AGENT);
      xcd_barrier<false>(bar);
      if (bid == 0 && threadIdx.x == 0) { const unsigned tot = __hip_atomic_load(ctl + 32768, __ATOMIC_RELAXED, __HIP_MEMORY_SCOPE_AGENT);
          const unsigned long long dl = (unsigned long long)(tot / (unsigned)G) * WP_MULT, ts = __builtin_amdgcn_s_memrealtime();
          while (__builtin_amdgcn_s_memrealtime() - ts < dl) __builtin_amdgcn_s_sleep(8); } }
#endif
#undef IN
#undef SEAM
}

extern "C" void kernel_launch(void* const* d_in, const int* in_sizes, int n_in, void* d_out, int out_size, void* d_ws, size_t ws_size, hipStream_t stream) {
    static int grid = 0;
    if (grid == 0) {
        if (n_in != N_IN || out_size != MLAT * D || ws_size < WS_END) { fprintf(stderr, "kernel_launch: unexpected problem (n_in %d, out %d, ws %zu < %zu)\n", n_in, out_size, ws_size, (size_t)WS_END); grid = -1; return; }
        int dev = 0, cus = 0, per_cu = 0;
        if (hipGetDevice(&dev) != hipSuccess || hipDeviceGetAttribute(&cus, hipDeviceAttributeMultiprocessorCount, dev) != hipSuccess) { grid = -1; return; }
        if (hipFuncSetAttribute((const void*)fwd, hipFuncAttributeMaxDynamicSharedMemorySize, LDS_BYTES) != hipSuccess) { fprintf(stderr, "kernel_launch: hipFuncSetAttribute failed\n"); grid = -1; return; }
        if (hipOccupancyMaxActiveBlocksPerMultiprocessor(&per_cu, (const void*)fwd, 512, LDS_BYTES) != hipSuccess || per_cu < 1) fprintf(stderr, "kernel_launch: occupancy query reports %d\n", per_cu);
        (void)hipGetLastError();
        grid = cus;
        if (grid != 256) fprintf(stderr, "kernel_launch: %d CUs (built for 256)\n", grid);
    }
    if (grid < 0) return;
    (void)hipMemsetAsync((char*)d_ws + WS_CTL, 0, CTL_BYTES, stream);
    Args a{};
    for (int i = 0; i < N_IN; ++i) a.in[i] = (const float*)d_in[i];
    a.out = (float*)d_out; a.ws = (unsigned char*)d_ws;
#if MK_PER_PHASE
    for (int p = 0; p < NPH; ++p) {
        const int k = (p - 2) % 10, layer = (p - 2) / 10;
        if (p >= 2 && p < NPH - 1) { const bool even = !(layer & 1); if (even && k >= 8) continue; if (!even && k == 3) continue; }
        a.ph_lo = p; a.ph_hi = p + 1;
        hipLaunchKernelGGL(fwd, dim3(grid), dim3(512), LDS_BYTES, stream, a);
    }
#else
    a.ph_lo = 0; a.ph_hi = NPH;
    hipLaunchKernelGGL(fwd, dim3(grid), dim3(512), LDS_BYTES, stream, a);
#endif
}
```

```cpp
#include <hip/hip_runtime.h>
#include <cstdio>
#include <cstdint>

#ifndef MK_FP8_L1
#define MK_FP8_L1 1
#endif
#define FP8_MOE(i) ((i) == 3 || MK_FP8_L1)
#ifndef MK_BG
#define MK_BG 1
#endif
#define BG_ON (MK_BG && MK_FP8_L1)
#ifndef MK_QK8
#define MK_QK8 1
#endif
#ifndef MK_PV8
#define MK_PV8 1
#endif
#ifndef MK_NT
#define MK_NT 1
#endif
#ifndef MK_MOE_CHAIN
#define MK_MOE_CHAIN 1
#endif
#define MOE_CHAIN_ON (MK_MOE_CHAIN && MK_FP8_L1)
#define MOE_SKIP 3
#ifndef MK_WPROBE
#define MK_WPROBE 0
#endif
#ifndef WP_KMASK
#define WP_KMASK 0x3ff
#define WP_LMASK 0x1f
#define WP_MULT 10
#endif
#define WP_SEL(p) ((p) < 2 ? (((WP_LMASK >> 4) & 1) && ((WP_KMASK >> (p)) & 1)) : (p) >= 42 ? (((WP_LMASK >> 4) & 1) && ((WP_KMASK >> 2) & 1)) : (((WP_LMASK >> (((p) - 2) / 10)) & 1) && ((WP_KMASK >> (((p) - 2) % 10)) & 1)))
#ifndef MK_FP8_DFT
#define MK_FP8_DFT 1
#endif
#ifndef MK_FP8_MIXIN
#define MK_FP8_MIXIN 1
#endif
#ifndef MK_FP8_FFN
#define MK_FP8_FFN 2
#endif
#define FP8_FFN(i) (((MK_FP8_FFN) >> ((i) >> 1)) & 1)
#ifndef MK_DUP
#define MK_DUP 0u
#endif
#ifndef MK_PER_PHASE
#define MK_PER_PHASE 0
#endif

#define LAS __attribute__((address_space(3)))
#define GAS __attribute__((address_space(1)))
typedef unsigned short bf16;
typedef short bf16x8 __attribute__((ext_vector_type(8)));
typedef short s16x4 __attribute__((ext_vector_type(4)));
typedef float f32x4 __attribute__((ext_vector_type(4)));
typedef float f32x2 __attribute__((ext_vector_type(2)));
typedef float f32x16 __attribute__((ext_vector_type(16)));
typedef unsigned u32x4 __attribute__((ext_vector_type(4)));
typedef unsigned u32x2 __attribute__((ext_vector_type(2)));
typedef __bf16 bf16x2_t __attribute__((ext_vector_type(2)));

constexpr int NB = 32, SEQ = 2048, LC = 256, D = 1024, DEPTH = 4;
constexpr int MLAT = NB * SEQ, MCTX = NB * LC, MALL = MLAT + MCTX;
constexpr int TLAT = MLAT / 256, TCTX = MCTX / 256, TALL = MALL / 256;
constexpr int HEADS = 8, QKN = 64, QKR = 32, VD = 64, QLORA = 256, KVLORA = 128;
constexpr int QW = HEADS * (QKN + QKR);
constexpr int NKEY = SEQ + LC;
constexpr int DFF = 2816, DFFE = 3584, NEXP = 8;
constexpr float EPS = 1e-6f;
constexpr float QSCALE = 0.10206207261596577f * 1.4426950408889634f;

enum { I_X = 0, I_C, I_CTX, I_CCTX, I_ADAW, I_ADAB, I_NMG, I_NFG, I_MIXIN, I_CQG, I_CKVG, I_WUQ, I_WUKV, I_POOLW, I_POOLS, I_MIXOUT,
       I_FW1, I_FW3, I_FW2, I_FNET, I_ROUTER, I_MW1, I_MW3, I_MW2, I_FINALG, N_IN };

constexpr size_t al(size_t x) { return (x + 4095) & ~(size_t)4095; }
constexpr size_t WS_CTL = 0, CTL_BYTES = 1u << 20;
constexpr size_t WS_MOD = WS_CTL + CTL_BYTES;
constexpr size_t WS_ROPE = al(WS_MOD + (size_t)DEPTH * 33 * 6 * D * 4);
constexpr size_t WS_SSQQ = al(WS_ROPE + 64 * 16 * 4);
constexpr size_t WS_SSQK = al(WS_SSQQ + (size_t)MALL * 16);
constexpr size_t WS_HMID = al(WS_SSQK + (size_t)MALL * 16);
constexpr size_t WS_AMID = al(WS_HMID + 64 * D * 4);
constexpr size_t WS_LIST = al(WS_AMID + 64 * D * 4);
constexpr size_t WS_GLIST = al(WS_LIST + (size_t)2 * 8 * MALL * 4);
constexpr size_t WS_WMIXIN = al(WS_GLIST + (size_t)2 * 8 * MALL * 4);
constexpr size_t WS_WUQ = al(WS_WMIXIN + (size_t)2 * 1024 * 1024 * 2);
constexpr size_t WS_WUK = al(WS_WUQ + (size_t)2 * 768 * 256 * 2);
constexpr size_t WS_WUV = al(WS_WUK + (size_t)2 * 512 * 128 * 2);
constexpr size_t WS_WMIXOUT = al(WS_WUV + (size_t)2 * 512 * 128 * 2);
constexpr size_t WS_WFFN13 = al(WS_WMIXOUT + (size_t)2 * 1024 * 1024 * 2);
constexpr size_t WS_WFFN2 = al(WS_WFFN13 + (size_t)2 * 5632 * 1024 * 2);
constexpr size_t WS_WFNET = al(WS_WFFN2 + (size_t)2 * 1024 * 2816 * 2);
constexpr size_t WS_WDFTC = al(WS_WFNET + (size_t)2 * 1024 * 1024 * 2);
constexpr size_t WS_WDFTL = al(WS_WDFTC + (size_t)2 * 256 * 256 * 2);
constexpr size_t WS_WDFTX = al(WS_WDFTL + (size_t)2048 * 2048 * 2);
constexpr size_t WS_WMOE13 = al(WS_WDFTX + (size_t)256 * 256 * 2);
constexpr size_t WS_WMOE2 = al(WS_WMOE13 + (size_t)8 * 7168 * 1024 * 2);
constexpr size_t WS_XCUR = al(WS_WMOE2 + (size_t)8 * 1024 * 3584 * 2);
constexpr size_t WS_RA = al(WS_XCUR + (size_t)MALL * D * 2);
constexpr size_t WS_RB = al(WS_RA + (size_t)MALL * D * 2);
constexpr size_t RB_CQ = 0;
constexpr size_t RB_CKV = al(RB_CQ + (size_t)MALL * 256 * 2);
constexpr size_t RB_KR = al(RB_CKV + (size_t)MALL * 128 * 2);
constexpr size_t RB_POOL = al(RB_KR + (size_t)MALL * 32 * 2);
constexpr size_t RB_Q = al(RB_POOL + (size_t)MALL * 512 * 2);
constexpr size_t RB_KN = al(RB_Q + (size_t)MALL * 768 * 2);
constexpr size_t RB_VT = al(RB_KN + (size_t)MALL * 512 * 2);
constexpr size_t RB_EVEN_END = al(RB_VT + (size_t)NB * 512 * NKEY * 2);
constexpr size_t RB_Z = 0;
constexpr size_t RB_ZC = al(RB_Z + (size_t)NB * 4 * 256 * 2048 * 2);
constexpr size_t RB_ACT = 0;
constexpr size_t RB_SIZE = al((size_t)(MALL + 2048) * DFFE * 2);
static_assert(RB_EVEN_END <= RB_SIZE && (size_t)MALL * DFF * 2 <= RB_SIZE && RB_ZC + (size_t)NB * 4 * 256 * 256 * 2 <= RB_SIZE, "region B");
constexpr size_t WS_G16 = WS_RB + RB_SIZE;
constexpr size_t WS_END = al(WS_G16 + (size_t)DEPTH * 33 * 1024 * 2);
static_assert(WS_END < 1150000000ull, "workspace budget");

constexpr int CW_TMO = 0;
constexpr int CW_BAR = 4096;
constexpr int CW_CNT = 16384;

constexpr int STAGE_BYTES = 131072;
constexpr int ATQ_OFF = 90112;
constexpr int MISC_OFF = 143360;
constexpr int LDS_BYTES = 147456;

__device__ __forceinline__ unsigned pkbf(float lo, float hi) { f32x2 v = {lo, hi}; bf16x2_t b = __builtin_convertvector(v, bf16x2_t); return __builtin_bit_cast(unsigned, b); }
#if MK_NT
#define NTLD(ptr) __builtin_nontemporal_load(ptr)
#define NTST(ptr, v) __builtin_nontemporal_store((v), (ptr))
#else
#define NTLD(ptr) (*(ptr))
#define NTST(ptr, v) (*(ptr) = (v))
#endif
__device__ __forceinline__ unsigned pk4_fp8(float a, float b, float c, float d);
__device__ __forceinline__ float bf2f(unsigned short b) { return __uint_as_float(((unsigned)b) << 16); }
__device__ __forceinline__ float wave_sum(float v) {
#pragma unroll
    for (int o = 1; o < 64; o <<= 1) v += __shfl_xor(v, o);
    return v;
}
__device__ __forceinline__ float silu_f(float x) { return x / (1.0f + __expf(-x)); }

#define XB_TMO      128
#define XB_XCNT(j)  (256  + 64 * (j))
#define XB_XSUB(j)  (1280 + 64 * (j))
#define XB_XGEN(j)  (2304 + 64 * (j))
#define XB_TOP      3328
#define XB_TOPGEN   3392
#define XCD_BAR_WORDS 3456
#define XB_SPIN_CAP (1u << 22)

__device__ __forceinline__ unsigned xb_ld(unsigned* p)              { return __hip_atomic_load(p, __ATOMIC_RELAXED, __HIP_MEMORY_SCOPE_AGENT); }
__device__ __forceinline__ unsigned xb_add(unsigned* p, unsigned v) { return __hip_atomic_fetch_add(p, v, __ATOMIC_RELAXED, __HIP_MEMORY_SCOPE_AGENT); }
__device__ __forceinline__ unsigned xb_xcc_id() { return (unsigned)__builtin_amdgcn_s_getreg((3 << 11) | 20) & 0xFu; }
#define XB_SPIN(cond, bar) do { unsigned _sp = 0; while (cond) { __builtin_amdgcn_s_sleep(1); \
    if ((++_sp & 255u) == 0u) { if (xb_ld(&(bar)[XB_TMO])) break; if (_sp > XB_SPIN_CAP) { atomicAdd(&(bar)[XB_TMO], 1u); break; } } } } while (0)

struct XcdBarrier { unsigned* bar; unsigned x; volatile LAS unsigned* st; };

__device__ __forceinline__ XcdBarrier xcd_barrier_post(unsigned* bar, volatile LAS unsigned* st) {
    XcdBarrier b; b.bar = bar; b.x = xb_xcc_id(); b.st = st;
    if (threadIdx.x == 0) (void)xb_add(&bar[XB_XCNT(b.x)], 1u);
    return b;
}
__device__ __forceinline__ void xcd_barrier_complete(unsigned* bar, unsigned x, unsigned& nloc, unsigned& nx) {
    const unsigned G = gridDim.x * gridDim.y * gridDim.z;
    unsigned sum, cnt, mine, sp = 0u;
    for (;;) {
        sum = 0u; cnt = 0u; mine = 0u;
#pragma unroll
        for (unsigned j = 0; j < 16; ++j) { const unsigned c = xb_ld(&bar[XB_XCNT(j)]); sum += c; cnt += (c > 0u) ? 1u : 0u; mine = (j == x) ? c : mine; }
        if (sum == G) break;
        __builtin_amdgcn_s_sleep(1);
        if ((++sp & 255u) == 0u) { if (xb_ld(&bar[XB_TMO])) break; if (sp > XB_SPIN_CAP) { atomicAdd(&bar[XB_TMO], 1u); break; } }
    }
    nloc = mine > 0u ? mine : 1u; nx = cnt > 0u ? cnt : 1u;
}
template <bool FIRST>
__device__ __forceinline__ void xcd_barrier(const XcdBarrier& b) {
    asm volatile("s_waitcnt vmcnt(0)" ::: "memory");
    __syncthreads();
    if (threadIdx.x == 0) {
        unsigned* bar = b.bar; asm volatile("" : "+s"(bar));
        __builtin_amdgcn_s_waitcnt(0);
        unsigned nloc = b.st[0], nx = b.st[1];
        if constexpr (FIRST) { if (nloc == 0u) { xcd_barrier_complete(bar, b.x, nloc, nx); b.st[0] = nloc; b.st[1] = nx; } }
        const unsigned old = xb_add(&bar[XB_XSUB(b.x)], 1u);
        const unsigned gen = old / nloc;
        if (old + 1u == (gen + 1u) * nloc) {
            __builtin_amdgcn_fence(__ATOMIC_RELEASE, "agent");
            asm volatile("s_waitcnt vmcnt(0)" ::: "memory");
            const unsigned og = xb_add(&bar[XB_TOP], 1u);
            const unsigned tg = og / nx;
            if (og + 1u == (tg + 1u) * nx) xb_add(&bar[XB_TOPGEN], 1u);
            else XB_SPIN(xb_ld(&bar[XB_TOPGEN]) == tg, bar);
            xb_add(&bar[XB_XGEN(b.x)], 1u);
            __builtin_amdgcn_fence(__ATOMIC_ACQUIRE, "agent");
            asm volatile("s_waitcnt vmcnt(0)" ::: "memory");
        } else {
            XB_SPIN(xb_ld(&bar[XB_XGEN(b.x)]) == gen, bar);
            __builtin_amdgcn_fence(__ATOMIC_ACQUIRE, "agent");
            asm volatile("s_waitcnt vmcnt(0)" ::: "memory");
        }
    }
    __syncthreads();
}

namespace gm {
constexpr int BK = 64, HALF = 128, HTB = HALF * BK * 2;
__device__ __forceinline__ int lds_byte(int r, int c) { const int st = (r >> 4) * 2 + (c >> 5), rr = r & 15, cc = c & 31, ob = rr * 64 + cc * 2; return st * 1024 + (ob ^ (((ob >> 9) & 1) << 5)); }
__device__ __forceinline__ void stage_rc(int b, int& R, int& C) { const int st = b / 1024, sb = b % 1024, swz = sb ^ (((sb >> 9) & 1) << 5); R = (st >> 1) * 16 + swz / 64; C = (st & 1) * 32 + (swz % 64) / 2; }
__device__ __forceinline__ int perm32(int rho) { const int n = rho >> 4, i = rho & 15; return 8 * (i >> 2) + 4 * n + (i & 3); }

struct Unit { const char* A; const char* B; unsigned lda, ldb; int nt; int x0, x1, x2, x3; };
typedef int v8i_t __attribute__((ext_vector_type(8))); typedef int v4i_t __attribute__((ext_vector_type(4)));


__device__ __forceinline__ bool flat_index(int i, int G, int c, int total, int& idx) {
    const long Lx = (long)i * G + c; if (Lx >= total) return false;
    int wgid = (int)Lx; const int q = total / 8, r = total % 8, xcd = wgid % 8, off = wgid / 8;
    idx = (xcd < r ? xcd * (q + 1) : r * (q + 1) + (xcd - r) * q) + off; return true;
}
__device__ __forceinline__ bool flat_pos(int pos, int total, int& idx) {
    if (pos >= total) return false;
    const int wgid = pos, q = total / 8, r = total % 8, xcd = wgid % 8, off = wgid / 8;
    idx = (xcd < r ? xcd * (q + 1) : r * (q + 1) + (xcd - r) * q) + off; return true;
}
__device__ __forceinline__ void tile_order(int idx, int nM, int nN, int& pm, int& pn) {
    const int nig = 8 * nN, gid = idx / nig, fm = gid * 8, gsz = (nM - fm) < 8 ? (nM - fm) : 8;
    pm = fm + ((idx % nig) % gsz); pn = (idx % nig) / gsz;
}

template <class Epi, class Sched, bool GATHER, bool FP8 = false>
__device__ __forceinline__ void gemm_phase(LAS unsigned char* lds, const Sched& S, const Epi& E) {
    int tid = threadIdx.x; asm volatile("" : "+v"(tid));
    const int wid = __builtin_amdgcn_readfirstlane(tid >> 6), lane = tid & 63, wr = wid >> 2, wc = wid & 3, fr = lane & 15, fq = lane >> 4;
    const unsigned ldsw = (unsigned)wid * 1024u;
    const int aoff = lds_byte(wr * 64 + fr, fq * 8), boff = lds_byte(wc * 32 + fr, fq * 8);
#define G_SA(b, h) (((b) * 2 + (h)) * HTB)
#define G_SB(b, h) ((4 + (b) * 2 + (h)) * HTB)
#define G_LD(ptr, dst) __builtin_amdgcn_global_load_lds((const unsigned*)(ptr), (LAS unsigned*)(dst), 16, 0, 0)
#define G_STAGE_B(bufoff, P, hh, kb) do { const char* _p0 = P##p + (size_t)(kb) + ((hh) ? (size_t)P##s * 128u : (size_t)0); const char* _p1 = _p0 + (size_t)P##s * 64u; \
        asm volatile("" : "+s"(_p0), "+s"(_p1)); \
        G_LD(_p0 + P##v, lds + (bufoff) + ldsw); G_LD(_p1 + P##v, lds + (bufoff) + ldsw + 8192); } while (0)
#define G_STAGE_A(bufoff, P, hh, kb) do { if constexpr (GATHER) { const char* _p = P##p + (size_t)(kb); asm volatile("" : "+s"(_p)); \
        G_LD(_p + P##g[(hh) * 2], lds + (bufoff) + ldsw); G_LD(_p + P##g[(hh) * 2 + 1], lds + (bufoff) + ldsw + 8192); } else { G_STAGE_B(bufoff, P, hh, kb); } } while (0)
#define G_LDA(dst, b, h) do { _Pragma("unroll") for (int m = 0; m < 4; ++m) { const v4i_t _l = *(const LAS v4i_t*)(lds + G_SA(b, h) + aoff + m * 2048), _h = *(const LAS v4i_t*)(lds + G_SA(b, h) + aoff + m * 2048 + 1024); \
        dst[m] = __builtin_shufflevector(_l, _h, 0, 1, 2, 3, 4, 5, 6, 7); } } while (0)
#define G_LDB(dst, b, h) do { _Pragma("unroll") for (int n = 0; n < 2; ++n) { const v4i_t _l = *(const LAS v4i_t*)(lds + G_SB(b, h) + boff + n * 2048), _h = *(const LAS v4i_t*)(lds + G_SB(b, h) + boff + n * 2048 + 1024); \
        dst[n] = __builtin_shufflevector(_l, _h, 0, 1, 2, 3, 4, 5, 6, 7); } } while (0)
#define G_LO(x) __builtin_bit_cast(bf16x8, (v4i_t)__builtin_shufflevector(x, x, 0, 1, 2, 3))
#define G_HI(x) __builtin_bit_cast(bf16x8, (v4i_t)__builtin_shufflevector(x, x, 4, 5, 6, 7))
#define G_MMA(ai, bj, At, Bt) do { __builtin_amdgcn_s_setprio(1); \
        if constexpr (FP8) { _Pragma("unroll") for (int m = 0; m < 4; ++m) _Pragma("unroll") for (int n = 0; n < 2; ++n) \
            asm volatile("v_mfma_f32_16x16x128_f8f6f4 %0, %1, %2, %0" : "+v"(acc[ai][bj][m][n]) : "v"(Bt[n]), "v"(At[m])); } \
        else { _Pragma("unroll") for (int m = 0; m < 4; ++m) _Pragma("unroll") for (int n = 0; n < 2; ++n) { \
            acc[ai][bj][m][n] = __builtin_amdgcn_mfma_f32_16x16x32_bf16(G_LO(Bt[n]), G_LO(At[m]), acc[ai][bj][m][n], 0, 0, 0); \
            acc[ai][bj][m][n] = __builtin_amdgcn_mfma_f32_16x16x32_bf16(G_HI(Bt[n]), G_HI(At[m]), acc[ai][bj][m][n], 0, 0, 0); } } \
        __builtin_amdgcn_s_setprio(0); } while (0)
#define G_MMA0(ai, bj, At, Bt) do { __builtin_amdgcn_s_setprio(1);     \
        if constexpr (FP8) { _Pragma("unroll") for (int m = 0; m < 4; ++m) _Pragma("unroll") for (int n = 0; n < 2; ++n) \
            asm volatile("v_mfma_f32_16x16x128_f8f6f4 %0, %1, %2, 0" : "=&v"(acc[ai][bj][m][n]) : "v"(Bt[n]), "v"(At[m])); } \
        else { _Pragma("unroll") for (int m = 0; m < 4; ++m) _Pragma("unroll") for (int n = 0; n < 2; ++n) { \
            acc[ai][bj][m][n] = __builtin_amdgcn_mfma_f32_16x16x32_bf16(G_LO(Bt[n]), G_LO(At[m]), (f32x4){0.f, 0.f, 0.f, 0.f}, 0, 0, 0); \
            acc[ai][bj][m][n] = __builtin_amdgcn_mfma_f32_16x16x32_bf16(G_HI(Bt[n]), G_HI(At[m]), acc[ai][bj][m][n], 0, 0, 0); } } \
        __builtin_amdgcn_s_setprio(0); } while (0)
#define G_WAIT_V(n) asm volatile("s_waitcnt vmcnt(" #n ")" ::: "memory")
#define G_WAIT_L(n) asm volatile("s_waitcnt lgkmcnt(" #n ")" ::: "memory")
#define G_BAR __builtin_amdgcn_s_barrier()
#define G_SCHED __builtin_amdgcn_sched_barrier(0)
#define G_SETUP(P_A, P_B, U) do { int _t = threadIdx.x; asm volatile("" : "+v"(_t)); int R0, C0; stage_rc(_t * 16, R0, C0); const int Rb0 = (R0 & ~31) + perm32(R0 & 31);     \
        P_A##p = (U).A; P_A##s = (U).lda; P_B##p = (U).B; P_B##s = (U).ldb; P_B##v = (unsigned)Rb0 * (U).ldb + (unsigned)C0 * 2u; \
        if constexpr (GATHER) { _Pragma("unroll") for (int _q = 0; _q < 4; ++_q) P_A##g[_q] = (unsigned)S.gather_row((U), R0 + 64 * _q) * (U).lda + (unsigned)C0 * 2u; P_A##v = 0u; } \
        else { P_A##v = (unsigned)R0 * (U).lda + (unsigned)C0 * 2u; } } while (0)
    Unit cur, nxt; int ui = 0;
    if (!S.next(0, cur)) return;
    f32x4 acc[2][2][4][2];
    v8i_t At[4], B0[2], B1[2];
    const char *cAp, *cBp, *nAp, *nBp; unsigned cAs, cBs, nAs, nBs, cAv, cBv, nAv, nBv; unsigned cAg[4], nAg[4];
#pragma unroll
    for (int q = 0; q < 4; ++q) { cAg[q] = 0u; nAg[q] = 0u; }
    G_SETUP(cA, cB, cur);
    G_STAGE_B(G_SB(0, 0), cB, 0, 0); G_STAGE_B(G_SB(0, 1), cB, 1, 0); G_STAGE_A(G_SA(0, 0), cA, 0, 0); G_STAGE_A(G_SA(0, 1), cA, 1, 0);
    if (wr == 1) G_BAR;
    G_WAIT_V(2); G_BAR;
    G_STAGE_B(G_SB(1, 0), cB, 0, 128); G_STAGE_A(G_SA(1, 0), cA, 0, 128); G_STAGE_B(G_SB(1, 1), cB, 1, 128);
    G_WAIT_V(6); G_BAR;
    for (;;) {
        const bool has_next = S.next(ui + 1, nxt);
        if (has_next) { G_SETUP(nA, nB, nxt); } else { nAp = cAp; nBp = cBp; nAs = cAs; nBs = cBs; nAv = cAv; nBv = cBv;
#pragma unroll
            for (int q = 0; q < 4; ++q) nAg[q] = cAg[q]; }
        int nt = cur.nt; asm volatile("" : "+s"(nt));
#define G_KSTEP(MM) { \
            const bool last = (t == nt - 2); \
            const size_t k1 = (size_t)(t + 1) * 128; \
              \
            G_LDB(B0, 0, 0); G_LDB(B1, 0, 1); G_SCHED; G_LDA(At, 0, 0); G_STAGE_A(G_SA(1, 1), cA, 1, k1); \
            G_WAIT_V(8); G_WAIT_L(0); G_BAR; MM(0, 0, At, B0); MM(0, 1, At, B1); G_BAR; G_SCHED; \
              \
            G_LDA(At, 0, 1); \
            if (last) { G_STAGE_B(G_SB(0, 0), nB, 0, 0); G_STAGE_B(G_SB(0, 1), nB, 1, 0); G_STAGE_A(G_SA(0, 0), nA, 0, 0); } \
            else { const size_t k2 = (size_t)(t + 2) * 128; G_STAGE_B(G_SB(0, 0), cB, 0, k2); G_STAGE_B(G_SB(0, 1), cB, 1, k2); G_STAGE_A(G_SA(0, 0), cA, 0, k2); } \
            G_WAIT_V(8); G_WAIT_L(0); G_BAR; MM(1, 0, At, B0); MM(1, 1, At, B1); G_BAR; G_SCHED; \
              \
            G_LDB(B0, 1, 0); G_LDB(B1, 1, 1); G_SCHED; G_LDA(At, 1, 0); \
            if (last) { G_STAGE_A(G_SA(0, 1), nA, 1, 0); } else { const size_t k2 = (size_t)(t + 2) * 128; G_STAGE_A(G_SA(0, 1), cA, 1, k2); } \
            G_WAIT_V(8); G_WAIT_L(0); G_BAR; G_MMA(0, 0, At, B0); G_MMA(0, 1, At, B1); G_BAR; G_SCHED; \
              \
            G_LDA(At, 1, 1); \
            if (last) { G_STAGE_B(G_SB(1, 0), nB, 0, 128); G_STAGE_B(G_SB(1, 1), nB, 1, 128); G_STAGE_A(G_SA(1, 0), nA, 0, 128); } \
            else { const size_t k3 = (size_t)(t + 3) * 128; G_STAGE_B(G_SB(1, 0), cB, 0, k3); G_STAGE_B(G_SB(1, 1), cB, 1, k3); G_STAGE_A(G_SA(1, 0), cA, 0, k3); } \
            G_WAIT_V(8); G_WAIT_L(0); G_BAR; G_MMA(1, 0, At, B0); G_MMA(1, 1, At, B1); G_BAR; G_SCHED; \
        }
        { const int t = 0; G_KSTEP(G_MMA0) }
        for (int t = 2; t < nt; t += 2) G_KSTEP(G_MMA)
#undef G_KSTEP
        if (wr == 0) G_BAR;
        if constexpr (FP8) asm volatile("s_nop 15\n\ts_nop 15" ::: "memory");
        { int _t = threadIdx.x; asm volatile("" : "+v"(_t)); const int _w = __builtin_amdgcn_readfirstlane(_t >> 6), _l = _t & 63;
          E(acc, cur, _w >> 2, _w & 3, _l & 15, _l >> 4); }
        if (!has_next) break;
        cur = nxt; cAp = nAp; cBp = nBp; cAs = nAs; cBs = nBs; cAv = nAv; cBv = nBv;
#pragma unroll
        for (int q = 0; q < 4; ++q) cAg[q] = nAg[q];
        ++ui;
        if (wr == 1) G_BAR;
    }
    G_WAIT_V(0);
    G_BAR;
#undef G_SA
#undef G_SB
#undef G_LD
#undef G_STAGE_A
#undef G_STAGE_B
#undef G_LDA
#undef G_LDB
#undef G_MMA
#undef G_MMA0
#undef G_WAIT_V
#undef G_WAIT_L
#undef G_BAR
#undef G_SCHED
#undef G_SETUP
}
}

typedef const f32x4 (&AccRef)[2][2][4][2];
__device__ __forceinline__ u32x4 pack8(const f32x4 a, const f32x4 b) { u32x4 w; w.x = pkbf(a[0], a[1]); w.y = pkbf(a[2], a[3]); w.z = pkbf(b[0], b[1]); w.w = pkbf(b[2], b[3]); return w; }

__device__ __forceinline__ void rope8(f32x4& v0, f32x4& v1, int fq, int t, const float* ropeC, const float* ropeS) {
    const int pos = (fq < 2) ? (t >> 6) : (t & 63);
    const f32x4 c0 = *(const f32x4*)(ropeC + pos * 8), c1 = *(const f32x4*)(ropeC + pos * 8 + 4);
    const f32x4 s0 = *(const f32x4*)(ropeS + pos * 8), s1 = *(const f32x4*)(ropeS + pos * 8 + 4);
    f32x4 p0, p1;
#pragma unroll
    for (int j = 0; j < 4; ++j) { p0[j] = __shfl_xor(v0[j], 16); p1[j] = __shfl_xor(v1[j], 16); }
    const float sg = (fq & 1) ? 1.0f : -1.0f;
    v0 = v0 * c0 + (p0 * s0) * sg; v1 = v1 * c1 + (p1 * s1) * sg;
}

struct SchedMixIn {
    const char* H; const char* W; int G, c, total; bool ctx_full;
    __device__ __forceinline__ bool next(int i, gm::Unit& u) const {
        int idx; if (!gm::flat_index(i, G, c, total, idx)) return false;
        int pm, pn;
        if (idx < 1024) gm::tile_order(idx, 256, 4, pm, pn);
        else { const int j = idx - 1024; if (ctx_full) { gm::tile_order(j, 32, 4, pm, pn); pm += 256; } else { pm = 256 + j; pn = 1; } }
        constexpr unsigned P = MK_FP8_MIXIN ? 1024u : 2048u;
        u.A = H + (size_t)pm * 256 * P; u.lda = P; u.B = W + (size_t)pn * 256 * P; u.ldb = P; u.nt = 16 / (MK_FP8_MIXIN ? 2 : 1); u.x0 = pm; u.x1 = pn; u.x2 = 0; u.x3 = 0; return true;
    }
};
struct EpiMixIn {
    bf16 *CQ, *CKV, *KR, *POOL; float *SSQQ, *SSQK; const float *ropeC, *ropeS;
    __device__ __forceinline__ void operator()(AccRef accr, const gm::Unit& u, int wr, int wc, int fr, int fq) const {
        const int pn = u.x1, row0 = u.x0 * 256 + wr * 64 + fr, cl = wc * 32 + fq * 8;
        constexpr float WS = MK_FP8_MIXIN ? (1.0f / 32.0f) : 1.0f;
        f32x4 acc[2][2][4][2];
#pragma unroll
        for (int a_ = 0; a_ < 2; ++a_)
#pragma unroll
            for (int b_ = 0; b_ < 2; ++b_)
#pragma unroll
                for (int m_ = 0; m_ < 4; ++m_)
#pragma unroll
                    for (int n_ = 0; n_ < 2; ++n_) acc[a_][b_][m_][n_] = accr[a_][b_][m_][n_] * WS;
        if (pn == 0) {
#pragma unroll
            for (int ai = 0; ai < 2; ++ai)
#pragma unroll
                for (int m = 0; m < 4; ++m) { const int row = row0 + ai * 128 + m * 16; float ss = 0.f;
#pragma unroll
                    for (int bj = 0; bj < 2; ++bj) { const f32x4 a = acc[ai][bj][m][0], b = acc[ai][bj][m][1];
                        ss += (a[0] * a[0] + a[1] * a[1]) + (a[2] * a[2] + a[3] * a[3]) + (b[0] * b[0] + b[1] * b[1]) + (b[2] * b[2] + b[3] * b[3]);
                        *(u32x4*)(CQ + (size_t)row * 256 + bj * 128 + cl) = pack8(a, b); }
                    ss += __shfl_xor(ss, 16); ss += __shfl_xor(ss, 32);
                    if (fq == 0) SSQQ[(size_t)row * 4 + wc] = ss; }
        } else if (pn == 1) {
            const bool lat = u.x0 < TLAT;
#pragma unroll
            for (int ai = 0; ai < 2; ++ai)
#pragma unroll
                for (int m = 0; m < 4; ++m) { const int row = row0 + ai * 128 + m * 16;
                    const f32x4 a = acc[ai][0][m][0], b = acc[ai][0][m][1];
                    float ss = (a[0] * a[0] + a[1] * a[1]) + (a[2] * a[2] + a[3] * a[3]) + (b[0] * b[0] + b[1] * b[1]) + (b[2] * b[2] + b[3] * b[3]);
                    *(u32x4*)(CKV + (size_t)row * 128 + cl) = pack8(a, b);
                    ss += __shfl_xor(ss, 16); ss += __shfl_xor(ss, 32);
                    if (fq == 0) SSQK[(size_t)row * 4 + wc] = ss;
                    if (wc == 0) { f32x4 r0 = acc[ai][1][m][0], r1 = acc[ai][1][m][1];
                        if (lat) rope8(r0, r1, fq, row & (SEQ - 1), ropeC, ropeS);
                        *(u32x4*)(KR + (size_t)row * 32 + fq * 8) = pack8(r0, r1); } }
        } else {
#pragma unroll
            for (int ai = 0; ai < 2; ++ai)
#pragma unroll
                for (int m = 0; m < 4; ++m) { const int row = row0 + ai * 128 + m * 16;
#pragma unroll
                    for (int bj = 0; bj < 2; ++bj) *(u32x4*)(POOL + (size_t)row * 512 + (pn - 2) * 256 + bj * 128 + cl) = pack8(acc[ai][bj][m][0], acc[ai][bj][m][1]); }
        }
    }
};

struct SchedE3 {
    const char *CQ, *CKV, *WUQ, *WUK, *WUV; int G, c, nq, total;
    __device__ __forceinline__ bool next(int i, gm::Unit& u) const {
        int idx; if (!gm::flat_index(i, G, c, total, idx)) return false;
        int pm, pn; u.x3 = 0;
        if (idx < nq * 3) { gm::tile_order(idx, nq, 3, pm, pn);
            u.A = CQ + (size_t)pm * 256 * 512; u.lda = 512; u.B = WUQ + (size_t)pn * 256 * 512; u.ldb = 512; u.nt = 4; u.x0 = pm; u.x1 = pn; u.x2 = 0; return true; }
        int j = idx - nq * 3;
        if (j < 576) { gm::tile_order(j, 288, 2, pm, pn);
            u.A = CKV + (size_t)pm * 256 * 256; u.lda = 256; u.B = WUK + (size_t)pn * 256 * 256; u.ldb = 256; u.nt = 2; u.x0 = pm; u.x1 = pn; u.x2 = 1; return true; }
        j -= 576; pm = j & 1; pn = j >> 1;
        u.A = WUV + (size_t)pm * 256 * 256; u.lda = 256; u.B = CKV + (size_t)pn * 256 * 256; u.ldb = 256; u.nt = 2; u.x0 = pm; u.x1 = pn; u.x2 = 2; return true;
    }
};
struct EpiE3 {
    bf16 *Q, *KN, *VT; const float *SSQQ, *SSQK, *ropeC, *ropeS;
    __device__ __forceinline__ void operator()(AccRef acc, const gm::Unit& u, int wr, int wc, int fr, int fq) const {
        const int pm = u.x0, pn = u.x1, ty = u.x2, cl = wc * 32 + fq * 8;
        if (ty == 0) {
            const bool lat = pm < TLAT;
            float rq[2][4];
#pragma unroll
            for (int ai = 0; ai < 2; ++ai)
#pragma unroll
                for (int m = 0; m < 4; ++m) { const f32x4 sq = *(const f32x4*)(SSQQ + (size_t)(pm * 256 + wr * 64 + fr + ai * 128 + m * 16) * 4);
                    rq[ai][m] = __builtin_amdgcn_rsqf(((sq[0] + sq[1]) + (sq[2] + sq[3])) * (1.0f / 256.0f) + EPS); }
#pragma unroll
            for (int ai = 0; ai < 2; ++ai)
#pragma unroll
                for (int m = 0; m < 4; ++m) { const int row = pm * 256 + wr * 64 + fr + ai * 128 + m * 16;
#pragma unroll
                    for (int bj = 0; bj < 2; ++bj) { f32x4 a = acc[ai][bj][m][0] * rq[ai][m], b = acc[ai][bj][m][1] * rq[ai][m];
                        const int g32 = 8 * pn + 4 * bj + wc;
                        if (lat && (g32 % 3) == 2) rope8(a, b, fq, row & (SEQ - 1), ropeC, ropeS);
                        *(u32x4*)(Q + (size_t)row * QW + pn * 256 + bj * 128 + cl) = pack8(a, b); } }
        } else if (ty == 1) {
            float rk[2][4];
#pragma unroll
            for (int ai = 0; ai < 2; ++ai)
#pragma unroll
                for (int m = 0; m < 4; ++m) { const f32x4 sq = *(const f32x4*)(SSQK + (size_t)(pm * 256 + wr * 64 + fr + ai * 128 + m * 16) * 4);
                    rk[ai][m] = __builtin_amdgcn_rsqf(((sq[0] + sq[1]) + (sq[2] + sq[3])) * (1.0f / 128.0f) + EPS); }
#pragma unroll
            for (int ai = 0; ai < 2; ++ai)
#pragma unroll
                for (int m = 0; m < 4; ++m) { const int row = pm * 256 + wr * 64 + fr + ai * 128 + m * 16;
#pragma unroll
                    for (int bj = 0; bj < 2; ++bj) {
                        if (MK_QK8) { const f32x4 x0 = acc[ai][bj][m][0] * rk[ai][m], x1 = acc[ai][bj][m][1] * rk[ai][m]; u32x2 w; w.x = pk4_fp8(x0[0], x0[1], x0[2], x0[3]); w.y = pk4_fp8(x1[0], x1[1], x1[2], x1[3]);
                            *(u32x2*)((unsigned char*)KN + (size_t)row * 512 + pn * 256 + bj * 128 + cl) = w; }
                        else *(u32x4*)(KN + (size_t)row * 512 + pn * 256 + bj * 128 + cl) = pack8(acc[ai][bj][m][0] * rk[ai][m], acc[ai][bj][m][1] * rk[ai][m]); } }
        } else {
            const int b = pn < TLAT ? (pn >> 3) : (pn - TLAT), key0 = pn < TLAT ? ((pn & 7) * 256) : SEQ;
            f32x4 s0[2], s1[2];
#pragma unroll
            for (int bj = 0; bj < 2; ++bj)
#pragma unroll
                for (int j = 0; j < 8; ++j) { const f32x4 sq = *(const f32x4*)(SSQK + ((size_t)pn * 256 + bj * 128 + cl + j) * 4);
                    const float rk = __builtin_amdgcn_rsqf(((sq[0] + sq[1]) + (sq[2] + sq[3])) * (1.0f / 128.0f) + EPS);
                    if (j < 4) s0[bj][j] = rk; else s1[bj][j - 4] = rk; }
#pragma unroll
            for (int bj = 0; bj < 2; ++bj)
#pragma unroll
                for (int ai = 0; ai < 2; ++ai)
#pragma unroll
                    for (int m = 0; m < 4; ++m) { const int f = pm * 256 + wr * 64 + fr + ai * 128 + m * 16;
                        if (MK_PV8) {
                            const int kabs = key0 + bj * 128 + cl, k8 = (kabs & 63) >> 3; unsigned char* vp = (unsigned char*)VT + ((size_t)b * 512 + f) * NKEY + (kabs & ~63);
                            const f32x4 x0 = acc[ai][bj][m][0] * s0[bj], x1 = acc[ai][bj][m][1] * s1[bj];
                            *(unsigned*)(vp + 4 * k8) = pk4_fp8(x0[0], x0[1], x0[2], x0[3]); *(unsigned*)(vp + 32 + 4 * k8) = pk4_fp8(x1[0], x1[1], x1[2], x1[3]); }
                        else *(u32x4*)(VT + ((size_t)b * 512 + f) * NKEY + key0 + bj * 128 + cl) = pack8(acc[ai][bj][m][0] * s0[bj], acc[ai][bj][m][1] * s1[bj]); }
        }
    }
};

struct SchedResid {
    const char* A; const char* W; unsigned lda; int nt, nM, G, c;
    __device__ __forceinline__ bool next(int i, gm::Unit& u) const {
        int idx; if (!gm::flat_index(i, G, c, nM * 4, idx)) return false;
        int pm, pn; gm::tile_order(idx, nM, 4, pm, pn);
        u.A = A + (size_t)pm * 256 * lda; u.lda = lda; u.B = W + (size_t)pn * 256 * lda; u.ldb = lda; u.nt = nt; u.x0 = pm; u.x1 = pn; u.x2 = 0; u.x3 = 0; return true;
    }
};
struct EpiResid {
    const float *src_lat, *src_ctx; const bf16* src16; bf16* dst; const float* gate; float ascale;
    __device__ __forceinline__ void operator()(AccRef acc, const gm::Unit& u, int wr, int wc, int fr, int fq) const {
        const int pm = u.x0, pn = u.x1; const bool lat = pm < TLAT;
        const int b = lat ? (pm >> 3) : 32;
        const int col0 = pn * 256 + wc * 32 + fq * 8;
        f32x4 g[2][2];
#pragma unroll
        for (int bj = 0; bj < 2; ++bj) { g[bj][0] = *(const f32x4*)(gate + (size_t)b * 6144 + col0 + bj * 128) * ascale; g[bj][1] = *(const f32x4*)(gate + (size_t)b * 6144 + col0 + bj * 128 + 4) * ascale; }
        if (src16) {
            u32x4 xr[2][4][2];
#pragma unroll
            for (int ai = 0; ai < 2; ++ai)
#pragma unroll
                for (int m = 0; m < 4; ++m)
#pragma unroll
                    for (int bj = 0; bj < 2; ++bj) xr[ai][m][bj] = *(const u32x4*)(src16 + (size_t)(pm * 256 + wr * 64 + fr + ai * 128 + m * 16) * D + col0 + bj * 128);
#pragma unroll
            for (int ai = 0; ai < 2; ++ai)
#pragma unroll
                for (int m = 0; m < 4; ++m) { const size_t off = (size_t)(pm * 256 + wr * 64 + fr + ai * 128 + m * 16) * D + col0;
#pragma unroll
                    for (int bj = 0; bj < 2; ++bj) { const u32x4 w = xr[ai][m][bj];
                        const f32x4 x0 = (f32x4){__uint_as_float(w.x << 16), __uint_as_float(w.x & 0xffff0000u), __uint_as_float(w.y << 16), __uint_as_float(w.y & 0xffff0000u)};
                        const f32x4 x1 = (f32x4){__uint_as_float(w.z << 16), __uint_as_float(w.z & 0xffff0000u), __uint_as_float(w.w << 16), __uint_as_float(w.w & 0xffff0000u)};
                        *(u32x4*)(dst + off + bj * 128) = pack8(x0 + g[bj][0] * acc[ai][bj][m][0], x1 + g[bj][1] * acc[ai][bj][m][1]); } }
        } else {
            const float* sp = lat ? src_lat : src_ctx - (size_t)MLAT * D;
#pragma unroll
            for (int ai = 0; ai < 2; ++ai) {
                f32x4 xf[4][2][2];
#pragma unroll
                for (int m = 0; m < 4; ++m)
#pragma unroll
                    for (int bj = 0; bj < 2; ++bj) { const float* q = sp + (size_t)(pm * 256 + wr * 64 + fr + ai * 128 + m * 16) * D + col0 + bj * 128; xf[m][bj][0] = *(const f32x4*)q; xf[m][bj][1] = *(const f32x4*)(q + 4); }
                asm volatile("" ::: "memory");
#pragma unroll
                for (int m = 0; m < 4; ++m) { const size_t off = (size_t)(pm * 256 + wr * 64 + fr + ai * 128 + m * 16) * D + col0;
#pragma unroll
                    for (int bj = 0; bj < 2; ++bj) *(u32x4*)(dst + off + bj * 128) = pack8(xf[m][bj][0] + g[bj][0] * acc[ai][bj][m][0], xf[m][bj][1] + g[bj][1] * acc[ai][bj][m][1]); }
            }
        }
    }
};

struct SchedUp {
    const char* A; const char* W; int nM, nN, G, c; unsigned ld; int nt;
    __device__ __forceinline__ bool next(int i, gm::Unit& u) const {
        int idx; if (!gm::flat_index(i, G, c, nM * nN, idx)) return false;
        int pm, pn; gm::tile_order(idx, nM, nN, pm, pn);
        u.A = A + (size_t)pm * 256 * ld; u.lda = ld; u.B = W + (size_t)pn * 256 * ld; u.ldb = ld; u.nt = nt; u.x0 = pm; u.x1 = pn; u.x2 = 0; u.x3 = 0; return true;
    }
};
__device__ __forceinline__ f32x4 swiglu4s(const f32x4 a, const f32x4 b, float cexp, float cout) {
    const float lc = -__builtin_log2f(cout), ic = 1.0f / cout;
    f32x4 e;
#pragma unroll
    for (int j = 0; j < 4; ++j) e[j] = __builtin_amdgcn_exp2f(__builtin_fmaf(a[j], cexp, lc));
    const f32x4 d = e + ic; f32x4 r;
#pragma unroll
    for (int j = 0; j < 4; ++j) r[j] = __builtin_amdgcn_rcpf(d[j]);
    return (a * b) * r; }
__device__ __forceinline__ f32x4 swiglu4(const f32x4 a, const f32x4 b) { return swiglu4s(a, b, -1.4426950408889634f, 1.0f); }
struct EpiSwiglu {
    bf16* ACT; int ld;
    __device__ __forceinline__ void operator()(AccRef acc, const gm::Unit& u, int wr, int wc, int fr, int fq) const {
        const int row0 = u.x0 * 256 + wr * 64 + fr, col = u.x1 * 128 + wc * 32 + fq * 8;
#pragma unroll
        for (int ai = 0; ai < 2; ++ai)
#pragma unroll
            for (int m = 0; m < 4; ++m)
                *(u32x4*)(ACT + (size_t)(row0 + ai * 128 + m * 16) * ld + col) = pack8(swiglu4(acc[ai][0][m][0], acc[ai][1][m][0]), swiglu4(acc[ai][0][m][1], acc[ai][1][m][1]));
    }
};

struct SchedDftC {
    const char *WC, *HF; int G, c, total;
    __device__ __forceinline__ bool next(int i, gm::Unit& u) const {
        int idx; if (!gm::flat_index(i, G, c, total, idx)) return false;
        u.lda = 512; u.ldb = 2048; u.nt = 4; u.x3 = 0;
        if (idx < 1024) { const int bg = idx >> 3, kt = idx & 7, b = bg >> 2, g = bg & 3, ty = kt < 4 ? 0 : 1;
            u.A = WC + (size_t)ty * 256 * 512; u.B = HF + ((size_t)(b * SEQ + kt * 256) * D + g * 256) * 2; u.x0 = bg; u.x1 = kt; u.x2 = 0; return true; }
        const int j = idx - 1024, bg = j >> 1, ty = j & 1, b = bg >> 2, g = bg & 3;
        u.A = WC + (size_t)ty * 256 * 512; u.B = HF + ((size_t)(MLAT + b * LC) * D + g * 256) * 2; u.x0 = bg; u.x1 = 0; u.x2 = 1 + ty; return true;
    }
};
__device__ __forceinline__ unsigned pk4_fp8(float a, float b, float c, float d);
__device__ __forceinline__ u32x2 pack8_fp8(const f32x4 a, const f32x4 b) { u32x2 w; w.x = pk4_fp8(a[0], a[1], a[2], a[3]); w.y = pk4_fp8(b[0], b[1], b[2], b[3]); return w; }
struct EpiDftC {
    bf16 *Z, *ZC;
    __device__ __forceinline__ void operator()(AccRef acc, const gm::Unit& u, int wr, int wc, int fr, int fq) const {
        const int bg = u.x0, cl = wc * 32 + fq * 8;
        if (MK_FP8_DFT) {
            unsigned char* z8 = (unsigned char*)Z; unsigned char* zc8 = (unsigned char*)ZC;
#pragma unroll
            for (int ai = 0; ai < 2; ++ai)
#pragma unroll
                for (int m = 0; m < 4; ++m) { const int f = wr * 64 + fr + ai * 128 + m * 16;
                    if (u.x2 == 0) {
#pragma unroll
                        for (int bj = 0; bj < 2; ++bj) *(u32x2*)(z8 + ((size_t)bg * 256 + f) * 2048 + u.x1 * 256 + bj * 128 + cl) = pack8_fp8(acc[ai][bj][m][0], acc[ai][bj][m][1]); }
                    else if (u.x2 == 1) *(u32x2*)(zc8 + ((size_t)bg * 256 + f) * 256 + cl) = pack8_fp8(acc[ai][0][m][0], acc[ai][0][m][1]);
                    else *(u32x2*)(zc8 + ((size_t)bg * 256 + f) * 256 + 128 + cl) = pack8_fp8(acc[ai][1][m][0], acc[ai][1][m][1]); }
        } else
        if (u.x2 == 0) {
#pragma unroll
            for (int ai = 0; ai < 2; ++ai)
#pragma unroll
                for (int m = 0; m < 4; ++m) { const int f = wr * 64 + fr + ai * 128 + m * 16;
#pragma unroll
                    for (int bj = 0; bj < 2; ++bj) *(u32x4*)(Z + ((size_t)bg * 256 + f) * 2048 + u.x1 * 256 + bj * 128 + cl) = pack8(acc[ai][bj][m][0], acc[ai][bj][m][1]); }
        } else {
            if (u.x2 == 1) {
#pragma unroll
                for (int ai = 0; ai < 2; ++ai)
#pragma unroll
                    for (int m = 0; m < 4; ++m) { const int f = wr * 64 + fr + ai * 128 + m * 16;
                        *(u32x4*)(ZC + ((size_t)bg * 256 + f) * 256 + cl) = pack8(acc[ai][0][m][0], acc[ai][0][m][1]); }
            } else {
#pragma unroll
                for (int ai = 0; ai < 2; ++ai)
#pragma unroll
                    for (int m = 0; m < 4; ++m) { const int f = wr * 64 + fr + ai * 128 + m * 16;
                        *(u32x4*)(ZC + ((size_t)bg * 256 + f) * 256 + 128 + cl) = pack8(acc[ai][1][m][0], acc[ai][1][m][1]); }
            }
        }
    }
};

struct SchedDftS {
    const char *WL, *WX, *Z, *ZC; int G, c, total;
    __device__ __forceinline__ bool next(int i, gm::Unit& u) const {
        int idx; if (!gm::flat_index(i, G, c, total, idx)) return false;
        u.x3 = 0;
        if (idx < 1024) { const int bg = idx >> 3, kt = idx & 7;
            constexpr unsigned P = MK_FP8_DFT ? 2048u : 4096u;
            u.A = WL + (size_t)kt * 256 * P; u.lda = P; u.B = Z + (size_t)bg * 256 * P; u.ldb = P; u.nt = 32 / (MK_FP8_DFT ? 2 : 1); u.x0 = bg; u.x1 = kt; u.x2 = 0; return true; }
        const int bg = idx - 1024; constexpr unsigned PX = MK_FP8_DFT ? 256u : 512u;
        u.A = WX; u.lda = PX; u.B = ZC + (size_t)bg * 256 * PX; u.ldb = PX; u.nt = 4 / (MK_FP8_DFT ? 2 : 1); u.x0 = bg; u.x1 = 0; u.x2 = 1; return true;
    }
};
struct EpiDftS {
    bf16* F; const float* AMID;
    __device__ __forceinline__ void operator()(AccRef acc, const gm::Unit& u, int wr, int wc, int fr, int fq) const {
        const int bg = u.x0, b = bg >> 2, g = bg & 3, cl = wc * 32 + fq * 8; const bool cx = u.x2 != 0;
        constexpr float TS = MK_FP8_DFT ? (1.0f / 16.0f) : 1.0f;
        const float scale = cx ? (1.0f / 256.0f) : 0.0013810679320049757f;
        const size_t rbase = cx ? (size_t)(MLAT + b * LC) : (size_t)b * SEQ + u.x1 * 256;
        const float* am = AMID + (size_t)(cx ? 32 + b : b) * D + g * 256;
        f32x4 a4[2][2];
#pragma unroll
        for (int bj = 0; bj < 2; ++bj) { a4[bj][0] = *(const f32x4*)(am + bj * 128 + cl); a4[bj][1] = *(const f32x4*)(am + bj * 128 + cl + 4); }
#pragma unroll
        for (int ai = 0; ai < 2; ++ai)
#pragma unroll
            for (int m = 0; m < 4; ++m) { const int k = wr * 64 + fr + ai * 128 + m * 16; const float sg = (k & 1) ? -1.0f : 1.0f;
#pragma unroll
                for (int bj = 0; bj < 2; ++bj)
                    *(u32x4*)(F + (rbase + k) * D + g * 256 + bj * 128 + cl) = pack8((acc[ai][bj][m][0] * TS + a4[bj][0] * sg) * scale, (acc[ai][bj][m][1] * TS + a4[bj][1] * sg) * scale); }
    }
};

constexpr float W8_SCALE = 32.0f, A8_SCALE = 4.0f;
__device__ __forceinline__ unsigned pk4_fp8(float a, float b, float c, float d) {
    a = __builtin_amdgcn_fmed3f(a, -448.f, 448.f); b = __builtin_amdgcn_fmed3f(b, -448.f, 448.f); c = __builtin_amdgcn_fmed3f(c, -448.f, 448.f); d = __builtin_amdgcn_fmed3f(d, -448.f, 448.f);
    int w = 0; w = __builtin_amdgcn_cvt_pk_fp8_f32(a, b, w, false); w = __builtin_amdgcn_cvt_pk_fp8_f32(c, d, w, true); return (unsigned)w; }
struct MoeInfo { int cnt[8]; int nt; };
__device__ __forceinline__ void moe_info(const unsigned* cntw, MoeInfo& mi) {
    int t = 0;
#pragma unroll
    for (int e = 0; e < 8; ++e) { mi.cnt[e] = (int)__builtin_amdgcn_readfirstlane(__hip_atomic_load(cntw + 64 * e, __ATOMIC_RELAXED, __HIP_MEMORY_SCOPE_AGENT)); t += (mi.cnt[e] + 255) >> 8; }
    mi.nt = t;
}
__device__ __forceinline__ void moe_find(const MoeInfo& mi, int gt, int& e, int& rt, int& cnt) {
    e = 0; rt = gt; cnt = mi.cnt[0]; int tb = 0;
#pragma unroll
    for (int k = 1; k < 8; ++k) { tb += (mi.cnt[k - 1] + 255) >> 8; if (gt >= tb) { e = k; rt = gt - tb; cnt = mi.cnt[k]; } }
}
struct SchedMoeUp {
    const char *H2, *W13; const int* list; MoeInfo mi; int G, c;
    __device__ __forceinline__ bool next(int i, gm::Unit& u) const {
        int idx; if (!gm::flat_index(i, G, c, mi.nt * 28, idx)) return false;
        int gt, pn; gm::tile_order(idx, mi.nt, 28, gt, pn);
        int e, rt, cnt; moe_find(mi, gt, e, rt, cnt);
        u.A = H2; u.lda = 2048; u.B = W13 + ((size_t)e * 7168 + (size_t)pn * 256) * 2048; u.ldb = 2048; u.nt = 16; u.x0 = gt; u.x1 = pn; u.x2 = e * 65536 * 2 + cnt; u.x3 = rt * 256; return true;
    }
    __device__ __forceinline__ int gather_row(const gm::Unit& u, int lr) const {
        const int e = u.x2 >> 17, cnt = u.x2 & 0x1ffff; int j = u.x3 + lr; j = j < cnt ? j : cnt - 1;
        return list[(size_t)e * MALL + j];
    }
};
struct SchedMoeUp8 {
    const char *H2, *W13; const int* list; MoeInfo mi; int G, c;
    int rd;
    __device__ __forceinline__ bool next(int i, gm::Unit& u) const {
        const int F = G - rd; int pos;
        if (c < rd) pos = MOE_SKIP * F + i * G + c;
        else pos = i < MOE_SKIP ? i * F + (c - rd) : MOE_SKIP * F + (i - MOE_SKIP) * G + c;
        int idx; if (!gm::flat_pos(pos, mi.nt * 28, idx)) return false;
        int gt, pn; gm::tile_order(idx, mi.nt, 28, gt, pn);
        int e, rt, cnt; moe_find(mi, gt, e, rt, cnt);
        u.A = H2; u.lda = 1024; u.B = W13 + ((size_t)e * 7168 + (size_t)pn * 256) * 1024; u.ldb = 1024; u.nt = 8; u.x0 = gt; u.x1 = pn; u.x2 = e * 65536 * 2 + cnt; u.x3 = rt * 256; return true;
    }
    __device__ __forceinline__ int gather_row(const gm::Unit& u, int lr) const {
        const int e = u.x2 >> 17, cnt = u.x2 & 0x1ffff; int j = u.x3 + lr; j = j < cnt ? j : cnt - 1;
        return list[(size_t)e * MALL + j];
    }
};
struct EpiSwiglu8 {
    unsigned char* ACT8; int ld;
    __device__ __forceinline__ void operator()(AccRef acc, const gm::Unit& u, int wr, int wc, int fr, int fq) const {
        const int row0 = u.x0 * 256 + wr * 64 + fr, col = u.x1 * 128 + wc * 32 + fq * 8;
#pragma unroll 1
        for (int rep_ = 0; rep_ < 1 + (int)((MK_DUP >> 24) & 1u); ++rep_)
#pragma unroll
        for (int ai = 0; ai < 2; ++ai)
#pragma unroll
            for (int m = 0; m < 4; ++m) {
                constexpr float CE = -1.4426950408889634f / W8_SCALE, CO = A8_SCALE / (W8_SCALE * W8_SCALE);
                const f32x4 v0 = swiglu4s(acc[ai][0][m][0], acc[ai][1][m][0], CE, CO), v1 = swiglu4s(acc[ai][0][m][1], acc[ai][1][m][1], CE, CO);
                u32x2 w; w.x = pk4_fp8(v0[0], v0[1], v0[2], v0[3]); w.y = pk4_fp8(v1[0], v1[1], v1[2], v1[3]);
                *(u32x2*)(ACT8 + (size_t)(row0 + ai * 128 + m * 16) * ld + col) = w; }
    }
};
struct SchedMoeDown8 {
    const char *Ab, *W2; MoeInfo mi; int G, c;
    __device__ __forceinline__ bool next(int i, gm::Unit& u) const {
        int idx; if (!gm::flat_index(i, G, c, mi.nt * 4, idx)) return false;
        int gt, pn; gm::tile_order(idx, mi.nt, 4, gt, pn);
        int e, rt, cnt; moe_find(mi, gt, e, rt, cnt);
        u.A = Ab + (size_t)gt * 256 * 3584; u.lda = 3584; u.B = W2 + ((size_t)e * 1024 + (size_t)pn * 256) * 3584; u.ldb = 3584; u.nt = 28; u.x0 = gt; u.x1 = pn; u.x2 = e * 65536 * 2 + cnt; u.x3 = rt * 256; return true;
    }
};
struct SchedMoeUpDense {
    const char *H2, *W13; MoeInfo mi; int G, c;
    __device__ __forceinline__ bool next(int i, gm::Unit& u) const {
        int idx; if (!gm::flat_index(i, G, c, mi.nt * 28, idx)) return false;
        int gt, pn; gm::tile_order(idx, mi.nt, 28, gt, pn);
        int e, rt, cnt; moe_find(mi, gt, e, rt, cnt);
        u.A = H2 + (size_t)(gt & 255) * 256 * 2048; u.lda = 2048; u.B = W13 + ((size_t)e * 7168 + (size_t)pn * 256) * 2048; u.ldb = 2048; u.nt = 16; u.x0 = gt; u.x1 = pn; u.x2 = 0; u.x3 = 0; return true;
    }
};
struct SchedMoeDown {
    const char *Ab, *W2; MoeInfo mi; int G, c;
    __device__ __forceinline__ bool next(int i, gm::Unit& u) const {
        int idx; if (!gm::flat_index(i, G, c, mi.nt * 4, idx)) return false;
        int gt, pn; gm::tile_order(idx, mi.nt, 4, gt, pn);
        int e, rt, cnt; moe_find(mi, gt, e, rt, cnt);
        u.A = Ab + (size_t)gt * 256 * 7168; u.lda = 7168; u.B = W2 + ((size_t)e * 1024 + (size_t)pn * 256) * 7168; u.ldb = 7168; u.nt = 56; u.x0 = gt; u.x1 = pn; u.x2 = e * 65536 * 2 + cnt; u.x3 = rt * 256; return true;
    }
};
struct EpiMoeDown {
    bf16* x16; const bf16* gate16; const int* list; const float* glist; float ascale; bf16* dst16;
    __device__ __forceinline__ void operator()(AccRef acc, const gm::Unit& u, int wr, int wc, int fr, int fq) const {
        const int e = u.x2 >> 17, cnt = u.x2 & 0x1ffff, col0 = u.x1 * 256 + wc * 32 + fq * 8;
        int tok[2][4]; float gv[2][4];
#pragma unroll
        for (int ai = 0; ai < 2; ++ai)
#pragma unroll
            for (int m = 0; m < 4; ++m) { int j = u.x3 + wr * 64 + fr + ai * 128 + m * 16; const bool ok = j < cnt; j = ok ? j : cnt - 1;
                const int t = list[(size_t)e * MALL + j]; tok[ai][m] = ok ? t : -1 - t; gv[ai][m] = glist[(size_t)e * MALL + j] * ascale; }
#pragma unroll
        for (int bj = 0; bj < 2; ++bj)
#pragma unroll
        for (int ai = 0; ai < 2; ++ai) {
            u32x4 xr[4], gr[4];
#pragma unroll
            for (int m = 0; m < 4; ++m) { const int t = tok[ai][m] < 0 ? -1 - tok[ai][m] : tok[ai][m]; const int b = t < MLAT ? (t >> 11) : 32;
                xr[m] = *(const u32x4*)(x16 + (size_t)t * D + col0 + bj * 128); gr[m] = *(const u32x4*)(gate16 + (size_t)b * 1024 + col0 + bj * 128); }
            asm volatile("" ::: "memory");
#pragma unroll
            for (int m = 0; m < 4; ++m) { const int t = tok[ai][m];
                if (t >= 0) { const u32x4 w = xr[m], q = gr[m]; const float s = gv[ai][m];
                    const f32x4 x0 = (f32x4){__uint_as_float(w.x << 16), __uint_as_float(w.x & 0xffff0000u), __uint_as_float(w.y << 16), __uint_as_float(w.y & 0xffff0000u)};
                    const f32x4 x1 = (f32x4){__uint_as_float(w.z << 16), __uint_as_float(w.z & 0xffff0000u), __uint_as_float(w.w << 16), __uint_as_float(w.w & 0xffff0000u)};
                    const f32x4 g0 = (f32x4){__uint_as_float(q.x << 16), __uint_as_float(q.x & 0xffff0000u), __uint_as_float(q.y << 16), __uint_as_float(q.y & 0xffff0000u)} * s;
                    const f32x4 g1 = (f32x4){__uint_as_float(q.z << 16), __uint_as_float(q.z & 0xffff0000u), __uint_as_float(q.w << 16), __uint_as_float(q.w & 0xffff0000u)} * s;
                    *(u32x4*)(dst16 + (size_t)t * D + col0 + bj * 128) = pack8(x0 + g0 * acc[ai][bj][m][0], x1 + g1 * acc[ai][bj][m][1]); } }
        }
    }
};

struct ModP { f32x4 gm[4]; f32x4 sh[4]; };
__device__ __forceinline__ void load_modp(ModP& p, const float* g, const float* modrow, int off_sh, int off_sc, int lane) {
#pragma unroll
    for (int j = 0; j < 4; ++j) { const int c = 4 * lane + 256 * j;
        const f32x4 g4 = *(const f32x4*)(g + c), sc = *(const f32x4*)(modrow + off_sc + c);
        p.gm[j] = g4 * (sc + 1.0f); p.sh[j] = *(const f32x4*)(modrow + off_sh + c); }
}
struct XSrc { const float* lat; const float* ctx; const bf16* x16; };
__device__ __forceinline__ void load_xrow(const XSrc& xs, int row, int lane, f32x4 (&v)[4]) {
    if (xs.x16) { const u32x2* p = (const u32x2*)(xs.x16 + (size_t)row * D);
#pragma unroll
        for (int j = 0; j < 4; ++j) { const u32x2 w = NTLD(p + lane + 64 * j); v[j] = (f32x4){__uint_as_float(w.x << 16), __uint_as_float(w.x & 0xffff0000u), __uint_as_float(w.y << 16), __uint_as_float(w.y & 0xffff0000u)}; } }
    else { const f32x4* p = (const f32x4*)(row < MLAT ? xs.lat + (size_t)row * D : xs.ctx + (size_t)(row - MLAT) * D);
#pragma unroll
        for (int j = 0; j < 4; ++j) v[j] = NTLD(p + lane + 64 * j); }
}
struct XRaw { u32x2 w[4]; f32x4 f[4]; };
__device__ __forceinline__ void load_xraw(const XSrc& xs, int row, int lane, XRaw& r) {
    if (xs.x16) { const u32x2* p = (const u32x2*)(xs.x16 + (size_t)row * D);
#pragma unroll
        for (int j = 0; j < 4; ++j) r.w[j] = NTLD(p + lane + 64 * j); }
    else { const f32x4* p = (const f32x4*)(row < MLAT ? xs.lat + (size_t)row * D : xs.ctx + (size_t)(row - MLAT) * D);
#pragma unroll
        for (int j = 0; j < 4; ++j) r.f[j] = NTLD(p + lane + 64 * j); }
}
__device__ __forceinline__ void mod_row_raw(const XSrc& xs, const XRaw& r, const ModP& p, f32x4 (&h)[4]) {
    f32x4 v[4]; float ss = 0.f;
    if (xs.x16) {
#pragma unroll
        for (int j = 0; j < 4; ++j) { const u32x2 w = r.w[j]; v[j] = (f32x4){__uint_as_float(w.x << 16), __uint_as_float(w.x & 0xffff0000u), __uint_as_float(w.y << 16), __uint_as_float(w.y & 0xffff0000u)}; } }
    else {
#pragma unroll
        for (int j = 0; j < 4; ++j) v[j] = r.f[j]; }
#pragma unroll
    for (int j = 0; j < 4; ++j) ss += (v[j][0] * v[j][0] + v[j][1] * v[j][1]) + (v[j][2] * v[j][2] + v[j][3] * v[j][3]);
    ss = wave_sum(ss);
    const float rr = 1.0f / sqrtf(ss * (1.0f / D) + EPS);
#pragma unroll
    for (int j = 0; j < 4; ++j) h[j] = (v[j] * rr) * p.gm[j] + p.sh[j];
}
__device__ __forceinline__ void mod_row(const XSrc& xs, int row, const ModP& p, int lane, f32x4 (&h)[4]) {
    f32x4 v[4]; float ss = 0.f; load_xrow(xs, row, lane, v);
#pragma unroll
    for (int j = 0; j < 4; ++j) { ss += (v[j][0] * v[j][0] + v[j][1] * v[j][1]) + (v[j][2] * v[j][2] + v[j][3] * v[j][3]); }
    ss = wave_sum(ss);
    const float r = 1.0f / sqrtf(ss * (1.0f / D) + EPS);
#pragma unroll
    for (int j = 0; j < 4; ++j) h[j] = (v[j] * r) * p.gm[j] + p.sh[j];
}
__device__ __forceinline__ void store_row_bf16(bf16* dst, const f32x4 (&h)[4], int lane) {
#pragma unroll
    for (int j = 0; j < 4; ++j) { u32x2 w; w.x = pkbf(h[j][0], h[j][1]); w.y = pkbf(h[j][2], h[j][3]); ((u32x2*)dst)[lane + 64 * j] = w; }
}

__device__ __forceinline__ void phase_mod_plain(const XSrc& xs, const float* g, const float* modbase, int off_sh, int off_sc, bf16* H, bool out8, int nrows, int gw, int NGW, int lane) {
    const int rpw = (nrows + NGW - 1) / NGW; const int r0 = gw * rpw; int r1 = r0 + rpw; if (r1 > nrows) r1 = nrows;
    int curb = -1; ModP p; XRaw cur, nxt; nxt = XRaw{};
    if (r0 < r1) load_xraw(xs, r0, lane, cur);
    for (int row = r0; row < r1; ++row) {
        if (row + 1 < r1) load_xraw(xs, row + 1, lane, nxt);
        const int b = row < MLAT ? (row >> 11) : 32;
        if (b != curb) { load_modp(p, g, modbase + (size_t)b * 6144, off_sh, off_sc, lane); curb = b; }
        f32x4 h[4]; mod_row_raw(xs, cur, p, h); cur = nxt;
        if (out8) { unsigned char* o8 = (unsigned char*)H + (size_t)row * D;
#pragma unroll
            for (int j = 0; j < 4; ++j) ((unsigned*)o8)[lane + 64 * j] = pk4_fp8(h[j][0], h[j][1], h[j][2], h[j][3]); }
        else store_row_bf16(H + (size_t)row * D, h, lane);
    }
}

__device__ __forceinline__ void phase_mod_fold(const XSrc& xs, const float* g, const float* modbase, bf16* HF, float* HMID, bool with_ctx, int gw, int NGW, int lane) {
    constexpr int IL = SEQ / 2 + 1, IC = LC / 2 + 1;
    const int nitems = NB * IL + (with_ctx ? NB * IC : 0);
    const int ipw = (nitems + NGW - 1) / NGW; const int i0 = gw * ipw; int i1 = i0 + ipw; if (i1 > nitems) i1 = nitems;
    int curb = -1; ModP p;
    for (int it = i0; it < i1; ++it) {
        const bool cx = it >= NB * IL; const int j = cx ? it - NB * IL : it;
        const int b = cx ? j / IC : j / IL, n = cx ? j % IC : j % IL, Ls = cx ? LC : SEQ;
        const int mb = cx ? 32 : b, key = cx ? 64 : b;
        if (key != curb) { load_modp(p, g, modbase + (size_t)mb * 6144, 0, 1024, lane); curb = key; }
        const int rbase = cx ? MLAT + b * LC : b * SEQ;
        bf16* hf = HF + (size_t)rbase * D;
        f32x4 h1[4]; mod_row(xs, rbase + n, p, lane, h1);
        if (n == 0) { store_row_bf16(hf, h1, lane); f32x4 z[4];
#pragma unroll
            for (int q = 0; q < 4; ++q) z[q] = (f32x4){0.f, 0.f, 0.f, 0.f};
            store_row_bf16(hf + (size_t)(Ls / 2) * D, z, lane); }
        else if (n == Ls / 2) { float* hm = HMID + (size_t)(cx ? 32 + b : b) * D;
#pragma unroll
            for (int q = 0; q < 4; ++q) ((f32x4*)hm)[lane + 64 * q] = h1[q]; }
        else { f32x4 h2[4]; mod_row(xs, rbase + Ls - n, p, lane, h2); f32x4 s[4], d[4];
#pragma unroll
            for (int q = 0; q < 4; ++q) { s[q] = h1[q] + h2[q]; d[q] = h1[q] - h2[q]; }
            store_row_bf16(hf + (size_t)n * D, s, lane); store_row_bf16(hf + (size_t)(Ls / 2 + n) * D, d, lane); }
    }
}

constexpr int RW_REG = 8;
template <bool ROUTER>
__device__ __forceinline__ void phase_mod2(const XSrc& xs, const float* g, const float* modbase, bf16* H2, bool out8, int nrows,
                                           const float* router_w, unsigned* gcnt, int* list, float* glist, LAS unsigned char* lds, int vcu, int G, int wave, int lane, int tid) {
    const int rpb = nrows / G, rpw = rpb / 8;
    const int r0 = vcu * rpb + wave * rpw;
    LAS float* rwT = (LAS float*)lds; LAS int* bcnt = (LAS int*)(lds + 32768); LAS int* bbase = (LAS int*)(lds + 32768 + 64);
    if constexpr (ROUTER) {
        for (int i = tid; i < 8192; i += 512) { const int c = i >> 3, e = i & 7; rwT[e * 1024 + c] = router_w[i]; }
        if (tid < 16) bcnt[tid] = 0;
        __syncthreads();
    }
    int curb = -1; ModP p; int me0 = -1, me1 = -1; float mp0 = 0.f, mp1 = 0.f; XRaw cur, nxt; nxt = XRaw{};
    f32x4 rwr[RW_REG][4];
    if constexpr (ROUTER) {
#pragma unroll
        for (int e = 0; e < RW_REG; ++e)
#pragma unroll
            for (int j = 0; j < 4; ++j) rwr[e][j] = *(const LAS f32x4*)(rwT + e * 1024 + 4 * lane + 256 * j);
    }
    load_xraw(xs, r0, lane, cur);
    for (int rr = 0; rr < rpw; ++rr) {
        const int row = r0 + rr; const int b = row < MLAT ? (row >> 11) : 32;
        if (rr + 1 < rpw) load_xraw(xs, row + 1, lane, nxt);
        if (b != curb) { load_modp(p, g, modbase + (size_t)b * 6144, 3072, 4096, lane); curb = b; }
        f32x4 h[4]; mod_row_raw(xs, cur, p, h); cur = nxt;
        if (out8) { unsigned char* o8 = (unsigned char*)H2 + (size_t)row * D;
#pragma unroll
            for (int j = 0; j < 4; ++j) ((unsigned*)o8)[lane + 64 * j] = pk4_fp8(h[j][0], h[j][1], h[j][2], h[j][3]); }
        else store_row_bf16(H2 + (size_t)row * D, h, lane);
        if constexpr (ROUTER) {
            asm volatile("" ::: "memory");
            float lg[8];
#pragma unroll
            for (int e = 0; e < 8; ++e) { float s = 0.f;
#pragma unroll
                for (int j = 0; j < 4; ++j) { const f32x4 w = e < RW_REG ? rwr[e][j] : *(const LAS f32x4*)(rwT + e * 1024 + 4 * lane + 256 * j); s += (h[j][0] * w[0] + h[j][1] * w[1]) + (h[j][2] * w[2] + h[j][3] * w[3]); }
                lg[e] = s; }
            {
                const bool b5 = (lane & 32) != 0, b4 = (lane & 16) != 0, b3 = (lane & 8) != 0;
                float v4[4], v2[2];
#pragma unroll
                for (int j = 0; j < 4; ++j) { const float snd = b5 ? lg[j] : lg[4 + j], kp = b5 ? lg[4 + j] : lg[j]; v4[j] = kp + __shfl_xor(snd, 32); }
#pragma unroll
                for (int j = 0; j < 2; ++j) { const float snd = b4 ? v4[j] : v4[2 + j], kp = b4 ? v4[2 + j] : v4[j]; v2[j] = kp + __shfl_xor(snd, 16); }
                float v1; { const float snd = b3 ? v2[0] : v2[1], kp = b3 ? v2[1] : v2[0]; v1 = kp + __shfl_xor(snd, 8); }
                v1 += __shfl_xor(v1, 4); v1 += __shfl_xor(v1, 2); v1 += __shfl_xor(v1, 1);
#pragma unroll
                for (int e = 0; e < 8; ++e) lg[e] = __uint_as_float((unsigned)__builtin_amdgcn_readlane((int)__float_as_uint(v1), e * 8));
            }
            int e0 = 0; float v0 = lg[0];
#pragma unroll
            for (int e = 1; e < 8; ++e) if (lg[e] > v0) { v0 = lg[e]; e0 = e; }
            int e1 = -1; float v1 = -3.0e38f;
#pragma unroll
            for (int e = 0; e < 8; ++e) if (e != e0 && lg[e] > v1) { v1 = lg[e]; e1 = e; }
            const float p0 = 1.0f / (1.0f + __expf(v1 - v0));
            if (lane == rr) { me0 = e0; me1 = e1; mp0 = p0; mp1 = 1.0f - p0; }
        }
    }
    if constexpr (ROUTER) {
        int rank0 = 0, rank1 = 0, mycnt = 0;
        const unsigned long long lt = (lane == 0) ? 0ull : (~0ull >> (64 - lane));
#pragma unroll
        for (int e = 0; e < 8; ++e) {
            const unsigned long long m0 = __ballot(me0 == e), m1 = __ballot(me1 == e);
            if (me0 == e) rank0 = __popcll(m0 & lt);
            if (me1 == e) rank1 = __popcll(m1 & lt);
            if (lane == e) mycnt = __popcll(m0);
            if (lane == 8 + e) mycnt = __popcll(m1);
        }
        int woff = 0;
        if (lane < 16) woff = __hip_atomic_fetch_add(bcnt + lane, mycnt, __ATOMIC_RELAXED, __HIP_MEMORY_SCOPE_WORKGROUP);
        __syncthreads();
        if (tid < 16) bbase[tid] = (int)__hip_atomic_fetch_add(gcnt + 64 * tid, (unsigned)bcnt[tid], __ATOMIC_RELAXED, __HIP_MEMORY_SCOPE_AGENT);
        __syncthreads();
        const int w0 = __shfl(woff, me0 < 0 ? 0 : me0), w1 = __shfl(woff, me1 < 0 ? 8 : 8 + me1);
        if (me0 >= 0) { const int row = r0 + lane;
            const int p0 = bbase[me0] + w0 + rank0, p1 = bbase[8 + me1] + w1 + rank1;
            list[(size_t)me0 * MALL + p0] = row; glist[(size_t)me0 * MALL + p0] = mp0;
            list[(size_t)(8 + me1) * MALL + p1] = row; glist[(size_t)(8 + me1) * MALL + p1] = mp1; }
        __syncthreads();
    }
}

__device__ __forceinline__ void phase_final(const bf16* x16, float* out, const float* g, int gw, int NGW, int lane) {
    const int rpw = (MLAT + NGW - 1) / NGW; const int r0 = gw * rpw; int r1 = r0 + rpw; if (r1 > MLAT) r1 = MLAT;
    f32x4 g4[4];
#pragma unroll
    for (int j = 0; j < 4; ++j) g4[j] = *(const f32x4*)(g + 4 * lane + 256 * j);
    XSrc xs{nullptr, nullptr, x16};
    for (int row = r0; row < r1; ++row) { f32x4 v[4]; float ss = 0.f; load_xrow(xs, row, lane, v);
#pragma unroll
        for (int j = 0; j < 4; ++j) ss += (v[j][0] * v[j][0] + v[j][1] * v[j][1]) + (v[j][2] * v[j][2] + v[j][3] * v[j][3]);
        ss = wave_sum(ss); const float r = 1.0f / sqrtf(ss * (1.0f / D) + EPS);
#pragma unroll
        for (int j = 0; j < 4; ++j) NTST((f32x4*)(out + (size_t)row * D) + lane + 64 * j, (v[j] * r) * g4[j]); }
}

__device__ __forceinline__ void phase_pool(const bf16* POOL, bf16* MIXCAT, int nrows, int gw, int NGW, int lane) {
    const int rs = lane >> 4, cb = lane & 15;
    for (int it = gw; it < (nrows / 64) * 4; it += NGW) { const int seg = it >> 2, g = it & 3, w = 2 << g, hw = w >> 1;
        const int row0 = seg * 64 + rs * 16;
        const int Ls = row0 < MLAT ? SEQ : LC, sb = row0 < MLAT ? (row0 & ~(SEQ - 1)) : (MLAT + ((row0 - MLAT) & ~(LC - 1))), t0 = row0 - sb;
        const bf16* src = POOL + (size_t)sb * 512 + g * 128 + cb * 8; bf16* dstp = MIXCAT + (size_t)sb * D + 512 + g * 128 + cb * 8;
        float s[8];
#pragma unroll
        for (int k = 0; k < 8; ++k) s[k] = 0.f;
        for (int j = 0; j < w; ++j) { const int tt = t0 - hw + j;
            if (tt >= 0 && tt < Ls) { const u32x4 v = *(const u32x4*)(src + (size_t)tt * 512);
#pragma unroll
                for (int k = 0; k < 4; ++k) { s[2 * k] += __uint_as_float(v[k] << 16); s[2 * k + 1] += __uint_as_float(v[k] & 0xffff0000u); } } }
#pragma unroll 4
        for (int q = 0; q < 16; ++q) { const int t = t0 + q;
            int lo = t - hw; if (lo < 0) lo = 0; int hi = t + hw; if (hi > Ls) hi = Ls;
            const u32x4 self = *(const u32x4*)(src + (size_t)t * 512);
            const int tin = t + hw, tout = t - hw;
            u32x4 vin = (u32x4){0u, 0u, 0u, 0u}, vout = (u32x4){0u, 0u, 0u, 0u};
            if (q < 15) { if (tin < Ls) vin = *(const u32x4*)(src + (size_t)tin * 512); if (tout >= 0) vout = *(const u32x4*)(src + (size_t)tout * 512); }
            const float inv = 1.0f / (float)(hi - lo); u32x4 o;
#pragma unroll
            for (int k = 0; k < 4; ++k) o[k] = pkbf(s[2 * k] * inv - __uint_as_float(self[k] << 16), s[2 * k + 1] * inv - __uint_as_float(self[k] & 0xffff0000u));
            *(u32x4*)(dstp + (size_t)t * D) = o;
#pragma unroll
            for (int k = 0; k < 4; ++k) { s[2 * k] += __uint_as_float(vin[k] << 16) - __uint_as_float(vout[k] << 16); s[2 * k + 1] += __uint_as_float(vin[k] & 0xffff0000u) - __uint_as_float(vout[k] & 0xffff0000u); } }
    }
}

__device__ __forceinline__ void phase_amid(const float* HMID_, float* AMID_, LAS unsigned char* lds, int G, int bid, int tid) {
    LAS float* ct = (LAS float*)lds;
    if (tid < 256) ct[tid] = cospif((float)tid * (1.0f / 128.0f));
    __syncthreads();
    for (int o = bid * 512 + tid; o < 64 * 1024; o += G * 512) { const int r = o >> 10, gq = (o >> 8) & 3, m = o & 255;
        const float* hp = HMID_ + (size_t)r * D + gq * 256; float s = 0.f;
#pragma unroll 4
        for (int c = 0; c < 256; ++c) s += hp[c] * ct[(m * c) & 255];
        AMID_[o] = s; }
    __syncthreads();
}

constexpr int AT_KP = 208, AT_VP = 136, AT_VP8 = 80, AT_VOFF = 64 * AT_KP, AT_BUF = 22528;
__device__ __forceinline__ f32x16 mfma32(bf16x8 a, bf16x8 b, f32x16 c) { return __builtin_amdgcn_mfma_f32_32x32x16_bf16(a, b, c, 0, 0, 0); }
__device__ __forceinline__ bf16x8 pack_s(const f32x16& x, int s) {
    u32x4 p; p.x = pkbf(x[8 * s], x[8 * s + 1]); p.y = pkbf(x[8 * s + 2], x[8 * s + 3]); p.z = pkbf(x[8 * s + 4], x[8 * s + 5]); p.w = pkbf(x[8 * s + 6], x[8 * s + 7]);
    return __builtin_bit_cast(bf16x8, p);
}
__device__ __forceinline__ gm::v8i_t pack_p8(const f32x16& x0, const f32x16& x1) {
    gm::v8i_t p;
#pragma unroll
    for (int d = 0; d < 4; ++d) { int w = 0; w = __builtin_amdgcn_cvt_pk_fp8_f32(x0[4 * d], x0[4 * d + 1], w, false); w = __builtin_amdgcn_cvt_pk_fp8_f32(x0[4 * d + 2], x0[4 * d + 3], w, true); p[d] = w;
        int v = 0; v = __builtin_amdgcn_cvt_pk_fp8_f32(x1[4 * d], x1[4 * d + 1], v, false); v = __builtin_amdgcn_cvt_pk_fp8_f32(x1[4 * d + 2], x1[4 * d + 3], v, true); p[4 + d] = v; }
    return p;
}
#define AT_MX3(a, b, c) __builtin_fmaxf(__builtin_fmaxf((a), (b)), (c))
#define AT_SOFTMAX(S0, S1, M, L, O0, O1, FIRST) do { \
        float ma_ = AT_MX3(S0[0], S0[1], S0[2]), mb_ = AT_MX3(S0[3], S0[4], S0[5]), mc_ = AT_MX3(S1[0], S1[1], S1[2]), md_ = AT_MX3(S1[3], S1[4], S1[5]); \
        ma_ = AT_MX3(ma_, S0[6], S0[7]); mb_ = AT_MX3(mb_, S0[8], S0[9]); mc_ = AT_MX3(mc_, S1[6], S1[7]); md_ = AT_MX3(md_, S1[8], S1[9]); \
        ma_ = AT_MX3(ma_, S0[10], S0[11]); mb_ = AT_MX3(mb_, S0[12], S0[13]); mc_ = AT_MX3(mc_, S1[10], S1[11]); md_ = AT_MX3(md_, S1[12], S1[13]); \
        ma_ = AT_MX3(ma_, S0[14], S0[15]); mc_ = AT_MX3(mc_, S1[14], S1[15]); \
        float mx = __builtin_fmaxf(__builtin_fmaxf(ma_, mb_), __builtin_fmaxf(mc_, md_)); \
        mx = __builtin_fmaxf(mx, __shfl_xor(mx, 32)); \
        if (FIRST) { M += mx; _Pragma("unroll") for (int i_ = 0; i_ < 16; ++i_) { S0[i_] -= mx; S1[i_] -= mx; } } \
        else if (__any(mx > 8.0f)) { const float dl_ = __builtin_fmaxf(mx, 0.f), alpha_ = __builtin_amdgcn_exp2f(-dl_); M += dl_; L *= alpha_; \
            _Pragma("unroll") for (int i_ = 0; i_ < 16; ++i_) { S0[i_] -= dl_; S1[i_] -= dl_; O0[i_] *= alpha_; O1[i_] *= alpha_; } } \
        float pa_ = 0.f, pb_ = 0.f, pc_ = 0.f, pd_ = 0.f; \
        _Pragma("unroll") for (int i_ = 0; i_ < 16; i_ += 2) { S0[i_] = __builtin_amdgcn_exp2f(S0[i_]); S0[i_ + 1] = __builtin_amdgcn_exp2f(S0[i_ + 1]); S1[i_] = __builtin_amdgcn_exp2f(S1[i_]); S1[i_ + 1] = __builtin_amdgcn_exp2f(S1[i_ + 1]); \
            pa_ += S0[i_]; pb_ += S0[i_ + 1]; pc_ += S1[i_]; pd_ += S1[i_ + 1]; } \
        L += (pa_ + pb_) + (pc_ + pd_); } while (0)
__device__ __forceinline__ void attn_store(bf16* op, const f32x16& o0, const f32x16& o1, float inv) {
#pragma unroll
    for (int gq = 0; gq < 4; ++gq) {
        u32x2 w0, w1; w0.x = pkbf(o0[4 * gq] * inv, o0[4 * gq + 1] * inv); w0.y = pkbf(o0[4 * gq + 2] * inv, o0[4 * gq + 3] * inv);
        w1.x = pkbf(o1[4 * gq] * inv, o1[4 * gq + 1] * inv); w1.y = pkbf(o1[4 * gq + 2] * inv, o1[4 * gq + 3] * inv);
        *(u32x2*)(op + 8 * gq) = w0; *(u32x2*)(op + 32 + 8 * gq) = w1; }
}
__device__ __forceinline__ void attn_unit(LAS unsigned char* lds, const bf16* Q, const bf16* KN, const bf16* KR, const bf16* VT, bf16* O,
                                          int b, int hp, int qrow0, int key_lo, int ntiles, int tid) {
    const int lane = tid & 63, r = lane & 31, hh = lane >> 5, wid = __builtin_amdgcn_readfirstlane(tid >> 6), gsel = wid >> 2, wq = wid & 3, gt = tid & 255;
    const int h = hp * 2 + gsel;
    LAS unsigned char* gl = lds + gsel * (2 * AT_BUF);
    const int qrA = qrow0 + wq * 64 + r;
    bf16x8 qa[6];
    LAS unsigned char* qbl = lds + ATQ_OFF + wid * 6656 + r * AT_KP + hh * 16;
#pragma unroll
    for (int c = 0; c < 6; ++c) { qa[c] = *(const bf16x8*)(Q + (size_t)qrA * QW + h * 96 + 16 * c + 8 * hh);
        *(LAS bf16x8*)(qbl + c * 32) = *(const bf16x8*)(Q + (size_t)(qrA + 32) * QW + h * 96 + 16 * c + 8 * hh); }
    f32x16 oA0, oA1, oB0, oB1;
#pragma unroll
    for (int i = 0; i < 16; ++i) { oA0[i] = 0.f; oA1[i] = 0.f; oB0[i] = 0.f; oB1[i] = 0.f; }
    float mA = 0.f, lA = 0.f, mB = 0.f, lB = 0.f;
    const int kkey = gt >> 3, kpc = gt & 7, rkey = gt >> 2, rpc = gt & 3;
    const bf16* vsrc = VT + ((size_t)b * 512 + h * 64 + kkey) * NKEY + kpc * 8;
    const unsigned char* vsrc8 = (const unsigned char*)VT + ((size_t)b * 512 + h * 64 + (gt >> 2)) * NKEY + (gt & 3) * 16;
    u32x4 rk0, rk1, rr, rv0, rv1;
#define AT_LOAD(t) do { const int key0 = key_lo + (t) * 64; const size_t krow = key0 < SEQ ? (size_t)b * SEQ + key0 : (size_t)MLAT + (size_t)b * LC + (key0 - SEQ); \
        rk0 = *(const u32x4*)(KN + (krow + kkey) * 512 + h * 64 + kpc * 8); rk1 = *(const u32x4*)(KN + (krow + kkey + 32) * 512 + h * 64 + kpc * 8); \
        rr = *(const u32x4*)(KR + (krow + rkey) * 32 + rpc * 8); \
        if (MK_PV8) { rv0 = *(const u32x4*)(vsrc8 + key0); rv1 = rv0; } else { rv0 = *(const u32x4*)(vsrc + key0); rv1 = *(const u32x4*)(vsrc + (size_t)32 * NKEY + key0); } } while (0)
#define AT_STORE(bufp) do { *(LAS u32x4*)((bufp) + kkey * AT_KP + kpc * 16) = rk0; *(LAS u32x4*)((bufp) + (kkey + 32) * AT_KP + kpc * 16) = rk1; \
        *(LAS u32x4*)((bufp) + rkey * AT_KP + 128 + rpc * 16) = rr; \
        if (MK_PV8) { *(LAS u32x4*)((bufp) + AT_VOFF + (gt >> 2) * AT_VP8 + (gt & 3) * 16) = rv0; } else { \
        *(LAS u32x2*)((bufp) + AT_VOFF + kkey * AT_VP + kpc * 16) = (u32x2){rv0.x, rv0.y}; *(LAS u32x2*)((bufp) + AT_VOFF + kkey * AT_VP + kpc * 16 + 8) = (u32x2){rv0.z, rv0.w}; \
        *(LAS u32x2*)((bufp) + AT_VOFF + (kkey + 32) * AT_VP + kpc * 16) = (u32x2){rv1.x, rv1.y}; *(LAS u32x2*)((bufp) + AT_VOFF + (kkey + 32) * AT_VP + kpc * 16 + 8) = (u32x2){rv1.z, rv1.w}; } } while (0)
    AT_LOAD(0);
    AT_STORE(gl);
    __syncthreads();
    if (gsel == 1) __syncthreads();
    for (int t = 0; t < ntiles; ++t) {
        LAS unsigned char* buf = gl + (t & 1) * AT_BUF;
        f32x16 sA0, sA1, sB0, sB1;
        const LAS unsigned char* kb = buf + r * AT_KP + hh * 16;
#pragma unroll 1
        for (int rep_ = 0; rep_ < 1 + (int)((MK_DUP >> 25) & 1u); ++rep_) {
#pragma unroll
        for (int i = 0; i < 16; ++i) { sA0[i] = -mA; sA1[i] = -mA; sB0[i] = -mB; sB1[i] = -mB; }
#pragma unroll
        for (int c = 0; c < 6; ++c) {
            const bf16x8 a0 = *(const LAS bf16x8*)(kb + c * 32), a1 = *(const LAS bf16x8*)(kb + 32 * AT_KP + c * 32);
            const bf16x8 qbc = *(const LAS bf16x8*)(qbl + c * 32);
            sA0 = mfma32(a0, qa[c], sA0); sA1 = mfma32(a1, qa[c], sA1); sB0 = mfma32(a0, qbc, sB0); sB1 = mfma32(a1, qbc, sB1);
        }
        asm volatile("" ::: "memory"); }
        AT_SOFTMAX(sA0, sA1, mA, lA, oA0, oA1, t == 0);
        bf16x8 pA[4]; gm::v8i_t pA8;
        if (MK_PV8) pA8 = pack_p8(sA0, sA1); else { pA[0] = pack_s(sA0, 0); pA[1] = pack_s(sA0, 1); pA[2] = pack_s(sA1, 0); pA[3] = pack_s(sA1, 1); }
        AT_SOFTMAX(sB0, sB1, mB, lB, oB0, oB1, t == 0);
        bf16x8 pB[4]; gm::v8i_t pB8;
        if (MK_PV8) pB8 = pack_p8(sB0, sB1); else { pB[0] = pack_s(sB0, 0); pB[1] = pack_s(sB0, 1); pB[2] = pack_s(sB1, 0); pB[3] = pack_s(sB1, 1); }
        __syncthreads();
        __builtin_amdgcn_sched_barrier(0);
        if (t + 1 < ntiles) AT_LOAD(t + 1);
        if (MK_PV8) {
            const LAS unsigned char* vb8 = buf + AT_VOFF + r * AT_VP8 + hh * 32;
            const gm::v4i_t a0l = *(const LAS gm::v4i_t*)(vb8), a0h = *(const LAS gm::v4i_t*)(vb8 + 16), a1l = *(const LAS gm::v4i_t*)(vb8 + 32 * AT_VP8), a1h = *(const LAS gm::v4i_t*)(vb8 + 32 * AT_VP8 + 16);
            const gm::v8i_t va0 = __builtin_shufflevector(a0l, a0h, 0, 1, 2, 3, 4, 5, 6, 7), va1 = __builtin_shufflevector(a1l, a1h, 0, 1, 2, 3, 4, 5, 6, 7);
            asm volatile("s_nop 3\n\tv_mfma_f32_32x32x64_f8f6f4 %0, %1, %2, %0" : "+v"(oA0) : "v"(va0), "v"(pA8));
            asm volatile("v_mfma_f32_32x32x64_f8f6f4 %0, %1, %2, %0" : "+v"(oA1) : "v"(va1), "v"(pA8));
            asm volatile("v_mfma_f32_32x32x64_f8f6f4 %0, %1, %2, %0" : "+v"(oB0) : "v"(va0), "v"(pB8));
            asm volatile("v_mfma_f32_32x32x64_f8f6f4 %0, %1, %2, %0" : "+v"(oB1) : "v"(va1), "v"(pB8));
        } else {
        const LAS unsigned char* vb = buf + AT_VOFF + r * AT_VP + hh * 8;
#pragma unroll
        for (int ks = 0; ks < 4; ++ks) {
            const s16x4 l0 = *(const LAS s16x4*)(vb + ks * 32), h0 = *(const LAS s16x4*)(vb + ks * 32 + 16);
            const s16x4 l1 = *(const LAS s16x4*)(vb + 32 * AT_VP + ks * 32), h1 = *(const LAS s16x4*)(vb + 32 * AT_VP + ks * 32 + 16);
            const bf16x8 v0 = __builtin_shufflevector(l0, h0, 0, 1, 2, 3, 4, 5, 6, 7), v1 = __builtin_shufflevector(l1, h1, 0, 1, 2, 3, 4, 5, 6, 7);
            oA0 = mfma32(v0, pA[ks], oA0); oA1 = mfma32(v1, pA[ks], oA1); oB0 = mfma32(v0, pB[ks], oB0); oB1 = mfma32(v1, pB[ks], oB1);
        } }
        if (t + 1 < ntiles) { LAS unsigned char* nb = gl + ((t + 1) & 1) * AT_BUF; AT_STORE(nb); }
        __syncthreads();
    }
    if (MK_PV8) asm volatile("s_nop 15\n\ts_nop 15\n\ts_nop 15\n\ts_nop 15" ::: "memory");
    if (gsel == 0) __syncthreads();
    lA += __shfl_xor(lA, 32); lB += __shfl_xor(lB, 32);
    attn_store(O + (size_t)qrA * D + h * 64 + 4 * hh, oA0, oA1, 1.0f / lA);
    attn_store(O + (size_t)(qrA + 32) * D + h * 64 + 4 * hh, oB0, oB1, 1.0f / lB);
#undef AT_LOAD
#undef AT_STORE
}
#if MK_QK8 && MK_PV8
constexpr int AT_KP8 = 144;
__device__ __forceinline__ gm::v8i_t pack32_fp8(const u32x4 (&q)[4]) {
    gm::v8i_t p;
#pragma unroll
    for (int i = 0; i < 4; ++i) { const u32x4 w = q[i];
        int a = 0; a = __builtin_amdgcn_cvt_pk_fp8_f32(__uint_as_float(w.x << 16), __uint_as_float(w.x & 0xffff0000u), a, false); a = __builtin_amdgcn_cvt_pk_fp8_f32(__uint_as_float(w.y << 16), __uint_as_float(w.y & 0xffff0000u), a, true);
        int c = 0; c = __builtin_amdgcn_cvt_pk_fp8_f32(__uint_as_float(w.z << 16), __uint_as_float(w.z & 0xffff0000u), c, false); c = __builtin_amdgcn_cvt_pk_fp8_f32(__uint_as_float(w.w << 16), __uint_as_float(w.w & 0xffff0000u), c, true);
        p[2 * i] = a; p[2 * i + 1] = c; }
    return p;
}
__device__ __forceinline__ void attn_unit8(LAS unsigned char* lds, const bf16* Q, const bf16* KN, const bf16* KR, const bf16* VT, bf16* O,
                                           int b, int hp, int qrow0, int key_lo, int ntiles, int tid) {
    const int lane = tid & 63, r = lane & 31, hh = lane >> 5, wid = __builtin_amdgcn_readfirstlane(tid >> 6), gsel = wid >> 2, wq = wid & 3, gt = tid & 255;
    const int h = hp * 2 + gsel;
    LAS unsigned char* gl = lds + gsel * (2 * AT_BUF);
    const int qrA = qrow0 + wq * 64 + r;
    LAS unsigned char* qbl = lds + ATQ_OFF + wid * 6656 + lane * 16;
    gm::v8i_t qnA; bf16x8 qrA_[2];
    {   u32x4 t4[4];
#pragma unroll
        for (int i = 0; i < 4; ++i) t4[i] = *(const u32x4*)(Q + (size_t)qrA * QW + h * 96 + 32 * hh + 8 * i);
        qnA = pack32_fp8(t4);
#pragma unroll
        for (int c = 0; c < 2; ++c) qrA_[c] = *(const bf16x8*)(Q + (size_t)qrA * QW + h * 96 + 64 + 16 * c + 8 * hh);
#pragma unroll
        for (int i = 0; i < 4; ++i) t4[i] = *(const u32x4*)(Q + (size_t)(qrA + 32) * QW + h * 96 + 32 * hh + 8 * i);
        const gm::v8i_t qnB = pack32_fp8(t4);
        *(LAS gm::v4i_t*)(qbl) = __builtin_shufflevector(qnB, qnB, 0, 1, 2, 3); *(LAS gm::v4i_t*)(qbl + 1024) = __builtin_shufflevector(qnB, qnB, 4, 5, 6, 7);
#pragma unroll
        for (int c = 0; c < 2; ++c) *(LAS bf16x8*)(qbl + (2 + c) * 1024) = *(const bf16x8*)(Q + (size_t)(qrA + 32) * QW + h * 96 + 64 + 16 * c + 8 * hh); }
    f32x16 oA0, oA1, oB0, oB1;
#pragma unroll
    for (int i = 0; i < 16; ++i) { oA0[i] = 0.f; oA1[i] = 0.f; oB0[i] = 0.f; oB1[i] = 0.f; }
    float mA = 0.f, lA = 0.f, mB = 0.f, lB = 0.f;
    const int srow = gt >> 2, spc = gt & 3;
    const unsigned char* kn8 = (const unsigned char*)KN + h * 64 + spc * 16;
    const unsigned char* vsrc8 = (const unsigned char*)VT + ((size_t)b * 512 + h * 64 + srow) * NKEY + spc * 16;
    u32x4 rk0, rr, rv0;
#define AT_LOAD8(t) do { const int key0 = key_lo + (t) * 64; const size_t krow = key0 < SEQ ? (size_t)b * SEQ + key0 : (size_t)MLAT + (size_t)b * LC + (key0 - SEQ); \
        rk0 = *(const u32x4*)(kn8 + (krow + srow) * 512); rr = *(const u32x4*)(KR + (krow + srow) * 32 + spc * 8); rv0 = *(const u32x4*)(vsrc8 + key0); } while (0)
#define AT_STORE8(bufp) do { *(LAS u32x4*)((bufp) + srow * AT_KP8 + spc * 16) = rk0; *(LAS u32x4*)((bufp) + srow * AT_KP8 + 64 + spc * 16) = rr; \
        *(LAS u32x4*)((bufp) + AT_VOFF + srow * AT_VP8 + spc * 16) = rv0; } while (0)
    AT_LOAD8(0);
    AT_STORE8(gl);
    __syncthreads();
    if (gsel == 1) __syncthreads();
    for (int t = 0; t < ntiles; ++t) {
        LAS unsigned char* buf = gl + (t & 1) * AT_BUF;
        f32x16 sA0, sA1, sB0, sB1;
        const LAS unsigned char* kb = buf + r * AT_KP8;
#pragma unroll
        for (int i = 0; i < 16; ++i) { sA0[i] = -mA; sA1[i] = -mA; sB0[i] = -mB; sB1[i] = -mB; }
#pragma unroll
        for (int c = 0; c < 2; ++c) {
            const bf16x8 a0 = *(const LAS bf16x8*)(kb + 64 + c * 32 + hh * 16), a1 = *(const LAS bf16x8*)(kb + 32 * AT_KP8 + 64 + c * 32 + hh * 16);
            const bf16x8 qbc = *(const LAS bf16x8*)(qbl + (2 + c) * 1024);
            sA0 = mfma32(a0, qrA_[c], sA0); sA1 = mfma32(a1, qrA_[c], sA1); sB0 = mfma32(a0, qbc, sB0); sB1 = mfma32(a1, qbc, sB1);
        }
        {   const gm::v4i_t k0l = *(const LAS gm::v4i_t*)(kb + hh * 32), k0h = *(const LAS gm::v4i_t*)(kb + hh * 32 + 16), k1l = *(const LAS gm::v4i_t*)(kb + 32 * AT_KP8 + hh * 32), k1h = *(const LAS gm::v4i_t*)(kb + 32 * AT_KP8 + hh * 32 + 16);
            const gm::v4i_t qbl_ = *(const LAS gm::v4i_t*)(qbl), qbh_ = *(const LAS gm::v4i_t*)(qbl + 1024);
            const gm::v8i_t k0 = __builtin_shufflevector(k0l, k0h, 0, 1, 2, 3, 4, 5, 6, 7), k1 = __builtin_shufflevector(k1l, k1h, 0, 1, 2, 3, 4, 5, 6, 7), qnB = __builtin_shufflevector(qbl_, qbh_, 0, 1, 2, 3, 4, 5, 6, 7);
            asm volatile("s_nop 15\n\tv_mfma_f32_32x32x64_f8f6f4 %0, %1, %2, %0" : "+v"(sA0) : "v"(k0), "v"(qnA));
            asm volatile("s_nop 15\n\tv_mfma_f32_32x32x64_f8f6f4 %0, %1, %2, %0" : "+v"(sA1) : "v"(k1), "v"(qnA));
            asm volatile("s_nop 15\n\tv_mfma_f32_32x32x64_f8f6f4 %0, %1, %2, %0" : "+v"(sB0) : "v"(k0), "v"(qnB));
            asm volatile("s_nop 15\n\tv_mfma_f32_32x32x64_f8f6f4 %0, %1, %2, %0" : "+v"(sB1) : "v"(k1), "v"(qnB));
            asm volatile("s_nop 15\n\ts_nop 15\n\ts_nop 15\n\ts_nop 15\n\ts_nop 15" : "+v"(sA0), "+v"(sA1), "+v"(sB0), "+v"(sB1)); }
        AT_SOFTMAX(sA0, sA1, mA, lA, oA0, oA1, t == 0);
        const gm::v8i_t pA8 = pack_p8(sA0, sA1);
        AT_SOFTMAX(sB0, sB1, mB, lB, oB0, oB1, t == 0);
        const gm::v8i_t pB8 = pack_p8(sB0, sB1);
        __syncthreads();
        __builtin_amdgcn_sched_barrier(0);
        if (t + 1 < ntiles) AT_LOAD8(t + 1);
        {   const LAS unsigned char* vb8 = buf + AT_VOFF + r * AT_VP8 + hh * 32;
            const gm::v4i_t a0l = *(const LAS gm::v4i_t*)(vb8), a0h = *(const LAS gm::v4i_t*)(vb8 + 16), a1l = *(const LAS gm::v4i_t*)(vb8 + 32 * AT_VP8), a1h = *(const LAS gm::v4i_t*)(vb8 + 32 * AT_VP8 + 16);
            const gm::v8i_t va0 = __builtin_shufflevector(a0l, a0h, 0, 1, 2, 3, 4, 5, 6, 7), va1 = __builtin_shufflevector(a1l, a1h, 0, 1, 2, 3, 4, 5, 6, 7);
            asm volatile("s_nop 3\n\tv_mfma_f32_32x32x64_f8f6f4 %0, %1, %2, %0" : "+v"(oA0) : "v"(va0), "v"(pA8));
            asm volatile("v_mfma_f32_32x32x64_f8f6f4 %0, %1, %2, %0" : "+v"(oA1) : "v"(va1), "v"(pA8));
            asm volatile("v_mfma_f32_32x32x64_f8f6f4 %0, %1, %2, %0" : "+v"(oB0) : "v"(va0), "v"(pB8));
            asm volatile("v_mfma_f32_32x32x64_f8f6f4 %0, %1, %2, %0" : "+v"(oB1) : "v"(va1), "v"(pB8)); }
        if (t + 1 < ntiles) { LAS unsigned char* nb = gl + ((t + 1) & 1) * AT_BUF; AT_STORE8(nb); }
        __syncthreads();
    }
    asm volatile("s_nop 15\n\ts_nop 15\n\ts_nop 15\n\ts_nop 15\n\ts_nop 15" : "+v"(oA0), "+v"(oA1), "+v"(oB0), "+v"(oB1));
    if (gsel == 0) __syncthreads();
    lA += __shfl_xor(lA, 32); lB += __shfl_xor(lB, 32);
    attn_store(O + (size_t)qrA * D + h * 64 + 4 * hh, oA0, oA1, 1.0f / lA);
    attn_store(O + (size_t)(qrA + 32) * D + h * 64 + 4 * hh, oB0, oB1, 1.0f / lB);
#undef AT_LOAD8
#undef AT_STORE8
}
#endif
__device__ __forceinline__ void tr_item(const float* W, int N, int k0, int n0, bf16* dst, size_t drow0, int dld, const float* kscale, float cscale, LAS float* scr, int lane) {
#pragma unroll 1
    for (int ib = 0; ib < 32; ib += 16) { float wv[16];
#pragma unroll
        for (int ii = 0; ii < 16; ++ii) wv[ii] = W[(size_t)(k0 + 2 * (ib + ii) + (lane >> 5)) * N + n0 + (lane & 31)];
#pragma unroll
        for (int ii = 0; ii < 16; ++ii) { const int kk = 2 * (ib + ii) + (lane >> 5); float v = wv[ii] * cscale; if (kscale) v *= kscale[k0 + kk]; scr[kk * 33 + (lane & 31)] = v; } }
    asm volatile("s_waitcnt lgkmcnt(0)" ::: "memory");
    const int c = lane & 7;
#pragma unroll
    for (int j = 0; j < 4; ++j) { const int n = (lane >> 3) + 8 * j; const LAS float* s = scr + (8 * c) * 33 + n;
        u32x4 o; o.x = pkbf(s[0 * 33], s[1 * 33]); o.y = pkbf(s[2 * 33], s[3 * 33]); o.z = pkbf(s[4 * 33], s[5 * 33]); o.w = pkbf(s[6 * 33], s[7 * 33]);
        *(u32x4*)(dst + (drow0 + n) * (size_t)dld + k0 + 8 * c) = o; }
    asm volatile("s_waitcnt lgkmcnt(0)" ::: "memory");
}
__device__ __forceinline__ void tr_item8(const float* W, int N, int k0, int n0, unsigned char* dst, size_t drow0, int dld, float cscale, LAS float* scr, int lane) {
#pragma unroll 1
    for (int ib = 0; ib < 32; ib += 16) { float wv[16];
#pragma unroll
        for (int ii = 0; ii < 16; ++ii) wv[ii] = W[(size_t)(k0 + 2 * (ib + ii) + (lane >> 5)) * N + n0 + (lane & 31)];
#pragma unroll
        for (int ii = 0; ii < 16; ++ii) { const int kk = 2 * (ib + ii) + (lane >> 5); scr[kk * 33 + (lane & 31)] = wv[ii] * cscale; } }
    asm volatile("s_waitcnt lgkmcnt(0)" ::: "memory");
    const int c = lane & 7;
#pragma unroll
    for (int j = 0; j < 4; ++j) { const int n = (lane >> 3) + 8 * j; const LAS float* sp = scr + (8 * c) * 33 + n;
        u32x2 o; o.x = pk4_fp8(sp[0 * 33], sp[1 * 33], sp[2 * 33], sp[3 * 33]); o.y = pk4_fp8(sp[4 * 33], sp[5 * 33], sp[6 * 33], sp[7 * 33]);
        *(u32x2*)(dst + (drow0 + n) * (size_t)dld + k0 + 8 * c) = o; }
    asm volatile("s_waitcnt lgkmcnt(0)" ::: "memory");
}
__device__ __forceinline__ void tr_matrix(const float* W, int K, int N, bf16* dst, int dld, int mode, bf16* dst2, const float* kscale, float cscale, LAS float* scr, int gw, int NGW, int lane) {
    const int nblk = N / 32, nit = (K / 64) * nblk;
    for (int it = gw; it < nit; it += NGW) { const int kb = it / nblk, nb = it % nblk, n0 = 32 * nb; size_t dr; bf16* d = dst;
        if (mode == 0) dr = n0;
        else if (mode == 1) dr = n0 < 416 ? n0 : n0 + 96;
        else if (mode == 2) { const int hq = n0 >> 7, w = n0 & 127; if (w < 64) dr = hq * 64 + w; else { dr = hq * 64 + w - 64; d = dst2; } }
        else if (mode == 3) dr = (size_t)(n0 >> 7) * 256 + (n0 & 127);
        else dr = (size_t)(n0 >> 7) * 256 + 128 + (n0 & 127);
        tr_item(W, N, 64 * kb, n0, d, dr, dld, kscale, cscale, scr, lane); }
}
__device__ __forceinline__ void tr_matrix8(const float* W, int K, int N, unsigned char* dst, int dld, int mode, LAS float* scr, int gw, int NGW, int lane) {
    const int nblk = N / 32, nit = (K / 64) * nblk;
    for (int it = gw; it < nit; it += NGW) { const int kb = it / nblk, nb = it % nblk, n0 = 32 * nb; size_t dr;
        if (mode == 0) dr = n0; else if (mode == 1) dr = n0 < 416 ? n0 : n0 + 96; else if (mode == 3) dr = (size_t)(n0 >> 7) * 256 + (n0 & 127); else dr = (size_t)(n0 >> 7) * 256 + 128 + (n0 & 127);
        tr_item8(W, N, 64 * kb, n0, dst, dr, dld, W8_SCALE, scr, lane); }
}
__device__ __forceinline__ void split8(const float* v, bf16x8& hi, bf16x8& lo) {
    u32x4 h, l;
#pragma unroll
    for (int q = 0; q < 4; ++q) { const unsigned ph = pkbf(v[2 * q], v[2 * q + 1]); const float h0 = __uint_as_float(ph << 16), h1 = __uint_as_float(ph & 0xffff0000u);
        h[q] = ph; l[q] = pkbf(v[2 * q] - h0, v[2 * q + 1] - h1); }
    hi = __builtin_bit_cast(bf16x8, h); lo = __builtin_bit_cast(bf16x8, l);
}
__device__ __forceinline__ f32x16 mfma32m(bf16x8 a, bf16x8 b, f32x16 c) { return __builtin_amdgcn_mfma_f32_32x32x16_bf16(a, b, c, 0, 0, 0); }
__device__ __forceinline__ void mod_partial_item(const float* c, const float* cctx, const float* ada_w, float* MODP, int item, LAS float* st, int tid) {
    const int lane = tid & 63, wave = __builtin_amdgcn_readfirstlane(tid >> 6);
    const int li = item / 192, kc = (item / 12) % 16, cg = item % 12;
    for (int idx = tid; idx < 36 * 64; idx += 512) { const int r = idx >> 6, k = idx & 63; float v = 0.f;
        if (r < 33) { const float x = r < 32 ? c[(size_t)r * D + kc * 64 + k] : cctx[kc * 64 + k]; v = silu_f(x); }
        st[k * 36 + r] = v; }
    __syncthreads();
    const int m = lane & 31, kg = lane >> 5;
    bf16x8 ah[2][4], al[2][4];
#pragma unroll
    for (int ks = 0; ks < 4; ++ks) { float v0[8], v1[8];
#pragma unroll
        for (int j = 0; j < 8; ++j) { const int k = ks * 16 + kg * 8 + j; v0[j] = st[k * 36 + m]; const float x = st[k * 36 + 32]; v1[j] = m == 0 ? x : 0.f; }
        split8(v0, ah[0][ks], al[0][ks]); split8(v1, ah[1][ks], al[1][ks]); }
#pragma unroll 1
    for (int cb = 0; cb < 2; ++cb) {
        const int col = cg * 512 + wave * 64 + cb * 32 + m;
        const float* wp = ada_w + ((size_t)li * D + kc * 64 + kg * 8) * 6144 + col;
        float w[32];
#pragma unroll
        for (int ks = 0; ks < 4; ++ks)
#pragma unroll
            for (int j = 0; j < 8; ++j) w[ks * 8 + j] = wp[(size_t)(ks * 16 + j) * 6144];
        f32x16 a0, a1;
#pragma unroll
        for (int i = 0; i < 16; ++i) { a0[i] = 0.f; a1[i] = 0.f; }
#pragma unroll
        for (int ks = 0; ks < 4; ++ks) { bf16x8 bh, bl; split8(&w[ks * 8], bh, bl);
            a0 = mfma32m(ah[0][ks], bh, a0); a0 = mfma32m(ah[0][ks], bl, a0); a0 = mfma32m(al[0][ks], bh, a0);
            a1 = mfma32m(ah[1][ks], bh, a1); a1 = mfma32m(ah[1][ks], bl, a1); a1 = mfma32m(al[1][ks], bh, a1); }
        float* mp = MODP + (((size_t)kc * 4 + li) * 33) * 6144 + col;
#pragma unroll
        for (int i = 0; i < 16; ++i) mp[(size_t)(8 * (i >> 2) + 4 * kg + (i & 3)) * 6144] = a0[i];
        if (kg == 0) mp[(size_t)32 * 6144] = a1[0];
    }
    __syncthreads();
}

constexpr int NPH = 43;
struct Args { const float* in[N_IN]; float* out; unsigned char* ws; int ph_lo, ph_hi; };
#define AIN(i) ((const float*)(const GAS float*)a.in[i])
#define AOUT ((float*)(GAS float*)a.out)

__device__ __forceinline__ void moe_convert(const float* w1, const float* w3, const float* w2, bf16* W13, bf16* W2, LAS float* scr, int gw, int NGW, int lane) {
    constexpr int PER = 1792, TOT = 8 * 3 * PER;
    for (int it = gw; it < TOT; it += NGW) { const int ex = it / (3 * PER), rem = it % (3 * PER), which = rem / PER, j = rem % PER;
        if (which < 2) { const int nblk = DFFE / 32, kb = j / nblk, nb = j % nblk, n0 = 32 * nb;
            const float* W = (which ? w3 : w1) + (size_t)ex * D * DFFE;
            tr_item(W, DFFE, 64 * kb, n0, W13 + (size_t)ex * 7168 * 1024, (size_t)(n0 >> 7) * 256 + which * 128 + (n0 & 127), 1024, nullptr, 1.0f, scr, lane); }
        else { const int nblk = D / 32, kb = j / nblk, nb = j % nblk, n0 = 32 * nb;
            tr_item(w2 + (size_t)ex * DFFE * D, D, 64 * kb, n0, W2 + (size_t)ex * 1024 * DFFE, n0, DFFE, nullptr, 1.0f, scr, lane); } }
}

constexpr int MOE_CV_ITEMS = 8 * 3 * 1792;
constexpr int BG0_MIXIN_E = 1024 * 6, BG0_MIXOUT_E = BG0_MIXIN_E + 1024 * 6, BG0_UP_E = BG0_MIXOUT_E + 512 * 6, BG0_END = BG0_UP_E + 1024 * 14;
constexpr int BG1_DFTS_E = 1024 * 7, BG1_FNET_E = BG1_DFTS_E + 1024 * 6, BG1_MD0_E = BG1_FNET_E + (MOE_CHAIN_ON ? 0 : 8064), BG1_MIXIN = BG1_MD0_E + 8064, BG1_END = BG1_MIXIN + 1792 * 6;
static_assert(BG0_END <= MOE_CV_ITEMS && BG1_END <= MOE_CV_ITEMS, "background plan");
__device__ __forceinline__ void moe_convert8(const float* w1, const float* w3, const float* w2, unsigned char* W13, unsigned char* W2, LAS float* scr, int gw, int NGW, int lane, int lo = 0, int hi = MOE_CV_ITEMS) {
    constexpr int PER = 1792;
    for (int it = lo + gw; it < hi; it += NGW) { const int ex = it / (3 * PER), rem = it % (3 * PER), which = rem / PER, j = rem % PER;
        if (which < 2) { const int nblk = DFFE / 32, kb = j / nblk, nb = j % nblk, n0 = 32 * nb;
            const float* W = (which ? w3 : w1) + (size_t)ex * D * DFFE;
            tr_item8(W, DFFE, 64 * kb, n0, W13 + (size_t)ex * 7168 * 1024, (size_t)(n0 >> 7) * 256 + which * 128 + (n0 & 127), 1024, W8_SCALE, scr, lane); }
        else { const int nblk = D / 32, kb = j / nblk, nb = j % nblk, n0 = 32 * nb;
            tr_item8(w2 + (size_t)ex * DFFE * D, D, 64 * kb, n0, W2 + (size_t)ex * 1024 * DFFE, n0, DFFE, W8_SCALE, scr, lane); } }
}

__global__ void __launch_bounds__(512, 2) fwd(Args a) {
    extern __shared__ __attribute__((aligned(16))) unsigned char lds_raw[];
    LAS unsigned char* lds = (LAS unsigned char*)lds_raw;
    volatile LAS unsigned* MISC = (volatile LAS unsigned*)(lds + MISC_OFF);
    const int G = gridDim.x, bid = blockIdx.x, NGW = G * 8;
    unsigned* ctl = (unsigned*)(GAS unsigned*)(a.ws + WS_CTL);
#define WSP_DECL GAS unsigned char* wsg_ = (GAS unsigned char*)a.ws; asm volatile("" : "+s"(wsg_)); unsigned char* wsp = (unsigned char*)wsg_; int tid = threadIdx.x; asm volatile("" : "+v"(tid)); const int lane = tid & 63, wave = __builtin_amdgcn_readfirstlane(tid >> 6), gw = bid * 8 + wave; (void)lane; (void)gw
#define MOD ((float*)(wsp + WS_MOD))
#define ROPEC ((float*)(wsp + WS_ROPE))
#define ROPES (ROPEC + 512)
#define SSQQ ((float*)(wsp + WS_SSQQ))
#define SSQK ((float*)(wsp + WS_SSQK))
#define HMID ((float*)(wsp + WS_HMID))
#define AMID ((float*)(wsp + WS_AMID))
#define LIST ((int*)(wsp + WS_LIST))
#define GLIST ((float*)(wsp + WS_GLIST))
#define WMIXIN ((bf16*)(wsp + WS_WMIXIN))
#define WUQ ((bf16*)(wsp + WS_WUQ))
#define WUK ((bf16*)(wsp + WS_WUK))
#define WUV ((bf16*)(wsp + WS_WUV))
#define WMIXOUT ((bf16*)(wsp + WS_WMIXOUT))
#define WFFN13 ((bf16*)(wsp + WS_WFFN13))
#define WFFN2 ((bf16*)(wsp + WS_WFFN2))
#define WFNET ((bf16*)(wsp + WS_WFNET))
#define WDFTC ((bf16*)(wsp + WS_WDFTC))
#define WDFTL ((bf16*)(wsp + WS_WDFTL))
#define WDFTX ((bf16*)(wsp + WS_WDFTX))
#define WMOE13 ((bf16*)(wsp + WS_WMOE13))
#define WMOE2 ((bf16*)(wsp + WS_WMOE2))
#define WMOE13_8(q) ((unsigned char*)WMOE13 + (BG_ON ? (size_t)(q) * 8 * 7168 * 1024 : (size_t)0))
#define WMOE2_8(q) ((unsigned char*)WMOE2 + (BG_ON ? (size_t)(q) * 8 * 1024 * 3584 : (size_t)0))
#define BG_FILL(T_, q_, lo_, hi_) do { if (BG_ON) { const int lo__ = (lo_), hi__ = (hi_); if (lo__ < hi__) { const int r__ = (T_) % G; \
    if (r__ == 0 || bid >= r__) { const int q__ = (q_); __syncthreads(); \
        moe_convert8(AIN(I_MW1) + (size_t)q__ * 8 * D * DFFE, AIN(I_MW3) + (size_t)q__ * 8 * D * DFFE, AIN(I_MW2) + (size_t)q__ * 8 * DFFE * D, WMOE13_8(q__), WMOE2_8(q__), (LAS float*)(lds + wave * 8448), \
                     (r__ == 0 ? bid : bid - r__) * 8 + wave, (r__ == 0 ? G : G - r__) * 8, lane, lo__, hi__); } } } } while (0)
#define XCUR ((bf16*)(wsp + WS_XCUR))
#define RA ((bf16*)(wsp + WS_RA))
#define CQ ((bf16*)(wsp + WS_RB + RB_CQ))
#define CKV ((bf16*)(wsp + WS_RB + RB_CKV))
#define KR ((bf16*)(wsp + WS_RB + RB_KR))
#define POOL ((bf16*)(wsp + WS_RB + RB_POOL))
#define QB ((bf16*)(wsp + WS_RB + RB_Q))
#define KN ((bf16*)(wsp + WS_RB + RB_KN))
#define VT ((bf16*)(wsp + WS_RB + RB_VT))
#define ZB ((bf16*)(wsp + WS_RB + RB_Z))
#define ZC ((bf16*)(wsp + WS_RB + RB_ZC))
#define ACT ((bf16*)(wsp + WS_RB + RB_ACT))

    const int lo = a.ph_lo, hi = a.ph_hi;
    if (threadIdx.x < 64) MISC[threadIdx.x] = 0u;
    __syncthreads();
    XcdBarrier bar; bar.bar = ctl + CW_BAR; bar.x = 0; bar.st = MISC + 8;
    if (hi - lo > 1) bar = xcd_barrier_post(ctl + CW_BAR, MISC + 8);
#ifndef MK_EN
#define MK_EN 0xFFFFFFFFu
#endif
#define EN(b) (((MK_EN) >> (b)) & 1u)
#ifndef MK_DUP
#define MK_DUP 0u
#endif
#define REP(b) _Pragma("unroll 1") for (int _rep = 0; _rep < ((((MK_DUP) >> (b)) & 1u) ? 2 : 1); ++_rep)
#define IN(p) (lo <= (p) && (p) < hi)
#if MK_WPROBE
    unsigned wacc = 0u;
#define SEAM(p) do { if (hi > (p) + 1) { const unsigned long long t0_ = __builtin_amdgcn_s_memrealtime(); xcd_barrier<false>(bar); if (WP_SEL(p)) wacc += (unsigned)(__builtin_amdgcn_s_memrealtime() - t0_); } } while (0)
#define SEAM0(p) do { if (hi > (p) + 1) { const unsigned long long t0_ = __builtin_amdgcn_s_memrealtime(); xcd_barrier<true>(bar); if (WP_SEL(p)) wacc += (unsigned)(__builtin_amdgcn_s_memrealtime() - t0_); } } while (0)
#else
#define SEAM(p) do { if (hi > (p) + 1) { xcd_barrier<false>(bar); if ((MK_DUP >> 12) & 1u) xcd_barrier<false>(bar); } } while (0)
#define SEAM0(p) do { if (hi > (p) + 1) xcd_barrier<true>(bar); } while (0)
#endif

    if (EN(0) && IN(0)) REP(11) { WSP_DECL;
        LAS float* scr = (LAS float*)(lds + wave * 8448);
        for (int item = bid; item < 4 * 16 * 12; item += G) mod_partial_item(AIN(I_C), AIN(I_CCTX), AIN(I_ADAW), (float*)(wsp + WS_RB), item, (LAS float*)(lds + 67584), tid);
        int gwr = gw;
#define ADV(nit) gwr = (gwr - ((nit) % NGW) + NGW) % NGW
#pragma unroll 1
        for (int e = 0; e < 2; ++e) {
            if (MK_FP8_MIXIN) tr_matrix8(AIN(I_MIXIN) + (size_t)e * D * 928, D, 928, (unsigned char*)(WMIXIN + (size_t)e * 1024 * 1024), 1024, 1, scr, gwr, NGW, lane);
            else tr_matrix(AIN(I_MIXIN) + (size_t)e * D * 928, D, 928, WMIXIN + (size_t)e * 1024 * 1024, 1024, 1, nullptr, nullptr, 1.0f, scr, gwr, NGW, lane); ADV(464);
            tr_matrix(AIN(I_WUQ) + (size_t)e * 256 * 768, 256, 768, WUQ + (size_t)e * 768 * 256, 256, 0, nullptr, AIN(I_CQG) + e * 256, QSCALE, scr, gwr, NGW, lane); ADV(96);
            tr_matrix(AIN(I_WUKV) + (size_t)e * 128 * 1024, 128, 1024, WUK + (size_t)e * 512 * 128, 128, 2, WUV + (size_t)e * 512 * 128, AIN(I_CKVG) + e * 128, 1.0f, scr, gwr, NGW, lane); ADV(64);
            tr_matrix(AIN(I_MIXOUT) + (size_t)e * 1024 * 1024, 512, 1024, WMIXOUT + (size_t)e * 1024 * 1024, 1024, 0, nullptr, nullptr, 1.0f, scr, gwr, NGW, lane); ADV(256);
            if (FP8_FFN(2 * e)) {
                tr_matrix8(AIN(I_FW1) + (size_t)e * D * DFF, D, DFF, (unsigned char*)(WFFN13 + (size_t)e * 5632 * 1024), 1024, 3, scr, gwr, NGW, lane); ADV(1408);
                tr_matrix8(AIN(I_FW3) + (size_t)e * D * DFF, D, DFF, (unsigned char*)(WFFN13 + (size_t)e * 5632 * 1024), 1024, 4, scr, gwr, NGW, lane); ADV(1408);
                tr_matrix8(AIN(I_FW2) + (size_t)e * DFF * D, DFF, D, (unsigned char*)(WFFN2 + (size_t)e * 1024 * DFF), DFF, 0, scr, gwr, NGW, lane); ADV(1408);
            } else {
            tr_matrix(AIN(I_FW1) + (size_t)e * D * DFF, D, DFF, WFFN13 + (size_t)e * 5632 * 1024, 1024, 3, nullptr, nullptr, 1.0f, scr, gwr, NGW, lane); ADV(1408);
            tr_matrix(AIN(I_FW3) + (size_t)e * D * DFF, D, DFF, WFFN13 + (size_t)e * 5632 * 1024, 1024, 4, nullptr, nullptr, 1.0f, scr, gwr, NGW, lane); ADV(1408);
            tr_matrix(AIN(I_FW2) + (size_t)e * DFF * D, DFF, D, WFFN2 + (size_t)e * 1024 * DFF, DFF, 0, nullptr, nullptr, 1.0f, scr, gwr, NGW, lane); ADV(1408);
            }
            tr_matrix(AIN(I_FNET) + (size_t)e * D * D, D, D, WFNET + (size_t)e * 1024 * 1024, 1024, 0, nullptr, nullptr, 1.0f, scr, gwr, NGW, lane); ADV(512);
            if (MK_FP8_MIXIN) { for (int i = gw * 64 + lane; i < 96 * 1024 / 16; i += NGW * 64) *(u32x4*)((unsigned char*)(WMIXIN + (size_t)e * 1024 * 1024) + 416 * 1024 + (size_t)i * 16) = (u32x4){0u, 0u, 0u, 0u}; }
            else for (int i = gw * 64 + lane; i < 96 * 1024 / 8; i += NGW * 64) *(u32x4*)(WMIXIN + (size_t)e * 1024 * 1024 + 416 * 1024 + (size_t)i * 8) = (u32x4){0u, 0u, 0u, 0u};
            for (int it = (gw - e * 1024 + NGW) % NGW; it < 4 * 16 * 16; it += NGW) {        const int gq = it >> 8, ic = (it >> 4) & 15, nb = it & 15, n = nb * 64 + lane;
                const float* pw = AIN(I_POOLW) + ((size_t)(e * 4 + gq) * 128 + ic * 8) * 128; const float* ps = AIN(I_POOLS) + e * 512 + gq * 128;
                const float* mw = AIN(I_MIXOUT) + ((size_t)e * 1024 + 512 + gq * 128) * 1024 + n;
                float acc[8];
#pragma unroll
                for (int q = 0; q < 8; ++q) acc[q] = 0.f;
#pragma unroll 1
                for (int jb = 0; jb < 128; jb += 16) { float wv[16];
#pragma unroll
                    for (int jj = 0; jj < 16; ++jj) wv[jj] = mw[(size_t)(jb + jj) * 1024];
#pragma unroll
                    for (int jj = 0; jj < 16; ++jj) { const float w = wv[jj] * ps[jb + jj];
#pragma unroll
                        for (int q = 0; q < 8; ++q) acc[q] += pw[q * 128 + jb + jj] * w; } }
                u32x4 o; o.x = pkbf(acc[0], acc[1]); o.y = pkbf(acc[2], acc[3]); o.z = pkbf(acc[4], acc[5]); o.w = pkbf(acc[6], acc[7]);
                *(u32x4*)(WMIXOUT + (size_t)e * 1024 * 1024 + (size_t)n * 1024 + 512 + gq * 128 + ic * 8) = o; }
        }
#undef ADV
        const int gt = bid * 512 + tid, NT = G * 512;
        for (int i = gt; i < 2 * 65536; i += NT) { const int ty = i >> 16, m = (i >> 8) & 255, c = i & 255; const float x = (float)((m * c) & 255) * (1.0f / 128.0f);
            WDFTC[i] = (bf16)(pkbf(ty ? sinpif(x) : cospif(x), 0.f) & 0xffffu); }
        if (MK_FP8_DFT) {
            for (int i4 = gt; i4 < 2048 * 2048 / 4; i4 += NT) { float v[4];
#pragma unroll
                for (int q = 0; q < 4; ++q) { const int i = i4 * 4 + q, k = i >> 11, kk = i & 2047;
                    if (kk < 1024) v[q] = __builtin_amdgcn_cosf((float)((k * kk) & 2047) * (1.0f / 2048.0f)); else if (kk == 1024) v[q] = 0.f; else v[q] = -__builtin_amdgcn_sinf((float)((k * (kk - 1024)) & 2047) * (1.0f / 2048.0f)); }
                ((unsigned*)WDFTL)[i4] = pk4_fp8(v[0] * 16.f, v[1] * 16.f, v[2] * 16.f, v[3] * 16.f); }
            for (int i4 = gt; i4 < 65536 / 4; i4 += NT) { float v[4];
#pragma unroll
                for (int q = 0; q < 4; ++q) { const int i = i4 * 4 + q, k = i >> 8, kk = i & 255;
                    if (kk < 128) v[q] = __builtin_amdgcn_cosf((float)((k * kk) & 255) * (1.0f / 256.0f)); else if (kk == 128) v[q] = 0.f; else v[q] = -__builtin_amdgcn_sinf((float)((k * (kk - 128)) & 255) * (1.0f / 256.0f)); }
                ((unsigned*)WDFTX)[i4] = pk4_fp8(v[0] * 16.f, v[1] * 16.f, v[2] * 16.f, v[3] * 16.f); }
        } else {
        for (int i4 = gt; i4 < 2048 * 2048 / 4; i4 += NT) { float v[4];
#pragma unroll
            for (int q = 0; q < 4; ++q) { const int i = i4 * 4 + q, k = i >> 11, kk = i & 2047;
                if (kk < 1024) v[q] = __builtin_amdgcn_cosf((float)((k * kk) & 2047) * (1.0f / 2048.0f)); else if (kk == 1024) v[q] = 0.f; else v[q] = -__builtin_amdgcn_sinf((float)((k * (kk - 1024)) & 2047) * (1.0f / 2048.0f)); }
            u32x2 w; w.x = pkbf(v[0], v[1]); w.y = pkbf(v[2], v[3]); ((u32x2*)WDFTL)[i4] = w; }
        for (int i4 = gt; i4 < 65536 / 4; i4 += NT) { float v[4];
#pragma unroll
            for (int q = 0; q < 4; ++q) { const int i = i4 * 4 + q, k = i >> 8, kk = i & 255;
                if (kk < 128) v[q] = __builtin_amdgcn_cosf((float)((k * kk) & 255) * (1.0f / 256.0f)); else if (kk == 128) v[q] = 0.f; else v[q] = -__builtin_amdgcn_sinf((float)((k * (kk - 128)) & 255) * (1.0f / 256.0f)); }
            u32x2 w; w.x = pkbf(v[0], v[1]); w.y = pkbf(v[2], v[3]); ((u32x2*)WDFTX)[i4] = w; }
        }
        if (gt < 512) { const int pos = gt >> 3, j = gt & 7; const double inv = pow(10000.0, -(double)j / 8.0), ang = (double)pos * inv; ROPEC[gt] = (float)cos(ang); ROPES[gt] = (float)sin(ang); }
    }
    if (lo == 0) SEAM0(0);
    if (IN(1)) { WSP_DECL; const float* MODP = (const float*)(wsp + WS_RB);
        for (int o = bid * 512 + tid; o < 4 * 33 * 6144; o += G * 512) { float sacc = 0.f;
#pragma unroll
            for (int kc = 0; kc < 16; ++kc) sacc += MODP[(size_t)kc * (4 * 33 * 6144) + o];
            const int li = o / (33 * 6144), col = o % 6144;
            const float mv = sacc + AIN(I_ADAB)[(size_t)li * 6144 + col];
            MOD[o] = mv;
            if (col >= 5120) ((bf16*)(wsp + WS_G16))[(size_t)(o / 6144) * 1024 + (col - 5120)] = (bf16)(pkbf(mv, 0.f) & 0xffffu); }
        SEAM(1);
    }

#pragma unroll 1
    for (int i = 0; i < DEPTH; ++i) {
        const int pb = 2 + 10 * i; const bool even = !(i & 1); const int e = i >> 1; const bool ctxn = i < 2;
#define modbase (MOD + (size_t)i * 33 * 6144)
#define XS_MIX (XSrc{AIN(I_X), AIN(I_CTX), (i == 0) ? (const bf16*)nullptr : (const bf16*)XCUR})
#define XS_CUR (XSrc{nullptr, nullptr, (const bf16*)XCUR})
        const int nrows = ctxn ? MALL : MLAT;
        if (EN(1) && IN(pb + 0)) { WSP_DECL;
            if (even) { REP(5) phase_mod_plain(XS_MIX, AIN(I_NMG) + i * D, modbase, 0, 1024, RA, MK_FP8_MIXIN != 0, MALL, gw, NGW, lane); }
            else {
#pragma unroll 1
                for (int st = 0; st < 2; ++st) {
                    if ((st ^ (wave & 1)) == 0) { REP(6) phase_mod_fold(XS_MIX, AIN(I_NMG) + i * D, modbase, RA, HMID, i == 1, gw, NGW, lane); }
                    else if (FP8_MOE(i)) moe_convert8(AIN(I_MW1) + (size_t)e * 8 * D * DFFE, AIN(I_MW3) + (size_t)e * 8 * D * DFFE, AIN(I_MW2) + (size_t)e * 8 * DFFE * D, WMOE13_8(e), WMOE2_8(e), (LAS float*)(lds + wave * 8448), gw, NGW, lane, BG_ON ? (e == 0 ? BG0_END : BG1_END) : 0, MOE_CV_ITEMS);
                    else moe_convert(AIN(I_MW1) + (size_t)e * 8 * D * DFFE, AIN(I_MW3) + (size_t)e * 8 * D * DFFE, AIN(I_MW2) + (size_t)e * 8 * DFFE * D, WMOE13, WMOE2, (LAS float*)(lds + wave * 8448), gw, NGW, lane);
                }
            }
            SEAM(pb + 0);
        }
        if (IN(pb + 1)) { WSP_DECL;
            if (even) { if (EN(2)) { SchedMixIn S{(const char*)RA, (const char*)(WMIXIN + (size_t)e * 1024 * 1024), G, bid, 1024 + (i == 0 ? 128 : 32), i == 0};
                        EpiMixIn E{CQ, CKV, KR, POOL, SSQQ, SSQK, ROPEC, ROPES};
                        REP(16) gm::gemm_phase<EpiMixIn, SchedMixIn, false, MK_FP8_MIXIN != 0>(lds, S, E);
                        BG_FILL(1024 + (i == 0 ? 128 : 32), i == 0 ? 0 : 1, i == 0 ? 0 : BG1_MIXIN, i == 0 ? BG0_MIXIN_E : BG1_END); } }
            else if (EN(3)) { phase_amid(HMID, AMID, lds, G, bid, tid);
                   SchedDftC S{(const char*)WDFTC, (const char*)RA, G, bid, 1024 + (i == 1 ? 256 : 0)}; EpiDftC E{ZB, ZC};
                   REP(17) gm::gemm_phase<EpiDftC, SchedDftC, false>(lds, S, E); }
            SEAM(pb + 1);
        }
        if (IN(pb + 2)) { WSP_DECL;
            if (even) { if (EN(4)) { REP(14) phase_pool(POOL, RA, nrows, gw, NGW, lane);
                        const int nq = (i == 0) ? TALL : TLAT;
                        SchedE3 S{(const char*)CQ, (const char*)CKV, (const char*)(WUQ + (size_t)e * 768 * 256), (const char*)(WUK + (size_t)e * 512 * 128), (const char*)(WUV + (size_t)e * 512 * 128), G, bid, nq, nq * 3 + 1152};
                        EpiE3 E{QB, KN, VT, SSQQ, SSQK, ROPEC, ROPES};
                        REP(15) gm::gemm_phase<EpiE3, SchedE3, false>(lds, S, E); } }
            else if (EN(5)) { SchedDftS S{(const char*)WDFTL, (const char*)WDFTX, (const char*)ZB, (const char*)ZC, G, bid, 1024 + (i == 1 ? 128 : 0)}; EpiDftS E{RA, AMID};
                   REP(18) gm::gemm_phase<EpiDftS, SchedDftS, false, MK_FP8_DFT != 0>(lds, S, E);
                   BG_FILL(1024 + (i == 1 ? 128 : 0), 1, 0, i == 1 ? BG1_DFTS_E : 0); }
            SEAM(pb + 2);
        }
        if (EN(6) && even && IN(pb + 3)) { WSP_DECL;
            const int total = 1024 + (i == 0 ? 128 : 0);
            REP(2) for (int it = 0;; ++it) { const int u = it * G + bid; if (u >= total) break;
                const bool cx = u >= 1024; const int xl_ = bid >> 3;
                const int bhp = cx ? u - 1024 : (G == 256 ? ((bid & 7) + 8 * ((xl_ >> 3) + 4 * it)) : (u & 127)), qt = cx ? 0 : (G == 256 ? (xl_ & 7) : (u >> 7)), b = bhp >> 2, hp = bhp & 3;
#if MK_QK8 && MK_PV8
                attn_unit8(lds, QB, KN, KR, VT, RA, b, hp, cx ? MLAT + b * LC : b * SEQ + qt * 256, cx ? SEQ : 0, cx ? 4 : 36, tid); }
#else
                attn_unit(lds, QB, KN, KR, VT, RA, b, hp, cx ? MLAT + b * LC : b * SEQ + qt * 256, cx ? SEQ : 0, cx ? 4 : 36, tid); }
#endif
            SEAM(pb + 3);
        }
        if (EN(7) && IN(pb + 4)) { WSP_DECL;
            SchedResid S{(const char*)RA, (const char*)(even ? WMIXOUT + (size_t)e * 1024 * 1024 : WFNET + (size_t)e * 1024 * 1024), 2048u, 16, nrows / 256, G, bid};
            if ((MK_DUP >> 8) & 1u) { EpiResid Ed{AIN(I_X), AIN(I_CTX), (i == 0) ? (const bf16*)nullptr : (const bf16*)XCUR, (bf16*)AOUT, modbase + 2048, 1.0f}; gm::gemm_phase<EpiResid, SchedResid, false>(lds, S, Ed); }
            EpiResid E{AIN(I_X), AIN(I_CTX), (i == 0) ? (const bf16*)nullptr : (const bf16*)XCUR, XCUR, modbase + 2048, 1.0f};
            gm::gemm_phase<EpiResid, SchedResid, false>(lds, S, E);
            BG_FILL((nrows / 256) * 4, i == 0 ? 0 : 1, i == 0 ? BG0_MIXIN_E : BG1_DFTS_E, i == 0 ? BG0_MIXOUT_E : (i == 1 ? BG1_FNET_E : 0));
            SEAM(pb + 4);
        }
        if (EN(8) && IN(pb + 5)) { WSP_DECL;
            if (even) REP(7) phase_mod2<false>(XS_CUR, AIN(I_NFG) + i * D, modbase, RA, FP8_FFN(i), nrows, nullptr, nullptr, nullptr, nullptr, lds, bid, G, wave, lane, tid);
            else phase_mod2<true>(XS_CUR, AIN(I_NFG) + i * D, modbase, RA, FP8_MOE(i), nrows, AIN(I_ROUTER) + (size_t)e * D * 8, (unsigned*)(wsp + WS_CTL) + CW_CNT + e * 16 * 64, LIST, GLIST, lds, bid, G, wave, lane, tid);
            SEAM(pb + 5);
        }
        if (even) {
            if (EN(9) && IN(pb + 6)) { WSP_DECL;
                if (FP8_FFN(i)) { SchedUp S{(const char*)RA, (const char*)(WFFN13 + (size_t)e * 5632 * 1024), nrows / 256, 22, G, bid, 1024u, 8}; EpiSwiglu8 E{(unsigned char*)ACT, DFF};
                    REP(1) gm::gemm_phase<EpiSwiglu8, SchedUp, false, true>(lds, S, E); }
                else { SchedUp S{(const char*)RA, (const char*)(WFFN13 + (size_t)e * 5632 * 1024), nrows / 256, 22, G, bid, 2048u, 16}; EpiSwiglu E{ACT, DFF};
                    REP(1) gm::gemm_phase<EpiSwiglu, SchedUp, false>(lds, S, E); }
                BG_FILL((nrows / 256) * 22, 0, BG0_MIXOUT_E, i == 0 ? BG0_UP_E : 0);
                SEAM(pb + 6); }
            if (EN(10) && IN(pb + 7)) { WSP_DECL;
                if (FP8_FFN(i)) { SchedResid S{(const char*)ACT, (const char*)(WFFN2 + (size_t)e * 1024 * DFF), (unsigned)DFF, DFF / 128, nrows / 256, G, bid};
                    if ((MK_DUP >> 9) & 1u) { EpiResid Ed{nullptr, nullptr, (const bf16*)XCUR, (bf16*)AOUT, modbase + 5 * 1024, 1.0f / (W8_SCALE * A8_SCALE)}; gm::gemm_phase<EpiResid, SchedResid, false, true>(lds, S, Ed); }
                    EpiResid E{nullptr, nullptr, (const bf16*)XCUR, XCUR, modbase + 5 * 1024, 1.0f / (W8_SCALE * A8_SCALE)};
                    gm::gemm_phase<EpiResid, SchedResid, false, true>(lds, S, E); }
                else { SchedResid S{(const char*)ACT, (const char*)(WFFN2 + (size_t)e * 1024 * DFF), (unsigned)(DFF * 2), DFF / 64, nrows / 256, G, bid};
                    if ((MK_DUP >> 9) & 1u) { EpiResid Ed{nullptr, nullptr, (const bf16*)XCUR, (bf16*)AOUT, modbase + 5 * 1024, 1.0f}; gm::gemm_phase<EpiResid, SchedResid, false>(lds, S, Ed); }
                    EpiResid E{nullptr, nullptr, (const bf16*)XCUR, XCUR, modbase + 5 * 1024, 1.0f};
                    gm::gemm_phase<EpiResid, SchedResid, false>(lds, S, E); }
                BG_FILL((nrows / 256) * 4, 0, BG0_UP_E, i == 0 ? BG0_END : 0);
                SEAM(pb + 7); }
        } else {
#pragma unroll 1
            for (int s = 0; s < 2; ++s) {
                const int cwo = CW_CNT + (e * 16 + s * 8) * 64;
                if (EN(11) && IN(pb + 6 + 2 * s)) { WSP_DECL;
                    if (FP8_MOE(i)) { SchedMoeUp8 S; S.H2 = (const char*)RA; S.W13 = (const char*)WMOE13_8(e); S.list = LIST + (size_t)s * 8 * MALL; moe_info((const unsigned*)(wsp + WS_CTL) + cwo, S.mi); S.G = G; S.c = bid; S.rd = 0;
                        if (MOE_CHAIN_ON && s == 1) S.rd = (i == 1) ? 160 : 32;
                        EpiSwiglu8 E{(unsigned char*)ACT + (MOE_CHAIN_ON ? (size_t)s * (RB_SIZE / 2) : (size_t)0), DFFE};
                        REP(0) gm::gemm_phase<EpiSwiglu8, SchedMoeUp8, true, true>(lds, S, E); }
                    else { SchedMoeUp S; S.H2 = (const char*)RA; S.W13 = (const char*)WMOE13; S.list = LIST + (size_t)s * 8 * MALL; moe_info((const unsigned*)(wsp + WS_CTL) + cwo, S.mi); S.G = G; S.c = bid;
                        EpiSwiglu E{ACT, DFFE};
                        REP(0) gm::gemm_phase<EpiSwiglu, SchedMoeUp, true>(lds, S, E); }
                    SEAM(pb + 6 + 2 * s); }
                if (EN(12) && IN(pb + 7 + 2 * s)) { WSP_DECL;
                    if (FP8_MOE(i)) { SchedMoeDown8 S; S.Ab = (const char*)ACT + (MOE_CHAIN_ON ? (size_t)s * (RB_SIZE / 2) : (size_t)0); S.W2 = (const char*)WMOE2_8(e); moe_info((const unsigned*)(wsp + WS_CTL) + cwo, S.mi); S.G = G; S.c = bid;
                        if ((MK_DUP >> 10) & 1u) { EpiMoeDown Ed{XCUR, (const bf16*)(wsp + WS_G16) + (size_t)i * 33 * 1024, LIST + (size_t)s * 8 * MALL, GLIST + (size_t)s * 8 * MALL, 1.0f / (W8_SCALE * A8_SCALE), (bf16*)AOUT}; gm::gemm_phase<EpiMoeDown, SchedMoeDown8, false, true>(lds, S, Ed); }
                        EpiMoeDown E{XCUR, (const bf16*)(wsp + WS_G16) + (size_t)i * 33 * 1024, LIST + (size_t)s * 8 * MALL, GLIST + (size_t)s * 8 * MALL, 1.0f / (W8_SCALE * A8_SCALE), XCUR};
                        gm::gemm_phase<EpiMoeDown, SchedMoeDown8, false, true>(lds, S, E);
                        if (!(MOE_CHAIN_ON && s == 0)) BG_FILL(S.mi.nt * 4, 1, BG1_MD0_E, i == 1 ? BG1_MIXIN : 0); }
                    else { SchedMoeDown S; S.Ab = (const char*)ACT; S.W2 = (const char*)WMOE2; moe_info((const unsigned*)(wsp + WS_CTL) + cwo, S.mi); S.G = G; S.c = bid;
                        EpiMoeDown E{XCUR, (const bf16*)(wsp + WS_G16) + (size_t)i * 33 * 1024, LIST + (size_t)s * 8 * MALL, GLIST + (size_t)s * 8 * MALL, 1.0f, XCUR};
                        gm::gemm_phase<EpiMoeDown, SchedMoeDown, false>(lds, S, E); }
                    if (!(MOE_CHAIN_ON && s == 0)) SEAM(pb + 7 + 2 * s); else __syncthreads(); }
            }
        }
    }
    if (EN(13) && IN(NPH - 1)) { WSP_DECL; phase_final(XCUR, AOUT, AIN(I_FINALG), gw, NGW, lane); }
#if MK_WPROBE
    { if (threadIdx.x == 0) __hip_atomic_fetch_add(ctl + 32768, wacc, __ATOMIC_RELAXED, __HIP_MEMORY_SCOPE_AGENT);
      xcd_barrier<false>(bar);
      if (bid == 0 && threadIdx.x == 0) { const unsigned tot = __hip_atomic_load(ctl + 32768, __ATOMIC_RELAXED, __HIP_MEMORY_SCOPE_AGENT);
          const unsigned long long dl = (unsigned long long)(tot / (unsigned)G) * WP_MULT, ts = __builtin_amdgcn_s_memrealtime();
          while (__builtin_amdgcn_s_memrealtime() - ts < dl) __builtin_amdgcn_s_sleep(8); } }
#endif
#undef IN
#undef SEAM
}

extern "C" void kernel_launch(void* const* d_in, const int* in_sizes, int n_in, void* d_out, int out_size, void* d_ws, size_t ws_size, hipStream_t stream) {
    static int grid = 0;
    if (grid == 0) {
        if (n_in != N_IN || out_size != MLAT * D || ws_size < WS_END) { fprintf(stderr, "kernel_launch: unexpected problem (n_in %d, out %d, ws %zu < %zu)\n", n_in, out_size, ws_size, (size_t)WS_END); grid = -1; return; }
        int dev = 0, cus = 0, per_cu = 0;
        if (hipGetDevice(&dev) != hipSuccess || hipDeviceGetAttribute(&cus, hipDeviceAttributeMultiprocessorCount, dev) != hipSuccess) { grid = -1; return; }
        if (hipFuncSetAttribute((const void*)fwd, hipFuncAttributeMaxDynamicSharedMemorySize, LDS_BYTES) != hipSuccess) { fprintf(stderr, "kernel_launch: hipFuncSetAttribute failed\n"); grid = -1; return; }
        if (hipOccupancyMaxActiveBlocksPerMultiprocessor(&per_cu, (const void*)fwd, 512, LDS_BYTES) != hipSuccess || per_cu < 1) fprintf(stderr, "kernel_launch: occupancy query reports %d\n", per_cu);
        (void)hipGetLastError();
        grid = cus;
        if (grid != 256) fprintf(stderr, "kernel_launch: %d CUs (built for 256)\n", grid);
    }
    if (grid < 0) return;
    (void)hipMemsetAsync((char*)d_ws + WS_CTL, 0, CTL_BYTES, stream);
    Args a{};
    for (int i = 0; i < N_IN; ++i) a.in[i] = (const float*)d_in[i];
    a.out = (float*)d_out; a.ws = (unsigned char*)d_ws;
#if MK_PER_PHASE
    for (int p = 0; p < NPH; ++p) {
        const int k = (p - 2) % 10, layer = (p - 2) / 10;
        if (p >= 2 && p < NPH - 1) { const bool even = !(layer & 1); if (even && k >= 8) continue; if (!even && k == 3) continue; }
        a.ph_lo = p; a.ph_hi = p + 1;
        hipLaunchKernelGGL(fwd, dim3(grid), dim3(512), LDS_BYTES, stream, a);
    }
#else
    a.ph_lo = 0; a.ph_hi = NPH;
    hipLaunchKernelGGL(fwd, dim3(grid), dim3(512), LDS_BYTES, stream, a);
#endif
}
```
